# Optimizing an MI355X kernel written in HIP

```python
import jax, jax.numpy as jnp
from jax import lax
import numpy as np

D_MODEL = 1024
BATCH = 16
SEQ = 2048
DEPTH = 2

CTX_LEN = 256
GRID_W = 64
HEAD_DIM = 64
N_Q_HEADS = 4
N_KV_HEADS = 2
Q_PER_KV = N_Q_HEADS // N_KV_HEADS
Q_W = N_Q_HEADS * HEAD_DIM
KV_W = N_KV_HEADS * HEAD_DIM
FOURIER_GROUPS = 4
FOURIER_GROUP_W = 64
F_W = FOURIER_GROUPS * FOURIER_GROUP_W
N_BRANCH = 4
BRANCH_W = 256
IN_W = 3 * (Q_W + 2 * KV_W) + F_W + N_BRANCH * D_MODEL
Q_BLOCK = 128
WINDOW = 128
NA_KH_MAX = 8
NA_KW = 16
ROPE_THETA = 10000.0
N_EXPERTS = 16
EXPERT_FF = 1024
EC_CAPACITY = 2
N_MOD = 6
DN_ALPHA = (2 * DEPTH) ** 0.25
DN_BETA = (8 * DEPTH) ** -0.25
LN_EPS = 1e-6
RMS_EPS = 1e-6
NEG_INF = -1e30

kernel_name = "hybrid_gated_mixers_ec_moe_dit"


def layer_norm(h, g, b):
    hf = h.astype(jnp.float32)
    mu = jnp.mean(hf, -1, keepdims=True)
    var = jnp.mean(jnp.square(hf - mu), -1, keepdims=True)
    return ((hf - mu) * lax.rsqrt(var + LN_EPS)).astype(h.dtype) * g + b


def rms_norm(h, g):
    hf = h.astype(jnp.float32)
    return (hf * lax.rsqrt(jnp.mean(hf * hf, -1, keepdims=True) + RMS_EPS)).astype(h.dtype) * g


def heads(t, n):
    return t.reshape(t.shape[:-1] + (n, HEAD_DIM))


def group_q(q):
    return q.reshape(q.shape[:-2] + (N_KV_HEADS, Q_PER_KV, HEAD_DIM))


def flat_heads(o):
    return o.reshape(o.shape[:2] + (Q_W,))


def split_columns(p):
    widths = (Q_W, KV_W, KV_W, F_W, Q_W, KV_W, KV_W, Q_W, KV_W, KV_W)
    offs, o = [], 0
    for w in widths:
        o += w
        offs.append(o)
    return jnp.split(p, offs, axis=-1)


def axial_rope_tables(n_tokens, dtype):
    t = jnp.arange(n_tokens)
    axis_dim = HEAD_DIM // 2
    inv = ROPE_THETA ** (-jnp.arange(0, axis_dim, 2, dtype=jnp.float32) / axis_dim)
    out = []
    for pos in (t // GRID_W, t % GRID_W):
        ang = pos.astype(jnp.float32)[:, None, None] * inv
        out.append(jnp.cos(ang).astype(dtype))
        out.append(jnp.sin(ang).astype(dtype))
    return tuple(out)


def rotate(t, cos, sin):
    h = t.shape[-1] // 2
    t1, t2 = t[..., :h], t[..., h:]
    return jnp.concatenate([t1 * cos - t2 * sin, t1 * sin + t2 * cos], -1)


def axial_rope(t, rope):
    cos_r, sin_r, cos_c, sin_c = rope
    half = HEAD_DIM // 2
    return jnp.concatenate([rotate(t[..., :half], cos_r, sin_r),
                            rotate(t[..., half:], cos_c, sin_c)], -1)


def neighbourhood_tables(n_tokens):
    rows = n_tokens // GRID_W
    kh = min(NA_KH_MAX, rows)
    t = jnp.arange(n_tokens)
    r, col = t // GRID_W, t % GRID_W
    r0 = jnp.clip(r - kh // 2, 0, rows - kh)
    c0 = jnp.clip(col - NA_KW // 2, 0, GRID_W - NA_KW)
    kr = r0[:, None, None] + jnp.arange(kh)[None, :, None]
    kc = c0[:, None, None] + jnp.arange(NA_KW)[None, None, :]
    shape = (n_tokens, kh, NA_KW)
    idx = jnp.broadcast_to(kr * GRID_W + kc, shape).reshape(n_tokens, -1)
    off_r = jnp.broadcast_to(kr - r[:, None, None] + NA_KH_MAX - 1, shape).reshape(n_tokens, -1)
    off_c = jnp.broadcast_to(kc - col[:, None, None] + NA_KW - 1, shape).reshape(n_tokens, -1)
    return idx, off_r, off_c


def gqa_softmax(q, k, v, bias=None, sink=None):
    s = jnp.einsum("bqhgd,bkhd->bhgqk", q, k).astype(jnp.float32) * HEAD_DIM ** -0.5
    if bias is not None:
        s = s + bias
    if sink is not None:
        sk = jnp.broadcast_to(sink.astype(jnp.float32)[None, :, :, None, None], s.shape[:-1] + (1,))
        p = jax.nn.softmax(jnp.concatenate([s, sk], -1), axis=-1)[..., :-1]
    else:
        p = jax.nn.softmax(s, axis=-1)
    return jnp.einsum("bhgqk,bkhd->bqhgd", p.astype(v.dtype), v)


def to_blocks(q):
    B, S = q.shape[:2]
    return jnp.swapaxes(q.reshape((B, S // Q_BLOCK, Q_BLOCK) + q.shape[2:]), 0, 1)


def from_blocks(ob, like):
    return flat_heads(jnp.swapaxes(ob, 0, 1).reshape(like.shape))


def global_attention(q, k_all, v_all):
    ob = lax.map(lambda qq: gqa_softmax(qq, k_all, v_all), to_blocks(q))
    return from_blocks(ob, q)


def window_attention(q, k_lat, v_lat, k_ctx, v_ctx, sink):
    S = q.shape[1]
    nblk = S // Q_BLOCK
    span = Q_BLOCK + 2 * WINDOW
    pad = ((0, 0), (WINDOW, WINDOW), (0, 0), (0, 0))
    k_pad, v_pad = jnp.pad(k_lat, pad), jnp.pad(v_lat, pad)
    ctx_bias = jnp.zeros((Q_BLOCK, k_ctx.shape[1]), jnp.float32)

    def one_block(args):
        qq, blk = args
        start = blk * Q_BLOCK
        kk = lax.dynamic_slice_in_dim(k_pad, start, span, axis=1)
        vv = lax.dynamic_slice_in_dim(v_pad, start, span, axis=1)
        q_pos = start + jnp.arange(Q_BLOCK)
        k_pos = start - WINDOW + jnp.arange(span)
        ok = (jnp.abs(q_pos[:, None] - k_pos[None, :]) <= WINDOW) & (k_pos >= 0) & (k_pos < S)
        bias = jnp.concatenate([ctx_bias, jnp.where(ok, 0.0, NEG_INF)], -1)
        return gqa_softmax(qq, jnp.concatenate([k_ctx, kk], 1), jnp.concatenate([v_ctx, vv], 1), bias, sink)

    ob = lax.map(one_block, (to_blocks(q), jnp.arange(nblk)))
    return from_blocks(ob, q)


def neighbourhood_attention(q, k_lat, v_lat, k_ctx, v_ctx, rpb, na_tab):
    idx, off_r, off_c = na_tab
    S = q.shape[1]
    nblk = S // Q_BLOCK
    n_nb = idx.shape[1]
    n_ctx = k_ctx.shape[1]
    scale = HEAD_DIM ** -0.5
    rpb_g = rpb.reshape((N_KV_HEADS, Q_PER_KV) + rpb.shape[1:]).astype(jnp.float32)
    bias = rpb_g[:, :, off_r, off_c]
    bias_b = jnp.moveaxis(bias.reshape(N_KV_HEADS, Q_PER_KV, nblk, Q_BLOCK, n_nb), 2, 0)
    idx_b = idx.reshape(nblk, Q_BLOCK, n_nb)

    def one_block(args):
        qq, ib, bb = args
        kk, vv = k_lat[:, ib], v_lat[:, ib]
        s_ctx = jnp.einsum("bqhgd,bchd->bhgqc", qq, k_ctx).astype(jnp.float32) * scale
        s_nb = jnp.einsum("bqhgd,bqkhd->bhgqk", qq, kk).astype(jnp.float32) * scale + bb
        p = jax.nn.softmax(jnp.concatenate([s_ctx, s_nb], -1), axis=-1).astype(v_lat.dtype)
        return (jnp.einsum("bhgqc,bchd->bqhgd", p[..., :n_ctx], v_ctx)
                + jnp.einsum("bhgqk,bqkhd->bqhgd", p[..., n_ctx:], vv))

    ob = lax.map(one_block, (to_blocks(q), idx_b, bias_b))
    return from_blocks(ob, q)


def fourier_mix(u):
    g = u.reshape(u.shape[:-1] + (FOURIER_GROUPS, FOURIER_GROUP_W)).astype(jnp.float32)
    f = jnp.fft.fft2(g, axes=(-3, -1), norm="ortho").real
    return f.reshape(u.shape).astype(u.dtype)


def merge_branches(branches, gate_logits, w_branch, w_out):
    gates = jax.nn.sigmoid(gate_logits)
    merged = gates[..., :D_MODEL] * (branches[0] @ w_branch[0])
    for i in range(1, N_BRANCH):
        merged = merged + gates[..., i * D_MODEL:(i + 1) * D_MODEL] * (branches[i] @ w_branch[i])
    return merged @ w_out


def token_mixers(u_lat, u_ctx, w_in, qk_gain, sink_logit, na_rpb, w_branch, w_out, rope, na_tab, with_ctx):
    pl = split_columns(u_lat @ w_in)
    pc = split_columns(u_ctx @ w_in)
    sink = sink_logit.reshape(N_KV_HEADS, Q_PER_KV)
    qa = group_q(axial_rope(rms_norm(heads(pl[0], N_Q_HEADS), qk_gain[0]), rope))
    ka = axial_rope(rms_norm(heads(pl[1], N_KV_HEADS), qk_gain[1]), rope)
    va = heads(pl[2], N_KV_HEADS)
    ka_c = rms_norm(heads(pc[1], N_KV_HEADS), qk_gain[1])
    va_c = heads(pc[2], N_KV_HEADS)
    br_a = global_attention(qa, jnp.concatenate([ka_c, ka], 1), jnp.concatenate([va_c, va], 1))
    br_b = fourier_mix(pl[3])
    qc = group_q(axial_rope(heads(pl[4], N_Q_HEADS), rope))
    kc = axial_rope(heads(pl[5], N_KV_HEADS), rope)
    vc = heads(pl[6], N_KV_HEADS)
    kc_c, vc_c = heads(pc[5], N_KV_HEADS), heads(pc[6], N_KV_HEADS)
    br_c = window_attention(qc, kc, vc, kc_c, vc_c, sink)
    qd = group_q(heads(pl[7], N_Q_HEADS))
    kd, vd = heads(pl[8], N_KV_HEADS), heads(pl[9], N_KV_HEADS)
    kd_c, vd_c = heads(pc[8], N_KV_HEADS), heads(pc[9], N_KV_HEADS)
    br_d = neighbourhood_attention(qd, kd, vd, kd_c, vd_c, na_rpb, na_tab)
    y_lat = merge_branches([br_a, br_b, br_c, br_d], pl[10], w_branch, w_out)
    if not with_ctx:
        return y_lat, None
    qa_c = group_q(rms_norm(heads(pc[0], N_Q_HEADS), qk_gain[0]))
    qc_c = group_q(heads(pc[4], N_Q_HEADS))
    qd_c = group_q(heads(pc[7], N_Q_HEADS))
    br_ctx = [flat_heads(gqa_softmax(qa_c, ka_c, va_c)),
              fourier_mix(pc[3]),
              flat_heads(gqa_softmax(qc_c, kc_c, vc_c, sink=sink)),
              flat_heads(gqa_softmax(qd_c, kd_c, vd_c))]
    y_ctx = merge_branches(br_ctx, pc[10], w_branch, w_out)
    return y_lat, y_ctx


def expert_choice_ffn(h, w_router, w_gate, w_up, w_down):
    B, n, D = h.shape
    cap = max(1, EC_CAPACITY * n // N_EXPERTS)
    aff = jax.nn.softmax(jnp.einsum("bnd,de->bne", h, w_router).astype(jnp.float32), axis=-1)
    sel_w, sel_idx = lax.top_k(jnp.swapaxes(aff, 1, 2), cap)
    xs = jax.vmap(lambda hb, ib: hb[ib])(h, sel_idx)
    a = jnp.einsum("becd,edf->becf", xs, w_gate)
    u = jnp.einsum("becd,edf->becf", xs, w_up)
    y = jnp.einsum("becf,efd->becd", jax.nn.silu(a) * u, w_down) * sel_w[..., None].astype(h.dtype)
    scatter = lambda yb, ib: jnp.zeros((n, D), h.dtype).at[ib.reshape(-1)].add(yb.reshape(-1, D))
    return jax.vmap(scatter)(y, sel_idx)


def trunk_layer(h_lat, h_ctx, c, c_ctx, w_mod, b_mod, w_in, qk_gain, sink_logit, na_rpb, w_branch,
                w_out, ln1_g, ln1_b, w_router, w_gate, w_up, w_down, ln2_g, ln2_b, rope, na_tab, with_ctx):
    m_lat = (jax.nn.silu(c) @ w_mod + b_mod)[:, None, :]
    m_ctx = jax.nn.silu(c_ctx) @ w_mod + b_mod
    sh1, sc1, g1, sh2, sc2, g2 = jnp.split(m_lat, N_MOD, -1)
    csh1, csc1, cg1, csh2, csc2, cg2 = jnp.split(m_ctx, N_MOD, -1)
    u_lat = h_lat * (1.0 + sc1) + sh1
    u_ctx = h_ctx * (1.0 + csc1) + csh1
    y_lat, y_ctx = token_mixers(u_lat, u_ctx, w_in, qk_gain, sink_logit, na_rpb, w_branch, w_out,
                                rope, na_tab, with_ctx)
    h_lat = layer_norm(DN_ALPHA * h_lat + g1 * y_lat, ln1_g, ln1_b)
    u_lat = h_lat * (1.0 + sc2) + sh2
    h_lat = layer_norm(DN_ALPHA * h_lat + g2 * expert_choice_ffn(u_lat, w_router, w_gate, w_up, w_down),
                       ln2_g, ln2_b)
    if with_ctx:
        h_ctx = layer_norm(DN_ALPHA * h_ctx + cg1 * y_ctx, ln1_g, ln1_b)
        u_ctx = h_ctx * (1.0 + csc2) + csh2
        h_ctx = layer_norm(DN_ALPHA * h_ctx + cg2 * expert_choice_ffn(u_ctx, w_router, w_gate, w_up, w_down),
                           ln2_g, ln2_b)
    return h_lat, h_ctx


def setup_inputs(seed: int = 0) -> dict:
    key = jax.random.key(seed)
    ks = jax.random.split(key, 22)
    L, D, E, F = DEPTH, D_MODEL, N_EXPERTS, EXPERT_FF

    def nrm(k, shape, s):
        return jax.random.normal(k, shape, jnp.float32) * s

    return {
        "x": nrm(ks[0], (BATCH, SEQ, D), 1.0),
        "c": nrm(ks[1], (BATCH, D), 1.0),
        "ctx": nrm(ks[2], (BATCH, CTX_LEN, D), 1.0),
        "c_ctx": nrm(ks[3], (D,), 1.0),
        "w_mod": nrm(ks[4], (L, D, N_MOD * D), 0.5 * D ** -0.5),
        "b_mod": nrm(ks[5], (L, N_MOD * D), 0.02),
        "w_in": nrm(ks[6], (L, D, IN_W), D ** -0.5),
        "qk_gain": 1.0 + nrm(ks[7], (L, 2, HEAD_DIM), 0.1),
        "sink_logit": nrm(ks[8], (L, N_Q_HEADS), 0.5),
        "na_rpb": nrm(ks[9], (L, N_Q_HEADS, 2 * NA_KH_MAX - 1, 2 * NA_KW - 1), 0.5),
        "w_branch": nrm(ks[10], (L, N_BRANCH, BRANCH_W, D), DN_BETA * BRANCH_W ** -0.5),
        "w_out": nrm(ks[11], (L, D, D), DN_BETA * D ** -0.5),
        "ln1_g": 1.0 + nrm(ks[12], (L, D), 0.1),
        "ln1_b": nrm(ks[13], (L, D), 0.02),
        "w_router": nrm(ks[14], (L, D, E), D ** -0.5),
        "w_gate": nrm(ks[15], (L, E, D, F), D ** -0.5),
        "w_up": nrm(ks[16], (L, E, D, F), D ** -0.5),
        "w_down": nrm(ks[17], (L, E, F, D), DN_BETA * F ** -0.5),
        "ln2_g": 1.0 + nrm(ks[18], (L, D), 0.1),
        "ln2_b": nrm(ks[19], (L, D), 0.02),
    }


def reference(x, c, ctx, c_ctx, w_mod, b_mod, w_in, qk_gain, sink_logit, na_rpb, w_branch, w_out,
              ln1_g, ln1_b, w_router, w_gate, w_up, w_down, ln2_g, ln2_b):
    n_tokens = x.shape[1]
    rope = axial_rope_tables(n_tokens, x.dtype)
    na_tab = neighbourhood_tables(n_tokens)
    h_lat, h_ctx = x, ctx
    for l in range(DEPTH):
        h_lat, h_ctx = trunk_layer(
            h_lat, h_ctx, c, c_ctx, w_mod[l], b_mod[l], w_in[l], qk_gain[l], sink_logit[l], na_rpb[l],
            w_branch[l], w_out[l], ln1_g[l], ln1_b[l], w_router[l], w_gate[l], w_up[l], w_down[l],
            ln2_g[l], ln2_b[l], rope, na_tab, l < DEPTH - 1)
    return h_lat
```

```cpp
#include <hip/hip_runtime.h>
#include <hip/hip_cooperative_groups.h>
#include <cstdio>
#include <cstdint>
#include <type_traits>
namespace cg = cooperative_groups;

typedef _Float16 h16;
typedef _Float16 h16x8 __attribute__((ext_vector_type(8)));
typedef _Float16 h16x4 __attribute__((ext_vector_type(4)));
typedef float f32x4 __attribute__((ext_vector_type(4)));

constexpr int DM = 1024, NBATCH = 16, SEQ = 2048, CTX = 256, DEPTH = 2;
constexpr int TL = NBATCH * SEQ;
constexpr int TC = NBATCH * CTX;
constexpr int TT = TL + TC;
constexpr int INW = 5888, NMOD = 6 * DM, PMW = 1536;
constexpr int NEXP = 16, FF = 1024, CAPL = 256, CAPC = 32;
constexpr int GL = NBATCH * NEXP * CAPL;
constexpr int GC = NBATCH * NEXP * CAPC;
constexpr int GT = GL + GC;
constexpr float ALPHA = 1.4142135623730951f;
constexpr float LN_EPS = 1e-6f, RMS_EPS = 1e-6f;
constexpr int NTHREADS = 512, NWAVES = 8;
constexpr int LDS_BYTES = 147456;
constexpr int BG_G1 = 2, BG_OUT = 3, BG_DN = 2;
constexpr int PROBE_MODE = 0, RP_P0 = 1, RP_LN2 = 1;
constexpr int RP_G1 = 1, RP_FOU = 1, RP_MRG = 1, RP_OUT = 1, RP_UP = 1, RP_DN = 1, RP_ATT = 1, RP_U = 1, RP_TOPK = 1;


constexpr size_t MiB = 1u << 20;
constexpr size_t WS_CTL = 0;
constexpr size_t WS_MODV = 1 * MiB;
constexpr size_t WS_WFIN = 2 * MiB;
constexpr size_t WS_BDT = 3 * MiB;
constexpr size_t WS_TAB = 6 * MiB;
constexpr size_t WS_AFFL = 7 * MiB;
constexpr size_t WS_AFFC = 9 * MiB;
constexpr size_t WS_SELW = 10 * MiB;
constexpr size_t WS_STAT = 9 * MiB + 512 * 1024;
constexpr size_t WS_SELR = 10 * MiB + 512 * 1024;
constexpr size_t WS_SLOT = 11 * MiB;
constexpr size_t WS_WG = 13 * MiB + 512 * 1024;
constexpr size_t WS_SGB = 15 * MiB + 768 * 1024;
constexpr size_t WS_HB = 16 * MiB;
constexpr size_t WS_S = 160 * MiB;
constexpr size_t WS_U16 = WS_S;
constexpr size_t WS_PM = WS_S + 72 * MiB;
constexpr size_t WS_QI = WS_PM;
constexpr size_t WS_KI = WS_PM + 54 * MiB;
constexpr size_t WS_VI = WS_PM + 81 * MiB;
constexpr size_t WS_ZTL = WS_PM + 108 * MiB;
constexpr size_t WS_ZTC = WS_ZTL + 32 * MiB;
constexpr size_t WS_XG = WS_S + 72 * MiB;
constexpr size_t WS_BR = WS_S + 216 * MiB;
constexpr size_t WS_H16 = WS_S + 216 * MiB;
constexpr size_t WS_GSCR = WS_S + 288 * MiB;
constexpr size_t WS_MPART = WS_S + 320 * MiB;
constexpr size_t WS_WINT = WS_S + 360 * MiB;
constexpr size_t WS_WBT = WS_WINT + 24 * MiB;
constexpr size_t WS_WOT = WS_WBT + 4 * MiB;
constexpr size_t WS_DFT = WS_WOT + 4 * MiB;
constexpr size_t WS_DFTC = WS_DFT + 16 * MiB;
constexpr size_t WS_WGU1 = WS_DFTC + 1 * MiB;
constexpr size_t WS_END = WS_WGU1 + 64 * MiB;
constexpr size_t DO_WGU = 0;
constexpr size_t DO_WD = 64 * MiB;
constexpr size_t DO_WD1 = 96 * MiB;

struct Params {
    const float *x, *c, *ctx, *c_ctx, *w_mod, *b_mod, *w_in, *qk_gain, *sink, *rpb, *w_branch, *w_out, *ln1_g, *ln1_b, *w_router, *w_gate, *w_up, *w_down, *ln2_g, *ln2_b;
    float* out; unsigned char* ws;
};
typedef const __attribute__((address_space(4))) Params* kargp_t;
#if defined(__HIP_DEVICE_COMPILE__)
__device__ __forceinline__ Params ldp() { kargp_t q = (kargp_t)__builtin_amdgcn_kernarg_segment_ptr(); asm volatile("" : "+s"(q)); return *q; }
#else
__device__ __forceinline__ Params ldp() { return Params{}; }
#endif

#define VCU_LDS_ADDR (LDS_BYTES - 256 + 64)
__device__ __forceinline__ int bidx() { const unsigned v = *(volatile __attribute__((address_space(3))) unsigned*)(VCU_LDS_ADDR); int b = __builtin_amdgcn_readfirstlane((int)v); asm volatile("" : "+s"(b)); return b; }
__device__ __forceinline__ int tidx() { int t = threadIdx.x; asm volatile("" : "+v"(t)); return t; }
template <int CTRL> __device__ __forceinline__ float dpp_f(float v) { return __builtin_bit_cast(float, __builtin_amdgcn_update_dpp(0, __builtin_bit_cast(int, v), CTRL, 0xf, 0xf, true)); }
__device__ __forceinline__ float xor16_sum(float v) { const auto r = __builtin_amdgcn_permlane16_swap(__float_as_uint(v), __float_as_uint(v), false, false); return __uint_as_float(r[0]) + __uint_as_float(r[1]); }
__device__ __forceinline__ float xor32_sum(float v) { const auto r = __builtin_amdgcn_permlane32_swap(__float_as_uint(v), __float_as_uint(v), false, false); return __uint_as_float(r[0]) + __uint_as_float(r[1]); }
__device__ __forceinline__ float xor16_max(float v) { const auto r = __builtin_amdgcn_permlane16_swap(__float_as_uint(v), __float_as_uint(v), false, false); return fmaxf(__uint_as_float(r[0]), __uint_as_float(r[1])); }
__device__ __forceinline__ float xor32_max(float v) { const auto r = __builtin_amdgcn_permlane32_swap(__float_as_uint(v), __float_as_uint(v), false, false); return fmaxf(__uint_as_float(r[0]), __uint_as_float(r[1])); }
__device__ __forceinline__ float wave_sum(float v) {
    v += dpp_f<0xB1>(v);
    v += dpp_f<0x4E>(v);
    v += dpp_f<0x141>(v);
    v += dpp_f<0x140>(v);
    v = xor16_sum(v); v = xor32_sum(v);
    return v;
}
__device__ __forceinline__ float wave_max(float v) {
    v = fmaxf(v, dpp_f<0xB1>(v)); v = fmaxf(v, dpp_f<0x4E>(v)); v = fmaxf(v, dpp_f<0x141>(v)); v = fmaxf(v, dpp_f<0x140>(v));
    v = xor16_max(v); v = xor32_max(v);
    return v;
}
typedef unsigned u32x4 __attribute__((ext_vector_type(4)));
__device__ __forceinline__ unsigned pk_h2(float lo, float hi) { typedef _Float16 h2 __attribute__((ext_vector_type(2))); h2 v = {(h16)lo, (h16)hi}; return __builtin_bit_cast(unsigned, v); }
typedef __bf16 bf16x2_t __attribute__((ext_vector_type(2)));
typedef float f32x2_t __attribute__((ext_vector_type(2)));
typedef short bf16x8_t __attribute__((ext_vector_type(8)));
__device__ __forceinline__ unsigned pk_b2(float lo, float hi) { f32x2_t v = {lo, hi}; bf16x2_t b = __builtin_convertvector(v, bf16x2_t); return __builtin_bit_cast(unsigned, b); }
__device__ __forceinline__ float sigmoid_f(float v) { return __builtin_amdgcn_rcpf(1.f + __builtin_amdgcn_exp2f(v * -1.4426950408889634f)); }
__device__ __forceinline__ float silu_f(float v) { return v * sigmoid_f(v); }
__device__ __forceinline__ float sig2_f(float t) { return __builtin_amdgcn_rcpf(1.f + __builtin_amdgcn_exp2f(t)); }
__device__ __forceinline__ int mv_of(int R) { return R < TL ? (R >> 11) : 16; }

__device__ __forceinline__ void phase0(const Params& p, float* lds) {
    float* modv = (float*)(p.ws + WS_MODV); float* tab = (float*)(p.ws + WS_TAB);
    const int tid = tidx(), lane = tid & 63, wave = tid >> 6, c = bidx(), G = gridDim.x;
    if (c < 192) {
        float* sc = lds;
        float* red = lds + 17 * 1024;
        for (int e = tid; e < 17 * 1024; e += NTHREADS) { const int mv = e >> 10, k = e & 1023; const float v = mv < 16 ? p.c[mv * 1024 + k] : p.c_ctx[k]; sc[e] = silu_f(v); }
        __syncthreads();
        const int col0 = c * 64; const int l = col0 / NMOD, n0 = col0 % NMOD; const int rg = lane >> 4, cq = lane & 15;
        f32x4 acc[17];
#pragma unroll
        for (int m = 0; m < 17; ++m) acc[m] = (f32x4){0.f, 0.f, 0.f, 0.f};
        const float* w = p.w_mod + ((size_t)l * DM + wave * 128 + rg) * NMOD + n0 + cq * 4;
#pragma unroll 4
        for (int i = 0; i < 32; ++i) { const f32x4 wv = *(const f32x4*)(w + (size_t)(4 * i) * NMOD);
#pragma unroll
            for (int m = 0; m < 17; ++m) acc[m] += wv * sc[m * 1024 + wave * 128 + rg + 4 * i]; }
#pragma unroll
        for (int m = 0; m < 17; ++m) {
#pragma unroll
            for (int e = 0; e < 4; ++e) { float v = acc[m][e]; v += __shfl_xor(v, 16); v += __shfl_xor(v, 32); acc[m][e] = v; }
            if (rg == 0) *(f32x4*)(red + (wave * 17 + m) * 64 + cq * 4) = acc[m]; }
        __syncthreads();
        for (int e = tid; e < 17 * 64; e += NTHREADS) { const int m = e >> 6, ln = e & 63; float sacc = 0.f;
#pragma unroll
            for (int wv = 0; wv < 8; ++wv) sacc += red[(wv * 17 + m) * 64 + ln];
            const int nn = n0 + ln; modv[((size_t)l * 17 + m) * NMOD + nn] = sacc + p.b_mod[l * NMOD + nn]; }
        __syncthreads();
    }
    float* cT = lds; float* sT = lds + 2048;
    __syncthreads();
    for (int j = tid; j < 2048; j += NTHREADS) { cT[j] = cospif((float)j / 1024.f); sT[j] = sinpif((float)j / 1024.f); }
    if (c == G - 1) for (int e = tid; e < 64 * 16; e += NTHREADS) { const int pos = e >> 4, j = e & 15; const float inv = powf(10000.f, -(float)j / 16.f); const float ang = (float)pos * inv;
        tab[4096 + e] = cosf(ang); tab[4096 + 1024 + e] = sinf(ang); }
    __syncthreads();
    const int gt = c * NTHREADS + tid, NG = G * NTHREADS;
    { h16* DFT = (h16*)(p.ws + WS_DFT); h16* DFTC = (h16*)(p.ws + WS_DFTC);
      for (int o = gt; o < 1024 * 512 + 256 * 64; o += NG) {
        unsigned w[4];
        if (o < 1024 * 512) { const int k = (o >> 9) + 1, j0 = (o & 511) * 8;
#pragma unroll
            for (int q = 0; q < 4; ++q) { float v[2];
#pragma unroll
                for (int h = 0; h < 2; ++h) { const int j = j0 + q * 2 + h; const int idx = (k * (j & 2047)) & 2047; v[h] = (j >> 11) ? sT[idx] : cT[idx]; }
                w[q] = pk_h2(v[0], v[1]); }
            *(u32x4*)(DFT + (size_t)(k - 1) * 4096 + j0) = (u32x4){w[0], w[1], w[2], w[3]}; }
        else { const int oo = o - 1024 * 512; const int k = oo >> 6, j0 = (oo & 63) * 8;
#pragma unroll
            for (int q = 0; q < 4; ++q) { float v[2];
#pragma unroll
                for (int h = 0; h < 2; ++h) { const int j = j0 + q * 2 + h; const int idx = ((k * (j & 255)) & 255) * 8; v[h] = (j >> 8) ? -sT[idx] : cT[idx]; }
                w[q] = pk_h2(v[0], v[1]); }
            *(u32x4*)(DFTC + (size_t)k * 512 + j0) = (u32x4){w[0], w[1], w[2], w[3]}; } } }
    { h16* BDT = (h16*)(p.ws + WS_BDT);
      for (int o = gt; o < 512 * 256; o += NG) { const int zc = o >> 8, gc = o & 255; const int g = zc >> 7, cs = (zc >> 6) & 1, m = zc & 63; const int idx = ((m * (gc & 63)) & 63) * 32;
          BDT[o] = (h16)(((gc >> 6) == g) ? (cs ? sT[idx] : cT[idx]) * 0.125f : 0.f); } }
    { h16* WFIN = (h16*)(p.ws + WS_WFIN);
      for (int o = gt; o < 2 * 1024 * 64; o += NG) { const int gc4 = (o & 63) * 4, lk = o >> 6; const f32x4 v = *(const f32x4*)(p.w_in + (size_t)lk * INW + 512 + gc4);
          h16x4 hv = {(h16)v[0], (h16)v[1], (h16)v[2], (h16)v[3]}; *(h16x4*)(WFIN + (size_t)lk * 256 + gc4) = hv; } }
    __syncthreads();
}

__device__ __forceinline__ const float* hrow_of(const Params& p, const float* hB, int l, int R) { return l == 0 ? (R < TL ? p.x + (size_t)R * DM : p.ctx + (size_t)(R - TL) * DM) : hB + (size_t)R * DM; }
__device__ __forceinline__ void phase_u(const Params& p, int l) {
    const float* modv = (const float*)(p.ws + WS_MODV) + (size_t)l * 17 * NMOD; h16* u16 = (h16*)(p.ws + WS_U16); const float* hB = (const float*)(p.ws + WS_HB);
    const int lane = tidx() & 63, gw = bidx() * NWAVES + (tidx() >> 6);
    constexpr int rpw = TT / 2048;
    f32x4 sh[4], sc[4], h[4], hn[4]; int curmv = -1;
    const int R0 = gw * rpw;
    { const float* hr = hrow_of(p, hB, l, R0);
#pragma unroll
      for (int j = 0; j < 4; ++j) h[j] = *(const f32x4*)(hr + lane * 4 + 256 * j); }
    for (int i = 0; i < rpw; ++i) {
        const int R = R0 + i; const int mv = mv_of(R);
        if (mv != curmv) { const float* mvp = modv + (size_t)mv * NMOD; curmv = mv;
#pragma unroll
            for (int j = 0; j < 4; ++j) { const int col = lane * 4 + 256 * j; sh[j] = *(const f32x4*)(mvp + col); sc[j] = *(const f32x4*)(mvp + DM + col); } }
        asm volatile("" ::: "memory");
        if (i + 1 < rpw) { const float* hr = hrow_of(p, hB, l, R + 1);
#pragma unroll
            for (int j = 0; j < 4; ++j) hn[j] = *(const f32x4*)(hr + lane * 4 + 256 * j); }
        asm volatile("" ::: "memory");
#pragma unroll
        for (int j = 0; j < 4; ++j) { const int col = lane * 4 + 256 * j; const f32x4 u = h[j] * (1.f + sc[j]) + sh[j];
            *(unsigned long long*)(u16 + (size_t)R * DM + col) = (unsigned long long)pk_h2(u[0], u[1]) | ((unsigned long long)pk_h2(u[2], u[3]) << 32); }
#pragma unroll
        for (int j = 0; j < 4; ++j) h[j] = hn[j];
    }
}

constexpr float QSCALE = 0.125f * 1.4426950408889634f;
__device__ __forceinline__ void fourier_row0(const Params& p) {
    {
      const h16* ZTL = (const h16*)(p.ws + WS_ZTL); h16* brp = (h16*)(p.ws + WS_BR);
      const int lane_ = tidx() & 63, gw_ = bidx() * NWAVES + (tidx() >> 6), NGW_ = gridDim.x * NWAVES;
      for (int col = gw_; col < 4096; col += NGW_) { float sa = 0.f;
#pragma unroll
          for (int q = 0; q < 4; ++q) { const h16x8 v = *(const h16x8*)(ZTL + (size_t)col * 4096 + q * 512 + lane_ * 8);
#pragma unroll
              for (int e = 0; e < 8; ++e) sa += (float)v[e]; }
          sa = wave_sum(sa);
          if (lane_ == 0) brp[(size_t)((col >> 8) * 2048) * DM + 256 + (col & 255)] = (h16)(sa * 0.022097086912079608f); } }
}

#define MEMFENCE() asm volatile("" ::: "memory")
__device__ __forceinline__ void phase_wg(const Params& p) {
    const float* modv = (const float*)(p.ws + WS_MODV); float* wg = (float*)(p.ws + WS_WG); float* sgb = (float*)(p.ws + WS_SGB);
    const int tid = tidx(), lane = tid & 63, gw = bidx() * NWAVES + (tid >> 6), NGW = gridDim.x * NWAVES;
    for (int it = bidx() * NTHREADS + tid; it < 2 * 17 * 1024; it += gridDim.x * NTHREADS) {
        const int k = it & 1023, lm = it >> 10, l = lm / 17;
        const float G = p.ln1_g[l * DM + k] * (1.f + modv[(size_t)lm * NMOD + 4 * DM + k]);
        const float* w = p.w_router + ((size_t)l * DM + k) * 16; float* o = wg + (size_t)lm * 16384 + (size_t)((k >> 2) * 16) * 4 + (k & 3);
#pragma unroll
        for (int e4 = 0; e4 < 4; ++e4) { const f32x4 wv = *(const f32x4*)(w + e4 * 4);
#pragma unroll
            for (int c = 0; c < 4; ++c) o[(e4 * 4 + c) * 4] = G * wv[c]; } }
    for (int lm = gw; lm < 34; lm += NGW) { const int l = lm / 17;
        float sg[16], sb[16];
#pragma unroll
        for (int e = 0; e < 16; ++e) { sg[e] = 0.f; sb[e] = 0.f; }
        for (int q = 0; q < 16; ++q) { const int k = lane + 64 * q; const float sc = modv[(size_t)lm * NMOD + 4 * DM + k], sh = modv[(size_t)lm * NMOD + 3 * DM + k];
            const float G = p.ln1_g[l * DM + k] * (1.f + sc), Bp = p.ln1_b[l * DM + k] * (1.f + sc) + sh; const float* w = p.w_router + ((size_t)l * DM + k) * 16;
#pragma unroll
            for (int e4 = 0; e4 < 4; ++e4) { const f32x4 wv = *(const f32x4*)(w + e4 * 4);
#pragma unroll
                for (int c = 0; c < 4; ++c) { sg[e4 * 4 + c] += G * wv[c]; sb[e4 * 4 + c] += Bp * wv[c]; } } }
#pragma unroll
        for (int e = 0; e < 16; ++e) { const float a = wave_sum(sg[e]), b = wave_sum(sb[e]); if (lane == 0) { sgb[lm * 32 + e] = a; sgb[lm * 32 + 16 + e] = b; } } }
}
__device__ __forceinline__ void ln1_rows(const float* hB, h16* u16, float* stat, const float* mvp, const float* g, const float* bb, int R0, int nrows, int ioff, int lane, float& mu, float& rho, float* cst) {
    f32x4 gg[4], bv[4], sh[4], sc[4];
#pragma unroll
    for (int j = 0; j < 4; ++j) { const int col = lane * 4 + 256 * j; gg[j] = *(const f32x4*)(g + col); bv[j] = *(const f32x4*)(bb + col); sh[j] = *(const f32x4*)(mvp + 3 * DM + col); sc[j] = *(const f32x4*)(mvp + 4 * DM + col); }
    f32x4 v[4], vn[4];
#pragma unroll
    for (int j = 0; j < 4; ++j) v[j] = *(const f32x4*)(hB + (size_t)R0 * DM + lane * 4 + 256 * j);
    for (int i = 0; i < nrows; ++i) {
        const int R = R0 + i;
        MEMFENCE();
        if (i + 1 < nrows) {
#pragma unroll
            for (int j = 0; j < 4; ++j) vn[j] = *(const f32x4*)(hB + (size_t)(R + 1) * DM + lane * 4 + 256 * j); }
        MEMFENCE();
        float s = 0.f;
#pragma unroll
        for (int j = 0; j < 4; ++j) s += (v[j][0] + v[j][1]) + (v[j][2] + v[j][3]);
        const float mean = wave_sum(s) * (1.f / DM); float q = 0.f;
#pragma unroll
        for (int j = 0; j < 4; ++j) { v[j] = v[j] - mean; q += (v[j][0] * v[j][0] + v[j][1] * v[j][1]) + (v[j][2] * v[j][2] + v[j][3] * v[j][3]); }
        const float rstd = rsqrtf(wave_sum(q) * (1.f / DM) + LN_EPS);
        if (lane == 0) { float* st = stat + (size_t)R * 2; st[0] = mean; st[1] = rstd; if (cst) { cst[(ioff + i) * 2] = mean; cst[(ioff + i) * 2 + 1] = rstd; } }
        if ((lane & 15) == ioff + i) { mu = mean; rho = rstd; }
#pragma unroll
        for (int j = 0; j < 4; ++j) { const int col = lane * 4 + 256 * j;
            const f32x4 h1 = v[j] * rstd * gg[j] + bv[j];
            const f32x4 u2 = h1 * (1.f + sc[j]) + sh[j];
            *(unsigned long long*)(u16 + (size_t)R * DM + col) = (unsigned long long)pk_b2(u2[0], u2[1]) | ((unsigned long long)pk_b2(u2[2], u2[3]) << 32); }
#pragma unroll
        for (int j = 0; j < 4; ++j) v[j] = vn[j];
    }
}
__device__ __forceinline__ f32x4 ln1_router_mfma(const float* vrow, const float* wgl, int t0, int t1) {
    f32x4 a0 = {0.f, 0.f, 0.f, 0.f}, a1 = {0.f, 0.f, 0.f, 0.f};
    f32x4 b[8], bn[8];
#pragma unroll
    for (int u = 0; u < 8; ++u) b[u] = *(const f32x4*)(vrow + 16 * (t0 + u));
    for (int t = t0; t < t1; t += 8) {
        if (t + 8 < t1) {
#pragma unroll
            for (int u = 0; u < 8; ++u) bn[u] = *(const f32x4*)(vrow + 16 * (t + 8 + u)); }
#pragma unroll
        for (int u = 0; u < 8; ++u) { const f32x4 a = *(const f32x4*)(wgl + (t + u) * 256);
#pragma unroll
            for (int i = 0; i < 4; ++i) { if (u & 1) a1 = __builtin_amdgcn_mfma_f32_16x16x4f32(a[i], b[u][i], a1, 0, 0, 0); else a0 = __builtin_amdgcn_mfma_f32_16x16x4f32(a[i], b[u][i], a0, 0, 0, 0); } }
#pragma unroll
        for (int u = 0; u < 8; ++u) b[u] = bn[u];
    }
    return a0 + a1;
}
__device__ __forceinline__ void ln1_finish(const Params& p, const float* sgbm, const f32x4 D, float mu, float rho, int R, int lane) {
    float* affL = (float*)(p.ws + WS_AFFL); float* affC = (float*)(p.ws + WS_AFFC);
    const int eq = lane >> 4; const f32x4 sg = *(const f32x4*)(sgbm + 4 * eq), sb = *(const f32x4*)(sgbm + 16 + 4 * eq);
    const float rm = rho * mu; float lg[4];
#pragma unroll
    for (int r = 0; r < 4; ++r) lg[r] = rho * D[r] - rm * sg[r] + sb[r];
    float mx = fmaxf(fmaxf(lg[0], lg[1]), fmaxf(lg[2], lg[3])); mx = xor16_max(mx); mx = xor32_max(mx);
    float ex[4], se = 0.f;
#pragma unroll
    for (int r = 0; r < 4; ++r) { ex[r] = __builtin_amdgcn_exp2f((lg[r] - mx) * 1.4426950408889634f); se += ex[r]; }
    se = xor16_sum(se); se = xor32_sum(se);
#pragma unroll
    for (int r = 0; r < 4; ++r) { const float a = ex[r] / se; const int e = 4 * eq + r;
        if (R < TL) affL[((size_t)((R >> 11) * 16 + e)) * 2048 + (R & 2047)] = a; else { const int rr = R - TL; affC[((size_t)((rr >> 8) * 16 + e)) * 256 + (rr & 255)] = a; } }
}
__device__ __forceinline__ void phase_ln1_fill(const Params& p, int l, float* lds) {
    const float* wg = (const float*)(p.ws + WS_WG) + (size_t)l * 17 * 16384; const int tid = tidx(), bt = bidx() >> 4;
    __syncthreads();
    for (int e = tid; e < 4096; e += NTHREADS) *(f32x4*)(lds + e * 4) = *(const f32x4*)(wg + (size_t)bt * 16384 + e * 4);
    if (l == 0) for (int e = tid; e < 4096; e += NTHREADS) *(f32x4*)(lds + 16384 + e * 4) = *(const f32x4*)(wg + (size_t)16 * 16384 + e * 4);
    __syncthreads();
}
__device__ __forceinline__ void phase_ln1(const Params& p, int l, float* lds) {
    float* hB = (float*)(p.ws + WS_HB); h16* u16 = (h16*)(p.ws + WS_U16); const float* modv = (const float*)(p.ws + WS_MODV) + (size_t)l * 17 * NMOD;
    float* stat = (float*)(p.ws + WS_STAT); const float* wg = (const float*)(p.ws + WS_WG) + (size_t)l * 17 * 16384; const float* sgb = (const float*)(p.ws + WS_SGB) + l * 17 * 32;
    const float* g = p.ln1_g + l * DM; const float* bb = p.ln1_b + l * DM;
    const int tid = tidx(), lane = tid & 63, w = tid >> 6, c = bidx();
    const int bt = c >> 4;
    float* cst = lds + 32768; float* part = lds + 32768 + 64;
    __syncthreads();
    { const int Rg = c * 128 + w * 16; float mu = 0.f, rho = 0.f;
      ln1_rows(hB, u16, stat, modv + (size_t)bt * NMOD, g, bb, Rg, 16, 0, lane, mu, rho, nullptr);
      const f32x4 D = ln1_router_mfma(hB + (size_t)(Rg + (lane & 15)) * DM + 4 * (lane >> 4), lds + lane * 4, 0, 64);
      ln1_finish(p, sgb + bt * 32, D, mu, rho, Rg + (lane & 15), lane); }
    if (l == 0) { const int Cg = TL + c * 16; float mu = 0.f, rho = 0.f;
      ln1_rows(hB, u16, stat, modv + (size_t)16 * NMOD, g, bb, Cg + 2 * w, 2, 2 * w, lane, mu, rho, cst);
      __syncthreads();
      const f32x4 D = ln1_router_mfma(hB + (size_t)(Cg + (lane & 15)) * DM + 4 * (lane >> 4), lds + 16384 + lane * 4, 8 * w, 8 * w + 8);
      *(f32x4*)(part + (w * 64 + lane) * 4) = D;
      __syncthreads();
      if (w == 0) { f32x4 Ds = *(const f32x4*)(part + lane * 4);
#pragma unroll
          for (int q = 1; q < 8; ++q) Ds += *(const f32x4*)(part + (q * 64 + lane) * 4);
          ln1_finish(p, sgb + 16 * 32, Ds, cst[(lane & 15) * 2], cst[(lane & 15) * 2 + 1], Cg + (lane & 15), lane); } }
    __syncthreads();
}

__device__ __forceinline__ void phase_topk(const Params& p, int l, float* lds) {
    const float* affL = (const float*)(p.ws + WS_AFFL); const float* affC = (const float*)(p.ws + WS_AFFC); float* selw = (float*)(p.ws + WS_SELW); int* slot_of = (int*)(p.ws + WS_SLOT);
    int* selrow = (int*)(p.ws + WS_SELR);
    unsigned* a = (unsigned*)lds; unsigned* hist = (unsigned*)(lds + 2048 + 256); int* wsum = (int*)(lds + 2048 + 512); unsigned* ctl = (unsigned*)(lds + 2048 + 512 + 32);
    const int tid = tidx(), lane = tid & 63, wave = tid >> 6;
    const int nitems = (l == 0) ? 512 : 256;
    __syncthreads();
    for (int it = bidx(); it < nitems; it += gridDim.x) {
        const bool lat = it < 256; const int be = lat ? it : it - 256; const int b = be >> 4, e = be & 15; const int n = lat ? 2048 : 256, cap = lat ? CAPL : CAPC;
        const float* src = lat ? affL + (size_t)be * 2048 : affC + (size_t)be * 256;
        for (int i = tid; i < n; i += NTHREADS) a[i] = __float_as_uint(src[i]);
        unsigned prefix = 0u, pmask = 0u; int remaining = cap;
        for (int pass = 0; pass < 4; ++pass) {
            const int shift = 24 - 8 * pass;
            if (tid < 256) hist[tid] = 0u;
            __syncthreads();
            for (int i = tid; i < n; i += NTHREADS) { const unsigned u = a[i]; if ((u & pmask) == prefix) atomicAdd(&hist[(u >> shift) & 255u], 1u); }
            __syncthreads();
            if (tid < 64) {
                unsigned c4[4]; unsigned s4 = 0;
#pragma unroll
                for (int q = 0; q < 4; ++q) { c4[q] = hist[255 - (lane * 4 + q)]; s4 += c4[q]; }
                unsigned incl = s4;
#pragma unroll
                for (int o = 1; o < 64; o <<= 1) { const unsigned t = __shfl_up(incl, o); if (lane >= o) incl += t; }
                unsigned excl = incl - s4;
                const bool mine = (excl < (unsigned)remaining) && (incl >= (unsigned)remaining);
                if (mine) { unsigned cum = excl; int bin = 0; unsigned above = 0;
#pragma unroll
                    for (int q = 0; q < 4; ++q) { if (cum < (unsigned)remaining && cum + c4[q] >= (unsigned)remaining) { bin = 255 - (lane * 4 + q); above = cum; } cum += c4[q]; }
                    ctl[0] = (unsigned)bin; ctl[1] = above; }
            }
            __syncthreads();
            prefix |= ctl[0] << shift; pmask |= 255u << shift; remaining -= (int)ctl[1];
            __syncthreads();
        }
        const unsigned T = prefix; const int need_eq = remaining;
        const int i0 = tid * 4; int ngt = 0, neq = 0; unsigned u4[4];
#pragma unroll
        for (int q = 0; q < 4; ++q) { const int i = i0 + q; u4[q] = (i < n) ? a[i] : 0u; ngt += (i < n && u4[q] > T) ? 1 : 0; neq += (i < n && u4[q] == T) ? 1 : 0; }
        int ieq = neq;
#pragma unroll
        for (int o = 1; o < 64; o <<= 1) { const int t = __shfl_up(ieq, o); if (lane >= o) ieq += t; }
        if (lane == 63) wsum[wave] = ieq;
        __syncthreads();
        int eqbase = 0;
#pragma unroll
        for (int wv = 0; wv < 8; ++wv) eqbase += (wv < wave) ? wsum[wv] : 0;
        int eqrank = eqbase + ieq - neq;
        int nsel = 0; bool sel[4];
#pragma unroll
        for (int q = 0; q < 4; ++q) { const int i = i0 + q; const bool gt = (i < n) && (u4[q] > T); const bool eq = (i < n) && (u4[q] == T); sel[q] = gt || (eq && eqrank < need_eq); eqrank += eq ? 1 : 0; nsel += sel[q] ? 1 : 0; }
        __syncthreads();
        int isel = nsel;
#pragma unroll
        for (int o = 1; o < 64; o <<= 1) { const int t = __shfl_up(isel, o); if (lane >= o) isel += t; }
        if (lane == 63) wsum[wave] = isel;
        __syncthreads();
        int sbase = 0;
#pragma unroll
        for (int wv = 0; wv < 8; ++wv) sbase += (wv < wave) ? wsum[wv] : 0;
        int slot = sbase + isel - nsel;
        const int gbase = lat ? be * 256 : GL + e * 512 + b * 32;
#pragma unroll
        for (int q = 0; q < 4; ++q) { const int i = i0 + q; if (i < n) { const int R = lat ? b * 2048 + i : TL + b * 256 + i;
            if (sel[q]) { selrow[gbase + slot] = R; selw[gbase + slot] = __uint_as_float(u4[q]); slot_of[(size_t)R * 16 + e] = gbase + slot; ++slot; } else slot_of[(size_t)R * 16 + e] = -1; } }
        __syncthreads();
    }
}

struct Ln2S { int sl; float m, r; };
__device__ __forceinline__ Ln2S ln2_ldS(const int* slot_of, const float* stat, int R, int lane) { Ln2S s; s.sl = slot_of[(size_t)R * 16 + (lane & 15)]; s.m = stat[(size_t)R * 2]; s.r = stat[(size_t)R * 2 + 1]; return s; }
__device__ __forceinline__ void ln2_issue(const h16* Y, const float* hB, int R, int sl, int lane, h16x4 (&yv)[4][4], f32x4 (&h)[4]) {
    unsigned long long msk = __ballot(sl >= 0) & 0xFFFFull;
#pragma unroll
    for (int q = 0; q < 4; ++q) { if (msk) { const int e = __builtin_ctzll(msk); msk &= msk - 1; const int sr = __builtin_amdgcn_readlane(sl, e);
#pragma unroll
            for (int j = 0; j < 4; ++j) yv[q][j] = *(const h16x4*)(Y + (size_t)sr * DM + lane * 4 + 256 * j); }
        else {
#pragma unroll
            for (int j = 0; j < 4; ++j) yv[q][j] = (h16x4){(h16)0.f, (h16)0.f, (h16)0.f, (h16)0.f}; } }
#pragma unroll
    for (int j = 0; j < 4; ++j) h[j] = *(const f32x4*)(hB + (size_t)R * DM + lane * 4 + 256 * j);
}
__device__ __forceinline__ void ln2_rows(const Params& p, int l, const float* ldsv, int R0, int nrows, int mv, int lane) {
    float* hB = (float*)(p.ws + WS_HB); h16* u16 = (h16*)(p.ws + WS_U16); const h16* Y = (const h16*)(p.ws + WS_XG); const int* slot_of = (const int*)(p.ws + WS_SLOT);
    const float* mvp = (const float*)(p.ws + WS_MODV) + ((size_t)l * 17 + mv) * NMOD; const float* mvn = mvp + (size_t)17 * NMOD; const float* stat = (const float*)(p.ws + WS_STAT);
    const bool nextu = (l < DEPTH - 1);
    f32x4 gate[4], nsh[4], nsc[4];
#pragma unroll
    for (int j = 0; j < 4; ++j) { const int col = lane * 4 + 256 * j; gate[j] = *(const f32x4*)(mvp + 5 * DM + col); nsh[j] = (f32x4){0.f, 0.f, 0.f, 0.f}; nsc[j] = nsh[j];
        if (nextu) { nsh[j] = *(const f32x4*)(mvn + col); nsc[j] = *(const f32x4*)(mvn + DM + col); } }
    Ln2S sA = ln2_ldS(slot_of, stat, R0, lane), sB = sA, sC = sA, sD = sA;
    if (nrows > 1) sB = ln2_ldS(slot_of, stat, R0 + 1, lane);
    if (nrows > 2) sC = ln2_ldS(slot_of, stat, R0 + 2, lane);
    h16x4 yv0[4][4], yv1[4][4]; f32x4 h0[4], h1b[4];
    ln2_issue(Y, hB, R0, sA.sl, lane, yv0, h0);
    for (int i = 0; i < nrows; ++i) {
        const int R = R0 + i;
        MEMFENCE();
        if (i + 1 < nrows) ln2_issue(Y, hB, R + 1, sB.sl, lane, yv1, h1b);
        if (i + 3 < nrows) sD = ln2_ldS(slot_of, stat, R + 3, lane);
        MEMFENCE();
        f32x4 f[4];
#pragma unroll
        for (int j = 0; j < 4; ++j) { f[j] = (f32x4){0.f, 0.f, 0.f, 0.f};
#pragma unroll
            for (int q = 0; q < 4; ++q) { f[j][0] += (float)yv0[q][j][0]; f[j][1] += (float)yv0[q][j][1]; f[j][2] += (float)yv0[q][j][2]; f[j][3] += (float)yv0[q][j][3]; } }
        { unsigned long long msk = __ballot(sA.sl >= 0) & 0xFFFFull;
#pragma unroll
          for (int q = 0; q < 4; ++q) msk &= msk - 1;
          while (msk) { const int e = __builtin_ctzll(msk); msk &= msk - 1; const int sr = __builtin_amdgcn_readlane(sA.sl, e);
#pragma unroll
            for (int j = 0; j < 4; ++j) { const h16x4 y = *(const h16x4*)(Y + (size_t)sr * DM + lane * 4 + 256 * j); f[j][0] += (float)y[0]; f[j][1] += (float)y[1]; f[j][2] += (float)y[2]; f[j][3] += (float)y[3]; } } }
        f32x4 v[4]; float s = 0.f;
#pragma unroll
        for (int j = 0; j < 4; ++j) { const f32x4 g1v = *(const f32x4*)(ldsv + lane * 4 + 256 * j), b1v = *(const f32x4*)(ldsv + 1024 + lane * 4 + 256 * j);
            const f32x4 hh = (h0[j] - sA.m) * sA.r * g1v + b1v;
            v[j] = ALPHA * hh + gate[j] * f[j]; s += (v[j][0] + v[j][1]) + (v[j][2] + v[j][3]); }
        const float mean = wave_sum(s) * (1.f / DM); float q = 0.f;
#pragma unroll
        for (int j = 0; j < 4; ++j) { v[j] = v[j] - mean; q += (v[j][0] * v[j][0] + v[j][1] * v[j][1]) + (v[j][2] * v[j][2] + v[j][3] * v[j][3]); }
        const float rstd = rsqrtf(wave_sum(q) * (1.f / DM) + LN_EPS);
        float* orow = (l == DEPTH - 1) ? p.out + (size_t)R * DM : hB + (size_t)R * DM;
#pragma unroll
        for (int j = 0; j < 4; ++j) { const int col = lane * 4 + 256 * j; const f32x4 g2v = *(const f32x4*)(ldsv + 2048 + col), b2v = *(const f32x4*)(ldsv + 3072 + col);
            const f32x4 h2 = v[j] * rstd * g2v + b2v; if (l == DEPTH - 1) __builtin_nontemporal_store(h2, (f32x4*)(orow + col)); else *(f32x4*)(orow + col) = h2;
            if (nextu) { const f32x4 u = h2 * (1.f + nsc[j]) + nsh[j];
                *(unsigned long long*)(u16 + (size_t)R * DM + col) = (unsigned long long)pk_h2(u[0], u[1]) | ((unsigned long long)pk_h2(u[2], u[3]) << 32); } }
#pragma unroll
        for (int q2 = 0; q2 < 4; ++q2)
#pragma unroll
            for (int j = 0; j < 4; ++j) yv0[q2][j] = yv1[q2][j];
#pragma unroll
        for (int j = 0; j < 4; ++j) h0[j] = h1b[j];
        sA = sB; sB = sC; sC = sD;
    }
}
__device__ __forceinline__ void phase_ln2(const Params& p, int l, float* lds) {
    const int tid = tidx(), lane = tid & 63, w = tid >> 6, c = bidx();
    __syncthreads();
    for (int e = tid; e < 1024; e += NTHREADS) { const int k = e >> 8, col = (e & 255) * 4; const float* src = (k == 0 ? p.ln1_g : k == 1 ? p.ln1_b : k == 2 ? p.ln2_g : p.ln2_b) + l * DM + col;
        *(f32x4*)(lds + k * 1024 + col) = *(const f32x4*)src; }
    __syncthreads();
    ln2_rows(p, l, lds, c * 128 + w * 16, 16, c >> 4, lane);
    if (l == 0) ln2_rows(p, l, lds, TL + c * 16 + 2 * w, 2, 16, lane);
    __syncthreads();
}

namespace fg {
#define FG_LAS __attribute__((address_space(3)))
constexpr int BM = 256, BK = 64, HALF = 128, HTB = HALF * BK * 2, STAGE_BYTES = 8 * HTB;
__host__ __device__ __forceinline__ int lds_byte(int r, int c) { const int st = (r >> 4) * 2 + (c >> 5), rr = r & 15, cc = c & 31, ob = rr * 64 + cc * 2; return st * 1024 + (ob ^ (((ob >> 9) & 1) << 5)); }
__host__ __device__ __forceinline__ void stage_rc(int b, int& R, int& C) { const int st = b / 1024, sb = b % 1024, swz = sb ^ (((sb >> 9) & 1) << 5); R = (st >> 1) * 16 + swz / 64; C = (st & 1) * 32 + (swz % 64) / 2; }
__host__ __device__ __forceinline__ int perm32(int rho) { const int n = rho >> 4, i = rho & 15; return 8 * (i >> 2) + 4 * n + (i & 3); }
struct Unit { const char* A; const char* B; int nt; int pm, pn, aux; const int* rows; };
template <class Epi, class Sched, int LD, bool BF = false, bool GATHER = false>
__device__ __forceinline__ void gemm_phase(FG_LAS unsigned char* lds, const Sched& S, const Epi& E) {
    const int tid = tidx(), wid = __builtin_amdgcn_readfirstlane(tid >> 6), lane = tid & 63, wr = wid >> 2, wc = wid & 3, fr = lane & 15, fq = lane >> 4;
    unsigned voffA[2], voffB[2]; int rowA[2], colA[2];
#pragma unroll
    for (int i = 0; i < 2; ++i) { int R, C; stage_rc(tid * 16 + i * 8192, R, C); const int Rb = Epi::PERM ? ((R & ~31) + perm32(R & 31)) : R;
        voffA[i] = (unsigned)(R * LD + C) * 2u; voffB[i] = (unsigned)(Rb * LD + C) * 2u; rowA[i] = R; colA[i] = C; }
    const size_t kstep = (size_t)(BK * 2);
    const size_t hstep = GATHER ? (size_t)0 : (size_t)HALF * LD * 2;
    const unsigned ldsw = (unsigned)wid * 1024u;
    const int aoff = lds_byte(wr * 64 + fr, fq * 8), boff = lds_byte(wc * 32 + fr, fq * 8);
#define FG_SA(b, h) (((b) * 2 + (h)) * HTB)
#define FG_SB(b, h) ((4 + (b) * 2 + (h)) * HTB)
#define FG_STAGE(bufoff, gbase, voff) do { _Pragma("unroll") for (int _i = 0; _i < 2; ++_i) \
        __builtin_amdgcn_global_load_lds((const unsigned*)((const char*)(gbase) + (voff)[_i]), (FG_LAS unsigned*)(lds + (bufoff) + ldsw + _i * 8192), 16, 0, 0); } while (0)
#define FG_STAGEA(bufoff, gbase, h, cur_) do { if (GATHER) { if (cur_) FG_STAGE(bufoff, gbase, cvA[h]); else FG_STAGE(bufoff, gbase, nvA[h]); } else FG_STAGE(bufoff, (gbase) + (h) * ((size_t)HALF * LD * 2), voffA); } while (0)
#define FG_LDA(dst, b, h) do { _Pragma("unroll") for (int m = 0; m < 4; ++m) _Pragma("unroll") for (int k = 0; k < 2; ++k) dst[m][k] = *(const FG_LAS h16x8*)(lds + FG_SA(b, h) + aoff + m * 2048 + k * 1024); } while (0)
#define FG_LDB(dst, b, h) do { _Pragma("unroll") for (int n = 0; n < 2; ++n) _Pragma("unroll") for (int k = 0; k < 2; ++k) dst[n][k] = *(const FG_LAS h16x8*)(lds + FG_SB(b, h) + boff + n * 2048 + k * 1024); } while (0)
#define FG_MMA(ai, bj, At, Bt) do { __builtin_amdgcn_s_setprio(1); _Pragma("unroll") for (int m = 0; m < 4; ++m) _Pragma("unroll") for (int n = 0; n < 2; ++n) _Pragma("unroll") for (int k = 0; k < 2; ++k) \
        acc[ai][bj][m][n] = BF ? __builtin_amdgcn_mfma_f32_16x16x32_bf16(__builtin_bit_cast(bf16x8_t, Bt[n][k]), __builtin_bit_cast(bf16x8_t, At[m][k]), acc[ai][bj][m][n], 0, 0, 0) : __builtin_amdgcn_mfma_f32_16x16x32_f16(Bt[n][k], At[m][k], acc[ai][bj][m][n], 0, 0, 0); __builtin_amdgcn_s_setprio(0); } while (0)
#define FG_WAIT_V(n) asm volatile("s_waitcnt vmcnt(" #n ")" ::: "memory")
#define FG_WAIT_L(n) asm volatile("s_waitcnt lgkmcnt(" #n ")" ::: "memory")
#define FG_BAR __builtin_amdgcn_s_barrier()
#define FG_SCHED __builtin_amdgcn_sched_barrier(0)
    Unit cur, nxt; int ui = 0;
    __syncthreads();
    if (!S.next(0, cur)) return;
    f32x4 acc[2][2][4][2];
#pragma unroll
    for (int a = 0; a < 2; ++a)
#pragma unroll
        for (int b = 0; b < 2; ++b)
#pragma unroll
            for (int m = 0; m < 4; ++m)
#pragma unroll
                for (int n = 0; n < 2; ++n) acc[a][b][m][n] = (f32x4){0.f, 0.f, 0.f, 0.f};
    h16x8 At[4][2], B0[2][2], B1[2][2];
    const char* cA = cur.A; const char* cB = cur.B;
    const size_t hstepB = (size_t)HALF * LD * 2;
    unsigned cvA[2][2], nvA[2][2];
    if (GATHER) {
#pragma unroll
        for (int h = 0; h < 2; ++h)
#pragma unroll
            for (int i = 0; i < 2; ++i) { cvA[h][i] = (unsigned)(cur.rows[h * HALF + rowA[i]] * LD + colA[i]) * 2u; nvA[h][i] = cvA[h][i]; } }
    FG_STAGE(FG_SB(0, 0), cB, voffB); FG_STAGE(FG_SB(0, 1), cB + hstepB, voffB); FG_STAGEA(FG_SA(0, 0), cA, 0, true); FG_STAGEA(FG_SA(0, 1), cA, 1, true);
    if (wr == 1) FG_BAR;
    FG_WAIT_V(2); FG_BAR;
    FG_STAGE(FG_SB(1, 0), cB + kstep, voffB); FG_STAGEA(FG_SA(1, 0), cA + kstep, 0, true); FG_STAGE(FG_SB(1, 1), cB + hstepB + kstep, voffB);
    FG_WAIT_V(6); FG_BAR;
    for (;;) {
        const bool has_next = S.next(ui + 1, nxt);
        const char* nA = has_next ? nxt.A : cA; const char* nB = has_next ? nxt.B : cB;
        if (GATHER && has_next) {
#pragma unroll
            for (int h = 0; h < 2; ++h)
#pragma unroll
                for (int i = 0; i < 2; ++i) nvA[h][i] = (unsigned)(nxt.rows[h * HALF + rowA[i]] * LD + colA[i]) * 2u; }
        const int nt = cur.nt;
        for (int t = 0; t < nt; t += 2) {
            const bool last = (t == nt - 2);
            const char* a1 = cA + (size_t)(t + 1) * kstep;
            const char* a2 = last ? nA : cA + (size_t)(t + 2) * kstep; const char* b2 = last ? nB : cB + (size_t)(t + 2) * kstep;
            const char* a3 = a2 + kstep; const char* b3 = b2 + kstep;
            FG_LDB(B0, 0, 0); FG_LDB(B1, 0, 1); FG_SCHED; FG_LDA(At, 0, 0); FG_STAGEA(FG_SA(1, 1), a1, 1, true);
            FG_WAIT_V(8); FG_WAIT_L(0); FG_BAR; FG_MMA(0, 0, At, B0); FG_MMA(0, 1, At, B1); FG_BAR; FG_SCHED;
            FG_LDA(At, 0, 1); FG_STAGE(FG_SB(0, 0), b2, voffB); FG_STAGE(FG_SB(0, 1), b2 + hstepB, voffB); FG_STAGEA(FG_SA(0, 0), a2, 0, !last);
            FG_WAIT_V(8); FG_WAIT_L(0); FG_BAR; FG_MMA(1, 0, At, B0); FG_MMA(1, 1, At, B1); FG_BAR; FG_SCHED;
            FG_LDB(B0, 1, 0); FG_LDB(B1, 1, 1); FG_SCHED; FG_LDA(At, 1, 0); FG_STAGEA(FG_SA(0, 1), a2, 1, !last);
            FG_WAIT_V(8); FG_WAIT_L(0); FG_BAR; FG_MMA(0, 0, At, B0); FG_MMA(0, 1, At, B1); FG_BAR; FG_SCHED;
            FG_LDA(At, 1, 1); FG_STAGE(FG_SB(1, 0), b3, voffB); FG_STAGE(FG_SB(1, 1), b3 + hstepB, voffB); FG_STAGEA(FG_SA(1, 0), a3, 0, !last);
            FG_WAIT_V(8); FG_WAIT_L(0); FG_BAR; FG_MMA(1, 0, At, B0); FG_MMA(1, 1, At, B1); FG_BAR; FG_SCHED;
        }
        if (wr == 0) FG_BAR;
        { const int t2_ = tidx(); E(acc, cur, wr, wc, t2_ & 15, (t2_ >> 4) & 3); }
        if (!has_next) break;
#pragma unroll
        for (int a = 0; a < 2; ++a)
#pragma unroll
            for (int b = 0; b < 2; ++b)
#pragma unroll
                for (int m = 0; m < 4; ++m)
#pragma unroll
                    for (int n = 0; n < 2; ++n) acc[a][b][m][n] = (f32x4){0.f, 0.f, 0.f, 0.f};
        cur = nxt; cA = nA; cB = nB; ++ui;
        if (GATHER) {
#pragma unroll
            for (int h = 0; h < 2; ++h)
#pragma unroll
                for (int i = 0; i < 2; ++i) cvA[h][i] = nvA[h][i]; }
        if (wr == 1) FG_BAR;
    }
    FG_WAIT_V(0);
    FG_BAR;
#undef FG_SA
#undef FG_SB
#undef FG_STAGE
#undef FG_LDA
#undef FG_STAGEA
#undef FG_LDB
#undef FG_MMA
#undef FG_WAIT_V
#undef FG_WAIT_L
#undef FG_BAR
#undef FG_SCHED
}
}
typedef FG_LAS unsigned char* ldsp_t;

template <bool BF = false>
__device__ __forceinline__ void transpose_item(const float* W, int ldw, h16* WT, int ldt, float* scr, int lane, float scl = 1.f) {
    f32x4 t[16];
#pragma unroll
    for (int i = 0; i < 16; ++i) t[i] = __builtin_nontemporal_load((const f32x4*)(W + (size_t)(i * 4 + (lane >> 4)) * ldw + (lane & 15) * 4));
#pragma unroll
    for (int i = 0; i < 16; ++i) { float* d = scr + (i * 4 + (lane >> 4)) * 65 + (lane & 15) * 4; d[0] = t[i][0]; d[1] = t[i][1]; d[2] = t[i][2]; d[3] = t[i][3]; }
    __builtin_amdgcn_wave_barrier();
    const int c = lane & 7;
#pragma unroll
    for (int j = 0; j < 8; ++j) { const int n = (lane >> 3) + 8 * j; const float* sp = scr + (8 * c) * 65 + n;
        u32x4 o; if (BF) { o.x = pk_b2(sp[0 * 65], sp[1 * 65]); o.y = pk_b2(sp[2 * 65], sp[3 * 65]); o.z = pk_b2(sp[4 * 65], sp[5 * 65]); o.w = pk_b2(sp[6 * 65], sp[7 * 65]); }
        else { o.x = pk_h2(sp[0 * 65] * scl, sp[1 * 65] * scl); o.y = pk_h2(sp[2 * 65] * scl, sp[3 * 65] * scl); o.z = pk_h2(sp[4 * 65] * scl, sp[5 * 65] * scl); o.w = pk_h2(sp[6 * 65] * scl, sp[7 * 65] * scl); }
        *(u32x4*)(WT + (size_t)n * ldt + 8 * c) = o; }
    __builtin_amdgcn_wave_barrier();
}
struct SchedWF {
    const char* BDT; const char* WFIN; int c;
    __device__ __forceinline__ bool next(int i, fg::Unit& u) const {
        if (i != 0 || c >= 16) return false;
        u.aux = c >> 3; u.pm = (c >> 2) & 1; u.pn = c & 3; u.nt = 4;
        u.A = BDT + (size_t)u.pm * 256 * 256 * 2; u.B = WFIN + ((size_t)u.aux * 1024 + u.pn * 256) * 256 * 2; return true;
    }
};
struct EpiWF {
    static constexpr bool PERM = true;
    h16* WinT;
    __device__ __forceinline__ void operator()(const f32x4 (&acc)[2][2][4][2], const fg::Unit& u, int wr, int wc, int fr, int fq) const {
        h16* base = WinT + ((size_t)u.aux * 6144 + 5632 + u.pm * 256 + 64 * wr + fr) * DM + u.pn * 256 + 32 * wc + 8 * fq;
#pragma unroll
        for (int ai = 0; ai < 2; ++ai)
#pragma unroll
            for (int m = 0; m < 4; ++m)
#pragma unroll
                for (int bj = 0; bj < 2; ++bj) { const f32x4 v0 = acc[ai][bj][m][0], v1 = acc[ai][bj][m][1];
                    *(u32x4*)(base + (size_t)(128 * ai + 16 * m) * DM + 128 * bj) = (u32x4){pk_h2(v0[0], v0[1]), pk_h2(v0[2], v0[3]), pk_h2(v1[0], v1[1]), pk_h2(v1[2], v1[3])}; }
    }
};
__device__ __forceinline__ void phase_convert_dense(const Params& p, float* lds, ldsp_t ldsf) {
    { SchedWF S{(const char*)(p.ws + WS_BDT), (const char*)(p.ws + WS_WFIN), bidx()}; EpiWF E{(h16*)(p.ws + WS_WINT)};
      fg::gemm_phase<EpiWF, SchedWF, 256>(ldsf, S, E); }
    __syncthreads();
}
__device__ __forceinline__ void dense_transposes(const Params& p, float* lds) {
    if (bidx() < 192) return;
    __syncthreads();
    const int lane = tidx() & 63, wave = tidx() >> 6, gw = (bidx() - 192) * NWAVES + wave, NGW = (gridDim.x - 192) * NWAVES;
    float* scr = lds + wave * (64 * 65);
    h16* WinT = (h16*)(p.ws + WS_WINT); h16* WbT = (h16*)(p.ws + WS_WBT); h16* WoT = (h16*)(p.ws + WS_WOT);
    constexpr int I_IN = 16 * 88, I_BR = 4 * 4 * 16, I_OUT = 16 * 16, I_L = I_IN + I_BR + I_OUT;
    for (int it = gw; it < 2 * I_L; it += NGW) {
        const int l = it / I_L; int r = it % I_L;
        if (r < I_IN) { const int kb = r / 88, db = r % 88; const int d0 = db * 64; const int sc0 = d0 < 512 ? d0 : d0 + 256;
            transpose_item(p.w_in + ((size_t)l * DM + kb * 64) * INW + sc0, INW, WinT + ((size_t)l * 6144 + d0) * DM + kb * 64, DM, scr, lane, d0 >= 1536 ? -1.4426950408889634f : 1.f); continue; }
        r -= I_IN;
        if (r < I_BR) { const int i = r >> 6, kb = (r >> 4) & 3, nb = r & 15;
            transpose_item(p.w_branch + (((size_t)l * 4 + i) * 256 + kb * 64) * DM + nb * 64, DM, WbT + ((size_t)l * DM + nb * 64) * DM + i * 256 + kb * 64, DM, scr, lane); continue; }
        r -= I_BR;
        { const int kb = r >> 4, nb = r & 15;
            transpose_item(p.w_out + ((size_t)l * DM + kb * 64) * DM + nb * 64, DM, WoT + ((size_t)l * DM + nb * 64) * DM + kb * 64, DM, scr, lane); }
    }
    __syncthreads();
}
__device__ __forceinline__ h16* wgu_of(const Params& p, int l) { return l == 0 ? (h16*)((unsigned char*)p.out + DO_WGU) : (h16*)(p.ws + WS_WGU1); }
__device__ __forceinline__ h16* wd_of(const Params& p, int l) { return (h16*)((unsigned char*)p.out + (l == 0 ? DO_WD : DO_WD1)); }
__device__ __forceinline__ void bg_convert(const Params& p, int l, float* lds, int budget, bool spread = false) {
    const int lane = tidx() & 63, wave = tidx() >> 6;
    float* scr = lds + wave * (64 * 65);
    h16* Wgu = wgu_of(p, l); h16* Wd = wd_of(p, l);
    const int x = spread ? ((bidx() >> 3) + (bidx() & 7)) & 7 : (bidx() & 7);
    unsigned* ctr = (unsigned*)(p.ws + WS_CTL) + 3072 + 64 * (l * 8 + x);
    constexpr int I_GU = 2 * 16 * 16, I_D = 16 * 16, I_E = I_GU + I_D, NIT = 16 * I_E, NPG = NIT / 8, BATCH = 4;
    __syncthreads();
    for (int n = 0; n < budget; ++n) {
        unsigned i0 = 0; if (lane == 0) i0 = __hip_atomic_fetch_add(ctr, (unsigned)BATCH, __ATOMIC_RELAXED, __HIP_MEMORY_SCOPE_AGENT);
        i0 = __builtin_amdgcn_readfirstlane(i0);
        if (i0 >= (unsigned)NPG) break;
        for (int q = 0; q < BATCH; ++q) { const int it = x * NPG + (int)i0 + q;
            const int e = it / I_E; int r = it % I_E;
            if (r < I_GU) { const int h = r >> 8, kb = (r >> 4) & 15, nb = r & 15; const int n0 = nb * 64; const int drow = (n0 >> 7) * 256 + h * 128 + (n0 & 127);
                const float* src = (h ? p.w_up : p.w_gate) + (((size_t)l * NEXP + e) * DM + kb * 64) * FF + n0;
                transpose_item<true>(src, FF, Wgu + ((size_t)e * 2048 + drow) * DM + kb * 64, DM, scr, lane); }
            else { r -= I_GU; const int kb = r >> 4, nb = r & 15;
                transpose_item<true>(p.w_down + (((size_t)l * NEXP + e) * FF + kb * 64) * DM + nb * 64, DM, Wd + ((size_t)e * DM + nb * 64) * FF + kb * 64, FF, scr, lane); } }
    }
    __syncthreads();
}

struct SchedG1 {
    const char* u16; const char* WinT; int l, c, G;
    __device__ __forceinline__ bool next(int i, fg::Unit& u) const {
        const int nsup_full = (l == 0) ? 36 : 32;
        const int L = (i * 8 + (c & 7)) * 32 + (c >> 3); const int s = L >> 5;
        if (s < nsup_full) { u.pm = s * 4 + ((L >> 3) & 3); u.pn = L & 7; }
        else { if (l == 0) return false; const int r = i - 4; if (r != 0 || c >= 48) return false; u.pm = 128 + c / 3; u.pn = 1 + 2 * (c % 3); }
        u.nt = 16; u.aux = 0;
        if (u.pn < 6) { u.A = u16 + (size_t)u.pm * 256 * DM * 2; u.B = WinT + (size_t)u.pn * 256 * DM * 2; }
        else { u.A = WinT + (size_t)(5632 + (u.pn - 6) * 256) * DM * 2; u.B = u16 + (size_t)u.pm * 256 * DM * 2; }
        return true;
    }
};
struct EpiG1 {
    static constexpr bool PERM = true;
    unsigned char* QI; unsigned char* KI; unsigned char* VI; h16* ZTL; h16* ZTC;
    const float* gain; const float* ropeC; const float* ropeS; FG_LAS float* xs; int lastlayer;
    __device__ __forceinline__ void operator()(const f32x4 (&acc)[2][2][4][2], const fg::Unit& u, int wr, int wc, int fr, int fq) const {
        if (u.pn < 6) {
            const int mixer = u.pn >> 1; const bool lat = u.pm < 128; const int b = lat ? (u.pm >> 3) : (u.pm - 128); const int tile0 = lat ? 4 + 4 * (u.pm & 7) : 0;
            const bool isq = (u.pn & 1) == 0; const int half = wc & 1; const int chunk = 4 * half + fq;
            const bool do_rms = (mixer == 0); const bool do_rope = lat && (mixer < 2);
            float rs[2][2][4];
            if (do_rms) {
#pragma unroll
                for (int bj = 0; bj < 2; ++bj)
#pragma unroll
                    for (int ai = 0; ai < 2; ++ai)
#pragma unroll
                        for (int m = 0; m < 4; ++m) { const f32x4 v0 = acc[ai][bj][m][0], v1 = acc[ai][bj][m][1];
                            float ss = (v0[0] * v0[0] + v0[1] * v0[1]) + (v0[2] * v0[2] + v0[3] * v0[3]) + (v1[0] * v1[0] + v1[1] * v1[1]) + (v1[2] * v1[2] + v1[3] * v1[3]);
                            ss = xor16_sum(ss); ss = xor32_sum(ss); rs[bj][ai][m] = ss;
                            if (fq == 0) xs[(half * 256 + 128 * ai + 64 * wr + 16 * m + fr) * 4 + 2 * bj + (wc >> 1)] = ss; }
                asm volatile("s_waitcnt lgkmcnt(0)" ::: "memory"); __builtin_amdgcn_s_barrier(); asm volatile("" ::: "memory");
#pragma unroll
                for (int bj = 0; bj < 2; ++bj)
#pragma unroll
                    for (int ai = 0; ai < 2; ++ai)
#pragma unroll
                        for (int m = 0; m < 4; ++m) { const float so = xs[((half ^ 1) * 256 + 128 * ai + 64 * wr + 16 * m + fr) * 4 + 2 * bj + (wc >> 1)];
                            rs[bj][ai][m] = rsqrtf((rs[bj][ai][m] + so) * (1.f / 64.f) + RMS_EPS); }
            }
            f32x4 g0 = {1.f, 1.f, 1.f, 1.f}, g1 = {1.f, 1.f, 1.f, 1.f};
            if (do_rms) { const float* gp = gain + (isq ? 0 : 64) + chunk * 8; g0 = *(const f32x4*)gp; g1 = *(const f32x4*)(gp + 4); }
            const int j0 = (fq & 1) * 8;
            const bool upper = (fq & 2) != 0;
            auto body = [&](auto HC) {
                constexpr bool H1 = decltype(HC)::value;
#pragma unroll
                for (int mh = 0; mh < 2; ++mh) {
                    f32x4 tc0[2], tc1[2], ts0[2], ts1[2];
                    if (do_rope) {
#pragma unroll
                        for (int k = 0; k < 2; ++k) { const int pos = H1 ? (16 * (2 * mh + k) + fr) : (4 * (u.pm & 7) + 2 * k + wr);
                            tc0[k] = *(const f32x4*)(ropeC + pos * 16 + j0); tc1[k] = *(const f32x4*)(ropeC + pos * 16 + j0 + 4); ts0[k] = *(const f32x4*)(ropeS + pos * 16 + j0); ts1[k] = *(const f32x4*)(ropeS + pos * 16 + j0 + 4); }
                        asm volatile("" ::: "memory"); }
#pragma unroll
                    for (int bj = 0; bj < 2; ++bj) { const int hh = 2 * bj + (wc >> 1);
                        const bool isv = !isq && bj == 1; const bool proc = !isv && (isq || mixer < 2);
                        unsigned char* base; int rstride;
                        if (isq) { base = QI + ((size_t)((mixer * 16 + b) * 4 + hh) * 36 + tile0) * 8192 + chunk * 1024; rstride = 16; }
                        else if (bj == 0) { base = KI + ((size_t)((mixer * 16 + b) * 2 + hh) * 36 + tile0) * 8192 + chunk * 1024; rstride = 16; }
                        else { base = VI + ((size_t)((mixer * 16 + b) * 2 + (hh - 2)) * 36 + tile0) * 8192 + half * 4096 + fq * 16; rstride = 64; }
#pragma unroll
                        for (int ai = 0; ai < 2; ++ai)
#pragma unroll
                            for (int mm = 0; mm < 2; ++mm) { const int m = 2 * mh + mm; f32x4 v0 = acc[ai][bj][m][0], v1 = acc[ai][bj][m][1];
                                if (proc) {
                                    if (do_rms) { const float r_ = rs[bj][ai][m]; v0 = v0 * r_ * g0; v1 = v1 * r_ * g1; }
                                    if (do_rope) { const int k = H1 ? mm : ai;
                                        const f32x4 c0 = tc0[k], c1 = tc1[k], s0 = ts0[k], s1 = ts1[k];
                                        f32x4 p0, p1;
#pragma unroll
                                        for (int e = 0; e < 4; ++e) { const auto r0 = __builtin_amdgcn_permlane32_swap(__float_as_uint(v0[e]), __float_as_uint(v0[e]), false, false); p0[e] = __uint_as_float(upper ? r0[0] : r0[1]);
                                            const auto r1 = __builtin_amdgcn_permlane32_swap(__float_as_uint(v1[e]), __float_as_uint(v1[e]), false, false); p1[e] = __uint_as_float(upper ? r1[0] : r1[1]); }
                                        if (upper) { v0 = p0 * s0 + v0 * c0; v1 = p1 * s1 + v1 * c1; } else { v0 = v0 * c0 - p0 * s0; v1 = v1 * c1 - p1 * s1; } }
                                    if (isq) { v0 = v0 * QSCALE; v1 = v1 * QSCALE; } }
                                *(u32x4*)(base + (size_t)(2 * ai + wr) * 8192 + (16 * m + fr) * rstride) = (u32x4){pk_h2(v0[0], v0[1]), pk_h2(v0[2], v0[3]), pk_h2(v1[0], v1[1]), pk_h2(v1[2], v1[3])}; } }
                }
            };
            if (half) body(std::true_type{}); else body(std::false_type{});
            __builtin_amdgcn_s_waitcnt(0x0F70);
        } else {
            const int R0 = u.pm * 256 + 32 * wc + 8 * fq;
            h16* zb; size_t pitch; int cstride;
            if (R0 < TL) { const int b = R0 >> 11; zb = ZTL + (size_t)b * 256 * 4096 + (R0 & 2047); pitch = 4096; cstride = 2048; }
            else { const int rr = R0 - TL; const int b = rr >> 8; zb = ZTC + (size_t)b * 256 * 512 + (rr & 255); pitch = 512; cstride = 256; }
#pragma unroll
            for (int ai = 0; ai < 2; ++ai)
#pragma unroll
                for (int m = 0; m < 4; ++m) { const int zc = (u.pn - 6) * 256 + 128 * ai + 64 * wr + 16 * m + fr; const int g = zc >> 7, cs = (zc >> 6) & 1, mm = zc & 63;
                    h16* rowp = zb + (size_t)(g * 64 + mm) * pitch + cs * cstride;
#pragma unroll
                    for (int bj = 0; bj < 2; ++bj) { const f32x4 v0 = acc[ai][bj][m][0], v1 = acc[ai][bj][m][1];
                        *(u32x4*)(rowp + 128 * bj) = (u32x4){pk_h2(v0[0], v0[1]), pk_h2(v0[2], v0[3]), pk_h2(v1[0], v1[1]), pk_h2(v1[2], v1[3])}; } }
        }
    }
};
__device__ __forceinline__ void phase_g1_fast(const Params& p, int l, ldsp_t lds) {
    SchedG1 S{(const char*)(p.ws + WS_U16), (const char*)(p.ws + WS_WINT) + (size_t)l * 6144 * DM * 2, l, (int)bidx(), (int)gridDim.x};
    const float* tab = (const float*)(p.ws + WS_TAB);
    EpiG1 E{p.ws + WS_QI, p.ws + WS_KI, p.ws + WS_VI, (h16*)(p.ws + WS_ZTL), (h16*)(p.ws + WS_ZTC), p.qk_gain + l * 128, tab + 4096, tab + 4096 + 1024, (FG_LAS float*)(lds + 131072), l == DEPTH - 1};
    fg::gemm_phase<EpiG1, SchedG1, DM>(lds, S, E);
}

struct SchedOut {
    const char* A; const char* B; int l, c;
    __device__ __forceinline__ bool next(int i, fg::Unit& u) const {
        const int nsup = (l == 0) ? 18 : 16;
        const int L = (i * 8 + (c & 7)) * 32 + (c >> 3); const int s = L >> 5; if (s >= nsup) return false;
        u.pm = s * 8 + ((L >> 2) & 7); u.pn = L & 3; u.nt = 16; u.aux = 0;
        u.A = A + (size_t)u.pm * 256 * DM * 2; u.B = B + (size_t)u.pn * 256 * DM * 2; return true;
    }
};
struct EpiOut {
    static constexpr bool PERM = false;
    const float* x; const float* ctx; float* hB; const float* modv; int l;
    __device__ __forceinline__ void operator()(const f32x4 (&acc)[2][2][4][2], const fg::Unit& u, int wr, int wc, int fr, int fq) const {
        const int mv = u.pm < 128 ? (u.pm >> 3) : 16; const float* g1p = modv + (size_t)mv * NMOD + 2 * DM;
        const int R0 = u.pm * 256 + 64 * wr + fr; const int c0 = u.pn * 256 + 32 * wc + 4 * fq;
        const float* hbase = (l == 0 ? (R0 < TL ? x + (size_t)R0 * DM : ctx + (size_t)(R0 - TL) * DM) : hB + (size_t)R0 * DM) + c0;
        float* obase = hB + (size_t)R0 * DM + c0;
        f32x4 g1[2][2];
#pragma unroll
        for (int bj = 0; bj < 2; ++bj)
#pragma unroll
            for (int n = 0; n < 2; ++n) g1[bj][n] = *(const f32x4*)(g1p + c0 + 128 * bj + 16 * n);
#pragma unroll
        for (int ai = 0; ai < 2; ++ai) {
            f32x4 hv[4][2][2];
#pragma unroll
            for (int m = 0; m < 4; ++m)
#pragma unroll
                for (int bj = 0; bj < 2; ++bj)
#pragma unroll
                    for (int n = 0; n < 2; ++n) hv[m][bj][n] = *(const f32x4*)(hbase + (size_t)(128 * ai + 16 * m) * DM + 128 * bj + 16 * n);
            asm volatile("" ::: "memory");
#pragma unroll
            for (int m = 0; m < 4; ++m)
#pragma unroll
                for (int bj = 0; bj < 2; ++bj)
#pragma unroll
                    for (int n = 0; n < 2; ++n) *(f32x4*)(obase + (size_t)(128 * ai + 16 * m) * DM + 128 * bj + 16 * n) = ALPHA * hv[m][bj][n] + g1[bj][n] * acc[ai][bj][m][n];
            asm volatile("" ::: "memory");
        }
    }
};
__device__ __forceinline__ void phase_out_fast(const Params& p, int l, ldsp_t lds) {
    SchedOut S{(const char*)(p.ws + WS_PM), (const char*)(p.ws + WS_WOT) + (size_t)l * DM * DM * 2, l, (int)bidx()};
    EpiOut E{p.x, p.ctx, (float*)(p.ws + WS_HB), (const float*)(p.ws + WS_MODV) + (size_t)l * 17 * NMOD, l};
    fg::gemm_phase<EpiOut, SchedOut, DM>(lds, S, E);
}

__device__ __forceinline__ int expert_of_rtile(int rt) { return rt < 256 ? (rt & 15) : ((rt - 256) >> 1); }
struct SchedUp {
    const char* u16; const char* Wgu; const int* selrow; int l, c;
    __device__ __forceinline__ bool next(int i, fg::Unit& u) const {
        const int nsup = (l == 0) ? 72 : 64;
        const int L = (i * 8 + (c & 7)) * 32 + (c >> 3); const int s = L >> 5; if (s >= nsup) return false;
        const int o = s * 4 + ((L >> 3) & 3); const int rt = o < 256 ? ((o & 15) * 16 + (o >> 4)) : o;
        u.pm = rt; u.pn = L & 7; u.nt = 16; u.aux = expert_of_rtile(rt);
        u.A = u16; u.rows = selrow + rt * 256; u.B = Wgu + ((size_t)u.aux * 2048 + u.pn * 256) * DM * 2; return true;
    }
};
struct EpiUp {
    static constexpr bool PERM = true;
    h16* H;
    __device__ __forceinline__ void operator()(const f32x4 (&acc)[2][2][4][2], const fg::Unit& u, int wr, int wc, int fr, int fq) const {
#pragma unroll
        for (int ai = 0; ai < 2; ++ai)
#pragma unroll
            for (int m = 0; m < 4; ++m) { const int R = u.pm * 256 + 128 * ai + 64 * wr + 16 * m + fr; const int col = u.pn * 128 + 32 * wc + 8 * fq; float o[8];
#pragma unroll
                for (int n = 0; n < 2; ++n)
#pragma unroll
                    for (int j = 0; j < 4; ++j) o[n * 4 + j] = silu_f(acc[ai][0][m][n][j]) * acc[ai][1][m][n][j];
                *(u32x4*)(H + (size_t)R * FF + col) = (u32x4){pk_b2(o[0], o[1]), pk_b2(o[2], o[3]), pk_b2(o[4], o[5]), pk_b2(o[6], o[7])}; }
    }
};
__device__ __forceinline__ void phase_up_fast(const Params& p, int l, ldsp_t lds) {
    SchedUp S{(const char*)(p.ws + WS_U16), (const char*)wgu_of(p, l), (const int*)(p.ws + WS_SELR), l, (int)bidx()};
    EpiUp E{(h16*)(p.ws + WS_H16)};
    fg::gemm_phase<EpiUp, SchedUp, DM, true, true>(lds, S, E);
}
struct SchedDown {
    const char* H; const char* Wd; int l, c;
    __device__ __forceinline__ bool next(int i, fg::Unit& u) const {
        const int nsup = (l == 0) ? 36 : 32;
        const int L = (i * 8 + (c & 7)) * 32 + (c >> 3); const int s = L >> 5; if (s >= nsup) return false;
        const int o = s * 8 + ((L >> 2) & 7); const int rt = o < 256 ? ((o & 15) * 16 + (o >> 4)) : o;
        u.pm = rt; u.pn = L & 3; u.nt = 16; u.aux = expert_of_rtile(rt);
        u.A = H + (size_t)rt * 256 * FF * 2; u.B = Wd + ((size_t)u.aux * DM + u.pn * 256) * FF * 2; return true;
    }
};
struct EpiDown {
    static constexpr bool PERM = true;
    h16* Y; const float* selw;
    __device__ __forceinline__ void operator()(const f32x4 (&acc)[2][2][4][2], const fg::Unit& u, int wr, int wc, int fr, int fq) const {
        const int R0 = u.pm * 256 + 64 * wr + fr;
        float w[2][4];
#pragma unroll
        for (int ai = 0; ai < 2; ++ai)
#pragma unroll
            for (int m = 0; m < 4; ++m) w[ai][m] = selw[R0 + 128 * ai + 16 * m];
        asm volatile("" ::: "memory");
        h16* base = Y + (size_t)R0 * DM + u.pn * 256 + 32 * wc + 8 * fq;
#pragma unroll
        for (int ai = 0; ai < 2; ++ai)
#pragma unroll
            for (int m = 0; m < 4; ++m)
#pragma unroll
                for (int bj = 0; bj < 2; ++bj) { const f32x4 v0 = acc[ai][bj][m][0] * w[ai][m], v1 = acc[ai][bj][m][1] * w[ai][m];
                    *(u32x4*)(base + (size_t)(128 * ai + 16 * m) * DM + 128 * bj) = (u32x4){pk_h2(v0[0], v0[1]), pk_h2(v0[2], v0[3]), pk_h2(v1[0], v1[1]), pk_h2(v1[2], v1[3])}; }
    }
};
__device__ __forceinline__ void phase_down_fast(const Params& p, int l, ldsp_t lds) {
    SchedDown S{(const char*)(p.ws + WS_H16), (const char*)wd_of(p, l), l, (int)bidx()};
    EpiDown E{(h16*)(p.ws + WS_XG), (const float*)(p.ws + WS_SELW)};
    fg::gemm_phase<EpiDown, SchedDown, DM, true>(lds, S, E);
}


struct SchedMerge {
    const char* u16; const char* br; const char* WinT; const char* WbT; int l, c, i0, i1;
    __device__ __forceinline__ bool next(int i, fg::Unit& u) const {
        i += i0; if (i >= i1) return false;
        int ib, sub;
        if (i < 16) { const int ti = i >> 3; sub = i & 7; ib = sub >> 1;
            const int L = (ti * 8 + (c & 7)) * 32 + (c >> 3); const int s = L >> 5;
            u.pm = s * 8 + ((L >> 2) & 7); u.pn = L & 3; u.aux = sub; }
        else { if (l != 0 || i >= 18) return false; const int tct = c >> 2; ib = c & 3; sub = 2 * ib + (i & 1);
            u.pm = 128 + (tct >> 2); u.pn = tct & 3; u.aux = sub | 8; }
        if ((sub & 1) == 0) { u.nt = 16; u.A = u16 + (size_t)u.pm * 256 * DM * 2; u.B = WinT + (size_t)(1536 + ib * 1024 + u.pn * 256) * DM * 2; }
        else { u.nt = 4; u.A = br + (size_t)u.pm * 256 * DM * 2 + ib * 512; u.B = WbT + (size_t)u.pn * 256 * DM * 2 + ib * 512; }
        return true;
    }
};
struct EpiMerge {
    static constexpr bool PERM = true;
    h16* mg; h16* part; unsigned char* scr;
    __device__ __forceinline__ void operator()(const f32x4 (&acc)[2][2][4][2], const fg::Unit& u, int wr, int wc, int fr, int fq) const {
        const int tid = tidx();
        if ((u.aux & 1) == 0) {
#pragma unroll
            for (int ai = 0; ai < 2; ++ai)
#pragma unroll
                for (int m = 0; m < 4; ++m)
#pragma unroll
                    for (int bj = 0; bj < 2; ++bj) { const int q = (ai * 4 + m) * 2 + bj; const f32x4 v0 = acc[ai][bj][m][0], v1 = acc[ai][bj][m][1];
                        *(u32x4*)(scr + ((size_t)q * 512 + tid) * 16) = (u32x4){pk_h2(sig2_f(v0[0]), sig2_f(v0[1])), pk_h2(sig2_f(v0[2]), sig2_f(v0[3])), pk_h2(sig2_f(v1[0]), sig2_f(v1[1])), pk_h2(sig2_f(v1[2]), sig2_f(v1[3]))}; }
        } else {
            const bool partial = (u.aux & 8) != 0; const bool first = partial || ((u.aux & 7) == 1);
            h16* base = partial ? part + ((size_t)((u.aux & 7) >> 1) * TC + (size_t)(u.pm - 128) * 256) * DM : mg + (size_t)u.pm * 256 * DM;
            base += (size_t)(64 * wr + fr) * DM + u.pn * 256 + 32 * wc + 8 * fq;
#pragma unroll
            for (int ai = 0; ai < 2; ++ai) {
                h16x8 gv[8], pr[8];
#pragma unroll
                for (int m = 0; m < 4; ++m)
#pragma unroll
                    for (int bj = 0; bj < 2; ++bj) { const int q = (ai * 4 + m) * 2 + bj; gv[m * 2 + bj] = *(const h16x8*)(scr + ((size_t)q * 512 + tid) * 16);
                        if (!first) pr[m * 2 + bj] = *(const h16x8*)(base + (size_t)(128 * ai + 16 * m) * DM + 128 * bj); }
                asm volatile("" ::: "memory");
#pragma unroll
                for (int m = 0; m < 4; ++m)
#pragma unroll
                    for (int bj = 0; bj < 2; ++bj) { const h16x8 g = gv[m * 2 + bj]; const f32x4 v0 = acc[ai][bj][m][0], v1 = acc[ai][bj][m][1];
                        float o[8] = {(float)g[0] * v0[0], (float)g[1] * v0[1], (float)g[2] * v0[2], (float)g[3] * v0[3], (float)g[4] * v1[0], (float)g[5] * v1[1], (float)g[6] * v1[2], (float)g[7] * v1[3]};
                        if (!first) { const h16x8 pp = pr[m * 2 + bj];
#pragma unroll
                            for (int e = 0; e < 8; ++e) o[e] += (float)pp[e]; }
                        *(u32x4*)(base + (size_t)(128 * ai + 16 * m) * DM + 128 * bj) = (u32x4){pk_h2(o[0], o[1]), pk_h2(o[2], o[3]), pk_h2(o[4], o[5]), pk_h2(o[6], o[7])}; }
                asm volatile("" ::: "memory");
            }
        }
    }
};
__device__ __forceinline__ void phase_merge_fast(const Params& p, int l, ldsp_t lds, int i0, int i1) {
    SchedMerge S{(const char*)(p.ws + WS_U16), (const char*)(p.ws + WS_BR), (const char*)(p.ws + WS_WINT) + (size_t)l * 6144 * DM * 2, (const char*)(p.ws + WS_WBT) + (size_t)l * DM * DM * 2, l, bidx(), i0, i1};
    EpiMerge E{(h16*)(p.ws + WS_PM), (h16*)(p.ws + WS_MPART), (l == 0 ? p.ws + WS_WGU1 : (unsigned char*)p.out + DO_WGU) + (size_t)bidx() * 131072};
    fg::gemm_phase<EpiMerge, SchedMerge, DM>(lds, S, E);
}
__device__ __forceinline__ void phase_merge_sum(const Params& p) {
    const h16* part = (const h16*)(p.ws + WS_MPART); h16* mg = (h16*)(p.ws + WS_PM) + (size_t)TL * DM;
    const int gt = bidx() * NTHREADS + tidx(), NG = gridDim.x * NTHREADS;
    for (int o = gt; o < TC * DM / 8; o += NG) { float acc[8];
#pragma unroll
        for (int e = 0; e < 8; ++e) acc[e] = 0.f;
#pragma unroll
        for (int i = 0; i < 4; ++i) { const h16x8 v = *(const h16x8*)(part + (size_t)i * TC * DM + (size_t)o * 8);
#pragma unroll
            for (int e = 0; e < 8; ++e) acc[e] += (float)v[e]; }
        *(u32x4*)(mg + (size_t)o * 8) = (u32x4){pk_h2(acc[0], acc[1]), pk_h2(acc[2], acc[3]), pk_h2(acc[4], acc[5]), pk_h2(acc[6], acc[7])}; }
}

struct EpiDft {
    static constexpr bool PERM = true;
    h16* br; int row0, rows_per_b; float scl;
    __device__ __forceinline__ void operator()(const f32x4 (&acc)[2][2][4][2], const fg::Unit& u, int wr, int wc, int fr, int fq) const {
#pragma unroll
        for (int ai = 0; ai < 2; ++ai)
#pragma unroll
            for (int m = 0; m < 4; ++m) { const int kr = u.pm * 256 + 128 * ai + 64 * wr + 16 * m + fr; const size_t R = (size_t)row0 + (size_t)u.pn * rows_per_b + kr;
#pragma unroll
                for (int bj = 0; bj < 2; ++bj) { const int col = 128 * bj + 32 * wc + 8 * fq; const f32x4 v0 = acc[ai][bj][m][0] * scl, v1 = acc[ai][bj][m][1] * scl;
                    *(u32x4*)(br + R * DM + 256 + col) = (u32x4){pk_h2(v0[0], v0[1]), pk_h2(v0[2], v0[3]), pk_h2(v1[0], v1[1]), pk_h2(v1[2], v1[3])}; } }
    }
};

namespace fa {
typedef float f32x16 __attribute__((ext_vector_type(16)));
typedef short v4i16_t __attribute__((ext_vector_type(4)));
typedef short s16x4 __attribute__((ext_vector_type(4)));
constexpr float LOG2E = 1.4426950408889634f;
constexpr int NSLOT = 3, SLOTB = 8192;
constexpr int LDS_K = 0, LDS_V = NSLOT * SLOTB, LDS_WS = 2 * NSLOT * SLOTB, LDS_OST = LDS_WS + 8 * 64 * 4, LDS_RPB = LDS_OST + 8 * 4096;
__device__ __forceinline__ int crow(int r, int hi) { return (r & 3) + 8 * (r >> 2) + 4 * hi; }
#define SBAR() __builtin_amdgcn_sched_barrier(0)
__device__ __forceinline__ void glds16(const void* gsrc, unsigned lds_dst) { unsigned keep;
    asm volatile("s_mov_b32 %0, m0\n\ts_mov_b32 m0, %2\n\ts_nop 0\n\tglobal_load_lds_dwordx4 %1, off\n\ts_mov_b32 m0, %0" : "=&s"(keep) : "v"(gsrc), "s"(lds_dst) : "memory"); }
__device__ __forceinline__ float max3f(float a, float b, float c) { float r; asm("v_max3_f32 %0, %1, %2, %3" : "=v"(r) : "v"(a), "v"(b), "v"(c)); return r; }
__device__ __forceinline__ float max2f(float a, float b) { float r; asm("v_max_f32_e32 %0, %1, %2" : "=v"(r) : "v"(a), "v"(b)); return r; }
__device__ __forceinline__ float fadd_s(float a, float b) { float r; asm("v_add_f32_e32 %0, %1, %2" : "=v"(r) : "v"(a), "v"(b)); return r; }
__device__ __forceinline__ float fsub_s(float a, float b) { float r; asm("v_sub_f32_e32 %0, %1, %2" : "=v"(r) : "v"(a), "v"(b)); return r; }
#define WAIT_BAR(N) asm volatile("s_waitcnt vmcnt(" #N ") lgkmcnt(0)\n\ts_barrier" ::: "memory")
typedef __attribute__((address_space(3))) const char* lds_cptr;
__device__ __forceinline__ void kload8(h16x8* kf, lds_cptr kp) {
    kf[0] = *(const FG_LAS h16x8*)(kp);        kf[1] = *(const FG_LAS h16x8*)(kp + 512);
    kf[2] = *(const FG_LAS h16x8*)(kp + 2048); kf[3] = *(const FG_LAS h16x8*)(kp + 2560);
    kf[4] = *(const FG_LAS h16x8*)(kp + 4096); kf[5] = *(const FG_LAS h16x8*)(kp + 4608);
    kf[6] = *(const FG_LAS h16x8*)(kp + 6144); kf[7] = *(const FG_LAS h16x8*)(kp + 6656);
}
__device__ __forceinline__ void kload2(h16x8* kf, lds_cptr kp, int j) { kf[2 * j] = *(const FG_LAS h16x8*)(kp + j * 2048); kf[2 * j + 1] = *(const FG_LAS h16x8*)(kp + j * 2048 + 512); }
__device__ __forceinline__ s16x4 vtr(lds_cptr p) { return __builtin_bit_cast(s16x4, __builtin_amdgcn_ds_read_tr16_b64_v4i16((FG_LAS v4i16_t*)p)); }
__device__ __forceinline__ void qkt(f32x16& p0, f32x16& p1, lds_cptr Kslot, const h16x8* qr, const f32x16& negm, int r32, int hi) {
    lds_cptr kb = Kslot + hi * 1024 + r32 * 16;
#pragma unroll
    for (int d0 = 0; d0 < 4; ++d0) {
        const h16x8 b0 = *(const FG_LAS h16x8*)(kb + d0 * 2048), b1 = *(const FG_LAS h16x8*)(kb + d0 * 2048 + 512);
        if (d0 == 0) { p0 = __builtin_amdgcn_mfma_f32_32x32x16_f16(b0, qr[0], negm, 0, 0, 0); p1 = __builtin_amdgcn_mfma_f32_32x32x16_f16(b1, qr[0], negm, 0, 0, 0); }
        else { p0 = __builtin_amdgcn_mfma_f32_32x32x16_f16(b0, qr[d0], p0, 0, 0, 0); p1 = __builtin_amdgcn_mfma_f32_32x32x16_f16(b1, qr[d0], p1, 0, 0, 0); } }
}
__device__ __forceinline__ float rowmax(const f32x16& p0, const f32x16& p1) {
    float a = max3f(p0[0], p0[1], p1[0]), b = max3f(p0[2], p0[3], p1[1]); a = max3f(a, p1[2], p1[3]);
#pragma unroll
    for (int r = 4; r < 16; r += 4) { a = max3f(a, p0[r], p0[r + 1]); b = max3f(b, p0[r + 2], p0[r + 3]); a = max3f(a, p1[r], p1[r + 1]); b = max3f(b, p1[r + 2], p1[r + 3]); }
    const float m = max2f(a, b);
    auto rr = __builtin_amdgcn_permlane32_swap(__float_as_uint(m), __float_as_uint(m), false, false);
    return max2f(__uint_as_float(rr[0]), __uint_as_float(rr[1]));
}
__device__ __forceinline__ void pv(f32x16* o, lds_cptr vb, h16x8 pa0, h16x8 pa1, h16x8 pa2, h16x8 pa3) {
    typedef short s8 __attribute__((ext_vector_type(8)));
#pragma unroll
    for (int d0 = 0; d0 < 2; ++d0) { s16x4 lo[4], hh[4];
#pragma unroll
        for (int ks = 0; ks < 4; ++ks) { lo[ks] = vtr(vb + d0 * 4096 + ks * 1024); hh[ks] = vtr(vb + d0 * 4096 + ks * 1024 + 512); }
#define PKV(k) __builtin_bit_cast(h16x8, (s8){lo[k][0], lo[k][1], lo[k][2], lo[k][3], hh[k][0], hh[k][1], hh[k][2], hh[k][3]})
        o[d0] = __builtin_amdgcn_mfma_f32_32x32x16_f16(pa0, PKV(0), o[d0], 0, 0, 0);
        o[d0] = __builtin_amdgcn_mfma_f32_32x32x16_f16(pa1, PKV(1), o[d0], 0, 0, 0);
        o[d0] = __builtin_amdgcn_mfma_f32_32x32x16_f16(pa2, PKV(2), o[d0], 0, 0, 0);
        o[d0] = __builtin_amdgcn_mfma_f32_32x32x16_f16(pa3, PKV(3), o[d0], 0, 0, 0);
#undef PKV
    }
}
template <int MIXER, int THRL>
__device__ __forceinline__ void attn_unit(const unsigned char* QI, const unsigned char* KI, const unsigned char* VI, h16* br, const float* sinkp, const float* rpb, int mixer, int b, int kvh, int qb, bool isctx, ldsp_t lds, unsigned* qctr, volatile FG_LAS unsigned* qw) {
    const int tid = tidx(), lane = tid & 63, wid = __builtin_amdgcn_readfirstlane(tid >> 6), r32 = lane & 31, hi = lane >> 5, g = wid >> 2, qsub = wid & 3, hq = kvh * 2 + g;
    const int brcol = (mixer == 0 ? 0 : mixer == 1 ? 512 : 768) + hq * 64;
    const int q0 = (isctx ? TL + b * 256 + qb * 128 : b * 2048 + qb * 128) + qsub * 32;
    int jlo = 0, nlat = 0;
    if (!isctx) {
        if (MIXER == 0) { jlo = 0; nlat = 32; }
        else if (MIXER == 1) { jlo = max(0, 2 * qb - 2); nlat = min(31, 2 * qb + 3) - jlo + 1; }
        else { jlo = min(max(2 * qb - 4, 0), 24); nlat = min(max(2 * qb - 3, 0), 24) + 7 - jlo + 1; }
    }
    const int nreal = 4 + nlat; const int NT = (nreal + 1) & ~1;
#define FA_TILE(s) ((s) < 4 ? (s) : 4 + jlo + min((s), nreal - 1) - 4)
    const unsigned lds0 = (unsigned)(size_t)lds;
    FG_LAS float* wsf = (FG_LAS float*)(lds + LDS_WS) + wid * 64;
    const unsigned char* ksrc = KI + ((size_t)((mixer * 16 + b) * 2 + kvh) * 36) * 8192 + wid * 1024 + lane * 16;
    const unsigned char* vsrc = VI + ((size_t)((mixer * 16 + b) * 2 + kvh) * 36) * 8192 + wid * 1024 + lane * 16;
    const unsigned kdst = lds0 + LDS_K + wid * 1024, vdst = lds0 + LDS_V + wid * 1024;
#define DMA_K(t, slot) glds16(ksrc + (size_t)FA_TILE(t) * 8192, (unsigned)__builtin_amdgcn_readfirstlane(kdst + (slot)))
#define DMA_V(t, slot) glds16(vsrc + (size_t)FA_TILE(t) * 8192, (unsigned)__builtin_amdgcn_readfirstlane(vdst + (slot)))
    h16x8 kf[8];
    const lds_cptr shm3 = (lds_cptr)lds; const lds_cptr kp0 = shm3 + LDS_K + hi * 1024 + r32 * 16;
    const lds_cptr vp0 = shm3 + LDS_V + ((lane >> 4) & 1) * 32 + (lane & 3) * 8 + (4 * hi + ((lane & 15) >> 2)) * 64;
    DMA_K(0, 0); DMA_V(0, 0); DMA_K(1, SLOTB);
    if (MIXER == 2) { FG_LAS float* tb = (FG_LAS float*)(lds + LDS_RPB); for (int i = tid; i < 930; i += NTHREADS) tb[i] = rpb[(size_t)(kvh * 2) * 465 + i] * LOG2E; }
    h16x8 qr[4];
    { const int qtile = (isctx ? 0 : 4) + 2 * qb + (qsub >> 1);
      const unsigned char* qp = QI + (((size_t)((mixer * 16 + b) * 4 + hq) * 36) + qtile) * 8192 + hi * 1024 + ((qsub & 1) * 32 + r32) * 16;
#pragma unroll
      for (int d0 = 0; d0 < 4; ++d0) qr[d0] = *(const h16x8*)(qp + d0 * 2048); }
    float mhat = 0.f, l_reg = 0.f; f32x16 o[2]; o[0] = f32x16{}; o[1] = f32x16{}; f32x16 negm = f32x16{}; asm volatile("" : "+v"(negm));
    const int tq = qb * 128 + qsub * 32 + r32;
    const int qrow = 2 * qb + (qsub >> 1);
    const int qcl = tq & 63; const int r0w = min(max(qrow - 4, 0), 24), c0q = min(max(qcl - 8, 0), 48);
#define CMASK(P0, P1, s) do { if (MIXER != 0 && (s) >= 4) { const float NEGI = -INFINITY; const int j_ = jlo + (s) - 4; \
        if ((s) >= nreal) { _Pragma("unroll") for (int r = 0; r < 16; ++r) { P0[r] = NEGI; P1[r] = NEGI; } } \
        else if (MIXER == 1) { const int dt = tq - 64 * j_; \
            _Pragma("unroll") for (int r = 0; r < 16; ++r) { const int kk = crow(r, hi); P0[r] = ((unsigned)(kk - dt + 128) <= 256u) ? P0[r] : NEGI; P1[r] = ((unsigned)(kk + 32 - dt + 128) <= 256u) ? P1[r] : NEGI; } } \
        else { const bool rowok = (j_ >= r0w) && (j_ <= r0w + 7); const int jr_ = rowok ? j_ : r0w; \
            const FG_LAS float* tb = (const FG_LAS float*)(lds + LDS_RPB) + g * 465 + (jr_ - qrow + 7) * 31 + (15 - qcl); \
            _Pragma("unroll") for (int r = 0; r < 16; ++r) { const int kc = crow(r, hi); \
                { const bool ok = rowok && ((unsigned)(kc - c0q) < 16u); const float bv = tb[ok ? kc : qcl]; P0[r] = ok ? P0[r] + bv : NEGI; } \
                { const int kc1 = kc + 32; const bool ok = rowok && ((unsigned)(kc1 - c0q) < 16u); const float bv = tb[ok ? kc1 : qcl]; P1[r] = ok ? P1[r] + bv : NEGI; } } } } } while (0)
    bool resc = false;
#define START(P0, P1) do { const float rm = rowmax(P0, P1); resc = false; \
    { const float dl = rm; mhat = fadd_s(mhat, dl); \
      _Pragma("unroll") for (int r = 0; r < 16; ++r) { P0[r] = fsub_s(P0[r], dl); P1[r] = fsub_s(P1[r], dl); } \
      _Pragma("unroll") for (int r = 0; r < 16; ++r) negm[r] = -mhat; asm volatile("" : "+v"(negm)); } \
    _Pragma("unroll") for (int r = 0; r < 16; ++r) P0[r] = __builtin_amdgcn_exp2f(P0[r]); } while (0)
#define RESC() do { if (resc) { asm volatile("s_waitcnt lgkmcnt(0)" ::: "memory"); \
      _Pragma("unroll") for (int d_ = 0; d_ < 2; ++d_) _Pragma("unroll") for (int r = 0; r < 16; ++r) o[d_][r] *= wsf[crow(r, hi)]; } } while (0)
    f32x16 pA0, pA1, pB0, pB1;
    int sl_prev = 0, sl_cur = 0, sl_next = SLOTB;
#define ROT() do { sl_prev = sl_cur; sl_cur = sl_next; sl_next = (sl_next == (NSLOT - 1) * SLOTB) ? 0 : sl_next + SLOTB; } while (0)
    DMA_K(2, 2 * SLOTB);
    WAIT_BAR(3);
    qkt(pA0, pA1, shm3 + LDS_K, qr, negm, r32, hi); asm volatile("s_nop 15\n\ts_nop 7" : "+v"(pA0), "+v"(pA1));
    START(pA0, pA1);
#pragma unroll
    for (int r = 0; r < 16; ++r) pA1[r] = __builtin_amdgcn_exp2f(pA1[r]);
    WAIT_BAR(0);
    DMA_K(3, 0); DMA_V(1, SLOTB);
    ROT();
    kload8(kf, kp0 + sl_cur);
    WAIT_BAR(2);
    s16x4 vlo[8], vhi[8]; u32x4 pw0, pw1, pw2, pw3;
    typedef short s8v __attribute__((ext_vector_type(8)));
#define PKW(P, B) pk_h2(P[B], P[B + 1])
#define PAF(k) __builtin_bit_cast(h16x8, pw##k)
#define VFR(i) __builtin_bit_cast(h16x8, (s8v){vlo[i][0], vlo[i][1], vlo[i][2], vlo[i][3], vhi[i][0], vhi[i][1], vhi[i][2], vhi[i][3]})
#define PIN(x) asm volatile("" : "+v"(x))
#define MX3(a, b, c) __builtin_fmaxf(__builtin_fmaxf((a), (b)), (c))
#define GAPA(MF, A0, A1, A2, A3, W0, W1, PW) do { MF; sacc += A0; sacc += A1; sacc += A2; sacc += A3; PIN(sacc); W0; W1; PIN(PW); SBAR(); } while (0)
#define EX(v) __builtin_amdgcn_exp2f(v)
#define GAPB(MF, X, B) do { MF; X[B] = EX(X[B]); X[B + 1] = EX(X[B + 1]); X[B + 2] = EX(X[B + 2]); X[B + 3] = EX(X[B + 3]); PIN(X); SBAR(); } while (0)
#define VRD(i) do { vlo[i] = vtr(vp_ + (((i) >> 2) * 4096 + ((i) & 3) * 1024)); vhi[i] = vtr(vp_ + (((i) >> 2) * 4096 + ((i) & 3) * 1024 + 512)); } while (0)
#define KRD(G, j) do { if (G) { kload2(kf, kp0 + sl_next, j); SBAR(); } } while (0)
#define MF32(a, b, c) __builtin_amdgcn_mfma_f32_32x32x16_f16(a, b, c, 0, 0, 0)
#define STEP(C0, C1, P0, P1, t, GK, GV, GL) do { SBAR(); \
    const lds_cptr vp_ = vp0 + sl_prev; \
    VRD(0); SBAR(); float sacc = (P0[0] + P0[1]); \
    GAPA(C0 = MF32(kf[0], qr[0], negm), P0[2], P0[3], P0[4], P0[5],     pw0[0] = PKW(P0, 0), pw0[1] = PKW(P0, 2), pw0); \
    VRD(4); SBAR(); GAPA(C1 = MF32(kf[1], qr[0], negm), P0[6], P0[7], P0[8], P0[9],     pw0[2] = PKW(P0, 4), pw0[3] = PKW(P0, 6), pw0); \
    VRD(1); SBAR(); GAPA(C0 = MF32(kf[2], qr[1], C0),   P0[10], P0[11], P0[12], P0[13], pw1[0] = PKW(P0, 8), pw1[1] = PKW(P0, 10), pw1); \
    VRD(5); SBAR(); GAPA(C1 = MF32(kf[3], qr[1], C1),   P0[14], P0[15], P1[0], P1[1],   pw1[2] = PKW(P0, 12), pw1[3] = PKW(P0, 14), pw1); \
    VRD(2); SBAR(); GAPA(C0 = MF32(kf[4], qr[2], C0),   P1[2], P1[3], P1[4], P1[5],     pw2[0] = PKW(P1, 0), pw2[1] = PKW(P1, 2), pw2); \
    VRD(6); SBAR(); GAPA(C1 = MF32(kf[5], qr[2], C1),   P1[6], P1[7], P1[8], P1[9],     pw2[2] = PKW(P1, 4), pw2[3] = PKW(P1, 6), pw2); \
    VRD(3); SBAR(); GAPA(C0 = MF32(kf[6], qr[3], C0),   P1[10], P1[11], P1[12], P1[13], pw3[0] = PKW(P1, 8), pw3[1] = PKW(P1, 10), pw3); \
    VRD(7); SBAR(); GAPA(C1 = MF32(kf[7], qr[3], C1),   P1[14], P1[15], 0.f, 0.f,       pw3[2] = PKW(P1, 12), pw3[3] = PKW(P1, 14), pw3); \
    l_reg += sacc; \
    if (GK) { DMA_K((t) + 3, sl_cur); } if (GV) { DMA_V((t) + 1, sl_next); } \
    CMASK(C0, C1, t); \
    { float a = MX3(C0[0], C0[1], C1[0]), b_ = MX3(C0[2], C0[3], C1[1]); a = MX3(a, C1[2], C1[3]); \
      _Pragma("unroll") for (int r = 4; r < 16; r += 4) { a = MX3(a, C0[r], C0[r + 1]); b_ = MX3(b_, C0[r + 2], C0[r + 3]); a = MX3(a, C1[r], C1[r + 1]); b_ = MX3(b_, C1[r + 2], C1[r + 3]); } \
      float rm = __builtin_fmaxf(a, b_); { auto rr = __builtin_amdgcn_permlane32_swap(__float_as_uint(rm), __float_as_uint(rm), false, false); rm = __builtin_fmaxf(__uint_as_float(rr[0]), __uint_as_float(rr[1])); } \
      resc = false; \
      if (__builtin_expect(__any(rm > (float)THRL), 0)) { const float dl = __builtin_fmaxf(rm, 0.f); mhat += dl; \
        _Pragma("unroll") for (int r = 0; r < 16; ++r) { C0[r] -= dl; C1[r] -= dl; } \
        _Pragma("unroll") for (int r = 0; r < 16; ++r) negm[r] = -mhat; asm volatile("" : "+v"(negm)); \
        const float f = __builtin_amdgcn_exp2f(-dl); l_reg *= f; if (hi == 0) wsf[r32] = f; resc = true; } } \
    SBAR(); \
    GAPB(o[0] = MF32(PAF(0), VFR(0), o[0]), C0, 0); \
    GAPB(o[1] = MF32(PAF(0), VFR(4), o[1]), C0, 4); \
    KRD(GL, 0); GAPB(o[0] = MF32(PAF(1), VFR(1), o[0]), C0, 8); \
    KRD(GL, 1); GAPB(o[1] = MF32(PAF(1), VFR(5), o[1]), C0, 12); \
    KRD(GL, 2); GAPB(o[0] = MF32(PAF(2), VFR(2), o[0]), C1, 0); \
    KRD(GL, 3); GAPB(o[1] = MF32(PAF(2), VFR(6), o[1]), C1, 4); \
    GAPB(o[0] = MF32(PAF(3), VFR(3), o[0]), C1, 8); \
    GAPB(o[1] = MF32(PAF(3), VFR(7), o[1]), C1, 12); \
    } while (0)
    int t = 1;
    for (; t + 5 < NT; t += 2) {
        STEP(pB0, pB1, pA0, pA1, t, true, true, true);     WAIT_BAR(2); RESC(); ROT();
        STEP(pA0, pA1, pB0, pB1, t + 1, true, true, true); WAIT_BAR(2); RESC(); ROT();
    }
#define ENDW(tt) do { if ((tt) + 3 < NT) { WAIT_BAR(2); } else if ((tt) + 2 < NT) { WAIT_BAR(1); } else { WAIT_BAR(0); } } while (0)
    for (; t + 1 < NT; t += 2) {
        STEP(pB0, pB1, pA0, pA1, t, (t + 3 < NT), (t + 1 < NT), (t + 1 < NT));         ENDW(t);     RESC(); ROT();
        STEP(pA0, pA1, pB0, pB1, t + 1, (t + 4 < NT), (t + 2 < NT), (t + 2 < NT));     ENDW(t + 1); RESC(); ROT();
    }
    STEP(pB0, pB1, pA0, pA1, NT - 1, false, false, false); RESC();
    unsigned nraw = 0u; if (tid == 0) nraw = __hip_atomic_fetch_add(qctr, 1u, __ATOMIC_RELAXED, __HIP_MEMORY_SCOPE_AGENT);
    { float sacc = pB0[0] + pB0[1];
#pragma unroll
      for (int r = 2; r < 16; ++r) sacc += pB0[r];
#pragma unroll
      for (int r = 0; r < 16; ++r) sacc += pB1[r];
      l_reg += sacc;
      pw0 = (u32x4){PKW(pB0, 0), PKW(pB0, 2), PKW(pB0, 4), PKW(pB0, 6)}; pw1 = (u32x4){PKW(pB0, 8), PKW(pB0, 10), PKW(pB0, 12), PKW(pB0, 14)};
      pw2 = (u32x4){PKW(pB1, 0), PKW(pB1, 2), PKW(pB1, 4), PKW(pB1, 6)}; pw3 = (u32x4){PKW(pB1, 8), PKW(pB1, 10), PKW(pB1, 12), PKW(pB1, 14)};
      SBAR(); pv(o, vp0 + sl_cur, PAF(0), PAF(1), PAF(2), PAF(3)); }
    { auto rr = __builtin_amdgcn_permlane32_swap(__float_as_uint(l_reg), __float_as_uint(l_reg), false, false); l_reg = __uint_as_float(rr[0]) + __uint_as_float(rr[1]); }
    if (mixer == 1) l_reg += __builtin_amdgcn_exp2f(sinkp[hq] * LOG2E - mhat);
    if (hi == 0) wsf[32 + r32] = l_reg; asm volatile("s_waitcnt lgkmcnt(0)" ::: "memory");
    float rli[16];
#pragma unroll
    for (int r = 0; r < 16; ++r) rli[r] = __builtin_amdgcn_rcpf(wsf[32 + crow(r, hi)]);
    h16* Ow = br + (size_t)q0 * DM + brcol;
    { FG_LAS h16* stg = (FG_LAS h16*)(lds + LDS_OST) + wid * 2048;
#pragma unroll
      for (int r = 0; r < 16; ++r) { const int orow = crow(r, hi);
#pragma unroll
          for (int d0 = 0; d0 < 2; ++d0) stg[orow * 64 + d0 * 32 + r32] = (h16)(o[d0][r] * rli[r]); }
      asm volatile("s_waitcnt lgkmcnt(0)" ::: "memory");
#pragma unroll
      for (int i = 0; i < 4; ++i) { const int row = i * 8 + (lane >> 3), ch = lane & 7; const u32x4 v = *(const FG_LAS u32x4*)(stg + row * 64 + ch * 8); *(u32x4*)(Ow + (size_t)row * DM + ch * 8) = v; } }
    if (tid == 0) qw[0] = nraw;
    asm volatile("s_waitcnt lgkmcnt(0)\n\ts_barrier" ::: "memory");
#undef FA_TILE
#undef DMA_K
#undef DMA_V
#undef CMASK
#undef START
#undef RESC
#undef ROT
#undef PKW
#undef PAF
#undef VFR
#undef PIN
#undef MX3
#undef GAPA
#undef GAPB
#undef EX
#undef VRD
#undef KRD
#undef MF32
#undef STEP
#undef ENDW
}
#undef SBAR
#undef WAIT_BAR
}
struct SchedTwo { fg::Unit u0, u1; __device__ __forceinline__ bool next(int i, fg::Unit& o) const { if (i == 0) { o = u0; return true; } if (i == 1) { o = u1; return true; } return false; } };
struct EpiDftSym {
    static constexpr bool PERM = true;
    h16* br; unsigned char* scr;
    __device__ __forceinline__ void operator()(const f32x4 (&acc)[2][2][4][2], const fg::Unit& u, int wr, int wc, int fr, int fq) const {
        const int tid = tidx(); const float scl = 0.022097086912079608f;
        if (u.aux == 0) {
#pragma unroll
            for (int ai = 0; ai < 2; ++ai)
#pragma unroll
                for (int m = 0; m < 4; ++m)
#pragma unroll
                    for (int bj = 0; bj < 2; ++bj)
#pragma unroll
                        for (int n = 0; n < 2; ++n) { const int q = ((ai * 4 + m) * 2 + bj) * 2 + n; *(f32x4*)(scr + ((size_t)q * 512 + tid) * 16) = acc[ai][bj][m][n]; }
        } else {
#pragma unroll
            for (int ai = 0; ai < 2; ++ai) {
                f32x4 pv[4][2][2];
#pragma unroll
                for (int m = 0; m < 4; ++m)
#pragma unroll
                    for (int bj = 0; bj < 2; ++bj)
#pragma unroll
                        for (int n = 0; n < 2; ++n) { const int q = ((ai * 4 + m) * 2 + bj) * 2 + n; pv[m][bj][n] = *(const f32x4*)(scr + ((size_t)q * 512 + tid) * 16); }
                asm volatile("" ::: "memory");
#pragma unroll
                for (int m = 0; m < 4; ++m) { const int k = u.pm * 256 + 128 * ai + 64 * wr + 16 * m + fr + 1;
                    h16* lo = br + ((size_t)u.pn * 2048 + k) * DM + 256; h16* hi = br + ((size_t)u.pn * 2048 + (2048 - k)) * DM + 256;
#pragma unroll
                    for (int bj = 0; bj < 2; ++bj) { const int col = 128 * bj + 32 * wc + 8 * fq;
                        const f32x4 p0 = pv[m][bj][0], p1 = pv[m][bj][1];
                        const f32x4 q0v = acc[ai][bj][m][0], q1v = acc[ai][bj][m][1];
                        const f32x4 a0 = (p0 - q0v) * scl, a1 = (p1 - q1v) * scl, b0 = (p0 + q0v) * scl, b1 = (p1 + q1v) * scl;
                        *(u32x4*)(lo + col) = (u32x4){pk_h2(a0[0], a0[1]), pk_h2(a0[2], a0[3]), pk_h2(a1[0], a1[1]), pk_h2(a1[2], a1[3])};
                        *(u32x4*)(hi + col) = (u32x4){pk_h2(b0[0], b0[1]), pk_h2(b0[2], b0[3]), pk_h2(b1[0], b1[1]), pk_h2(b1[2], b1[3])}; } }
                asm volatile("" ::: "memory");
            }
        }
    }
};
struct SchedOne { fg::Unit u; __device__ __forceinline__ bool next(int i, fg::Unit& o) const { if (i != 0) return false; o = u; return true; } };
__device__ __forceinline__ void phase_mixers(const Params& p, int l, ldsp_t lds, int rep = 0) {
    const unsigned char* QI = p.ws + WS_QI; const unsigned char* KI = p.ws + WS_KI; const unsigned char* VI = p.ws + WS_VI; h16* br = (h16*)(p.ws + WS_BR);
    const float* sinkp = p.sink + l * 4; const float* rpb = p.rpb + (size_t)l * 4 * 465;
    const int x = bidx() & 7;
    unsigned* qctr = (unsigned*)(p.ws + WS_CTL) + 64 * (rep * 16 + l * 8 + x) + 32;
    volatile FG_LAS unsigned* qw = (volatile FG_LAS unsigned*)(lds + LDS_BYTES - 512);
    const int nq = (l == 0) ? 226 : 200;
    const int tid = tidx();
    if (rep == 0) fourier_row0(p);
    __syncthreads();
    bool have = false;
    for (;;) {
        if (!have && tid == 0) qw[0] = __hip_atomic_fetch_add(qctr, 1u, __ATOMIC_RELAXED, __HIP_MEMORY_SCOPE_AGENT);
        __syncthreads();
        int idx = (int)qw[0];
        have = false;
        if (idx >= nq) break;
        if (l == 0 && idx >= 72) idx = idx < 74 ? idx + 152 : idx - 2;
        if (rep > 0) { const bool isdft = idx < 8 || idx >= 224; if ((PROBE_MODE == 1 && isdft) || (PROBE_MODE == 2 && !isdft)) continue; }
        if (idx < 8) {
            const int id = idx;
            SchedTwo S; S.u0.pm = id & 3; S.u0.pn = 2 * x + (id >> 2); S.u0.nt = 32; S.u0.aux = 0;
            S.u0.A = (const char*)(p.ws + WS_DFT) + (size_t)S.u0.pm * 256 * 4096 * 2; S.u0.B = (const char*)(p.ws + WS_ZTL) + (size_t)S.u0.pn * 256 * 4096 * 2;
            S.u1 = S.u0; S.u1.aux = 1; S.u1.A += 4096; S.u1.B += 4096;
            EpiDftSym E{br, p.ws + WS_GSCR + (size_t)bidx() * 262144};
            fg::gemm_phase<EpiDftSym, SchedTwo, 4096>(lds, S, E);
        } else if (idx < 200) {
            const int w = (idx - 8) & 63; const int ty = (idx - 8) >> 6;
            if (ty == 0) { fa::attn_unit<0, 8>(QI, KI, VI, br, sinkp, rpb, 0, 2 * x + (w >> 5), (w >> 4) & 1, w & 15, false, lds, qctr, qw); }
            else if (ty == 1) { fa::attn_unit<2, 8>(QI, KI, VI, br, sinkp, rpb, 2, 2 * x + (w >> 5), (w >> 4) & 1, w & 15, false, lds, qctr, qw); }
            else { fa::attn_unit<1, 8>(QI, KI, VI, br, sinkp, rpb, 1, 2 * x + (w >> 5), (w >> 4) & 1, w & 15, false, lds, qctr, qw); }
            have = true;
        } else if (idx < 224) {
            const int w = idx - 200; const int mixer = w >> 3, rest = w & 7;
            fa::attn_unit<0, 8>(QI, KI, VI, br, sinkp, rpb, mixer, 2 * x + (rest >> 2), (rest >> 1) & 1, rest & 1, true, lds, qctr, qw); have = true;
        } else {
            SchedOne S; S.u.pm = 0; S.u.pn = 2 * x + (idx - 224); S.u.nt = 8; S.u.aux = 0;
            S.u.A = (const char*)(p.ws + WS_DFTC); S.u.B = (const char*)(p.ws + WS_ZTC) + (size_t)S.u.pn * 256 * 512 * 2;
            EpiDft E{br, TL, 256, 0.0625f};
            fg::gemm_phase<EpiDft, SchedOne, 512>(lds, S, E);
        }
    }
    __syncthreads();
}

#define XB_TMO      128
#define XB_XCNT(j)  (256  + 64 * (j))
#define XB_XSUB(j)  (1280 + 64 * (j))
#define XB_XGEN(j)  (2304 + 64 * (j))
#define XB_TOP      3328
#define XB_TOPGEN   3392
#define XB_SPIN_CAP (1u << 22)
__device__ __forceinline__ unsigned xb_ld(unsigned* p)              { return __hip_atomic_load(p, __ATOMIC_RELAXED, __HIP_MEMORY_SCOPE_AGENT); }
__device__ __forceinline__ unsigned xb_add(unsigned* p, unsigned v) { return __hip_atomic_fetch_add(p, v, __ATOMIC_RELAXED, __HIP_MEMORY_SCOPE_AGENT); }
__device__ __forceinline__ unsigned xb_xcc_id() { return (unsigned)__builtin_amdgcn_s_getreg((3 << 11) | 20) & 0xFu; }
#define XB_SPIN(cond, bar) do { unsigned _sp = 0; while (cond) { __builtin_amdgcn_s_sleep(1); \
    if ((++_sp & 255u) == 0u) { if (xb_ld(&(bar)[XB_TMO])) break; if (_sp > XB_SPIN_CAP) { atomicAdd(&(bar)[XB_TMO], 1u); break; } } } } while (0)
struct XcdBarrier { unsigned* bar; unsigned x; volatile FG_LAS unsigned* st; };
__device__ __forceinline__ XcdBarrier xcd_barrier_post(unsigned* bar, volatile FG_LAS unsigned* st) {
    XcdBarrier b; b.bar = bar; b.x = xb_xcc_id(); b.st = st;
    if (threadIdx.x == 0) (void)xb_add(&bar[XB_XCNT(b.x)], 1u);
    return b;
}
__device__ __forceinline__ void xcd_barrier_complete(unsigned* bar, unsigned x, unsigned& nloc, unsigned& nx) {
    const unsigned G = gridDim.x * gridDim.y * gridDim.z;
    unsigned sum, cnt, mine, sp = 0u;
    for (;;) {
        sum = 0u; cnt = 0u; mine = 0u;
#pragma unroll
        for (unsigned j = 0; j < 16; ++j) { const unsigned c = xb_ld(&bar[XB_XCNT(j)]); sum += c; cnt += (c > 0u) ? 1u : 0u; mine = (j == x) ? c : mine; }
        if (sum == G) break;
        __builtin_amdgcn_s_sleep(1);
        if ((++sp & 255u) == 0u) { if (xb_ld(&bar[XB_TMO])) break; if (sp > XB_SPIN_CAP) { atomicAdd(&bar[XB_TMO], 1u); break; } }
    }
    nloc = mine > 0u ? mine : 1u; nx = cnt > 0u ? cnt : 1u;
}
__device__ __forceinline__ void xcd_barrier(const XcdBarrier& b) {
    asm volatile("s_waitcnt vmcnt(0)" ::: "memory");
    unsigned* bar = b.bar; unsigned bx = __builtin_amdgcn_readfirstlane(b.x); asm volatile("" : "+s"(bar), "+s"(bx));
    __syncthreads();
    if (tidx() == 0) {
        __builtin_amdgcn_s_waitcnt(0);
        unsigned nloc = b.st[0], nx = b.st[1];
        if (nloc == 0u) { xcd_barrier_complete(bar, bx, nloc, nx); b.st[0] = nloc; b.st[1] = nx; }
        const unsigned old = xb_add(&bar[XB_XSUB(bx)], 1u);
        const unsigned gen = old / nloc;
        if (old + 1u == (gen + 1u) * nloc) {
            __builtin_amdgcn_fence(__ATOMIC_RELEASE, "agent");
            asm volatile("s_waitcnt vmcnt(0)" ::: "memory");
            const unsigned og = xb_add(&bar[XB_TOP], 1u);
            const unsigned tg = og / nx;
            if (og + 1u == (tg + 1u) * nx) xb_add(&bar[XB_TOPGEN], 1u);
            else XB_SPIN(xb_ld(&bar[XB_TOPGEN]) == tg, bar);
            __builtin_amdgcn_fence(__ATOMIC_ACQUIRE, "agent");
            xb_add(&bar[XB_XGEN(bx)], 1u);
            asm volatile("s_waitcnt vmcnt(0)" ::: "memory");
        } else {
            XB_SPIN(xb_ld(&bar[XB_XGEN(bx)]) == gen, bar);
            __builtin_amdgcn_fence(__ATOMIC_ACQUIRE, "agent");
            asm volatile("s_waitcnt vmcnt(0)" ::: "memory");
        }
    }
    __syncthreads();
}

__device__ __forceinline__ void xcd_barrier_arrive(const XcdBarrier& b) {
    asm volatile("s_waitcnt vmcnt(0)" ::: "memory");
    unsigned* bar = b.bar; unsigned bx = __builtin_amdgcn_readfirstlane(b.x); asm volatile("" : "+s"(bar), "+s"(bx));
    __syncthreads();
    if (tidx() == 0) {
        __builtin_amdgcn_s_waitcnt(0);
        unsigned nloc = b.st[0], nx = b.st[1];
        if (nloc == 0u) { xcd_barrier_complete(bar, bx, nloc, nx); b.st[0] = nloc; b.st[1] = nx; }
        const unsigned old = xb_add(&bar[XB_XSUB(bx)], 1u);
        const unsigned gen = old / nloc;
        unsigned mode = 0u, tg = 0u;
        if (old + 1u == (gen + 1u) * nloc) {
            __builtin_amdgcn_fence(__ATOMIC_RELEASE, "agent");
            asm volatile("s_waitcnt vmcnt(0)" ::: "memory");
            const unsigned og = xb_add(&bar[XB_TOP], 1u);
            tg = og / nx; mode = 1u;
            if (og + 1u == (tg + 1u) * nx) { xb_add(&bar[XB_TOPGEN], 1u); mode = 2u; }
            xb_add(&bar[XB_XGEN(bx)], 1u);
        }
        b.st[2] = mode; b.st[3] = gen; b.st[4] = tg;
    }
    __syncthreads();
}
__device__ __forceinline__ void xcd_barrier_wait(const XcdBarrier& b) {
    unsigned* bar = b.bar; unsigned bx = __builtin_amdgcn_readfirstlane(b.x); asm volatile("" : "+s"(bar), "+s"(bx));
    __syncthreads();
    if (tidx() == 0) {
        const unsigned mode = b.st[2], gen = b.st[3];
        if (mode != 2u) XB_SPIN(xb_ld(&bar[XB_TOPGEN]) == gen, bar);
        __builtin_amdgcn_fence(__ATOMIC_ACQUIRE, "agent");
        asm volatile("s_waitcnt vmcnt(0)" ::: "memory");
    }
    __syncthreads();
}

__global__ void __launch_bounds__(NTHREADS) mk_fwd(Params p_in) {
    extern __shared__ __attribute__((aligned(16))) unsigned char lds_raw[];
    float* lds = (float*)lds_raw; ldsp_t ldsf = (ldsp_t)lds_raw;
    cg::grid_group grid = cg::this_grid();
    volatile FG_LAS unsigned* misc = (volatile FG_LAS unsigned*)(ldsf + LDS_BYTES - 256);
    if (threadIdx.x < 32) misc[threadIdx.x] = (threadIdx.x == 16) ? blockIdx.x : 0u;
    __syncthreads();
    XcdBarrier xbar = xcd_barrier_post((unsigned*)(ldp().ws + WS_CTL) + 4096, misc + 8);
#define GSYNC() xcd_barrier(xbar)
    unsigned* cen = (unsigned*)(ldp().ws + WS_CTL) + 2048;
    if (threadIdx.x == 0) misc[17] = __hip_atomic_fetch_add(cen + 64 * xb_xcc_id(), 1u, __ATOMIC_RELAXED, __HIP_MEMORY_SCOPE_AGENT);
    for (int r_ = 0; r_ < RP_P0; ++r_) phase0(ldp(), lds);
    dense_transposes(ldp(), lds);
    if (ldp().ws == nullptr) grid.sync();
    GSYNC();
    if (threadIdx.x == 0) { bool ok = (gridDim.x == 256);
        for (int j = 0; j < 16; ++j) { const unsigned cj = __hip_atomic_load(cen + 64 * j, __ATOMIC_RELAXED, __HIP_MEMORY_SCOPE_AGENT); ok = ok && (cj == (j < 8 ? 32u : 0u)); }
        if (ok) misc[16] = misc[17] * 8u + xb_xcc_id(); }
    __syncthreads();
    phase_convert_dense(ldp(), lds, ldsf);
    phase_wg(ldp());
    for (int r_ = 0; r_ < RP_U; ++r_) phase_u(ldp(), 0);
    GSYNC();
    for (int l = 0; l < DEPTH; ++l) {
        for (int r_ = 0; r_ < RP_G1; ++r_) phase_g1_fast(ldp(), l, ldsf);
        if (l == 0 ? ((bidx() & 7) >= 4) : (bidx() >= 48)) bg_convert(ldp(), l, lds, BG_G1, true);
        GSYNC();
        for (int r_ = 0; r_ < RP_ATT; ++r_) phase_mixers(ldp(), l, ldsf, r_);
        xcd_barrier_arrive(xbar);
        phase_merge_fast(ldp(), l, ldsf, 0, 1);
        xcd_barrier_wait(xbar);
        phase_merge_fast(ldp(), l, ldsf, 1, 18);
        GSYNC();
        if (l == 0) { phase_merge_sum(ldp()); GSYNC(); }
        for (int r_ = 0; r_ < (l == 0 ? RP_OUT : 1); ++r_) phase_out_fast(ldp(), l, ldsf);
        if (l == 0 && (bidx() & 7) >= 2) bg_convert(ldp(), 0, lds, BG_OUT, true);
        xcd_barrier_arrive(xbar);
        phase_ln1_fill(ldp(), l, lds);
        xcd_barrier_wait(xbar);
        phase_ln1(ldp(), l, lds);
        GSYNC();
        for (int r_ = 0; r_ < RP_TOPK; ++r_) phase_topk(ldp(), l, lds);
        bg_convert(ldp(), l, lds, 1 << 20);
        GSYNC();
        for (int r_ = 0; r_ < RP_UP; ++r_) phase_up_fast(ldp(), l, ldsf);
        GSYNC();
        for (int r_ = 0; r_ < RP_DN; ++r_) phase_down_fast(ldp(), l, ldsf);
        if (l == 0 && (bidx() & 7) >= 4) bg_convert(ldp(), 1, lds, BG_DN, true);
        GSYNC();
        for (int r_ = 0; r_ < (l == 1 ? RP_LN2 : 1); ++r_) phase_ln2(ldp(), l, lds);
        if (l == 0) GSYNC();
    }
}

extern "C" void kernel_launch(void* const* d_in, const int* in_sizes, int n_in, void* d_out, int out_size, void* d_ws, size_t ws_size, hipStream_t stream) {
    static int grid = 0;
    if (grid == 0) {
        if (n_in != 20 || ws_size < WS_END) { fprintf(stderr, "kernel_launch: unexpected n_in %d or ws_size %zu (need %zu)\n", n_in, ws_size, (size_t)WS_END); grid = -1; return; }
        int dev = 0, cus = 0, per_cu = 0;
        hipGetDevice(&dev); hipDeviceGetAttribute(&cus, hipDeviceAttributeMultiprocessorCount, dev);
        hipFuncSetAttribute((const void*)mk_fwd, hipFuncAttributeMaxDynamicSharedMemorySize, LDS_BYTES);
        hipOccupancyMaxActiveBlocksPerMultiprocessor(&per_cu, (const void*)mk_fwd, NTHREADS, LDS_BYTES);
        if (per_cu < 1) { fprintf(stderr, "kernel_launch: occupancy query says %d blocks per CU\n", per_cu); per_cu = 1; }
        (void)hipGetLastError();
        if (cus * per_cu < 256) { fprintf(stderr, "kernel_launch: needs 256 co-resident workgroups, device offers %d x %d\n", cus, per_cu); grid = -1; return; }
        grid = 256;
    }
    if (grid < 0) return;
    hipMemsetAsync((char*)d_ws + WS_CTL, 0, 64 * 1024, stream);
    Params p{};
    const float** pp = (const float**)&p;
    for (int i = 0; i < 20; ++i) pp[i] = (const float*)d_in[i];
    p.out = (float*)d_out; p.ws = (unsigned char*)d_ws;
    void* args[] = {&p};
    hipError_t e = hipLaunchCooperativeKernel((const void*)mk_fwd, dim3(grid), dim3(NTHREADS), args, LDS_BYTES, stream);
    if (e != hipSuccess) fprintf(stderr, "cooperative launch failed: %s (grid %d)\n", hipGetErrorString(e), grid);
}
```

```cpp
#include <hip/hip_runtime.h>
#include <hip/hip_cooperative_groups.h>
#include <cstdio>
#include <cstdint>
#include <type_traits>
namespace cg = cooperative_groups;

typedef _Float16 h16;
typedef _Float16 h16x8 __attribute__((ext_vector_type(8)));
typedef _Float16 h16x4 __attribute__((ext_vector_type(4)));
typedef float f32x4 __attribute__((ext_vector_type(4)));

constexpr int DM = 1024, NBATCH = 16, SEQ = 2048, CTX = 256, DEPTH = 2;
constexpr int TL = NBATCH * SEQ;
constexpr int TC = NBATCH * CTX;
constexpr int TT = TL + TC;
constexpr int INW = 5888, NMOD = 6 * DM, PMW = 1536;
constexpr int NEXP = 16, FF = 1024, CAPL = 256, CAPC = 32;
constexpr int GL = NBATCH * NEXP * CAPL;
constexpr int GC = NBATCH * NEXP * CAPC;
constexpr int GT = GL + GC;
constexpr float ALPHA = 1.4142135623730951f;
constexpr float LN_EPS = 1e-6f, RMS_EPS = 1e-6f;
constexpr int NTHREADS = 512, NWAVES = 8;
constexpr int LDS_BYTES = 147456;
constexpr int BG_G1 = 2, BG_OUT = 3, BG_DN = 2;
constexpr int PROBE_MODE = 0, RP_P0 = 1, RP_LN2 = 1;
constexpr int RP_G1 = 1, RP_FOU = 1, RP_MRG = 1, RP_OUT = 1, RP_UP = 1, RP_DN = 1, RP_ATT = 1, RP_U = 1, RP_TOPK = 1;


constexpr size_t MiB = 1u << 20;
constexpr size_t WS_CTL = 0;
constexpr size_t WS_MODV = 1 * MiB;
constexpr size_t WS_WFIN = 2 * MiB;
constexpr size_t WS_BDT = 3 * MiB;
constexpr size_t WS_TAB = 6 * MiB;
constexpr size_t WS_AFFL = 7 * MiB;
constexpr size_t WS_AFFC = 9 * MiB;
constexpr size_t WS_SELW = 10 * MiB;
constexpr size_t WS_STAT = 9 * MiB + 512 * 1024;
constexpr size_t WS_SELR = 10 * MiB + 512 * 1024;
constexpr size_t WS_SLOT = 11 * MiB;
constexpr size_t WS_WG = 13 * MiB + 512 * 1024;
constexpr size_t WS_SGB = 15 * MiB + 768 * 1024;
constexpr size_t WS_HB = 16 * MiB;
constexpr size_t WS_S = 160 * MiB;
constexpr size_t WS_U16 = WS_S;
constexpr size_t WS_PM = WS_S + 72 * MiB;
constexpr size_t WS_QI = WS_PM;
constexpr size_t WS_KI = WS_PM + 54 * MiB;
constexpr size_t WS_VI = WS_PM + 81 * MiB;
constexpr size_t WS_ZTL = WS_PM + 108 * MiB;
constexpr size_t WS_ZTC = WS_ZTL + 32 * MiB;
constexpr size_t WS_XG = WS_S + 72 * MiB;
constexpr size_t WS_BR = WS_S + 216 * MiB;
constexpr size_t WS_H16 = WS_S + 216 * MiB;
constexpr size_t WS_GSCR = WS_S + 288 * MiB;
constexpr size_t WS_MPART = WS_S + 320 * MiB;
constexpr size_t WS_WINT = WS_S + 360 * MiB;
constexpr size_t WS_WBT = WS_WINT + 24 * MiB;
constexpr size_t WS_WOT = WS_WBT + 4 * MiB;
constexpr size_t WS_DFT = WS_WOT + 4 * MiB;
constexpr size_t WS_DFTC = WS_DFT + 16 * MiB;
constexpr size_t WS_WGU1 = WS_DFTC + 1 * MiB;
constexpr size_t WS_END = WS_WGU1 + 64 * MiB;
constexpr size_t DO_WGU = 0;
constexpr size_t DO_WD = 64 * MiB;
constexpr size_t DO_WD1 = 96 * MiB;

struct Params {
    const float *x, *c, *ctx, *c_ctx, *w_mod, *b_mod, *w_in, *qk_gain, *sink, *rpb, *w_branch, *w_out, *ln1_g, *ln1_b, *w_router, *w_gate, *w_up, *w_down, *ln2_g, *ln2_b;
    float* out; unsigned char* ws;
};
typedef const __attribute__((address_space(4))) Params* kargp_t;
#if defined(__HIP_DEVICE_COMPILE__)
__device__ __forceinline__ Params ldp() { kargp_t q = (kargp_t)__builtin_amdgcn_kernarg_segment_ptr(); asm volatile("" : "+s"(q)); return *q; }
#else
__device__ __forceinline__ Params ldp() { return Params{}; }
#endif

#define VCU_LDS_ADDR (LDS_BYTES - 256 + 64)
__device__ __forceinline__ int bidx() { const unsigned v = *(volatile __attribute__((address_space(3))) unsigned*)(VCU_LDS_ADDR); int b = __builtin_amdgcn_readfirstlane((int)v); asm volatile("" : "+s"(b)); return b; }
__device__ __forceinline__ int tidx() { int t = threadIdx.x; asm volatile("" : "+v"(t)); return t; }
template <int CTRL> __device__ __forceinline__ float dpp_f(float v) { return __builtin_bit_cast(float, __builtin_amdgcn_update_dpp(0, __builtin_bit_cast(int, v), CTRL, 0xf, 0xf, true)); }
__device__ __forceinline__ float xor16_sum(float v) { const auto r = __builtin_amdgcn_permlane16_swap(__float_as_uint(v), __float_as_uint(v), false, false); return __uint_as_float(r[0]) + __uint_as_float(r[1]); }
__device__ __forceinline__ float xor32_sum(float v) { const auto r = __builtin_amdgcn_permlane32_swap(__float_as_uint(v), __float_as_uint(v), false, false); return __uint_as_float(r[0]) + __uint_as_float(r[1]); }
__device__ __forceinline__ float xor16_max(float v) { const auto r = __builtin_amdgcn_permlane16_swap(__float_as_uint(v), __float_as_uint(v), false, false); return fmaxf(__uint_as_float(r[0]), __uint_as_float(r[1])); }
__device__ __forceinline__ float xor32_max(float v) { const auto r = __builtin_amdgcn_permlane32_swap(__float_as_uint(v), __float_as_uint(v), false, false); return fmaxf(__uint_as_float(r[0]), __uint_as_float(r[1])); }
__device__ __forceinline__ float wave_sum(float v) {
    v += dpp_f<0xB1>(v);
    v += dpp_f<0x4E>(v);
    v += dpp_f<0x141>(v);
    v += dpp_f<0x140>(v);
    v = xor16_sum(v); v = xor32_sum(v);
    return v;
}
__device__ __forceinline__ float wave_max(float v) {
    v = fmaxf(v, dpp_f<0xB1>(v)); v = fmaxf(v, dpp_f<0x4E>(v)); v = fmaxf(v, dpp_f<0x141>(v)); v = fmaxf(v, dpp_f<0x140>(v));
    v = xor16_max(v); v = xor32_max(v);
    return v;
}
typedef unsigned u32x4 __attribute__((ext_vector_type(4)));
__device__ __forceinline__ unsigned pk_h2(float lo, float hi) { typedef _Float16 h2 __attribute__((ext_vector_type(2))); h2 v = {(h16)lo, (h16)hi}; return __builtin_bit_cast(unsigned, v); }
typedef __bf16 bf16x2_t __attribute__((ext_vector_type(2)));
typedef float f32x2_t __attribute__((ext_vector_type(2)));
typedef short bf16x8_t __attribute__((ext_vector_type(8)));
__device__ __forceinline__ unsigned pk_b2(float lo, float hi) { f32x2_t v = {lo, hi}; bf16x2_t b = __builtin_convertvector(v, bf16x2_t); return __builtin_bit_cast(unsigned, b); }
__device__ __forceinline__ float sigmoid_f(float v) { return __builtin_amdgcn_rcpf(1.f + __builtin_amdgcn_exp2f(v * -1.4426950408889634f)); }
__device__ __forceinline__ float silu_f(float v) { return v * sigmoid_f(v); }
__device__ __forceinline__ float sig2_f(float t) { return __builtin_amdgcn_rcpf(1.f + __builtin_amdgcn_exp2f(t)); }
__device__ __forceinline__ int mv_of(int R) { return R < TL ? (R >> 11) : 16; }

__device__ __forceinline__ void phase0(const Params& p, float* lds) {
    float* modv = (float*)(p.ws + WS_MODV); float* tab = (float*)(p.ws + WS_TAB);
    const int tid = tidx(), lane = tid & 63, wave = tid >> 6, c = bidx(), G = gridDim.x;
    if (c < 192) {
        float* sc = lds;
        float* red = lds + 17 * 1024;
        for (int e = tid; e < 17 * 1024; e += NTHREADS) { const int mv = e >> 10, k = e & 1023; const float v = mv < 16 ? p.c[mv * 1024 + k] : p.c_ctx[k]; sc[e] = silu_f(v); }
        __syncthreads();
        const int col0 = c * 64; const int l = col0 / NMOD, n0 = col0 % NMOD; const int rg = lane >> 4, cq = lane & 15;
        f32x4 acc[17];
#pragma unroll
        for (int m = 0; m < 17; ++m) acc[m] = (f32x4){0.f, 0.f, 0.f, 0.f};
        const float* w = p.w_mod + ((size_t)l * DM + wave * 128 + rg) * NMOD + n0 + cq * 4;
#pragma unroll 4
        for (int i = 0; i < 32; ++i) { const f32x4 wv = *(const f32x4*)(w + (size_t)(4 * i) * NMOD);
#pragma unroll
            for (int m = 0; m < 17; ++m) acc[m] += wv * sc[m * 1024 + wave * 128 + rg + 4 * i]; }
#pragma unroll
        for (int m = 0; m < 17; ++m) {
#pragma unroll
            for (int e = 0; e < 4; ++e) { float v = acc[m][e]; v += __shfl_xor(v, 16); v += __shfl_xor(v, 32); acc[m][e] = v; }
            if (rg == 0) *(f32x4*)(red + (wave * 17 + m) * 64 + cq * 4) = acc[m]; }
        __syncthreads();
        for (int e = tid; e < 17 * 64; e += NTHREADS) { const int m = e >> 6, ln = e & 63; float sacc = 0.f;
#pragma unroll
            for (int wv = 0; wv < 8; ++wv) sacc += red[(wv * 17 + m) * 64 + ln];
            const int nn = n0 + ln; modv[((size_t)l * 17 + m) * NMOD + nn] = sacc + p.b_mod[l * NMOD + nn]; }
        __syncthreads();
    }
    float* cT = lds; float* sT = lds + 2048;
    __syncthreads();
    for (int j = tid; j < 2048; j += NTHREADS) { cT[j] = cospif((float)j / 1024.f); sT[j] = sinpif((float)j / 1024.f); }
    if (c == G - 1) for (int e = tid; e < 64 * 16; e += NTHREADS) { const int pos = e >> 4, j = e & 15; const float inv = powf(10000.f, -(float)j / 16.f); const float ang = (float)pos * inv;
        tab[4096 + e] = cosf(ang); tab[4096 + 1024 + e] = sinf(ang); }
    __syncthreads();
    const int gt = c * NTHREADS + tid, NG = G * NTHREADS;
    { h16* DFT = (h16*)(p.ws + WS_DFT); h16* DFTC = (h16*)(p.ws + WS_DFTC);
      for (int o = gt; o < 1024 * 512 + 256 * 64; o += NG) {
        unsigned w[4];
        if (o < 1024 * 512) { const int k = (o >> 9) + 1, j0 = (o & 511) * 8;
#pragma unroll
            for (int q = 0; q < 4; ++q) { float v[2];
#pragma unroll
                for (int h = 0; h < 2; ++h) { const int j = j0 + q * 2 + h; const int idx = (k * (j & 2047)) & 2047; v[h] = (j >> 11) ? sT[idx] : cT[idx]; }
                w[q] = pk_h2(v[0], v[1]); }
            *(u32x4*)(DFT + (size_t)(k - 1) * 4096 + j0) = (u32x4){w[0], w[1], w[2], w[3]}; }
        else { const int oo = o - 1024 * 512; const int k = oo >> 6, j0 = (oo & 63) * 8;
#pragma unroll
            for (int q = 0; q < 4; ++q) { float v[2];
#pragma unroll
                for (int h = 0; h < 2; ++h) { const int j = j0 + q * 2 + h; const int idx = ((k * (j & 255)) & 255) * 8; v[h] = (j >> 8) ? -sT[idx] : cT[idx]; }
                w[q] = pk_h2(v[0], v[1]); }
            *(u32x4*)(DFTC + (size_t)k * 512 + j0) = (u32x4){w[0], w[1], w[2], w[3]}; } } }
    { h16* BDT = (h16*)(p.ws + WS_BDT);
      for (int o = gt; o < 512 * 256; o += NG) { const int zc = o >> 8, gc = o & 255; const int g = zc >> 7, cs = (zc >> 6) & 1, m = zc & 63; const int idx = ((m * (gc & 63)) & 63) * 32;
          BDT[o] = (h16)(((gc >> 6) == g) ? (cs ? sT[idx] : cT[idx]) * 0.125f : 0.f); } }
    { h16* WFIN = (h16*)(p.ws + WS_WFIN);
      for (int o = gt; o < 2 * 1024 * 64; o += NG) { const int gc4 = (o & 63) * 4, lk = o >> 6; const f32x4 v = *(const f32x4*)(p.w_in + (size_t)lk * INW + 512 + gc4);
          h16x4 hv = {(h16)v[0], (h16)v[1], (h16)v[2], (h16)v[3]}; *(h16x4*)(WFIN + (size_t)lk * 256 + gc4) = hv; } }
    __syncthreads();
}

__device__ __forceinline__ const float* hrow_of(const Params& p, const float* hB, int l, int R) { return l == 0 ? (R < TL ? p.x + (size_t)R * DM : p.ctx + (size_t)(R - TL) * DM) : hB + (size_t)R * DM; }
__device__ __forceinline__ void phase_u(const Params& p, int l) {
    const float* modv = (const float*)(p.ws + WS_MODV) + (size_t)l * 17 * NMOD; h16* u16 = (h16*)(p.ws + WS_U16); const float* hB = (const float*)(p.ws + WS_HB);
    const int lane = tidx() & 63, gw = bidx() * NWAVES + (tidx() >> 6);
    constexpr int rpw = TT / 2048;
    f32x4 sh[4], sc[4], h[4], hn[4]; int curmv = -1;
    const int R0 = gw * rpw;
    { const float* hr = hrow_of(p, hB, l, R0);
#pragma unroll
      for (int j = 0; j < 4; ++j) h[j] = *(const f32x4*)(hr + lane * 4 + 256 * j); }
    for (int i = 0; i < rpw; ++i) {
        const int R = R0 + i; const int mv = mv_of(R);
        if (mv != curmv) { const float* mvp = modv + (size_t)mv * NMOD; curmv = mv;
#pragma unroll
            for (int j = 0; j < 4; ++j) { const int col = lane * 4 + 256 * j; sh[j] = *(const f32x4*)(mvp + col); sc[j] = *(const f32x4*)(mvp + DM + col); } }
        asm volatile("" ::: "memory");
        if (i + 1 < rpw) { const float* hr = hrow_of(p, hB, l, R + 1);
#pragma unroll
            for (int j = 0; j < 4; ++j) hn[j] = *(const f32x4*)(hr + lane * 4 + 256 * j); }
        asm volatile("" ::: "memory");
#pragma unroll
        for (int j = 0; j < 4; ++j) { const int col = lane * 4 + 256 * j; const f32x4 u = h[j] * (1.f + sc[j]) + sh[j];
            *(unsigned long long*)(u16 + (size_t)R * DM + col) = (unsigned long long)pk_h2(u[0], u[1]) | ((unsigned long long)pk_h2(u[2], u[3]) << 32); }
#pragma unroll
        for (int j = 0; j < 4; ++j) h[j] = hn[j];
    }
}

constexpr float QSCALE = 0.125f * 1.4426950408889634f;
__device__ __forceinline__ void fourier_row0(const Params& p) {
    {
      const h16* ZTL = (const h16*)(p.ws + WS_ZTL); h16* brp = (h16*)(p.ws + WS_BR);
      const int lane_ = tidx() & 63, gw_ = bidx() * NWAVES + (tidx() >> 6), NGW_ = gridDim.x * NWAVES;
      for (int col = gw_; col < 4096; col += NGW_) { float sa = 0.f;
#pragma unroll
          for (int q = 0; q < 4; ++q) { const h16x8 v = *(const h16x8*)(ZTL + (size_t)col * 4096 + q * 512 + lane_ * 8);
#pragma unroll
              for (int e = 0; e < 8; ++e) sa += (float)v[e]; }
          sa = wave_sum(sa);
          if (lane_ == 0) brp[(size_t)((col >> 8) * 2048) * DM + 256 + (col & 255)] = (h16)(sa * 0.022097086912079608f); } }
}

#define MEMFENCE() asm volatile("" ::: "memory")
__device__ __forceinline__ void phase_wg(const Params& p) {
    const float* modv = (const float*)(p.ws + WS_MODV); float* wg = (float*)(p.ws + WS_WG); float* sgb = (float*)(p.ws + WS_SGB);
    const int tid = tidx(), lane = tid & 63, gw = bidx() * NWAVES + (tid >> 6), NGW = gridDim.x * NWAVES;
    for (int it = bidx() * NTHREADS + tid; it < 2 * 17 * 1024; it += gridDim.x * NTHREADS) {
        const int k = it & 1023, lm = it >> 10, l = lm / 17;
        const float G = p.ln1_g[l * DM + k] * (1.f + modv[(size_t)lm * NMOD + 4 * DM + k]);
        const float* w = p.w_router + ((size_t)l * DM + k) * 16; float* o = wg + (size_t)lm * 16384 + (size_t)((k >> 2) * 16) * 4 + (k & 3);
#pragma unroll
        for (int e4 = 0; e4 < 4; ++e4) { const f32x4 wv = *(const f32x4*)(w + e4 * 4);
#pragma unroll
            for (int c = 0; c < 4; ++c) o[(e4 * 4 + c) * 4] = G * wv[c]; } }
    for (int lm = gw; lm < 34; lm += NGW) { const int l = lm / 17;
        float sg[16], sb[16];
#pragma unroll
        for (int e = 0; e < 16; ++e) { sg[e] = 0.f; sb[e] = 0.f; }
        for (int q = 0; q < 16; ++q) { const int k = lane + 64 * q; const float sc = modv[(size_t)lm * NMOD + 4 * DM + k], sh = modv[(size_t)lm * NMOD + 3 * DM + k];
            const float G = p.ln1_g[l * DM + k] * (1.f + sc), Bp = p.ln1_b[l * DM + k] * (1.f + sc) + sh; const float* w = p.w_router + ((size_t)l * DM + k) * 16;
#pragma unroll
            for (int e4 = 0; e4 < 4; ++e4) { const f32x4 wv = *(const f32x4*)(w + e4 * 4);
#pragma unroll
                for (int c = 0; c < 4; ++c) { sg[e4 * 4 + c] += G * wv[c]; sb[e4 * 4 + c] += Bp * wv[c]; } } }
#pragma unroll
        for (int e = 0; e < 16; ++e) { const float a = wave_sum(sg[e]), b = wave_sum(sb[e]); if (lane == 0) { sgb[lm * 32 + e] = a; sgb[lm * 32 + 16 + e] = b; } } }
}
__device__ __forceinline__ void ln1_rows(const float* hB, h16* u16, float* stat, const float* mvp, const float* g, const float* bb, int R0, int nrows, int ioff, int lane, float& mu, float& rho, float* cst) {
    f32x4 gg[4], bv[4], sh[4], sc[4];
#pragma unroll
    for (int j = 0; j < 4; ++j) { const int col = lane * 4 + 256 * j; gg[j] = *(const f32x4*)(g + col); bv[j] = *(const f32x4*)(bb + col); sh[j] = *(const f32x4*)(mvp + 3 * DM + col); sc[j] = *(const f32x4*)(mvp + 4 * DM + col); }
    f32x4 v[4], vn[4];
#pragma unroll
    for (int j = 0; j < 4; ++j) v[j] = *(const f32x4*)(hB + (size_t)R0 * DM + lane * 4 + 256 * j);
    for (int i = 0; i < nrows; ++i) {
        const int R = R0 + i;
        MEMFENCE();
        if (i + 1 < nrows) {
#pragma unroll
            for (int j = 0; j < 4; ++j) vn[j] = *(const f32x4*)(hB + (size_t)(R + 1) * DM + lane * 4 + 256 * j); }
        MEMFENCE();
        float s = 0.f;
#pragma unroll
        for (int j = 0; j < 4; ++j) s += (v[j][0] + v[j][1]) + (v[j][2] + v[j][3]);
        const float mean = wave_sum(s) * (1.f / DM); float q = 0.f;
#pragma unroll
        for (int j = 0; j < 4; ++j) { v[j] = v[j] - mean; q += (v[j][0] * v[j][0] + v[j][1] * v[j][1]) + (v[j][2] * v[j][2] + v[j][3] * v[j][3]); }
        const float rstd = rsqrtf(wave_sum(q) * (1.f / DM) + LN_EPS);
        if (lane == 0) { float* st = stat + (size_t)R * 2; st[0] = mean; st[1] = rstd; if (cst) { cst[(ioff + i) * 2] = mean; cst[(ioff + i) * 2 + 1] = rstd; } }
        if ((lane & 15) == ioff + i) { mu = mean; rho = rstd; }
#pragma unroll
        for (int j = 0; j < 4; ++j) { const int col = lane * 4 + 256 * j;
            const f32x4 h1 = v[j] * rstd * gg[j] + bv[j];
            const f32x4 u2 = h1 * (1.f + sc[j]) + sh[j];
            *(unsigned long long*)(u16 + (size_t)R * DM + col) = (unsigned long long)pk_b2(u2[0], u2[1]) | ((unsigned long long)pk_b2(u2[2], u2[3]) << 32); }
#pragma unroll
        for (int j = 0; j < 4; ++j) v[j] = vn[j];
    }
}
__device__ __forceinline__ f32x4 ln1_router_mfma(const float* vrow, const float* wgl, int t0, int t1) {
    f32x4 a0 = {0.f, 0.f, 0.f, 0.f}, a1 = {0.f, 0.f, 0.f, 0.f};
    f32x4 b[8], bn[8];
#pragma unroll
    for (int u = 0; u < 8; ++u) b[u] = *(const f32x4*)(vrow + 16 * (t0 + u));
    for (int t = t0; t < t1; t += 8) {
        if (t + 8 < t1) {
#pragma unroll
            for (int u = 0; u < 8; ++u) bn[u] = *(const f32x4*)(vrow + 16 * (t + 8 + u)); }
#pragma unroll
        for (int u = 0; u < 8; ++u) { const f32x4 a = *(const f32x4*)(wgl + (t + u) * 256);
#pragma unroll
            for (int i = 0; i < 4; ++i) { if (u & 1) a1 = __builtin_amdgcn_mfma_f32_16x16x4f32(a[i], b[u][i], a1, 0, 0, 0); else a0 = __builtin_amdgcn_mfma_f32_16x16x4f32(a[i], b[u][i], a0, 0, 0, 0); } }
#pragma unroll
        for (int u = 0; u < 8; ++u) b[u] = bn[u];
    }
    return a0 + a1;
}
__device__ __forceinline__ void ln1_finish(const Params& p, const float* sgbm, const f32x4 D, float mu, float rho, int R, int lane) {
    float* affL = (float*)(p.ws + WS_AFFL); float* affC = (float*)(p.ws + WS_AFFC);
    const int eq = lane >> 4; const f32x4 sg = *(const f32x4*)(sgbm + 4 * eq), sb = *(const f32x4*)(sgbm + 16 + 4 * eq);
    const float rm = rho * mu; float lg[4];
#pragma unroll
    for (int r = 0; r < 4; ++r) lg[r] = rho * D[r] - rm * sg[r] + sb[r];
    float mx = fmaxf(fmaxf(lg[0], lg[1]), fmaxf(lg[2], lg[3])); mx = xor16_max(mx); mx = xor32_max(mx);
    float ex[4], se = 0.f;
#pragma unroll
    for (int r = 0; r < 4; ++r) { ex[r] = __builtin_amdgcn_exp2f((lg[r] - mx) * 1.4426950408889634f); se += ex[r]; }
    se = xor16_sum(se); se = xor32_sum(se);
#pragma unroll
    for (int r = 0; r < 4; ++r) { const float a = ex[r] / se; const int e = 4 * eq + r;
        if (R < TL) affL[((size_t)((R >> 11) * 16 + e)) * 2048 + (R & 2047)] = a; else { const int rr = R - TL; affC[((size_t)((rr >> 8) * 16 + e)) * 256 + (rr & 255)] = a; } }
}
__device__ __forceinline__ void phase_ln1_fill(const Params& p, int l, float* lds) {
    const float* wg = (const float*)(p.ws + WS_WG) + (size_t)l * 17 * 16384; const int tid = tidx(), bt = bidx() >> 4;
    __syncthreads();
    for (int e = tid; e < 4096; e += NTHREADS) *(f32x4*)(lds + e * 4) = *(const f32x4*)(wg + (size_t)bt * 16384 + e * 4);
    if (l == 0) for (int e = tid; e < 4096; e += NTHREADS) *(f32x4*)(lds + 16384 + e * 4) = *(const f32x4*)(wg + (size_t)16 * 16384 + e * 4);
    __syncthreads();
}
__device__ __forceinline__ void phase_ln1(const Params& p, int l, float* lds) {
    float* hB = (float*)(p.ws + WS_HB); h16* u16 = (h16*)(p.ws + WS_U16); const float* modv = (const float*)(p.ws + WS_MODV) + (size_t)l * 17 * NMOD;
    float* stat = (float*)(p.ws + WS_STAT); const float* wg = (const float*)(p.ws + WS_WG) + (size_t)l * 17 * 16384; const float* sgb = (const float*)(p.ws + WS_SGB) + l * 17 * 32;
    const float* g = p.ln1_g + l * DM; const float* bb = p.ln1_b + l * DM;
    const int tid = tidx(), lane = tid & 63, w = tid >> 6, c = bidx();
    const int bt = c >> 4;
    float* cst = lds + 32768; float* part = lds + 32768 + 64;
    __syncthreads();
    { const int Rg = c * 128 + w * 16; float mu = 0.f, rho = 0.f;
      ln1_rows(hB, u16, stat, modv + (size_t)bt * NMOD, g, bb, Rg, 16, 0, lane, mu, rho, nullptr);
      const f32x4 D = ln1_router_mfma(hB + (size_t)(Rg + (lane & 15)) * DM + 4 * (lane >> 4), lds + lane * 4, 0, 64);
      ln1_finish(p, sgb + bt * 32, D, mu, rho, Rg + (lane & 15), lane); }
    if (l == 0) { const int Cg = TL + c * 16; float mu = 0.f, rho = 0.f;
      ln1_rows(hB, u16, stat, modv + (size_t)16 * NMOD, g, bb, Cg + 2 * w, 2, 2 * w, lane, mu, rho, cst);
      __syncthreads();
      const f32x4 D = ln1_router_mfma(hB + (size_t)(Cg + (lane & 15)) * DM + 4 * (lane >> 4), lds + 16384 + lane * 4, 8 * w, 8 * w + 8);
      *(f32x4*)(part + (w * 64 + lane) * 4) = D;
      __syncthreads();
      if (w == 0) { f32x4 Ds = *(const f32x4*)(part + lane * 4);
#pragma unroll
          for (int q = 1; q < 8; ++q) Ds += *(const f32x4*)(part + (q * 64 + lane) * 4);
          ln1_finish(p, sgb + 16 * 32, Ds, cst[(lane & 15) * 2], cst[(lane & 15) * 2 + 1], Cg + (lane & 15), lane); } }
    __syncthreads();
}

__device__ __forceinline__ void phase_topk(const Params& p, int l, float* lds) {
    const float* affL = (const float*)(p.ws + WS_AFFL); const float* affC = (const float*)(p.ws + WS_AFFC); float* selw = (float*)(p.ws + WS_SELW); int* slot_of = (int*)(p.ws + WS_SLOT);
    int* selrow = (int*)(p.ws + WS_SELR);
    unsigned* a = (unsigned*)lds; unsigned* hist = (unsigned*)(lds + 2048 + 256); int* wsum = (int*)(lds + 2048 + 512); unsigned* ctl = (unsigned*)(lds + 2048 + 512 + 32);
    const int tid = tidx(), lane = tid & 63, wave = tid >> 6;
    const int nitems = (l == 0) ? 512 : 256;
    __syncthreads();
    for (int it = bidx(); it < nitems; it += gridDim.x) {
        const bool lat = it < 256; const int be = lat ? it : it - 256; const int b = be >> 4, e = be & 15; const int n = lat ? 2048 : 256, cap = lat ? CAPL : CAPC;
        const float* src = lat ? affL + (size_t)be * 2048 : affC + (size_t)be * 256;
        for (int i = tid; i < n; i += NTHREADS) a[i] = __float_as_uint(src[i]);
        unsigned prefix = 0u, pmask = 0u; int remaining = cap;
        for (int pass = 0; pass < 4; ++pass) {
            const int shift = 24 - 8 * pass;
            if (tid < 256) hist[tid] = 0u;
            __syncthreads();
            for (int i = tid; i < n; i += NTHREADS) { const unsigned u = a[i]; if ((u & pmask) == prefix) atomicAdd(&hist[(u >> shift) & 255u], 1u); }
            __syncthreads();
            if (tid < 64) {
                unsigned c4[4]; unsigned s4 = 0;
#pragma unroll
                for (int q = 0; q < 4; ++q) { c4[q] = hist[255 - (lane * 4 + q)]; s4 += c4[q]; }
                unsigned incl = s4;
#pragma unroll
                for (int o = 1; o < 64; o <<= 1) { const unsigned t = __shfl_up(incl, o); if (lane >= o) incl += t; }
                unsigned excl = incl - s4;
                const bool mine = (excl < (unsigned)remaining) && (incl >= (unsigned)remaining);
                if (mine) { unsigned cum = excl; int bin = 0; unsigned above = 0;
#pragma unroll
                    for (int q = 0; q < 4; ++q) { if (cum < (unsigned)remaining && cum + c4[q] >= (unsigned)remaining) { bin = 255 - (lane * 4 + q); above = cum; } cum += c4[q]; }
                    ctl[0] = (unsigned)bin; ctl[1] = above; }
            }
            __syncthreads();
            prefix |= ctl[0] << shift; pmask |= 255u << shift; remaining -= (int)ctl[1];
            __syncthreads();
        }
        const unsigned T = prefix; const int need_eq = remaining;
        const int i0 = tid * 4; int ngt = 0, neq = 0; unsigned u4[4];
#pragma unroll
        for (int q = 0; q < 4; ++q) { const int i = i0 + q; u4[q] = (i < n) ? a[i] : 0u; ngt += (i < n && u4[q] > T) ? 1 : 0; neq += (i < n && u4[q] == T) ? 1 : 0; }
        int ieq = neq;
#pragma unroll
        for (int o = 1; o < 64; o <<= 1) { const int t = __shfl_up(ieq, o); if (lane >= o) ieq += t; }
        if (lane == 63) wsum[wave] = ieq;
        __syncthreads();
        int eqbase = 0;
#pragma unroll
        for (int wv = 0; wv < 8; ++wv) eqbase += (wv < wave) ? wsum[wv] : 0;
        int eqrank = eqbase + ieq - neq;
        int nsel = 0; bool sel[4];
#pragma unroll
        for (int q = 0; q < 4; ++q) { const int i = i0 + q; const bool gt = (i < n) && (u4[q] > T); const bool eq = (i < n) && (u4[q] == T); sel[q] = gt || (eq && eqrank < need_eq); eqrank += eq ? 1 : 0; nsel += sel[q] ? 1 : 0; }
        __syncthreads();
        int isel = nsel;
#pragma unroll
        for (int o = 1; o < 64; o <<= 1) { const int t = __shfl_up(isel, o); if (lane >= o) isel += t; }
        if (lane == 63) wsum[wave] = isel;
        __syncthreads();
        int sbase = 0;
#pragma unroll
        for (int wv = 0; wv < 8; ++wv) sbase += (wv < wave) ? wsum[wv] : 0;
        int slot = sbase + isel - nsel;
        const int gbase = lat ? be * 256 : GL + e * 512 + b * 32;
#pragma unroll
        for (int q = 0; q < 4; ++q) { const int i = i0 + q; if (i < n) { const int R = lat ? b * 2048 + i : TL + b * 256 + i;
            if (sel[q]) { selrow[gbase + slot] = R; selw[gbase + slot] = __uint_as_float(u4[q]); slot_of[(size_t)R * 16 + e] = gbase + slot; ++slot; } else slot_of[(size_t)R * 16 + e] = -1; } }
        __syncthreads();
    }
}

struct Ln2S { int sl; float m, r; };
__device__ __forceinline__ Ln2S ln2_ldS(const int* slot_of, const float* stat, int R, int lane) { Ln2S s; s.sl = slot_of[(size_t)R * 16 + (lane & 15)]; s.m = stat[(size_t)R * 2]; s.r = stat[(size_t)R * 2 + 1]; return s; }
__device__ __forceinline__ void ln2_issue(const h16* Y, const float* hB, int R, int sl, int lane, h16x4 (&yv)[4][4], f32x4 (&h)[4]) {
    unsigned long long msk = __ballot(sl >= 0) & 0xFFFFull;
#pragma unroll
    for (int q = 0; q < 4; ++q) { if (msk) { const int e = __builtin_ctzll(msk); msk &= msk - 1; const int sr = __builtin_amdgcn_readlane(sl, e);
#pragma unroll
            for (int j = 0; j < 4; ++j) yv[q][j] = *(const h16x4*)(Y + (size_t)sr * DM + lane * 4 + 256 * j); }
        else {
#pragma unroll
            for (int j = 0; j < 4; ++j) yv[q][j] = (h16x4){(h16)0.f, (h16)0.f, (h16)0.f, (h16)0.f}; } }
#pragma unroll
    for (int j = 0; j < 4; ++j) h[j] = *(const f32x4*)(hB + (size_t)R * DM + lane * 4 + 256 * j);
}
__device__ __forceinline__ void ln2_rows(const Params& p, int l, const float* ldsv, int R0, int nrows, int mv, int lane) {
    float* hB = (float*)(p.ws + WS_HB); h16* u16 = (h16*)(p.ws + WS_U16); const h16* Y = (const h16*)(p.ws + WS_XG); const int* slot_of = (const int*)(p.ws + WS_SLOT);
    const float* mvp = (const float*)(p.ws + WS_MODV) + ((size_t)l * 17 + mv) * NMOD; const float* mvn = mvp + (size_t)17 * NMOD; const float* stat = (const float*)(p.ws + WS_STAT);
    const bool nextu = (l < DEPTH - 1);
    f32x4 gate[4], nsh[4], nsc[4];
#pragma unroll
    for (int j = 0; j < 4; ++j) { const int col = lane * 4 + 256 * j; gate[j] = *(const f32x4*)(mvp + 5 * DM + col); nsh[j] = (f32x4){0.f, 0.f, 0.f, 0.f}; nsc[j] = nsh[j];
        if (nextu) { nsh[j] = *(const f32x4*)(mvn + col); nsc[j] = *(const f32x4*)(mvn + DM + col); } }
    Ln2S sA = ln2_ldS(slot_of, stat, R0, lane), sB = sA, sC = sA, sD = sA;
    if (nrows > 1) sB = ln2_ldS(slot_of, stat, R0 + 1, lane);
    if (nrows > 2) sC = ln2_ldS(slot_of, stat, R0 + 2, lane);
    h16x4 yv0[4][4], yv1[4][4]; f32x4 h0[4], h1b[4];
    ln2_issue(Y, hB, R0, sA.sl, lane, yv0, h0);
    for (int i = 0; i < nrows; ++i) {
        const int R = R0 + i;
        MEMFENCE();
        if (i + 1 < nrows) ln2_issue(Y, hB, R + 1, sB.sl, lane, yv1, h1b);
        if (i + 3 < nrows) sD = ln2_ldS(slot_of, stat, R + 3, lane);
        MEMFENCE();
        f32x4 f[4];
#pragma unroll
        for (int j = 0; j < 4; ++j) { f[j] = (f32x4){0.f, 0.f, 0.f, 0.f};
#pragma unroll
            for (int q = 0; q < 4; ++q) { f[j][0] += (float)yv0[q][j][0]; f[j][1] += (float)yv0[q][j][1]; f[j][2] += (float)yv0[q][j][2]; f[j][3] += (float)yv0[q][j][3]; } }
        { unsigned long long msk = __ballot(sA.sl >= 0) & 0xFFFFull;
#pragma unroll
          for (int q = 0; q < 4; ++q) msk &= msk - 1;
          while (msk) { const int e = __builtin_ctzll(msk); msk &= msk - 1; const int sr = __builtin_amdgcn_readlane(sA.sl, e);
#pragma unroll
            for (int j = 0; j < 4; ++j) { const h16x4 y = *(const h16x4*)(Y + (size_t)sr * DM + lane * 4 + 256 * j); f[j][0] += (float)y[0]; f[j][1] += (float)y[1]; f[j][2] += (float)y[2]; f[j][3] += (float)y[3]; } } }
        f32x4 v[4]; float s = 0.f;
#pragma unroll
        for (int j = 0; j < 4; ++j) { const f32x4 g1v = *(const f32x4*)(ldsv + lane * 4 + 256 * j), b1v = *(const f32x4*)(ldsv + 1024 + lane * 4 + 256 * j);
            const f32x4 hh = (h0[j] - sA.m) * sA.r * g1v + b1v;
            v[j] = ALPHA * hh + gate[j] * f[j]; s += (v[j][0] + v[j][1]) + (v[j][2] + v[j][3]); }
        const float mean = wave_sum(s) * (1.f / DM); float q = 0.f;
#pragma unroll
        for (int j = 0; j < 4; ++j) { v[j] = v[j] - mean; q += (v[j][0] * v[j][0] + v[j][1] * v[j][1]) + (v[j][2] * v[j][2] + v[j][3] * v[j][3]); }
        const float rstd = rsqrtf(wave_sum(q) * (1.f / DM) + LN_EPS);
        float* orow = (l == DEPTH - 1) ? p.out + (size_t)R * DM : hB + (size_t)R * DM;
#pragma unroll
        for (int j = 0; j < 4; ++j) { const int col = lane * 4 + 256 * j; const f32x4 g2v = *(const f32x4*)(ldsv + 2048 + col), b2v = *(const f32x4*)(ldsv + 3072 + col);
            const f32x4 h2 = v[j] * rstd * g2v + b2v; if (l == DEPTH - 1) __builtin_nontemporal_store(h2, (f32x4*)(orow + col)); else *(f32x4*)(orow + col) = h2;
            if (nextu) { const f32x4 u = h2 * (1.f + nsc[j]) + nsh[j];
                *(unsigned long long*)(u16 + (size_t)R * DM + col) = (unsigned long long)pk_h2(u[0], u[1]) | ((unsigned long long)pk_h2(u[2], u[3]) << 32); } }
#pragma unroll
        for (int q2 = 0; q2 < 4; ++q2)
#pragma unroll
            for (int j = 0; j < 4; ++j) yv0[q2][j] = yv1[q2][j];
#pragma unroll
        for (int j = 0; j < 4; ++j) h0[j] = h1b[j];
        sA = sB; sB = sC; sC = sD;
    }
}
__device__ __forceinline__ void phase_ln2(const Params& p, int l, float* lds) {
    const int tid = tidx(), lane = tid & 63, w = tid >> 6, c = bidx();
    __syncthreads();
    for (int e = tid; e < 1024; e += NTHREADS) { const int k = e >> 8, col = (e & 255) * 4; const float* src = (k == 0 ? p.ln1_g : k == 1 ? p.ln1_b : k == 2 ? p.ln2_g : p.ln2_b) + l * DM + col;
        *(f32x4*)(lds + k * 1024 + col) = *(const f32x4*)src; }
    __syncthreads();
    ln2_rows(p, l, lds, c * 128 + w * 16, 16, c >> 4, lane);
    if (l == 0) ln2_rows(p, l, lds, TL + c * 16 + 2 * w, 2, 16, lane);
    __syncthreads();
}

namespace fg {
#define FG_LAS __attribute__((address_space(3)))
constexpr int BM = 256, BK = 64, HALF = 128, HTB = HALF * BK * 2, STAGE_BYTES = 8 * HTB;
__host__ __device__ __forceinline__ int lds_byte(int r, int c) { const int st = (r >> 4) * 2 + (c >> 5), rr = r & 15, cc = c & 31, ob = rr * 64 + cc * 2; return st * 1024 + (ob ^ (((ob >> 9) & 1) << 5)); }
__host__ __device__ __forceinline__ void stage_rc(int b, int& R, int& C) { const int st = b / 1024, sb = b % 1024, swz = sb ^ (((sb >> 9) & 1) << 5); R = (st >> 1) * 16 + swz / 64; C = (st & 1) * 32 + (swz % 64) / 2; }
__host__ __device__ __forceinline__ int perm32(int rho) { const int n = rho >> 4, i = rho & 15; return 8 * (i >> 2) + 4 * n + (i & 3); }
struct Unit { const char* A; const char* B; int nt; int pm, pn, aux; const int* rows; };
template <class Epi, class Sched, int LD, bool BF = false, bool GATHER = false>
__device__ __forceinline__ void gemm_phase(FG_LAS unsigned char* lds, const Sched& S, const Epi& E) {
    const int tid = tidx(), wid = __builtin_amdgcn_readfirstlane(tid >> 6), lane = tid & 63, wr = wid >> 2, wc = wid & 3, fr = lane & 15, fq = lane >> 4;
    unsigned voffA[2], voffB[2]; int rowA[2], colA[2];
#pragma unroll
    for (int i = 0; i < 2; ++i) { int R, C; stage_rc(tid * 16 + i * 8192, R, C); const int Rb = Epi::PERM ? ((R & ~31) + perm32(R & 31)) : R;
        voffA[i] = (unsigned)(R * LD + C) * 2u; voffB[i] = (unsigned)(Rb * LD + C) * 2u; rowA[i] = R; colA[i] = C; }
    const size_t kstep = (size_t)(BK * 2);
    const size_t hstep = GATHER ? (size_t)0 : (size_t)HALF * LD * 2;
    const unsigned ldsw = (unsigned)wid * 1024u;
    const int aoff = lds_byte(wr * 64 + fr, fq * 8), boff = lds_byte(wc * 32 + fr, fq * 8);
#define FG_SA(b, h) (((b) * 2 + (h)) * HTB)
#define FG_SB(b, h) ((4 + (b) * 2 + (h)) * HTB)
#define FG_STAGE(bufoff, gbase, voff) do { _Pragma("unroll") for (int _i = 0; _i < 2; ++_i) \
        __builtin_amdgcn_global_load_lds((const unsigned*)((const char*)(gbase) + (voff)[_i]), (FG_LAS unsigned*)(lds + (bufoff) + ldsw + _i * 8192), 16, 0, 0); } while (0)
#define FG_STAGEA(bufoff, gbase, h, cur_) do { if (GATHER) { if (cur_) FG_STAGE(bufoff, gbase, cvA[h]); else FG_STAGE(bufoff, gbase, nvA[h]); } else FG_STAGE(bufoff, (gbase) + (h) * ((size_t)HALF * LD * 2), voffA); } while (0)
#define FG_LDA(dst, b, h) do { _Pragma("unroll") for (int m = 0; m < 4; ++m) _Pragma("unroll") for (int k = 0; k < 2; ++k) dst[m][k] = *(const FG_LAS h16x8*)(lds + FG_SA(b, h) + aoff + m * 2048 + k * 1024); } while (0)
#define FG_LDB(dst, b, h) do { _Pragma("unroll") for (int n = 0; n < 2; ++n) _Pragma("unroll") for (int k = 0; k < 2; ++k) dst[n][k] = *(const FG_LAS h16x8*)(lds + FG_SB(b, h) + boff + n * 2048 + k * 1024); } while (0)
#define FG_MMA(ai, bj, At, Bt) do { __builtin_amdgcn_s_setprio(1); _Pragma("unroll") for (int m = 0; m < 4; ++m) _Pragma("unroll") for (int n = 0; n < 2; ++n) _Pragma("unroll") for (int k = 0; k < 2; ++k) \
        acc[ai][bj][m][n] = BF ? __builtin_amdgcn_mfma_f32_16x16x32_bf16(__builtin_bit_cast(bf16x8_t, Bt[n][k]), __builtin_bit_cast(bf16x8_t, At[m][k]), acc[ai][bj][m][n], 0, 0, 0) : __builtin_amdgcn_mfma_f32_16x16x32_f16(Bt[n][k], At[m][k], acc[ai][bj][m][n], 0, 0, 0); __builtin_amdgcn_s_setprio(0); } while (0)
#define FG_WAIT_V(n) asm volatile("s_waitcnt vmcnt(" #n ")" ::: "memory")
#define FG_WAIT_L(n) asm volatile("s_waitcnt lgkmcnt(" #n ")" ::: "memory")
#define FG_BAR __builtin_amdgcn_s_barrier()
#define FG_SCHED __builtin_amdgcn_sched_barrier(0)
    Unit cur, nxt; int ui = 0;
    __syncthreads();
    if (!S.next(0, cur)) return;
    f32x4 acc[2][2][4][2];
#pragma unroll
    for (int a = 0; a < 2; ++a)
#pragma unroll
        for (int b = 0; b < 2; ++b)
#pragma unroll
            for (int m = 0; m < 4; ++m)
#pragma unroll
                for (int n = 0; n < 2; ++n) acc[a][b][m][n] = (f32x4){0.f, 0.f, 0.f, 0.f};
    h16x8 At[4][2], B0[2][2], B1[2][2];
    const char* cA = cur.A; const char* cB = cur.B;
    const size_t hstepB = (size_t)HALF * LD * 2;
    unsigned cvA[2][2], nvA[2][2];
    if (GATHER) {
#pragma unroll
        for (int h = 0; h < 2; ++h)
#pragma unroll
            for (int i = 0; i < 2; ++i) { cvA[h][i] = (unsigned)(cur.rows[h * HALF + rowA[i]] * LD + colA[i]) * 2u; nvA[h][i] = cvA[h][i]; } }
    FG_STAGE(FG_SB(0, 0), cB, voffB); FG_STAGE(FG_SB(0, 1), cB + hstepB, voffB); FG_STAGEA(FG_SA(0, 0), cA, 0, true); FG_STAGEA(FG_SA(0, 1), cA, 1, true);
    if (wr == 1) FG_BAR;
    FG_WAIT_V(2); FG_BAR;
    FG_STAGE(FG_SB(1, 0), cB + kstep, voffB); FG_STAGEA(FG_SA(1, 0), cA + kstep, 0, true); FG_STAGE(FG_SB(1, 1), cB + hstepB + kstep, voffB);
    FG_WAIT_V(6); FG_BAR;
    for (;;) {
        const bool has_next = S.next(ui + 1, nxt);
        const char* nA = has_next ? nxt.A : cA; const char* nB = has_next ? nxt.B : cB;
        if (GATHER && has_next) {
#pragma unroll
            for (int h = 0; h < 2; ++h)
#pragma unroll
                for (int i = 0; i < 2; ++i) nvA[h][i] = (unsigned)(nxt.rows[h * HALF + rowA[i]] * LD + colA[i]) * 2u; }
        const int nt = cur.nt;
        for (int t = 0; t < nt; t += 2) {
            const bool last = (t == nt - 2);
            const char* a1 = cA + (size_t)(t + 1) * kstep;
            const char* a2 = last ? nA : cA + (size_t)(t + 2) * kstep; const char* b2 = last ? nB : cB + (size_t)(t + 2) * kstep;
            const char* a3 = a2 + kstep; const char* b3 = b2 + kstep;
            FG_LDB(B0, 0, 0); FG_LDB(B1, 0, 1); FG_SCHED; FG_LDA(At, 0, 0); FG_STAGEA(FG_SA(1, 1), a1, 1, true);
            FG_WAIT_V(8); FG_WAIT_L(0); FG_BAR; FG_MMA(0, 0, At, B0); FG_MMA(0, 1, At, B1); FG_BAR; FG_SCHED;
            FG_LDA(At, 0, 1); FG_STAGE(FG_SB(0, 0), b2, voffB); FG_STAGE(FG_SB(0, 1), b2 + hstepB, voffB); FG_STAGEA(FG_SA(0, 0), a2, 0, !last);
            FG_WAIT_V(8); FG_WAIT_L(0); FG_BAR; FG_MMA(1, 0, At, B0); FG_MMA(1, 1, At, B1); FG_BAR; FG_SCHED;
            FG_LDB(B0, 1, 0); FG_LDB(B1, 1, 1); FG_SCHED; FG_LDA(At, 1, 0); FG_STAGEA(FG_SA(0, 1), a2, 1, !last);
            FG_WAIT_V(8); FG_WAIT_L(0); FG_BAR; FG_MMA(0, 0, At, B0); FG_MMA(0, 1, At, B1); FG_BAR; FG_SCHED;
            FG_LDA(At, 1, 1); FG_STAGE(FG_SB(1, 0), b3, voffB); FG_STAGE(FG_SB(1, 1), b3 + hstepB, voffB); FG_STAGEA(FG_SA(1, 0), a3, 0, !last);
            FG_WAIT_V(8); FG_WAIT_L(0); FG_BAR; FG_MMA(1, 0, At, B0); FG_MMA(1, 1, At, B1); FG_BAR; FG_SCHED;
        }
        if (wr == 0) FG_BAR;
        { const int t2_ = tidx(); E(acc, cur, wr, wc, t2_ & 15, (t2_ >> 4) & 3); }
        if (!has_next) break;
#pragma unroll
        for (int a = 0; a < 2; ++a)
#pragma unroll
            for (int b = 0; b < 2; ++b)
#pragma unroll
                for (int m = 0; m < 4; ++m)
#pragma unroll
                    for (int n = 0; n < 2; ++n) acc[a][b][m][n] = (f32x4){0.f, 0.f, 0.f, 0.f};
        cur = nxt; cA = nA; cB = nB; ++ui;
        if (GATHER) {
#pragma unroll
            for (int h = 0; h < 2; ++h)
#pragma unroll
                for (int i = 0; i < 2; ++i) cvA[h][i] = nvA[h][i]; }
        if (wr == 1) FG_BAR;
    }
    FG_WAIT_V(0);
    FG_BAR;
#undef FG_SA
#undef FG_SB
#undef FG_STAGE
#undef FG_LDA
#undef FG_STAGEA
#undef FG_LDB
#undef FG_MMA
#undef FG_WAIT_V
#undef FG_WAIT_L
#undef FG_BAR
#undef FG_SCHED
}
}
typedef FG_LAS unsigned char* ldsp_t;

template <bool BF = false>
__device__ __forceinline__ void transpose_item(const float* W, int ldw, h16* WT, int ldt, float* scr, int lane, float scl = 1.f) {
    f32x4 t[16];
#pragma unroll
    for (int i = 0; i < 16; ++i) t[i] = __builtin_nontemporal_load((const f32x4*)(W + (size_t)(i * 4 + (lane >> 4)) * ldw + (lane & 15) * 4));
#pragma unroll
    for (int i = 0; i < 16; ++i) { float* d = scr + (i * 4 + (lane >> 4)) * 65 + (lane & 15) * 4; d[0] = t[i][0]; d[1] = t[i][1]; d[2] = t[i][2]; d[3] = t[i][3]; }
    __builtin_amdgcn_wave_barrier();
    const int c = lane & 7;
#pragma unroll
    for (int j = 0; j < 8; ++j) { const int n = (lane >> 3) + 8 * j; const float* sp = scr + (8 * c) * 65 + n;
        u32x4 o; if (BF) { o.x = pk_b2(sp[0 * 65], sp[1 * 65]); o.y = pk_b2(sp[2 * 65], sp[3 * 65]); o.z = pk_b2(sp[4 * 65], sp[5 * 65]); o.w = pk_b2(sp[6 * 65], sp[7 * 65]); }
        else { o.x = pk_h2(sp[0 * 65] * scl, sp[1 * 65] * scl); o.y = pk_h2(sp[2 * 65] * scl, sp[3 * 65] * scl); o.z = pk_h2(sp[4 * 65] * scl, sp[5 * 65] * scl); o.w = pk_h2(sp[6 * 65] * scl, sp[7 * 65] * scl); }
        *(u32x4*)(WT + (size_t)n * ldt + 8 * c) = o; }
    __builtin_amdgcn_wave_barrier();
}
struct SchedWF {
    const char* BDT; const char* WFIN; int c;
    __device__ __forceinline__ bool next(int i, fg::Unit& u) const {
        if (i != 0 || c >= 16) return false;
        u.aux = c >> 3; u.pm = (c >> 2) & 1; u.pn = c & 3; u.nt = 4;
        u.A = BDT + (size_t)u.pm * 256 * 256 * 2; u.B = WFIN + ((size_t)u.aux * 1024 + u.pn * 256) * 256 * 2; return true;
    }
};
struct EpiWF {
    static constexpr bool PERM = true;
    h16* WinT;
    __device__ __forceinline__ void operator()(const f32x4 (&acc)[2][2][4][2], const fg::Unit& u, int wr, int wc, int fr, int fq) const {
        h16* base = WinT + ((size_t)u.aux * 6144 + 5632 + u.pm * 256 + 64 * wr + fr) * DM + u.pn * 256 + 32 * wc + 8 * fq;
#pragma unroll
        for (int ai = 0; ai < 2; ++ai)
#pragma unroll
            for (int m = 0; m < 4; ++m)
#pragma unroll
                for (int bj = 0; bj < 2; ++bj) { const f32x4 v0 = acc[ai][bj][m][0], v1 = acc[ai][bj][m][1];
                    *(u32x4*)(base + (size_t)(128 * ai + 16 * m) * DM + 128 * bj) = (u32x4){pk_h2(v0[0], v0[1]), pk_h2(v0[2], v0[3]), pk_h2(v1[0], v1[1]), pk_h2(v1[2], v1[3])}; }
    }
};
__device__ __forceinline__ void phase_convert_dense(const Params& p, float* lds, ldsp_t ldsf) {
    { SchedWF S{(const char*)(p.ws + WS_BDT), (const char*)(p.ws + WS_WFIN), bidx()}; EpiWF E{(h16*)(p.ws + WS_WINT)};
      fg::gemm_phase<EpiWF, SchedWF, 256>(ldsf, S, E); }
    __syncthreads();
}
__device__ __forceinline__ void dense_transposes(const Params& p, float* lds) {
    if (bidx() < 192) return;
    __syncthreads();
    const int lane = tidx() & 63, wave = tidx() >> 6, gw = (bidx() - 192) * NWAVES + wave, NGW = (gridDim.x - 192) * NWAVES;
    float* scr = lds + wave * (64 * 65);
    h16* WinT = (h16*)(p.ws + WS_WINT); h16* WbT = (h16*)(p.ws + WS_WBT); h16* WoT = (h16*)(p.ws + WS_WOT);
    constexpr int I_IN = 16 * 88, I_BR = 4 * 4 * 16, I_OUT = 16 * 16, I_L = I_IN + I_BR + I_OUT;
    for (int it = gw; it < 2 * I_L; it += NGW) {
        const int l = it / I_L; int r = it % I_L;
        if (r < I_IN) { const int kb = r / 88, db = r % 88; const int d0 = db * 64; const int sc0 = d0 < 512 ? d0 : d0 + 256;
            transpose_item(p.w_in + ((size_t)l * DM + kb * 64) * INW + sc0, INW, WinT + ((size_t)l * 6144 + d0) * DM + kb * 64, DM, scr, lane, d0 >= 1536 ? -1.4426950408889634f : 1.f); continue; }
        r -= I_IN;
        if (r < I_BR) { const int i = r >> 6, kb = (r >> 4) & 3, nb = r & 15;
            transpose_item(p.w_branch + (((size_t)l * 4 + i) * 256 + kb * 64) * DM + nb * 64, DM, WbT + ((size_t)l * DM + nb * 64) * DM + i * 256 + kb * 64, DM, scr, lane); continue; }
        r -= I_BR;
        { const int kb = r >> 4, nb = r & 15;
            transpose_item(p.w_out + ((size_t)l * DM + kb * 64) * DM + nb * 64, DM, WoT + ((size_t)l * DM + nb * 64) * DM + kb * 64, DM, scr, lane); }
    }
    __syncthreads();
}
__device__ __forceinline__ h16* wgu_of(const Params& p, int l) { return l == 0 ? (h16*)((unsigned char*)p.out + DO_WGU) : (h16*)(p.ws + WS_WGU1); }
__device__ __forceinline__ h16* wd_of(const Params& p, int l) { return (h16*)((unsigned char*)p.out + (l == 0 ? DO_WD : DO_WD1)); }
__device__ __forceinline__ void bg_convert(const Params& p, int l, float* lds, int budget, bool spread = false) {
    const int lane = tidx() & 63, wave = tidx() >> 6;
    float* scr = lds + wave * (64 * 65);
    h16* Wgu = wgu_of(p, l); h16* Wd = wd_of(p, l);
    const int x = spread ? ((bidx() >> 3) + (bidx() & 7)) & 7 : (bidx() & 7);
    unsigned* ctr = (unsigned*)(p.ws + WS_CTL) + 3072 + 64 * (l * 8 + x);
    constexpr int I_GU = 2 * 16 * 16, I_D = 16 * 16, I_E = I_GU + I_D, NIT = 16 * I_E, NPG = NIT / 8, BATCH = 4;
    __syncthreads();
    for (int n = 0; n < budget; ++n) {
        unsigned i0 = 0; if (lane == 0) i0 = __hip_atomic_fetch_add(ctr, (unsigned)BATCH, __ATOMIC_RELAXED, __HIP_MEMORY_SCOPE_AGENT);
        i0 = __builtin_amdgcn_readfirstlane(i0);
        if (i0 >= (unsigned)NPG) break;
        for (int q = 0; q < BATCH; ++q) { const int it = x * NPG + (int)i0 + q;
            const int e = it / I_E; int r = it % I_E;
            if (r < I_GU) { const int h = r >> 8, kb = (r >> 4) & 15, nb = r & 15; const int n0 = nb * 64; const int drow = (n0 >> 7) * 256 + h * 128 + (n0 & 127);
                const float* src = (h ? p.w_up : p.w_gate) + (((size_t)l * NEXP + e) * DM + kb * 64) * FF + n0;
                transpose_item<true>(src, FF, Wgu + ((size_t)e * 2048 + drow) * DM + kb * 64, DM, scr, lane); }
            else { r -= I_GU; const int kb = r >> 4, nb = r & 15;
                transpose_item<true>(p.w_down + (((size_t)l * NEXP + e) * FF + kb * 64) * DM + nb * 64, DM, Wd + ((size_t)e * DM + nb * 64) * FF + kb * 64, FF, scr, lane); } }
    }
    __syncthreads();
}

struct SchedG1 {
    const char* u16; const char* WinT; int l, c, G;
    __device__ __forceinline__ bool next(int i, fg::Unit& u) const {
        const int nsup_full = (l == 0) ? 36 : 32;
        const int L = (i * 8 + (c & 7)) * 32 + (c >> 3); const int s = L >> 5;
        if (s < nsup_full) { u.pm = s * 4 + ((L >> 3) & 3); u.pn = L & 7; }
        else { if (l == 0) return false; const int r = i - 4; if (r != 0 || c >= 48) return false; u.pm = 128 + c / 3; u.pn = 1 + 2 * (c % 3); }
        u.nt = 16; u.aux = 0;
        if (u.pn < 6) { u.A = u16 + (size_t)u.pm * 256 * DM * 2; u.B = WinT + (size_t)u.pn * 256 * DM * 2; }
        else { u.A = WinT + (size_t)(5632 + (u.pn - 6) * 256) * DM * 2; u.B = u16 + (size_t)u.pm * 256 * DM * 2; }
        return true;
    }
};
struct EpiG1 {
    static constexpr bool PERM = true;
    unsigned char* QI; unsigned char* KI; unsigned char* VI; h16* ZTL; h16* ZTC;
    const float* gain; const float* ropeC; const float* ropeS; FG_LAS float* xs; int lastlayer;
    __device__ __forceinline__ void operator()(const f32x4 (&acc)[2][2][4][2], const fg::Unit& u, int wr, int wc, int fr, int fq) const {
        if (u.pn < 6) {
            const int mixer = u.pn >> 1; const bool lat = u.pm < 128; const int b = lat ? (u.pm >> 3) : (u.pm - 128); const int tile0 = lat ? 4 + 4 * (u.pm & 7) : 0;
            const bool isq = (u.pn & 1) == 0; const int half = wc & 1; const int chunk = 4 * half + fq;
            const bool do_rms = (mixer == 0); const bool do_rope = lat && (mixer < 2);
            float rs[2][2][4];
            if (do_rms) {
#pragma unroll
                for (int bj = 0; bj < 2; ++bj)
#pragma unroll
                    for (int ai = 0; ai < 2; ++ai)
#pragma unroll
                        for (int m = 0; m < 4; ++m) { const f32x4 v0 = acc[ai][bj][m][0], v1 = acc[ai][bj][m][1];
                            float ss = (v0[0] * v0[0] + v0[1] * v0[1]) + (v0[2] * v0[2] + v0[3] * v0[3]) + (v1[0] * v1[0] + v1[1] * v1[1]) + (v1[2] * v1[2] + v1[3] * v1[3]);
                            ss = xor16_sum(ss); ss = xor32_sum(ss); rs[bj][ai][m] = ss;
                            if (fq == 0) xs[(half * 256 + 128 * ai + 64 * wr + 16 * m + fr) * 4 + 2 * bj + (wc >> 1)] = ss; }
                asm volatile("s_waitcnt lgkmcnt(0)" ::: "memory"); __builtin_amdgcn_s_barrier(); asm volatile("" ::: "memory");
#pragma unroll
                for (int bj = 0; bj < 2; ++bj)
#pragma unroll
                    for (int ai = 0; ai < 2; ++ai)
#pragma unroll
                        for (int m = 0; m < 4; ++m) { const float so = xs[((half ^ 1) * 256 + 128 * ai + 64 * wr + 16 * m + fr) * 4 + 2 * bj + (wc >> 1)];
                            rs[bj][ai][m] = rsqrtf((rs[bj][ai][m] + so) * (1.f / 64.f) + RMS_EPS); }
            }
            f32x4 g0 = {1.f, 1.f, 1.f, 1.f}, g1 = {1.f, 1.f, 1.f, 1.f};
            if (do_rms) { const float* gp = gain + (isq ? 0 : 64) + chunk * 8; g0 = *(const f32x4*)gp; g1 = *(const f32x4*)(gp + 4); }
            const int j0 = (fq & 1) * 8;
            const bool upper = (fq & 2) != 0;
            auto body = [&](auto HC) {
                constexpr bool H1 = decltype(HC)::value;
#pragma unroll
                for (int mh = 0; mh < 2; ++mh) {
                    f32x4 tc0[2], tc1[2], ts0[2], ts1[2];
                    if (do_rope) {
#pragma unroll
                        for (int k = 0; k < 2; ++k) { const int pos = H1 ? (16 * (2 * mh + k) + fr) : (4 * (u.pm & 7) + 2 * k + wr);
                            tc0[k] = *(const f32x4*)(ropeC + pos * 16 + j0); tc1[k] = *(const f32x4*)(ropeC + pos * 16 + j0 + 4); ts0[k] = *(const f32x4*)(ropeS + pos * 16 + j0); ts1[k] = *(const f32x4*)(ropeS + pos * 16 + j0 + 4); }
                        asm volatile("" ::: "memory"); }
#pragma unroll
                    for (int bj = 0; bj < 2; ++bj) { const int hh = 2 * bj + (wc >> 1);
                        const bool isv = !isq && bj == 1; const bool proc = !isv && (isq || mixer < 2);
                        unsigned char* base; int rstride;
                        if (isq) { base = QI + ((size_t)((mixer * 16 + b) * 4 + hh) * 36 + tile0) * 8192 + chunk * 1024; rstride = 16; }
                        else if (bj == 0) { base = KI + ((size_t)((mixer * 16 + b) * 2 + hh) * 36 + tile0) * 8192 + chunk * 1024; rstride = 16; }
                        else { base = VI + ((size_t)((mixer * 16 + b) * 2 + (hh - 2)) * 36 + tile0) * 8192 + half * 4096 + fq * 16; rstride = 64; }
#pragma unroll
                        for (int ai = 0; ai < 2; ++ai)
#pragma unroll
                            for (int mm = 0; mm < 2; ++mm) { const int m = 2 * mh + mm; f32x4 v0 = acc[ai][bj][m][0], v1 = acc[ai][bj][m][1];
                                if (proc) {
                                    if (do_rms) { const float r_ = rs[bj][ai][m]; v0 = v0 * r_ * g0; v1 = v1 * r_ * g1; }
                                    if (do_rope) { const int k = H1 ? mm : ai;
                                        const f32x4 c0 = tc0[k], c1 = tc1[k], s0 = ts0[k], s1 = ts1[k];
                                        f32x4 p0, p1;
#pragma unroll
                                        for (int e = 0; e < 4; ++e) { const auto r0 = __builtin_amdgcn_permlane32_swap(__float_as_uint(v0[e]), __float_as_uint(v0[e]), false, false); p0[e] = __uint_as_float(upper ? r0[0] : r0[1]);
                                            const auto r1 = __builtin_amdgcn_permlane32_swap(__float_as_uint(v1[e]), __float_as_uint(v1[e]), false, false); p1[e] = __uint_as_float(upper ? r1[0] : r1[1]); }
                                        if (upper) { v0 = p0 * s0 + v0 * c0; v1 = p1 * s1 + v1 * c1; } else { v0 = v0 * c0 - p0 * s0; v1 = v1 * c1 - p1 * s1; } }
                                    if (isq) { v0 = v0 * QSCALE; v1 = v1 * QSCALE; } }
                                *(u32x4*)(base + (size_t)(2 * ai + wr) * 8192 + (16 * m + fr) * rstride) = (u32x4){pk_h2(v0[0], v0[1]), pk_h2(v0[2], v0[3]), pk_h2(v1[0], v1[1]), pk_h2(v1[2], v1[3])}; } }
                }
            };
            if (half) body(std::true_type{}); else body(std::false_type{});
            __builtin_amdgcn_s_waitcnt(0x0F70);
        } else {
            const int R0 = u.pm * 256 + 32 * wc + 8 * fq;
            h16* zb; size_t pitch; int cstride;
            if (R0 < TL) { const int b = R0 >> 11; zb = ZTL + (size_t)b * 256 * 4096 + (R0 & 2047); pitch = 4096; cstride = 2048; }
            else { const int rr = R0 - TL; const int b = rr >> 8; zb = ZTC + (size_t)b * 256 * 512 + (rr & 255); pitch = 512; cstride = 256; }
#pragma unroll
            for (int ai = 0; ai < 2; ++ai)
#pragma unroll
                for (int m = 0; m < 4; ++m) { const int zc = (u.pn - 6) * 256 + 128 * ai + 64 * wr + 16 * m + fr; const int g = zc >> 7, cs = (zc >> 6) & 1, mm = zc & 63;
                    h16* rowp = zb + (size_t)(g * 64 + mm) * pitch + cs * cstride;
#pragma unroll
                    for (int bj = 0; bj < 2; ++bj) { const f32x4 v0 = acc[ai][bj][m][0], v1 = acc[ai][bj][m][1];
                        *(u32x4*)(rowp + 128 * bj) = (u32x4){pk_h2(v0[0], v0[1]), pk_h2(v0[2], v0[3]), pk_h2(v1[0], v1[1]), pk_h2(v1[2], v1[3])}; } }
        }
    }
};
__device__ __forceinline__ void phase_g1_fast(const Params& p, int l, ldsp_t lds) {
    SchedG1 S{(const char*)(p.ws + WS_U16), (const char*)(p.ws + WS_WINT) + (size_t)l * 6144 * DM * 2, l, (int)bidx(), (int)gridDim.x};
    const float* tab = (const float*)(p.ws + WS_TAB);
    EpiG1 E{p.ws + WS_QI, p.ws + WS_KI, p.ws + WS_VI, (h16*)(p.ws + WS_ZTL), (h16*)(p.ws + WS_ZTC), p.qk_gain + l * 128, tab + 4096, tab + 4096 + 1024, (FG_LAS float*)(lds + 131072), l == DEPTH - 1};
    fg::gemm_phase<EpiG1, SchedG1, DM>(lds, S, E);
}

struct SchedOut {
    const char* A; const char* B; int l, c, i0, i1;
    __device__ __forceinline__ bool next(int i, fg::Unit& u) const {
        i += i0; if (i >= i1) return false;
        const int nsup = (l == 0) ? 18 : 16;
        const int L = (i * 8 + (c & 7)) * 32 + (c >> 3); const int s = L >> 5; if (s >= nsup) return false;
        u.pm = s * 8 + ((L >> 2) & 7); u.pn = L & 3; u.nt = 16; u.aux = 0;
        u.A = A + (size_t)u.pm * 256 * DM * 2; u.B = B + (size_t)u.pn * 256 * DM * 2; return true;
    }
};
struct EpiOut {
    static constexpr bool PERM = false;
    const float* x; const float* ctx; float* hB; const float* modv; int l;
    __device__ __forceinline__ void operator()(const f32x4 (&acc)[2][2][4][2], const fg::Unit& u, int wr, int wc, int fr, int fq) const {
        const int mv = u.pm < 128 ? (u.pm >> 3) : 16; const float* g1p = modv + (size_t)mv * NMOD + 2 * DM;
        const int R0 = u.pm * 256 + 64 * wr + fr; const int c0 = u.pn * 256 + 32 * wc + 4 * fq;
        const float* hbase = (l == 0 ? (R0 < TL ? x + (size_t)R0 * DM : ctx + (size_t)(R0 - TL) * DM) : hB + (size_t)R0 * DM) + c0;
        float* obase = hB + (size_t)R0 * DM + c0;
        f32x4 g1[2][2];
#pragma unroll
        for (int bj = 0; bj < 2; ++bj)
#pragma unroll
            for (int n = 0; n < 2; ++n) g1[bj][n] = *(const f32x4*)(g1p + c0 + 128 * bj + 16 * n);
#pragma unroll
        for (int ai = 0; ai < 2; ++ai) {
            f32x4 hv[4][2][2];
#pragma unroll
            for (int m = 0; m < 4; ++m)
#pragma unroll
                for (int bj = 0; bj < 2; ++bj)
#pragma unroll
                    for (int n = 0; n < 2; ++n) hv[m][bj][n] = *(const f32x4*)(hbase + (size_t)(128 * ai + 16 * m) * DM + 128 * bj + 16 * n);
            asm volatile("" ::: "memory");
#pragma unroll
            for (int m = 0; m < 4; ++m)
#pragma unroll
                for (int bj = 0; bj < 2; ++bj)
#pragma unroll
                    for (int n = 0; n < 2; ++n) *(f32x4*)(obase + (size_t)(128 * ai + 16 * m) * DM + 128 * bj + 16 * n) = ALPHA * hv[m][bj][n] + g1[bj][n] * acc[ai][bj][m][n];
            asm volatile("" ::: "memory");
        }
    }
};
__device__ __forceinline__ void phase_out_fast(const Params& p, int l, ldsp_t lds, int i0, int i1) {
    SchedOut S{(const char*)(p.ws + WS_PM), (const char*)(p.ws + WS_WOT) + (size_t)l * DM * DM * 2, l, (int)bidx(), i0, i1};
    EpiOut E{p.x, p.ctx, (float*)(p.ws + WS_HB), (const float*)(p.ws + WS_MODV) + (size_t)l * 17 * NMOD, l};
    fg::gemm_phase<EpiOut, SchedOut, DM>(lds, S, E);
}

__device__ __forceinline__ int expert_of_rtile(int rt) { return rt < 256 ? (rt & 15) : ((rt - 256) >> 1); }
struct SchedUp {
    const char* u16; const char* Wgu; const int* selrow; int l, c;
    __device__ __forceinline__ bool next(int i, fg::Unit& u) const {
        const int nsup = (l == 0) ? 72 : 64;
        const int L = (i * 8 + (c & 7)) * 32 + (c >> 3); const int s = L >> 5; if (s >= nsup) return false;
        const int o = s * 4 + ((L >> 3) & 3); const int rt = o < 256 ? ((o & 15) * 16 + (o >> 4)) : o;
        u.pm = rt; u.pn = L & 7; u.nt = 16; u.aux = expert_of_rtile(rt);
        u.A = u16; u.rows = selrow + rt * 256; u.B = Wgu + ((size_t)u.aux * 2048 + u.pn * 256) * DM * 2; return true;
    }
};
struct EpiUp {
    static constexpr bool PERM = true;
    h16* H;
    __device__ __forceinline__ void operator()(const f32x4 (&acc)[2][2][4][2], const fg::Unit& u, int wr, int wc, int fr, int fq) const {
#pragma unroll
        for (int ai = 0; ai < 2; ++ai)
#pragma unroll
            for (int m = 0; m < 4; ++m) { const int R = u.pm * 256 + 128 * ai + 64 * wr + 16 * m + fr; const int col = u.pn * 128 + 32 * wc + 8 * fq; float o[8];
#pragma unroll
                for (int n = 0; n < 2; ++n)
#pragma unroll
                    for (int j = 0; j < 4; ++j) o[n * 4 + j] = silu_f(acc[ai][0][m][n][j]) * acc[ai][1][m][n][j];
                *(u32x4*)(H + (size_t)R * FF + col) = (u32x4){pk_b2(o[0], o[1]), pk_b2(o[2], o[3]), pk_b2(o[4], o[5]), pk_b2(o[6], o[7])}; }
    }
};
__device__ __forceinline__ void phase_up_fast(const Params& p, int l, ldsp_t lds) {
    SchedUp S{(const char*)(p.ws + WS_U16), (const char*)wgu_of(p, l), (const int*)(p.ws + WS_SELR), l, (int)bidx()};
    EpiUp E{(h16*)(p.ws + WS_H16)};
    fg::gemm_phase<EpiUp, SchedUp, DM, true, true>(lds, S, E);
}
struct SchedDown {
    const char* H; const char* Wd; int l, c;
    __device__ __forceinline__ bool next(int i, fg::Unit& u) const {
        const int nsup = (l == 0) ? 36 : 32;
        const int L = (i * 8 + (c & 7)) * 32 + (c >> 3); const int s = L >> 5; if (s >= nsup) return false;
        const int o = s * 8 + ((L >> 2) & 7); const int rt = o < 256 ? ((o & 15) * 16 + (o >> 4)) : o;
        u.pm = rt; u.pn = L & 3; u.nt = 16; u.aux = expert_of_rtile(rt);
        u.A = H + (size_t)rt * 256 * FF * 2; u.B = Wd + ((size_t)u.aux * DM + u.pn * 256) * FF * 2; return true;
    }
};
struct EpiDown {
    static constexpr bool PERM = true;
    h16* Y; const float* selw;
    __device__ __forceinline__ void operator()(const f32x4 (&acc)[2][2][4][2], const fg::Unit& u, int wr, int wc, int fr, int fq) const {
        const int R0 = u.pm * 256 + 64 * wr + fr;
        float w[2][4];
#pragma unroll
        for (int ai = 0; ai < 2; ++ai)
#pragma unroll
            for (int m = 0; m < 4; ++m) w[ai][m] = selw[R0 + 128 * ai + 16 * m];
        asm volatile("" ::: "memory");
        h16* base = Y + (size_t)R0 * DM + u.pn * 256 + 32 * wc + 8 * fq;
#pragma unroll
        for (int ai = 0; ai < 2; ++ai)
#pragma unroll
            for (int m = 0; m < 4; ++m)
#pragma unroll
                for (int bj = 0; bj < 2; ++bj) { const f32x4 v0 = acc[ai][bj][m][0] * w[ai][m], v1 = acc[ai][bj][m][1] * w[ai][m];
                    *(u32x4*)(base + (size_t)(128 * ai + 16 * m) * DM + 128 * bj) = (u32x4){pk_h2(v0[0], v0[1]), pk_h2(v0[2], v0[3]), pk_h2(v1[0], v1[1]), pk_h2(v1[2], v1[3])}; }
    }
};
__device__ __forceinline__ void phase_down_fast(const Params& p, int l, ldsp_t lds) {
    SchedDown S{(const char*)(p.ws + WS_H16), (const char*)wd_of(p, l), l, (int)bidx()};
    EpiDown E{(h16*)(p.ws + WS_XG), (const float*)(p.ws + WS_SELW)};
    fg::gemm_phase<EpiDown, SchedDown, DM, true>(lds, S, E);
}


struct SchedMerge {
    const char* u16; const char* br; const char* WinT; const char* WbT; int l, c, i0, i1;
    __device__ __forceinline__ bool next(int i, fg::Unit& u) const {
        i += i0; if (i >= i1) return false;
        int ib, sub;
        if (i < 16) { const int ti = i >> 3; sub = i & 7; ib = sub >> 1;
            const int L = (ti * 8 + (c & 7)) * 32 + (c >> 3); const int s = L >> 5;
            u.pm = s * 8 + ((L >> 2) & 7); u.pn = L & 3; u.aux = sub; }
        else { if (l != 0 || i >= 18) return false; const int tct = c >> 2; ib = c & 3; sub = 2 * ib + (i & 1);
            u.pm = 128 + (tct >> 2); u.pn = tct & 3; u.aux = sub | 8; }
        if ((sub & 1) == 0) { u.nt = 16; u.A = u16 + (size_t)u.pm * 256 * DM * 2; u.B = WinT + (size_t)(1536 + ib * 1024 + u.pn * 256) * DM * 2; }
        else { u.nt = 4; u.A = br + (size_t)u.pm * 256 * DM * 2 + ib * 512; u.B = WbT + (size_t)u.pn * 256 * DM * 2 + ib * 512; }
        return true;
    }
};
struct EpiMerge {
    static constexpr bool PERM = true;
    h16* mg; h16* part; unsigned char* scr;
    __device__ __forceinline__ void operator()(const f32x4 (&acc)[2][2][4][2], const fg::Unit& u, int wr, int wc, int fr, int fq) const {
        const int tid = tidx();
        if ((u.aux & 1) == 0) {
#pragma unroll
            for (int ai = 0; ai < 2; ++ai)
#pragma unroll
                for (int m = 0; m < 4; ++m)
#pragma unroll
                    for (int bj = 0; bj < 2; ++bj) { const int q = (ai * 4 + m) * 2 + bj; const f32x4 v0 = acc[ai][bj][m][0], v1 = acc[ai][bj][m][1];
                        *(u32x4*)(scr + ((size_t)q * 512 + tid) * 16) = (u32x4){pk_h2(sig2_f(v0[0]), sig2_f(v0[1])), pk_h2(sig2_f(v0[2]), sig2_f(v0[3])), pk_h2(sig2_f(v1[0]), sig2_f(v1[1])), pk_h2(sig2_f(v1[2]), sig2_f(v1[3]))}; }
        } else {
            const bool partial = (u.aux & 8) != 0; const bool first = partial || ((u.aux & 7) == 1);
            h16* base = partial ? part + ((size_t)((u.aux & 7) >> 1) * TC + (size_t)(u.pm - 128) * 256) * DM : mg + (size_t)u.pm * 256 * DM;
            base += (size_t)(64 * wr + fr) * DM + u.pn * 256 + 32 * wc + 8 * fq;
#pragma unroll
            for (int ai = 0; ai < 2; ++ai) {
                h16x8 gv[8], pr[8];
#pragma unroll
                for (int m = 0; m < 4; ++m)
#pragma unroll
                    for (int bj = 0; bj < 2; ++bj) { const int q = (ai * 4 + m) * 2 + bj; gv[m * 2 + bj] = *(const h16x8*)(scr + ((size_t)q * 512 + tid) * 16);
                        if (!first) pr[m * 2 + bj] = *(const h16x8*)(base + (size_t)(128 * ai + 16 * m) * DM + 128 * bj); }
                asm volatile("" ::: "memory");
#pragma unroll
                for (int m = 0; m < 4; ++m)
#pragma unroll
                    for (int bj = 0; bj < 2; ++bj) { const h16x8 g = gv[m * 2 + bj]; const f32x4 v0 = acc[ai][bj][m][0], v1 = acc[ai][bj][m][1];
                        float o[8] = {(float)g[0] * v0[0], (float)g[1] * v0[1], (float)g[2] * v0[2], (float)g[3] * v0[3], (float)g[4] * v1[0], (float)g[5] * v1[1], (float)g[6] * v1[2], (float)g[7] * v1[3]};
                        if (!first) { const h16x8 pp = pr[m * 2 + bj];
#pragma unroll
                            for (int e = 0; e < 8; ++e) o[e] += (float)pp[e]; }
                        *(u32x4*)(base + (size_t)(128 * ai + 16 * m) * DM + 128 * bj) = (u32x4){pk_h2(o[0], o[1]), pk_h2(o[2], o[3]), pk_h2(o[4], o[5]), pk_h2(o[6], o[7])}; }
                asm volatile("" ::: "memory");
            }
        }
    }
};
__device__ __forceinline__ void phase_merge_fast(const Params& p, int l, ldsp_t lds, int i0, int i1) {
    SchedMerge S{(const char*)(p.ws + WS_U16), (const char*)(p.ws + WS_BR), (const char*)(p.ws + WS_WINT) + (size_t)l * 6144 * DM * 2, (const char*)(p.ws + WS_WBT) + (size_t)l * DM * DM * 2, l, bidx(), i0, i1};
    EpiMerge E{(h16*)(p.ws + WS_PM), (h16*)(p.ws + WS_MPART), (l == 0 ? p.ws + WS_WGU1 : (unsigned char*)p.out + DO_WGU) + (size_t)bidx() * 131072};
    fg::gemm_phase<EpiMerge, SchedMerge, DM>(lds, S, E);
}
__device__ __forceinline__ void phase_merge_sum(const Params& p) {
    const h16* part = (const h16*)(p.ws + WS_MPART); h16* mg = (h16*)(p.ws + WS_PM) + (size_t)TL * DM;
    const int gt = bidx() * NTHREADS + tidx(), NG = gridDim.x * NTHREADS;
    for (int o = gt; o < TC * DM / 8; o += NG) { float acc[8];
#pragma unroll
        for (int e = 0; e < 8; ++e) acc[e] = 0.f;
#pragma unroll
        for (int i = 0; i < 4; ++i) { const h16x8 v = *(const h16x8*)(part + (size_t)i * TC * DM + (size_t)o * 8);
#pragma unroll
            for (int e = 0; e < 8; ++e) acc[e] += (float)v[e]; }
        *(u32x4*)(mg + (size_t)o * 8) = (u32x4){pk_h2(acc[0], acc[1]), pk_h2(acc[2], acc[3]), pk_h2(acc[4], acc[5]), pk_h2(acc[6], acc[7])}; }
}

struct EpiDft {
    static constexpr bool PERM = true;
    h16* br; int row0, rows_per_b; float scl;
    __device__ __forceinline__ void operator()(const f32x4 (&acc)[2][2][4][2], const fg::Unit& u, int wr, int wc, int fr, int fq) const {
#pragma unroll
        for (int ai = 0; ai < 2; ++ai)
#pragma unroll
            for (int m = 0; m < 4; ++m) { const int kr = u.pm * 256 + 128 * ai + 64 * wr + 16 * m + fr; const size_t R = (size_t)row0 + (size_t)u.pn * rows_per_b + kr;
#pragma unroll
                for (int bj = 0; bj < 2; ++bj) { const int col = 128 * bj + 32 * wc + 8 * fq; const f32x4 v0 = acc[ai][bj][m][0] * scl, v1 = acc[ai][bj][m][1] * scl;
                    *(u32x4*)(br + R * DM + 256 + col) = (u32x4){pk_h2(v0[0], v0[1]), pk_h2(v0[2], v0[3]), pk_h2(v1[0], v1[1]), pk_h2(v1[2], v1[3])}; } }
    }
};

namespace fa {
typedef float f32x16 __attribute__((ext_vector_type(16)));
typedef short v4i16_t __attribute__((ext_vector_type(4)));
typedef short s16x4 __attribute__((ext_vector_type(4)));
constexpr float LOG2E = 1.4426950408889634f;
constexpr int NSLOT = 3, SLOTB = 8192;
constexpr int LDS_K = 0, LDS_V = NSLOT * SLOTB, LDS_WS = 2 * NSLOT * SLOTB, LDS_OST = LDS_WS + 8 * 64 * 4, LDS_RPB = LDS_OST + 8 * 4096;
__device__ __forceinline__ int crow(int r, int hi) { return (r & 3) + 8 * (r >> 2) + 4 * hi; }
#define SBAR() __builtin_amdgcn_sched_barrier(0)
__device__ __forceinline__ void glds16(const void* gsrc, unsigned lds_dst) { unsigned keep;
    asm volatile("s_mov_b32 %0, m0\n\ts_mov_b32 m0, %2\n\ts_nop 0\n\tglobal_load_lds_dwordx4 %1, off\n\ts_mov_b32 m0, %0" : "=&s"(keep) : "v"(gsrc), "s"(lds_dst) : "memory"); }
__device__ __forceinline__ float max3f(float a, float b, float c) { float r; asm("v_max3_f32 %0, %1, %2, %3" : "=v"(r) : "v"(a), "v"(b), "v"(c)); return r; }
__device__ __forceinline__ float max2f(float a, float b) { float r; asm("v_max_f32_e32 %0, %1, %2" : "=v"(r) : "v"(a), "v"(b)); return r; }
__device__ __forceinline__ float fadd_s(float a, float b) { float r; asm("v_add_f32_e32 %0, %1, %2" : "=v"(r) : "v"(a), "v"(b)); return r; }
__device__ __forceinline__ float fsub_s(float a, float b) { float r; asm("v_sub_f32_e32 %0, %1, %2" : "=v"(r) : "v"(a), "v"(b)); return r; }
#define WAIT_BAR(N) asm volatile("s_waitcnt vmcnt(" #N ") lgkmcnt(0)\n\ts_barrier" ::: "memory")
typedef __attribute__((address_space(3))) const char* lds_cptr;
__device__ __forceinline__ void kload8(h16x8* kf, lds_cptr kp) {
    kf[0] = *(const FG_LAS h16x8*)(kp);        kf[1] = *(const FG_LAS h16x8*)(kp + 512);
    kf[2] = *(const FG_LAS h16x8*)(kp + 2048); kf[3] = *(const FG_LAS h16x8*)(kp + 2560);
    kf[4] = *(const FG_LAS h16x8*)(kp + 4096); kf[5] = *(const FG_LAS h16x8*)(kp + 4608);
    kf[6] = *(const FG_LAS h16x8*)(kp + 6144); kf[7] = *(const FG_LAS h16x8*)(kp + 6656);
}
__device__ __forceinline__ void kload2(h16x8* kf, lds_cptr kp, int j) { kf[2 * j] = *(const FG_LAS h16x8*)(kp + j * 2048); kf[2 * j + 1] = *(const FG_LAS h16x8*)(kp + j * 2048 + 512); }
__device__ __forceinline__ s16x4 vtr(lds_cptr p) { return __builtin_bit_cast(s16x4, __builtin_amdgcn_ds_read_tr16_b64_v4i16((FG_LAS v4i16_t*)p)); }
__device__ __forceinline__ void qkt(f32x16& p0, f32x16& p1, lds_cptr Kslot, const h16x8* qr, const f32x16& negm, int r32, int hi) {
    lds_cptr kb = Kslot + hi * 1024 + r32 * 16;
#pragma unroll
    for (int d0 = 0; d0 < 4; ++d0) {
        const h16x8 b0 = *(const FG_LAS h16x8*)(kb + d0 * 2048), b1 = *(const FG_LAS h16x8*)(kb + d0 * 2048 + 512);
        if (d0 == 0) { p0 = __builtin_amdgcn_mfma_f32_32x32x16_f16(b0, qr[0], negm, 0, 0, 0); p1 = __builtin_amdgcn_mfma_f32_32x32x16_f16(b1, qr[0], negm, 0, 0, 0); }
        else { p0 = __builtin_amdgcn_mfma_f32_32x32x16_f16(b0, qr[d0], p0, 0, 0, 0); p1 = __builtin_amdgcn_mfma_f32_32x32x16_f16(b1, qr[d0], p1, 0, 0, 0); } }
}
__device__ __forceinline__ float rowmax(const f32x16& p0, const f32x16& p1) {
    float a = max3f(p0[0], p0[1], p1[0]), b = max3f(p0[2], p0[3], p1[1]); a = max3f(a, p1[2], p1[3]);
#pragma unroll
    for (int r = 4; r < 16; r += 4) { a = max3f(a, p0[r], p0[r + 1]); b = max3f(b, p0[r + 2], p0[r + 3]); a = max3f(a, p1[r], p1[r + 1]); b = max3f(b, p1[r + 2], p1[r + 3]); }
    const float m = max2f(a, b);
    auto rr = __builtin_amdgcn_permlane32_swap(__float_as_uint(m), __float_as_uint(m), false, false);
    return max2f(__uint_as_float(rr[0]), __uint_as_float(rr[1]));
}
__device__ __forceinline__ void pv(f32x16* o, lds_cptr vb, h16x8 pa0, h16x8 pa1, h16x8 pa2, h16x8 pa3) {
    typedef short s8 __attribute__((ext_vector_type(8)));
#pragma unroll
    for (int d0 = 0; d0 < 2; ++d0) { s16x4 lo[4], hh[4];
#pragma unroll
        for (int ks = 0; ks < 4; ++ks) { lo[ks] = vtr(vb + d0 * 4096 + ks * 1024); hh[ks] = vtr(vb + d0 * 4096 + ks * 1024 + 512); }
#define PKV(k) __builtin_bit_cast(h16x8, (s8){lo[k][0], lo[k][1], lo[k][2], lo[k][3], hh[k][0], hh[k][1], hh[k][2], hh[k][3]})
        o[d0] = __builtin_amdgcn_mfma_f32_32x32x16_f16(pa0, PKV(0), o[d0], 0, 0, 0);
        o[d0] = __builtin_amdgcn_mfma_f32_32x32x16_f16(pa1, PKV(1), o[d0], 0, 0, 0);
        o[d0] = __builtin_amdgcn_mfma_f32_32x32x16_f16(pa2, PKV(2), o[d0], 0, 0, 0);
        o[d0] = __builtin_amdgcn_mfma_f32_32x32x16_f16(pa3, PKV(3), o[d0], 0, 0, 0);
#undef PKV
    }
}
template <int MIXER, int THRL>
__device__ __forceinline__ void attn_unit(const unsigned char* QI, const unsigned char* KI, const unsigned char* VI, h16* br, const float* sinkp, const float* rpb, int mixer, int b, int kvh, int qb, bool isctx, ldsp_t lds, unsigned* qctr, volatile FG_LAS unsigned* qw) {
    const int tid = tidx(), lane = tid & 63, wid = __builtin_amdgcn_readfirstlane(tid >> 6), r32 = lane & 31, hi = lane >> 5, g = wid >> 2, qsub = wid & 3, hq = kvh * 2 + g;
    const int brcol = (mixer == 0 ? 0 : mixer == 1 ? 512 : 768) + hq * 64;
    const int q0 = (isctx ? TL + b * 256 + qb * 128 : b * 2048 + qb * 128) + qsub * 32;
    int jlo = 0, nlat = 0;
    if (!isctx) {
        if (MIXER == 0) { jlo = 0; nlat = 32; }
        else if (MIXER == 1) { jlo = max(0, 2 * qb - 2); nlat = min(31, 2 * qb + 3) - jlo + 1; }
        else { jlo = min(max(2 * qb - 4, 0), 24); nlat = min(max(2 * qb - 3, 0), 24) + 7 - jlo + 1; }
    }
    const int nreal = 4 + nlat; const int NT = (nreal + 1) & ~1;
#define FA_TILE(s) ((s) < 4 ? (s) : 4 + jlo + min((s), nreal - 1) - 4)
    const unsigned lds0 = (unsigned)(size_t)lds;
    FG_LAS float* wsf = (FG_LAS float*)(lds + LDS_WS) + wid * 64;
    const unsigned char* ksrc = KI + ((size_t)((mixer * 16 + b) * 2 + kvh) * 36) * 8192 + wid * 1024 + lane * 16;
    const unsigned char* vsrc = VI + ((size_t)((mixer * 16 + b) * 2 + kvh) * 36) * 8192 + wid * 1024 + lane * 16;
    const unsigned kdst = lds0 + LDS_K + wid * 1024, vdst = lds0 + LDS_V + wid * 1024;
#define DMA_K(t, slot) glds16(ksrc + (size_t)FA_TILE(t) * 8192, (unsigned)__builtin_amdgcn_readfirstlane(kdst + (slot)))
#define DMA_V(t, slot) glds16(vsrc + (size_t)FA_TILE(t) * 8192, (unsigned)__builtin_amdgcn_readfirstlane(vdst + (slot)))
    h16x8 kf[8];
    const lds_cptr shm3 = (lds_cptr)lds; const lds_cptr kp0 = shm3 + LDS_K + hi * 1024 + r32 * 16;
    const lds_cptr vp0 = shm3 + LDS_V + ((lane >> 4) & 1) * 32 + (lane & 3) * 8 + (4 * hi + ((lane & 15) >> 2)) * 64;
    DMA_K(0, 0); DMA_V(0, 0); DMA_K(1, SLOTB);
    if (MIXER == 2) { FG_LAS float* tb = (FG_LAS float*)(lds + LDS_RPB); for (int i = tid; i < 930; i += NTHREADS) tb[i] = rpb[(size_t)(kvh * 2) * 465 + i] * LOG2E; }
    h16x8 qr[4];
    { const int qtile = (isctx ? 0 : 4) + 2 * qb + (qsub >> 1);
      const unsigned char* qp = QI + (((size_t)((mixer * 16 + b) * 4 + hq) * 36) + qtile) * 8192 + hi * 1024 + ((qsub & 1) * 32 + r32) * 16;
#pragma unroll
      for (int d0 = 0; d0 < 4; ++d0) qr[d0] = *(const h16x8*)(qp + d0 * 2048); }
    float mhat = 0.f, l_reg = 0.f; f32x16 o[2]; o[0] = f32x16{}; o[1] = f32x16{}; f32x16 negm = f32x16{}; asm volatile("" : "+v"(negm));
    const int tq = qb * 128 + qsub * 32 + r32;
    const int qrow = 2 * qb + (qsub >> 1);
    const int qcl = tq & 63; const int r0w = min(max(qrow - 4, 0), 24), c0q = min(max(qcl - 8, 0), 48);
#define CMASK(P0, P1, s) do { if (MIXER != 0 && (s) >= 4) { const float NEGI = -INFINITY; const int j_ = jlo + (s) - 4; \
        if ((s) >= nreal) { _Pragma("unroll") for (int r = 0; r < 16; ++r) { P0[r] = NEGI; P1[r] = NEGI; } } \
        else if (MIXER == 1) { const int dt = tq - 64 * j_; \
            _Pragma("unroll") for (int r = 0; r < 16; ++r) { const int kk = crow(r, hi); P0[r] = ((unsigned)(kk - dt + 128) <= 256u) ? P0[r] : NEGI; P1[r] = ((unsigned)(kk + 32 - dt + 128) <= 256u) ? P1[r] : NEGI; } } \
        else { const bool rowok = (j_ >= r0w) && (j_ <= r0w + 7); const int jr_ = rowok ? j_ : r0w; \
            const FG_LAS float* tb = (const FG_LAS float*)(lds + LDS_RPB) + g * 465 + (jr_ - qrow + 7) * 31 + (15 - qcl); \
            _Pragma("unroll") for (int r = 0; r < 16; ++r) { const int kc = crow(r, hi); \
                { const bool ok = rowok && ((unsigned)(kc - c0q) < 16u); const float bv = tb[ok ? kc : qcl]; P0[r] = ok ? P0[r] + bv : NEGI; } \
                { const int kc1 = kc + 32; const bool ok = rowok && ((unsigned)(kc1 - c0q) < 16u); const float bv = tb[ok ? kc1 : qcl]; P1[r] = ok ? P1[r] + bv : NEGI; } } } } } while (0)
    bool resc = false;
#define START(P0, P1) do { const float rm = rowmax(P0, P1); resc = false; \
    { const float dl = rm; mhat = fadd_s(mhat, dl); \
      _Pragma("unroll") for (int r = 0; r < 16; ++r) { P0[r] = fsub_s(P0[r], dl); P1[r] = fsub_s(P1[r], dl); } \
      _Pragma("unroll") for (int r = 0; r < 16; ++r) negm[r] = -mhat; asm volatile("" : "+v"(negm)); } \
    _Pragma("unroll") for (int r = 0; r < 16; ++r) P0[r] = __builtin_amdgcn_exp2f(P0[r]); } while (0)
#define RESC() do { if (resc) { asm volatile("s_waitcnt lgkmcnt(0)" ::: "memory"); \
      _Pragma("unroll") for (int d_ = 0; d_ < 2; ++d_) _Pragma("unroll") for (int r = 0; r < 16; ++r) o[d_][r] *= wsf[crow(r, hi)]; } } while (0)
    f32x16 pA0, pA1, pB0, pB1;
    int sl_prev = 0, sl_cur = 0, sl_next = SLOTB;
#define ROT() do { sl_prev = sl_cur; sl_cur = sl_next; sl_next = (sl_next == (NSLOT - 1) * SLOTB) ? 0 : sl_next + SLOTB; } while (0)
    DMA_K(2, 2 * SLOTB);
    WAIT_BAR(3);
    qkt(pA0, pA1, shm3 + LDS_K, qr, negm, r32, hi); asm volatile("s_nop 15\n\ts_nop 7" : "+v"(pA0), "+v"(pA1));
    START(pA0, pA1);
#pragma unroll
    for (int r = 0; r < 16; ++r) pA1[r] = __builtin_amdgcn_exp2f(pA1[r]);
    WAIT_BAR(0);
    DMA_K(3, 0); DMA_V(1, SLOTB);
    ROT();
    kload8(kf, kp0 + sl_cur);
    WAIT_BAR(2);
    s16x4 vlo[8], vhi[8]; u32x4 pw0, pw1, pw2, pw3;
    typedef short s8v __attribute__((ext_vector_type(8)));
#define PKW(P, B) pk_h2(P[B], P[B + 1])
#define PAF(k) __builtin_bit_cast(h16x8, pw##k)
#define VFR(i) __builtin_bit_cast(h16x8, (s8v){vlo[i][0], vlo[i][1], vlo[i][2], vlo[i][3], vhi[i][0], vhi[i][1], vhi[i][2], vhi[i][3]})
#define PIN(x) asm volatile("" : "+v"(x))
#define MX3(a, b, c) __builtin_fmaxf(__builtin_fmaxf((a), (b)), (c))
#define GAPA(MF, A0, A1, A2, A3, W0, W1, PW) do { MF; sacc += A0; sacc += A1; sacc += A2; sacc += A3; PIN(sacc); W0; W1; PIN(PW); SBAR(); } while (0)
#define EX(v) __builtin_amdgcn_exp2f(v)
#define GAPB(MF, X, B) do { MF; X[B] = EX(X[B]); X[B + 1] = EX(X[B + 1]); X[B + 2] = EX(X[B + 2]); X[B + 3] = EX(X[B + 3]); PIN(X); SBAR(); } while (0)
#define VRD(i) do { vlo[i] = vtr(vp_ + (((i) >> 2) * 4096 + ((i) & 3) * 1024)); vhi[i] = vtr(vp_ + (((i) >> 2) * 4096 + ((i) & 3) * 1024 + 512)); } while (0)
#define KRD(G, j) do { if (G) { kload2(kf, kp0 + sl_next, j); SBAR(); } } while (0)
#define MF32(a, b, c) __builtin_amdgcn_mfma_f32_32x32x16_f16(a, b, c, 0, 0, 0)
#define STEP(C0, C1, P0, P1, t, GK, GV, GL) do { SBAR(); \
    const lds_cptr vp_ = vp0 + sl_prev; \
    VRD(0); SBAR(); float sacc = (P0[0] + P0[1]); \
    GAPA(C0 = MF32(kf[0], qr[0], negm), P0[2], P0[3], P0[4], P0[5],     pw0[0] = PKW(P0, 0), pw0[1] = PKW(P0, 2), pw0); \
    VRD(4); SBAR(); GAPA(C1 = MF32(kf[1], qr[0], negm), P0[6], P0[7], P0[8], P0[9],     pw0[2] = PKW(P0, 4), pw0[3] = PKW(P0, 6), pw0); \
    VRD(1); SBAR(); GAPA(C0 = MF32(kf[2], qr[1], C0),   P0[10], P0[11], P0[12], P0[13], pw1[0] = PKW(P0, 8), pw1[1] = PKW(P0, 10), pw1); \
    VRD(5); SBAR(); GAPA(C1 = MF32(kf[3], qr[1], C1),   P0[14], P0[15], P1[0], P1[1],   pw1[2] = PKW(P0, 12), pw1[3] = PKW(P0, 14), pw1); \
    VRD(2); SBAR(); GAPA(C0 = MF32(kf[4], qr[2], C0),   P1[2], P1[3], P1[4], P1[5],     pw2[0] = PKW(P1, 0), pw2[1] = PKW(P1, 2), pw2); \
    VRD(6); SBAR(); GAPA(C1 = MF32(kf[5], qr[2], C1),   P1[6], P1[7], P1[8], P1[9],     pw2[2] = PKW(P1, 4), pw2[3] = PKW(P1, 6), pw2); \
    VRD(3); SBAR(); GAPA(C0 = MF32(kf[6], qr[3], C0),   P1[10], P1[11], P1[12], P1[13], pw3[0] = PKW(P1, 8), pw3[1] = PKW(P1, 10), pw3); \
    VRD(7); SBAR(); GAPA(C1 = MF32(kf[7], qr[3], C1),   P1[14], P1[15], 0.f, 0.f,       pw3[2] = PKW(P1, 12), pw3[3] = PKW(P1, 14), pw3); \
    l_reg += sacc; \
    if (GK) { DMA_K((t) + 3, sl_cur); } if (GV) { DMA_V((t) + 1, sl_next); } \
    CMASK(C0, C1, t); \
    { float a = MX3(C0[0], C0[1], C1[0]), b_ = MX3(C0[2], C0[3], C1[1]); a = MX3(a, C1[2], C1[3]); \
      _Pragma("unroll") for (int r = 4; r < 16; r += 4) { a = MX3(a, C0[r], C0[r + 1]); b_ = MX3(b_, C0[r + 2], C0[r + 3]); a = MX3(a, C1[r], C1[r + 1]); b_ = MX3(b_, C1[r + 2], C1[r + 3]); } \
      float rm = __builtin_fmaxf(a, b_); { auto rr = __builtin_amdgcn_permlane32_swap(__float_as_uint(rm), __float_as_uint(rm), false, false); rm = __builtin_fmaxf(__uint_as_float(rr[0]), __uint_as_float(rr[1])); } \
      resc = false; \
      if (__builtin_expect(__any(rm > (float)THRL), 0)) { const float dl = __builtin_fmaxf(rm, 0.f); mhat += dl; \
        _Pragma("unroll") for (int r = 0; r < 16; ++r) { C0[r] -= dl; C1[r] -= dl; } \
        _Pragma("unroll") for (int r = 0; r < 16; ++r) negm[r] = -mhat; asm volatile("" : "+v"(negm)); \
        const float f = __builtin_amdgcn_exp2f(-dl); l_reg *= f; if (hi == 0) wsf[r32] = f; resc = true; } } \
    SBAR(); \
    GAPB(o[0] = MF32(PAF(0), VFR(0), o[0]), C0, 0); \
    GAPB(o[1] = MF32(PAF(0), VFR(4), o[1]), C0, 4); \
    KRD(GL, 0); GAPB(o[0] = MF32(PAF(1), VFR(1), o[0]), C0, 8); \
    KRD(GL, 1); GAPB(o[1] = MF32(PAF(1), VFR(5), o[1]), C0, 12); \
    KRD(GL, 2); GAPB(o[0] = MF32(PAF(2), VFR(2), o[0]), C1, 0); \
    KRD(GL, 3); GAPB(o[1] = MF32(PAF(2), VFR(6), o[1]), C1, 4); \
    GAPB(o[0] = MF32(PAF(3), VFR(3), o[0]), C1, 8); \
    GAPB(o[1] = MF32(PAF(3), VFR(7), o[1]), C1, 12); \
    } while (0)
    int t = 1;
    for (; t + 5 < NT; t += 2) {
        STEP(pB0, pB1, pA0, pA1, t, true, true, true);     WAIT_BAR(2); RESC(); ROT();
        STEP(pA0, pA1, pB0, pB1, t + 1, true, true, true); WAIT_BAR(2); RESC(); ROT();
    }
#define ENDW(tt) do { if ((tt) + 3 < NT) { WAIT_BAR(2); } else if ((tt) + 2 < NT) { WAIT_BAR(1); } else { WAIT_BAR(0); } } while (0)
    for (; t + 1 < NT; t += 2) {
        STEP(pB0, pB1, pA0, pA1, t, (t + 3 < NT), (t + 1 < NT), (t + 1 < NT));         ENDW(t);     RESC(); ROT();
        STEP(pA0, pA1, pB0, pB1, t + 1, (t + 4 < NT), (t + 2 < NT), (t + 2 < NT));     ENDW(t + 1); RESC(); ROT();
    }
    STEP(pB0, pB1, pA0, pA1, NT - 1, false, false, false); RESC();
    unsigned nraw = 0u; if (tid == 0) nraw = __hip_atomic_fetch_add(qctr, 1u, __ATOMIC_RELAXED, __HIP_MEMORY_SCOPE_AGENT);
    { float sacc = pB0[0] + pB0[1];
#pragma unroll
      for (int r = 2; r < 16; ++r) sacc += pB0[r];
#pragma unroll
      for (int r = 0; r < 16; ++r) sacc += pB1[r];
      l_reg += sacc;
      pw0 = (u32x4){PKW(pB0, 0), PKW(pB0, 2), PKW(pB0, 4), PKW(pB0, 6)}; pw1 = (u32x4){PKW(pB0, 8), PKW(pB0, 10), PKW(pB0, 12), PKW(pB0, 14)};
      pw2 = (u32x4){PKW(pB1, 0), PKW(pB1, 2), PKW(pB1, 4), PKW(pB1, 6)}; pw3 = (u32x4){PKW(pB1, 8), PKW(pB1, 10), PKW(pB1, 12), PKW(pB1, 14)};
      SBAR(); pv(o, vp0 + sl_cur, PAF(0), PAF(1), PAF(2), PAF(3)); }
    { auto rr = __builtin_amdgcn_permlane32_swap(__float_as_uint(l_reg), __float_as_uint(l_reg), false, false); l_reg = __uint_as_float(rr[0]) + __uint_as_float(rr[1]); }
    if (mixer == 1) l_reg += __builtin_amdgcn_exp2f(sinkp[hq] * LOG2E - mhat);
    if (hi == 0) wsf[32 + r32] = l_reg; asm volatile("s_waitcnt lgkmcnt(0)" ::: "memory");
    float rli[16];
#pragma unroll
    for (int r = 0; r < 16; ++r) rli[r] = __builtin_amdgcn_rcpf(wsf[32 + crow(r, hi)]);
    h16* Ow = br + (size_t)q0 * DM + brcol;
    { FG_LAS h16* stg = (FG_LAS h16*)(lds + LDS_OST) + wid * 2048;
#pragma unroll
      for (int r = 0; r < 16; ++r) { const int orow = crow(r, hi);
#pragma unroll
          for (int d0 = 0; d0 < 2; ++d0) stg[orow * 64 + d0 * 32 + r32] = (h16)(o[d0][r] * rli[r]); }
      asm volatile("s_waitcnt lgkmcnt(0)" ::: "memory");
#pragma unroll
      for (int i = 0; i < 4; ++i) { const int row = i * 8 + (lane >> 3), ch = lane & 7; const u32x4 v = *(const FG_LAS u32x4*)(stg + row * 64 + ch * 8); *(u32x4*)(Ow + (size_t)row * DM + ch * 8) = v; } }
    if (tid == 0) qw[0] = nraw;
    asm volatile("s_waitcnt lgkmcnt(0)\n\ts_barrier" ::: "memory");
#undef FA_TILE
#undef DMA_K
#undef DMA_V
#undef CMASK
#undef START
#undef RESC
#undef ROT
#undef PKW
#undef PAF
#undef VFR
#undef PIN
#undef MX3
#undef GAPA
#undef GAPB
#undef EX
#undef VRD
#undef KRD
#undef MF32
#undef STEP
#undef ENDW
}
#undef SBAR
#undef WAIT_BAR
}
struct SchedTwo { fg::Unit u0, u1; __device__ __forceinline__ bool next(int i, fg::Unit& o) const { if (i == 0) { o = u0; return true; } if (i == 1) { o = u1; return true; } return false; } };
struct EpiDftSym {
    static constexpr bool PERM = true;
    h16* br; unsigned char* scr;
    __device__ __forceinline__ void operator()(const f32x4 (&acc)[2][2][4][2], const fg::Unit& u, int wr, int wc, int fr, int fq) const {
        const int tid = tidx(); const float scl = 0.022097086912079608f;
        if (u.aux == 0) {
#pragma unroll
            for (int ai = 0; ai < 2; ++ai)
#pragma unroll
                for (int m = 0; m < 4; ++m)
#pragma unroll
                    for (int bj = 0; bj < 2; ++bj)
#pragma unroll
                        for (int n = 0; n < 2; ++n) { const int q = ((ai * 4 + m) * 2 + bj) * 2 + n; *(f32x4*)(scr + ((size_t)q * 512 + tid) * 16) = acc[ai][bj][m][n]; }
        } else {
#pragma unroll
            for (int ai = 0; ai < 2; ++ai) {
                f32x4 pv[4][2][2];
#pragma unroll
                for (int m = 0; m < 4; ++m)
#pragma unroll
                    for (int bj = 0; bj < 2; ++bj)
#pragma unroll
                        for (int n = 0; n < 2; ++n) { const int q = ((ai * 4 + m) * 2 + bj) * 2 + n; pv[m][bj][n] = *(const f32x4*)(scr + ((size_t)q * 512 + tid) * 16); }
                asm volatile("" ::: "memory");
#pragma unroll
                for (int m = 0; m < 4; ++m) { const int k = u.pm * 256 + 128 * ai + 64 * wr + 16 * m + fr + 1;
                    h16* lo = br + ((size_t)u.pn * 2048 + k) * DM + 256; h16* hi = br + ((size_t)u.pn * 2048 + (2048 - k)) * DM + 256;
#pragma unroll
                    for (int bj = 0; bj < 2; ++bj) { const int col = 128 * bj + 32 * wc + 8 * fq;
                        const f32x4 p0 = pv[m][bj][0], p1 = pv[m][bj][1];
                        const f32x4 q0v = acc[ai][bj][m][0], q1v = acc[ai][bj][m][1];
                        const f32x4 a0 = (p0 - q0v) * scl, a1 = (p1 - q1v) * scl, b0 = (p0 + q0v) * scl, b1 = (p1 + q1v) * scl;
                        *(u32x4*)(lo + col) = (u32x4){pk_h2(a0[0], a0[1]), pk_h2(a0[2], a0[3]), pk_h2(a1[0], a1[1]), pk_h2(a1[2], a1[3])};
                        *(u32x4*)(hi + col) = (u32x4){pk_h2(b0[0], b0[1]), pk_h2(b0[2], b0[3]), pk_h2(b1[0], b1[1]), pk_h2(b1[2], b1[3])}; } }
                asm volatile("" ::: "memory");
            }
        }
    }
};
struct SchedOne { fg::Unit u; __device__ __forceinline__ bool next(int i, fg::Unit& o) const { if (i != 0) return false; o = u; return true; } };
__device__ __forceinline__ void phase_mixers(const Params& p, int l, ldsp_t lds, int rep = 0) {
    const unsigned char* QI = p.ws + WS_QI; const unsigned char* KI = p.ws + WS_KI; const unsigned char* VI = p.ws + WS_VI; h16* br = (h16*)(p.ws + WS_BR);
    const float* sinkp = p.sink + l * 4; const float* rpb = p.rpb + (size_t)l * 4 * 465;
    const int x = bidx() & 7;
    unsigned* qctr = (unsigned*)(p.ws + WS_CTL) + 64 * (rep * 16 + l * 8 + x) + 32;
    volatile FG_LAS unsigned* qw = (volatile FG_LAS unsigned*)(lds + LDS_BYTES - 512);
    const int nq = (l == 0) ? 226 : 200;
    const int tid = tidx();
    if (rep == 0) fourier_row0(p);
    __syncthreads();
    bool have = false;
    for (;;) {
        if (!have && tid == 0) qw[0] = __hip_atomic_fetch_add(qctr, 1u, __ATOMIC_RELAXED, __HIP_MEMORY_SCOPE_AGENT);
        __syncthreads();
        int idx = (int)qw[0];
        have = false;
        if (idx >= nq) break;
        if (l == 0 && idx >= 72) idx = idx < 74 ? idx + 152 : idx - 2;
        if (rep > 0) { const bool isdft = idx < 8 || idx >= 224; if ((PROBE_MODE == 1 && isdft) || (PROBE_MODE == 2 && !isdft)) continue; }
        if (idx < 8) {
            const int id = idx;
            SchedTwo S; S.u0.pm = id & 3; S.u0.pn = 2 * x + (id >> 2); S.u0.nt = 32; S.u0.aux = 0;
            S.u0.A = (const char*)(p.ws + WS_DFT) + (size_t)S.u0.pm * 256 * 4096 * 2; S.u0.B = (const char*)(p.ws + WS_ZTL) + (size_t)S.u0.pn * 256 * 4096 * 2;
            S.u1 = S.u0; S.u1.aux = 1; S.u1.A += 4096; S.u1.B += 4096;
            EpiDftSym E{br, p.ws + WS_GSCR + (size_t)bidx() * 262144};
            fg::gemm_phase<EpiDftSym, SchedTwo, 4096>(lds, S, E);
        } else if (idx < 200) {
            const int w = (idx - 8) & 63; const int ty = (idx - 8) >> 6;
            if (ty == 0) { fa::attn_unit<0, 8>(QI, KI, VI, br, sinkp, rpb, 0, 2 * x + (w >> 5), (w >> 4) & 1, w & 15, false, lds, qctr, qw); }
            else if (ty == 1) { fa::attn_unit<2, 8>(QI, KI, VI, br, sinkp, rpb, 2, 2 * x + (w >> 5), (w >> 4) & 1, w & 15, false, lds, qctr, qw); }
            else { fa::attn_unit<1, 8>(QI, KI, VI, br, sinkp, rpb, 1, 2 * x + (w >> 5), (w >> 4) & 1, w & 15, false, lds, qctr, qw); }
            have = true;
        } else if (idx < 224) {
            const int w = idx - 200; const int mixer = w >> 3, rest = w & 7;
            fa::attn_unit<0, 8>(QI, KI, VI, br, sinkp, rpb, mixer, 2 * x + (rest >> 2), (rest >> 1) & 1, rest & 1, true, lds, qctr, qw); have = true;
        } else {
            SchedOne S; S.u.pm = 0; S.u.pn = 2 * x + (idx - 224); S.u.nt = 8; S.u.aux = 0;
            S.u.A = (const char*)(p.ws + WS_DFTC); S.u.B = (const char*)(p.ws + WS_ZTC) + (size_t)S.u.pn * 256 * 512 * 2;
            EpiDft E{br, TL, 256, 0.0625f};
            fg::gemm_phase<EpiDft, SchedOne, 512>(lds, S, E);
        }
    }
    __syncthreads();
}

#define XB_TMO      128
#define XB_XCNT(j)  (256  + 64 * (j))
#define XB_XSUB(j)  (1280 + 64 * (j))
#define XB_XGEN(j)  (2304 + 64 * (j))
#define XB_TOP      3328
#define XB_TOPGEN   3392
#define XB_SPIN_CAP (1u << 22)
__device__ __forceinline__ unsigned xb_ld(unsigned* p)              { return __hip_atomic_load(p, __ATOMIC_RELAXED, __HIP_MEMORY_SCOPE_AGENT); }
__device__ __forceinline__ unsigned xb_add(unsigned* p, unsigned v) { return __hip_atomic_fetch_add(p, v, __ATOMIC_RELAXED, __HIP_MEMORY_SCOPE_AGENT); }
__device__ __forceinline__ unsigned xb_xcc_id() { return (unsigned)__builtin_amdgcn_s_getreg((3 << 11) | 20) & 0xFu; }
#define XB_SPIN(cond, bar) do { unsigned _sp = 0; while (cond) { __builtin_amdgcn_s_sleep(1); \
    if ((++_sp & 255u) == 0u) { if (xb_ld(&(bar)[XB_TMO])) break; if (_sp > XB_SPIN_CAP) { atomicAdd(&(bar)[XB_TMO], 1u); break; } } } } while (0)
struct XcdBarrier { unsigned* bar; unsigned x; volatile FG_LAS unsigned* st; };
__device__ __forceinline__ XcdBarrier xcd_barrier_post(unsigned* bar, volatile FG_LAS unsigned* st) {
    XcdBarrier b; b.bar = bar; b.x = xb_xcc_id(); b.st = st;
    if (threadIdx.x == 0) (void)xb_add(&bar[XB_XCNT(b.x)], 1u);
    return b;
}
__device__ __forceinline__ void xcd_barrier_complete(unsigned* bar, unsigned x, unsigned& nloc, unsigned& nx) {
    const unsigned G = gridDim.x * gridDim.y * gridDim.z;
    unsigned sum, cnt, mine, sp = 0u;
    for (;;) {
        sum = 0u; cnt = 0u; mine = 0u;
#pragma unroll
        for (unsigned j = 0; j < 16; ++j) { const unsigned c = xb_ld(&bar[XB_XCNT(j)]); sum += c; cnt += (c > 0u) ? 1u : 0u; mine = (j == x) ? c : mine; }
        if (sum == G) break;
        __builtin_amdgcn_s_sleep(1);
        if ((++sp & 255u) == 0u) { if (xb_ld(&bar[XB_TMO])) break; if (sp > XB_SPIN_CAP) { atomicAdd(&bar[XB_TMO], 1u); break; } }
    }
    nloc = mine > 0u ? mine : 1u; nx = cnt > 0u ? cnt : 1u;
}
__device__ __forceinline__ void xcd_barrier(const XcdBarrier& b) {
    asm volatile("s_waitcnt vmcnt(0)" ::: "memory");
    unsigned* bar = b.bar; unsigned bx = __builtin_amdgcn_readfirstlane(b.x); asm volatile("" : "+s"(bar), "+s"(bx));
    __syncthreads();
    if (tidx() == 0) {
        __builtin_amdgcn_s_waitcnt(0);
        unsigned nloc = b.st[0], nx = b.st[1];
        if (nloc == 0u) { xcd_barrier_complete(bar, bx, nloc, nx); b.st[0] = nloc; b.st[1] = nx; }
        const unsigned old = xb_add(&bar[XB_XSUB(bx)], 1u);
        const unsigned gen = old / nloc;
        if (old + 1u == (gen + 1u) * nloc) {
            __builtin_amdgcn_fence(__ATOMIC_RELEASE, "agent");
            asm volatile("s_waitcnt vmcnt(0)" ::: "memory");
            const unsigned og = xb_add(&bar[XB_TOP], 1u);
            const unsigned tg = og / nx;
            if (og + 1u == (tg + 1u) * nx) xb_add(&bar[XB_TOPGEN], 1u);
            else XB_SPIN(xb_ld(&bar[XB_TOPGEN]) == tg, bar);
            __builtin_amdgcn_fence(__ATOMIC_ACQUIRE, "agent");
            xb_add(&bar[XB_XGEN(bx)], 1u);
            asm volatile("s_waitcnt vmcnt(0)" ::: "memory");
        } else {
            XB_SPIN(xb_ld(&bar[XB_XGEN(bx)]) == gen, bar);
            __builtin_amdgcn_fence(__ATOMIC_ACQUIRE, "agent");
            asm volatile("s_waitcnt vmcnt(0)" ::: "memory");
        }
    }
    __syncthreads();
}

__device__ __forceinline__ void xcd_barrier_arrive(const XcdBarrier& b) {
    asm volatile("s_waitcnt vmcnt(0)" ::: "memory");
    unsigned* bar = b.bar; unsigned bx = __builtin_amdgcn_readfirstlane(b.x); asm volatile("" : "+s"(bar), "+s"(bx));
    __syncthreads();
    if (tidx() == 0) {
        __builtin_amdgcn_s_waitcnt(0);
        unsigned nloc = b.st[0], nx = b.st[1];
        if (nloc == 0u) { xcd_barrier_complete(bar, bx, nloc, nx); b.st[0] = nloc; b.st[1] = nx; }
        const unsigned old = xb_add(&bar[XB_XSUB(bx)], 1u);
        const unsigned gen = old / nloc;
        unsigned mode = 0u, tg = 0u;
        if (old + 1u == (gen + 1u) * nloc) {
            __builtin_amdgcn_fence(__ATOMIC_RELEASE, "agent");
            asm volatile("s_waitcnt vmcnt(0)" ::: "memory");
            const unsigned og = xb_add(&bar[XB_TOP], 1u);
            tg = og / nx; mode = 1u;
            if (og + 1u == (tg + 1u) * nx) { xb_add(&bar[XB_TOPGEN], 1u); mode = 2u; }
            xb_add(&bar[XB_XGEN(bx)], 1u);
        }
        b.st[2] = mode; b.st[3] = gen; b.st[4] = tg;
    }
    __syncthreads();
}
__device__ __forceinline__ void xcd_barrier_wait(const XcdBarrier& b) {
    unsigned* bar = b.bar; unsigned bx = __builtin_amdgcn_readfirstlane(b.x); asm volatile("" : "+s"(bar), "+s"(bx));
    __syncthreads();
    if (tidx() == 0) {
        const unsigned mode = b.st[2], gen = b.st[3];
        if (mode != 2u) XB_SPIN(xb_ld(&bar[XB_TOPGEN]) == gen, bar);
        __builtin_amdgcn_fence(__ATOMIC_ACQUIRE, "agent");
        asm volatile("s_waitcnt vmcnt(0)" ::: "memory");
    }
    __syncthreads();
}

__global__ void __launch_bounds__(NTHREADS) mk_fwd(Params p_in) {
    extern __shared__ __attribute__((aligned(16))) unsigned char lds_raw[];
    float* lds = (float*)lds_raw; ldsp_t ldsf = (ldsp_t)lds_raw;
    cg::grid_group grid = cg::this_grid();
    volatile FG_LAS unsigned* misc = (volatile FG_LAS unsigned*)(ldsf + LDS_BYTES - 256);
    if (threadIdx.x < 32) misc[threadIdx.x] = (threadIdx.x == 16) ? blockIdx.x : 0u;
    __syncthreads();
    XcdBarrier xbar = xcd_barrier_post((unsigned*)(ldp().ws + WS_CTL) + 4096, misc + 8);
#define GSYNC() xcd_barrier(xbar)
    unsigned* cen = (unsigned*)(ldp().ws + WS_CTL) + 2048;
    if (threadIdx.x == 0) misc[17] = __hip_atomic_fetch_add(cen + 64 * xb_xcc_id(), 1u, __ATOMIC_RELAXED, __HIP_MEMORY_SCOPE_AGENT);
    for (int r_ = 0; r_ < RP_P0; ++r_) phase0(ldp(), lds);
    dense_transposes(ldp(), lds);
    if (ldp().ws == nullptr) grid.sync();
    GSYNC();
    if (threadIdx.x == 0) { bool ok = (gridDim.x == 256);
        for (int j = 0; j < 16; ++j) { const unsigned cj = __hip_atomic_load(cen + 64 * j, __ATOMIC_RELAXED, __HIP_MEMORY_SCOPE_AGENT); ok = ok && (cj == (j < 8 ? 32u : 0u)); }
        if (ok) misc[16] = misc[17] * 8u + xb_xcc_id(); }
    __syncthreads();
    phase_convert_dense(ldp(), lds, ldsf);
    phase_wg(ldp());
    for (int r_ = 0; r_ < RP_U; ++r_) phase_u(ldp(), 0);
    GSYNC();
    for (int l = 0; l < DEPTH; ++l) {
        for (int r_ = 0; r_ < RP_G1; ++r_) phase_g1_fast(ldp(), l, ldsf);
        if (l == 0 ? ((bidx() & 7) >= 4) : (bidx() >= 48)) bg_convert(ldp(), l, lds, BG_G1, true);
        GSYNC();
        for (int r_ = 0; r_ < RP_ATT; ++r_) phase_mixers(ldp(), l, ldsf, r_);
        xcd_barrier_arrive(xbar);
        phase_merge_fast(ldp(), l, ldsf, 0, 1);
        xcd_barrier_wait(xbar);
        phase_merge_fast(ldp(), l, ldsf, 1, 18);
        GSYNC();
        if (l == 0) { phase_merge_sum(ldp()); xcd_barrier_arrive(xbar); }
        phase_out_fast(ldp(), l, ldsf, 0, 2);
        if (l == 0) {
            if ((bidx() & 7) >= 2) bg_convert(ldp(), 0, lds, BG_OUT, true);
            xcd_barrier_wait(xbar);
            phase_out_fast(ldp(), l, ldsf, 2, 3); }
        xcd_barrier_arrive(xbar);
        phase_ln1_fill(ldp(), l, lds);
        xcd_barrier_wait(xbar);
        phase_ln1(ldp(), l, lds);
        GSYNC();
        for (int r_ = 0; r_ < RP_TOPK; ++r_) phase_topk(ldp(), l, lds);
        xcd_barrier_arrive(xbar);
        bg_convert(ldp(), l, lds, 1 << 20);
        xcd_barrier_wait(xbar);
        for (int r_ = 0; r_ < RP_UP; ++r_) phase_up_fast(ldp(), l, ldsf);
        GSYNC();
        for (int r_ = 0; r_ < RP_DN; ++r_) phase_down_fast(ldp(), l, ldsf);
        if (l == 0 && (bidx() & 7) >= 4) bg_convert(ldp(), 1, lds, BG_DN, true);
        GSYNC();
        for (int r_ = 0; r_ < (l == 1 ? RP_LN2 : 1); ++r_) phase_ln2(ldp(), l, lds);
        if (l == 0) GSYNC();
    }
}

extern "C" void kernel_launch(void* const* d_in, const int* in_sizes, int n_in, void* d_out, int out_size, void* d_ws, size_t ws_size, hipStream_t stream) {
    static int grid = 0;
    if (grid == 0) {
        if (n_in != 20 || ws_size < WS_END) { fprintf(stderr, "kernel_launch: unexpected n_in %d or ws_size %zu (need %zu)\n", n_in, ws_size, (size_t)WS_END); grid = -1; return; }
        int dev = 0, cus = 0, per_cu = 0;
        hipGetDevice(&dev); hipDeviceGetAttribute(&cus, hipDeviceAttributeMultiprocessorCount, dev);
        hipFuncSetAttribute((const void*)mk_fwd, hipFuncAttributeMaxDynamicSharedMemorySize, LDS_BYTES);
        hipOccupancyMaxActiveBlocksPerMultiprocessor(&per_cu, (const void*)mk_fwd, NTHREADS, LDS_BYTES);
        if (per_cu < 1) { fprintf(stderr, "kernel_launch: occupancy query says %d blocks per CU\n", per_cu); per_cu = 1; }
        (void)hipGetLastError();
        if (cus * per_cu < 256) { fprintf(stderr, "kernel_launch: needs 256 co-resident workgroups, device offers %d x %d\n", cus, per_cu); grid = -1; return; }
        grid = 256;
    }
    if (grid < 0) return;
    hipMemsetAsync((char*)d_ws + WS_CTL, 0, 64 * 1024, stream);
    Params p{};
    const float** pp = (const float**)&p;
    for (int i = 0; i < 20; ++i) pp[i] = (const float*)d_in[i];
    p.out = (float*)d_out; p.ws = (unsigned char*)d_ws;
    void* args[] = {&p};
    hipError_t e = hipLaunchCooperativeKernel((const void*)mk_fwd, dim3(grid), dim3(NTHREADS), args, LDS_BYTES, stream);
    if (e != hipSuccess) fprintf(stderr, "cooperative launch failed: %s (grid %d)\n", hipGetErrorString(e), grid);
}
```

```cpp
#include <hip/hip_runtime.h>
#include <hip/hip_cooperative_groups.h>
#include <cstdio>
#include <cstdint>
#include <type_traits>
namespace cg = cooperative_groups;

typedef _Float16 h16;
typedef _Float16 h16x8 __attribute__((ext_vector_type(8)));
typedef _Float16 h16x4 __attribute__((ext_vector_type(4)));
typedef float f32x4 __attribute__((ext_vector_type(4)));

constexpr int DM = 1024, NBATCH = 16, SEQ = 2048, CTX = 256, DEPTH = 2;
constexpr int TL = NBATCH * SEQ;
constexpr int TC = NBATCH * CTX;
constexpr int TT = TL + TC;
constexpr int INW = 5888, NMOD = 6 * DM, PMW = 1536;
constexpr int NEXP = 16, FF = 1024, CAPL = 256, CAPC = 32;
constexpr int GL = NBATCH * NEXP * CAPL;
constexpr int GC = NBATCH * NEXP * CAPC;
constexpr int GT = GL + GC;
constexpr float ALPHA = 1.4142135623730951f;
constexpr float LN_EPS = 1e-6f, RMS_EPS = 1e-6f;
constexpr int NTHREADS = 512, NWAVES = 8;
constexpr int LDS_BYTES = 147456;
constexpr int BG_G1 = 2, BG_OUT = 3, BG_DN = 2;
constexpr int PROBE_MODE = 0, RP_P0 = 1, RP_LN2 = 1;
constexpr int RP_G1 = 1, RP_FOU = 1, RP_MRG = 1, RP_OUT = 1, RP_UP = 1, RP_DN = 1, RP_ATT = 1, RP_U = 1, RP_TOPK = 1;


constexpr size_t MiB = 1u << 20;
constexpr size_t WS_CTL = 0;
constexpr size_t WS_MODV = 1 * MiB;
constexpr size_t WS_WFIN = 2 * MiB;
constexpr size_t WS_BDT = 3 * MiB;
constexpr size_t WS_TAB = 6 * MiB;
constexpr size_t WS_AFFL = 7 * MiB;
constexpr size_t WS_AFFC = 9 * MiB;
constexpr size_t WS_SELW = 10 * MiB;
constexpr size_t WS_STAT = 9 * MiB + 512 * 1024;
constexpr size_t WS_SELR = 10 * MiB + 512 * 1024;
constexpr size_t WS_SLOT = 11 * MiB;
constexpr size_t WS_WG = 13 * MiB + 512 * 1024;
constexpr size_t WS_SGB = 15 * MiB + 768 * 1024;
constexpr size_t WS_HB = 16 * MiB;
constexpr size_t WS_S = 160 * MiB;
constexpr size_t WS_U16 = WS_S;
constexpr size_t WS_PM = WS_S + 72 * MiB;
constexpr size_t WS_QI = WS_PM;
constexpr size_t WS_KI = WS_PM + 54 * MiB;
constexpr size_t WS_VI = WS_PM + 81 * MiB;
constexpr size_t WS_ZTL = WS_PM + 108 * MiB;
constexpr size_t WS_ZTC = WS_ZTL + 32 * MiB;
constexpr size_t WS_XG = WS_S + 72 * MiB;
constexpr size_t WS_BR = WS_S + 216 * MiB;
constexpr size_t WS_H16 = WS_S + 216 * MiB;
constexpr size_t WS_GSCR = WS_S + 288 * MiB;
constexpr size_t WS_MPART = WS_S + 320 * MiB;
constexpr size_t WS_WINT = WS_S + 360 * MiB;
constexpr size_t WS_WBT = WS_WINT + 24 * MiB;
constexpr size_t WS_WOT = WS_WBT + 4 * MiB;
constexpr size_t WS_DFT = WS_WOT + 4 * MiB;
constexpr size_t WS_DFTC = WS_DFT + 16 * MiB;
constexpr size_t WS_WGU1 = WS_DFTC + 1 * MiB;
constexpr size_t WS_END = WS_WGU1 + 64 * MiB;
constexpr size_t DO_WGU = 0;
constexpr size_t DO_WD = 64 * MiB;
constexpr size_t DO_WD1 = 96 * MiB;

struct Params {
    const float *x, *c, *ctx, *c_ctx, *w_mod, *b_mod, *w_in, *qk_gain, *sink, *rpb, *w_branch, *w_out, *ln1_g, *ln1_b, *w_router, *w_gate, *w_up, *w_down, *ln2_g, *ln2_b;
    float* out; unsigned char* ws;
};
typedef const __attribute__((address_space(4))) Params* kargp_t;
#if defined(__HIP_DEVICE_COMPILE__)
__device__ __forceinline__ Params ldp() { kargp_t q = (kargp_t)__builtin_amdgcn_kernarg_segment_ptr(); asm volatile("" : "+s"(q)); return *q; }
#else
__device__ __forceinline__ Params ldp() { return Params{}; }
#endif

#define VCU_LDS_ADDR (LDS_BYTES - 256 + 64)
__device__ __forceinline__ int bidx() { const unsigned v = *(volatile __attribute__((address_space(3))) unsigned*)(VCU_LDS_ADDR); int b = __builtin_amdgcn_readfirstlane((int)v); asm volatile("" : "+s"(b)); return b; }
__device__ __forceinline__ int tidx() { int t = threadIdx.x; asm volatile("" : "+v"(t)); return t; }
template <int CTRL> __device__ __forceinline__ float dpp_f(float v) { return __builtin_bit_cast(float, __builtin_amdgcn_update_dpp(0, __builtin_bit_cast(int, v), CTRL, 0xf, 0xf, true)); }
__device__ __forceinline__ float xor16_sum(float v) { const auto r = __builtin_amdgcn_permlane16_swap(__float_as_uint(v), __float_as_uint(v), false, false); return __uint_as_float(r[0]) + __uint_as_float(r[1]); }
__device__ __forceinline__ float xor32_sum(float v) { const auto r = __builtin_amdgcn_permlane32_swap(__float_as_uint(v), __float_as_uint(v), false, false); return __uint_as_float(r[0]) + __uint_as_float(r[1]); }
__device__ __forceinline__ float xor16_max(float v) { const auto r = __builtin_amdgcn_permlane16_swap(__float_as_uint(v), __float_as_uint(v), false, false); return fmaxf(__uint_as_float(r[0]), __uint_as_float(r[1])); }
__device__ __forceinline__ float xor32_max(float v) { const auto r = __builtin_amdgcn_permlane32_swap(__float_as_uint(v), __float_as_uint(v), false, false); return fmaxf(__uint_as_float(r[0]), __uint_as_float(r[1])); }
__device__ __forceinline__ float wave_sum(float v) {
    v += dpp_f<0xB1>(v);
    v += dpp_f<0x4E>(v);
    v += dpp_f<0x141>(v);
    v += dpp_f<0x140>(v);
    v = xor16_sum(v); v = xor32_sum(v);
    return v;
}
__device__ __forceinline__ float wave_max(float v) {
    v = fmaxf(v, dpp_f<0xB1>(v)); v = fmaxf(v, dpp_f<0x4E>(v)); v = fmaxf(v, dpp_f<0x141>(v)); v = fmaxf(v, dpp_f<0x140>(v));
    v = xor16_max(v); v = xor32_max(v);
    return v;
}
typedef unsigned u32x4 __attribute__((ext_vector_type(4)));
__device__ __forceinline__ unsigned pk_h2(float lo, float hi) { typedef _Float16 h2 __attribute__((ext_vector_type(2))); h2 v = {(h16)lo, (h16)hi}; return __builtin_bit_cast(unsigned, v); }
typedef __bf16 bf16x2_t __attribute__((ext_vector_type(2)));
typedef float f32x2_t __attribute__((ext_vector_type(2)));
typedef short bf16x8_t __attribute__((ext_vector_type(8)));
__device__ __forceinline__ unsigned pk_b2(float lo, float hi) { f32x2_t v = {lo, hi}; bf16x2_t b = __builtin_convertvector(v, bf16x2_t); return __builtin_bit_cast(unsigned, b); }
__device__ __forceinline__ float sigmoid_f(float v) { return __builtin_amdgcn_rcpf(1.f + __builtin_amdgcn_exp2f(v * -1.4426950408889634f)); }
__device__ __forceinline__ float silu_f(float v) { return v * sigmoid_f(v); }
__device__ __forceinline__ float sig2_f(float t) { return __builtin_amdgcn_rcpf(1.f + __builtin_amdgcn_exp2f(t)); }
__device__ __forceinline__ int mv_of(int R) { return R < TL ? (R >> 11) : 16; }

__device__ __forceinline__ void phase0(const Params& p, float* lds) {
    float* modv = (float*)(p.ws + WS_MODV); float* tab = (float*)(p.ws + WS_TAB);
    const int tid = tidx(), lane = tid & 63, wave = tid >> 6, c = bidx(), G = gridDim.x;
    if (c < 192) {
        float* sc = lds;
        float* red = lds + 17 * 1024;
        for (int e = tid; e < 17 * 1024; e += NTHREADS) { const int mv = e >> 10, k = e & 1023; const float v = mv < 16 ? p.c[mv * 1024 + k] : p.c_ctx[k]; sc[e] = silu_f(v); }
        __syncthreads();
        const int col0 = c * 64; const int l = col0 / NMOD, n0 = col0 % NMOD; const int rg = lane >> 4, cq = lane & 15;
        f32x4 acc[17];
#pragma unroll
        for (int m = 0; m < 17; ++m) acc[m] = (f32x4){0.f, 0.f, 0.f, 0.f};
        const float* w = p.w_mod + ((size_t)l * DM + wave * 128 + rg) * NMOD + n0 + cq * 4;
#pragma unroll 4
        for (int i = 0; i < 32; ++i) { const f32x4 wv = *(const f32x4*)(w + (size_t)(4 * i) * NMOD);
#pragma unroll
            for (int m = 0; m < 17; ++m) acc[m] += wv * sc[m * 1024 + wave * 128 + rg + 4 * i]; }
#pragma unroll
        for (int m = 0; m < 17; ++m) {
#pragma unroll
            for (int e = 0; e < 4; ++e) { float v = acc[m][e]; v += __shfl_xor(v, 16); v += __shfl_xor(v, 32); acc[m][e] = v; }
            if (rg == 0) *(f32x4*)(red + (wave * 17 + m) * 64 + cq * 4) = acc[m]; }
        __syncthreads();
        for (int e = tid; e < 17 * 64; e += NTHREADS) { const int m = e >> 6, ln = e & 63; float sacc = 0.f;
#pragma unroll
            for (int wv = 0; wv < 8; ++wv) sacc += red[(wv * 17 + m) * 64 + ln];
            const int nn = n0 + ln; modv[((size_t)l * 17 + m) * NMOD + nn] = sacc + p.b_mod[l * NMOD + nn]; }
        __syncthreads();
    }
    float* cT = lds; float* sT = lds + 2048;
    __syncthreads();
    for (int j = tid; j < 2048; j += NTHREADS) { cT[j] = cospif((float)j / 1024.f); sT[j] = sinpif((float)j / 1024.f); }
    if (c == G - 1) for (int e = tid; e < 64 * 16; e += NTHREADS) { const int pos = e >> 4, j = e & 15; const float inv = powf(10000.f, -(float)j / 16.f); const float ang = (float)pos * inv;
        tab[4096 + e] = cosf(ang); tab[4096 + 1024 + e] = sinf(ang); }
    __syncthreads();
    const int gt = c * NTHREADS + tid, NG = G * NTHREADS;
    { h16* DFT = (h16*)(p.ws + WS_DFT); h16* DFTC = (h16*)(p.ws + WS_DFTC);
      for (int o = gt; o < 1024 * 512 + 256 * 64; o += NG) {
        unsigned w[4];
        if (o < 1024 * 512) { const int k = (o >> 9) + 1, j0 = (o & 511) * 8;
#pragma unroll
            for (int q = 0; q < 4; ++q) { float v[2];
#pragma unroll
                for (int h = 0; h < 2; ++h) { const int j = j0 + q * 2 + h; const int idx = (k * (j & 2047)) & 2047; v[h] = (j >> 11) ? sT[idx] : cT[idx]; }
                w[q] = pk_h2(v[0], v[1]); }
            *(u32x4*)(DFT + (size_t)(k - 1) * 4096 + j0) = (u32x4){w[0], w[1], w[2], w[3]}; }
        else { const int oo = o - 1024 * 512; const int k = oo >> 6, j0 = (oo & 63) * 8;
#pragma unroll
            for (int q = 0; q < 4; ++q) { float v[2];
#pragma unroll
                for (int h = 0; h < 2; ++h) { const int j = j0 + q * 2 + h; const int idx = ((k * (j & 255)) & 255) * 8; v[h] = (j >> 8) ? -sT[idx] : cT[idx]; }
                w[q] = pk_h2(v[0], v[1]); }
            *(u32x4*)(DFTC + (size_t)k * 512 + j0) = (u32x4){w[0], w[1], w[2], w[3]}; } } }
    { h16* BDT = (h16*)(p.ws + WS_BDT);
      for (int o = gt; o < 512 * 256; o += NG) { const int zc = o >> 8, gc = o & 255; const int g = zc >> 7, cs = (zc >> 6) & 1, m = zc & 63; const int idx = ((m * (gc & 63)) & 63) * 32;
          BDT[o] = (h16)(((gc >> 6) == g) ? (cs ? sT[idx] : cT[idx]) * 0.125f : 0.f); } }
    { h16* WFIN = (h16*)(p.ws + WS_WFIN);
      for (int o = gt; o < 2 * 1024 * 64; o += NG) { const int gc4 = (o & 63) * 4, lk = o >> 6; const f32x4 v = *(const f32x4*)(p.w_in + (size_t)lk * INW + 512 + gc4);
          h16x4 hv = {(h16)v[0], (h16)v[1], (h16)v[2], (h16)v[3]}; *(h16x4*)(WFIN + (size_t)lk * 256 + gc4) = hv; } }
    __syncthreads();
}

__device__ __forceinline__ const float* hrow_of(const Params& p, const float* hB, int l, int R) { return l == 0 ? (R < TL ? p.x + (size_t)R * DM : p.ctx + (size_t)(R - TL) * DM) : hB + (size_t)R * DM; }
__device__ __forceinline__ void phase_u(const Params& p, int l) {
    const float* modv = (const float*)(p.ws + WS_MODV) + (size_t)l * 17 * NMOD; h16* u16 = (h16*)(p.ws + WS_U16); const float* hB = (const float*)(p.ws + WS_HB);
    const int lane = tidx() & 63, gw = bidx() * NWAVES + (tidx() >> 6);
    constexpr int rpw = TT / 2048;
    f32x4 sh[4], sc[4], h[4], hn[4]; int curmv = -1;
    const int R0 = gw * rpw;
    { const float* hr = hrow_of(p, hB, l, R0);
#pragma unroll
      for (int j = 0; j < 4; ++j) h[j] = *(const f32x4*)(hr + lane * 4 + 256 * j); }
    for (int i = 0; i < rpw; ++i) {
        const int R = R0 + i; const int mv = mv_of(R);
        if (mv != curmv) { const float* mvp = modv + (size_t)mv * NMOD; curmv = mv;
#pragma unroll
            for (int j = 0; j < 4; ++j) { const int col = lane * 4 + 256 * j; sh[j] = *(const f32x4*)(mvp + col); sc[j] = *(const f32x4*)(mvp + DM + col); } }
        asm volatile("" ::: "memory");
        if (i + 1 < rpw) { const float* hr = hrow_of(p, hB, l, R + 1);
#pragma unroll
            for (int j = 0; j < 4; ++j) hn[j] = *(const f32x4*)(hr + lane * 4 + 256 * j); }
        asm volatile("" ::: "memory");
#pragma unroll
        for (int j = 0; j < 4; ++j) { const int col = lane * 4 + 256 * j; const f32x4 u = h[j] * (1.f + sc[j]) + sh[j];
            *(unsigned long long*)(u16 + (size_t)R * DM + col) = (unsigned long long)pk_h2(u[0], u[1]) | ((unsigned long long)pk_h2(u[2], u[3]) << 32); }
#pragma unroll
        for (int j = 0; j < 4; ++j) h[j] = hn[j];
    }
}

constexpr float QSCALE = 0.125f * 1.4426950408889634f;
__device__ __forceinline__ void fourier_row0(const Params& p) {
    {
      const h16* ZTL = (const h16*)(p.ws + WS_ZTL); h16* brp = (h16*)(p.ws + WS_BR);
      const int lane_ = tidx() & 63, gw_ = bidx() * NWAVES + (tidx() >> 6), NGW_ = gridDim.x * NWAVES;
      for (int col = gw_; col < 4096; col += NGW_) { float sa = 0.f;
#pragma unroll
          for (int q = 0; q < 4; ++q) { const h16x8 v = *(const h16x8*)(ZTL + (size_t)col * 4096 + q * 512 + lane_ * 8);
#pragma unroll
              for (int e = 0; e < 8; ++e) sa += (float)v[e]; }
          sa = wave_sum(sa);
          if (lane_ == 0) brp[(size_t)((col >> 8) * 2048) * DM + 256 + (col & 255)] = (h16)(sa * 0.022097086912079608f); } }
}

#define MEMFENCE() asm volatile("" ::: "memory")
__device__ __forceinline__ void phase_wg(const Params& p) {
    const float* modv = (const float*)(p.ws + WS_MODV); float* wg = (float*)(p.ws + WS_WG); float* sgb = (float*)(p.ws + WS_SGB);
    const int tid = tidx(), lane = tid & 63, gw = bidx() * NWAVES + (tid >> 6), NGW = gridDim.x * NWAVES;
    for (int it = bidx() * NTHREADS + tid; it < 2 * 17 * 1024; it += gridDim.x * NTHREADS) {
        const int k = it & 1023, lm = it >> 10, l = lm / 17;
        const float G = p.ln1_g[l * DM + k] * (1.f + modv[(size_t)lm * NMOD + 4 * DM + k]);
        const float* w = p.w_router + ((size_t)l * DM + k) * 16; float* o = wg + (size_t)lm * 16384 + (size_t)((k >> 2) * 16) * 4 + (k & 3);
#pragma unroll
        for (int e4 = 0; e4 < 4; ++e4) { const f32x4 wv = *(const f32x4*)(w + e4 * 4);
#pragma unroll
            for (int c = 0; c < 4; ++c) o[(e4 * 4 + c) * 4] = G * wv[c]; } }
    for (int lm = gw; lm < 34; lm += NGW) { const int l = lm / 17;
        float sg[16], sb[16];
#pragma unroll
        for (int e = 0; e < 16; ++e) { sg[e] = 0.f; sb[e] = 0.f; }
        for (int q = 0; q < 16; ++q) { const int k = lane + 64 * q; const float sc = modv[(size_t)lm * NMOD + 4 * DM + k], sh = modv[(size_t)lm * NMOD + 3 * DM + k];
            const float G = p.ln1_g[l * DM + k] * (1.f + sc), Bp = p.ln1_b[l * DM + k] * (1.f + sc) + sh; const float* w = p.w_router + ((size_t)l * DM + k) * 16;
#pragma unroll
            for (int e4 = 0; e4 < 4; ++e4) { const f32x4 wv = *(const f32x4*)(w + e4 * 4);
#pragma unroll
                for (int c = 0; c < 4; ++c) { sg[e4 * 4 + c] += G * wv[c]; sb[e4 * 4 + c] += Bp * wv[c]; } } }
#pragma unroll
        for (int e = 0; e < 16; ++e) { const float a = wave_sum(sg[e]), b = wave_sum(sb[e]); if (lane == 0) { sgb[lm * 32 + e] = a; sgb[lm * 32 + 16 + e] = b; } } }
}
__device__ __forceinline__ void ln1_rows(const float* hB, h16* u16, float* stat, const float* mvp, const float* g, const float* bb, int R0, int nrows, int ioff, int lane, float& mu, float& rho, float* cst) {
    f32x4 gg[4], bv[4], sh[4], sc[4];
#pragma unroll
    for (int j = 0; j < 4; ++j) { const int col = lane * 4 + 256 * j; gg[j] = *(const f32x4*)(g + col); bv[j] = *(const f32x4*)(bb + col); sh[j] = *(const f32x4*)(mvp + 3 * DM + col); sc[j] = *(const f32x4*)(mvp + 4 * DM + col); }
    f32x4 v[4], vn[4];
#pragma unroll
    for (int j = 0; j < 4; ++j) v[j] = *(const f32x4*)(hB + (size_t)R0 * DM + lane * 4 + 256 * j);
    for (int i = 0; i < nrows; ++i) {
        const int R = R0 + i;
        MEMFENCE();
        if (i + 1 < nrows) {
#pragma unroll
            for (int j = 0; j < 4; ++j) vn[j] = *(const f32x4*)(hB + (size_t)(R + 1) * DM + lane * 4 + 256 * j); }
        MEMFENCE();
        float s = 0.f;
#pragma unroll
        for (int j = 0; j < 4; ++j) s += (v[j][0] + v[j][1]) + (v[j][2] + v[j][3]);
        const float mean = wave_sum(s) * (1.f / DM); float q = 0.f;
#pragma unroll
        for (int j = 0; j < 4; ++j) { v[j] = v[j] - mean; q += (v[j][0] * v[j][0] + v[j][1] * v[j][1]) + (v[j][2] * v[j][2] + v[j][3] * v[j][3]); }
        const float rstd = rsqrtf(wave_sum(q) * (1.f / DM) + LN_EPS);
        if (lane == 0) { float* st = stat + (size_t)R * 2; st[0] = mean; st[1] = rstd; if (cst) { cst[(ioff + i) * 2] = mean; cst[(ioff + i) * 2 + 1] = rstd; } }
        if ((lane & 15) == ioff + i) { mu = mean; rho = rstd; }
#pragma unroll
        for (int j = 0; j < 4; ++j) { const int col = lane * 4 + 256 * j;
            const f32x4 h1 = v[j] * rstd * gg[j] + bv[j];
            const f32x4 u2 = h1 * (1.f + sc[j]) + sh[j];
            *(unsigned long long*)(u16 + (size_t)R * DM + col) = (unsigned long long)pk_b2(u2[0], u2[1]) | ((unsigned long long)pk_b2(u2[2], u2[3]) << 32); }
#pragma unroll
        for (int j = 0; j < 4; ++j) v[j] = vn[j];
    }
}
__device__ __forceinline__ f32x4 ln1_router_mfma(const float* vrow, const float* wgl, int t0, int t1) {
    f32x4 a0 = {0.f, 0.f, 0.f, 0.f}, a1 = {0.f, 0.f, 0.f, 0.f};
    f32x4 b[8], bn[8];
#pragma unroll
    for (int u = 0; u < 8; ++u) b[u] = *(const f32x4*)(vrow + 16 * (t0 + u));
    for (int t = t0; t < t1; t += 8) {
        if (t + 8 < t1) {
#pragma unroll
            for (int u = 0; u < 8; ++u) bn[u] = *(const f32x4*)(vrow + 16 * (t + 8 + u)); }
#pragma unroll
        for (int u = 0; u < 8; ++u) { const f32x4 a = *(const f32x4*)(wgl + (t + u) * 256);
#pragma unroll
            for (int i = 0; i < 4; ++i) { if (u & 1) a1 = __builtin_amdgcn_mfma_f32_16x16x4f32(a[i], b[u][i], a1, 0, 0, 0); else a0 = __builtin_amdgcn_mfma_f32_16x16x4f32(a[i], b[u][i], a0, 0, 0, 0); } }
#pragma unroll
        for (int u = 0; u < 8; ++u) b[u] = bn[u];
    }
    return a0 + a1;
}
__device__ __forceinline__ void ln1_finish(const Params& p, const float* sgbm, const f32x4 D, float mu, float rho, int R, int lane) {
    float* affL = (float*)(p.ws + WS_AFFL); float* affC = (float*)(p.ws + WS_AFFC);
    const int eq = lane >> 4; const f32x4 sg = *(const f32x4*)(sgbm + 4 * eq), sb = *(const f32x4*)(sgbm + 16 + 4 * eq);
    const float rm = rho * mu; float lg[4];
#pragma unroll
    for (int r = 0; r < 4; ++r) lg[r] = rho * D[r] - rm * sg[r] + sb[r];
    float mx = fmaxf(fmaxf(lg[0], lg[1]), fmaxf(lg[2], lg[3])); mx = xor16_max(mx); mx = xor32_max(mx);
    float ex[4], se = 0.f;
#pragma unroll
    for (int r = 0; r < 4; ++r) { ex[r] = __builtin_amdgcn_exp2f((lg[r] - mx) * 1.4426950408889634f); se += ex[r]; }
    se = xor16_sum(se); se = xor32_sum(se);
#pragma unroll
    for (int r = 0; r < 4; ++r) { const float a = ex[r] / se; const int e = 4 * eq + r;
        if (R < TL) affL[((size_t)((R >> 11) * 16 + e)) * 2048 + (R & 2047)] = a; else { const int rr = R - TL; affC[((size_t)((rr >> 8) * 16 + e)) * 256 + (rr & 255)] = a; } }
}
__device__ __forceinline__ void phase_ln1_fill(const Params& p, int l, float* lds) {
    const float* wg = (const float*)(p.ws + WS_WG) + (size_t)l * 17 * 16384; const int tid = tidx(), bt = bidx() >> 4;
    __syncthreads();
    for (int e = tid; e < 4096; e += NTHREADS) *(f32x4*)(lds + e * 4) = *(const f32x4*)(wg + (size_t)bt * 16384 + e * 4);
    if (l == 0) for (int e = tid; e < 4096; e += NTHREADS) *(f32x4*)(lds + 16384 + e * 4) = *(const f32x4*)(wg + (size_t)16 * 16384 + e * 4);
    __syncthreads();
}
__device__ __forceinline__ void phase_ln1(const Params& p, int l, float* lds) {
    float* hB = (float*)(p.ws + WS_HB); h16* u16 = (h16*)(p.ws + WS_U16); const float* modv = (const float*)(p.ws + WS_MODV) + (size_t)l * 17 * NMOD;
    float* stat = (float*)(p.ws + WS_STAT); const float* wg = (const float*)(p.ws + WS_WG) + (size_t)l * 17 * 16384; const float* sgb = (const float*)(p.ws + WS_SGB) + l * 17 * 32;
    const float* g = p.ln1_g + l * DM; const float* bb = p.ln1_b + l * DM;
    const int tid = tidx(), lane = tid & 63, w = tid >> 6, c = bidx();
    const int bt = c >> 4;
    float* cst = lds + 32768; float* part = lds + 32768 + 64;
    __syncthreads();
    { const int Rg = c * 128 + w * 16; float mu = 0.f, rho = 0.f;
      ln1_rows(hB, u16, stat, modv + (size_t)bt * NMOD, g, bb, Rg, 16, 0, lane, mu, rho, nullptr);
      const f32x4 D = ln1_router_mfma(hB + (size_t)(Rg + (lane & 15)) * DM + 4 * (lane >> 4), lds + lane * 4, 0, 64);
      ln1_finish(p, sgb + bt * 32, D, mu, rho, Rg + (lane & 15), lane); }
    if (l == 0) { const int Cg = TL + c * 16; float mu = 0.f, rho = 0.f;
      ln1_rows(hB, u16, stat, modv + (size_t)16 * NMOD, g, bb, Cg + 2 * w, 2, 2 * w, lane, mu, rho, cst);
      __syncthreads();
      const f32x4 D = ln1_router_mfma(hB + (size_t)(Cg + (lane & 15)) * DM + 4 * (lane >> 4), lds + 16384 + lane * 4, 8 * w, 8 * w + 8);
      *(f32x4*)(part + (w * 64 + lane) * 4) = D;
      __syncthreads();
      if (w == 0) { f32x4 Ds = *(const f32x4*)(part + lane * 4);
#pragma unroll
          for (int q = 1; q < 8; ++q) Ds += *(const f32x4*)(part + (q * 64 + lane) * 4);
          ln1_finish(p, sgb + 16 * 32, Ds, cst[(lane & 15) * 2], cst[(lane & 15) * 2 + 1], Cg + (lane & 15), lane); } }
    __syncthreads();
}

__device__ __forceinline__ void phase_topk(const Params& p, int l, float* lds) {
    const float* affL = (const float*)(p.ws + WS_AFFL); const float* affC = (const float*)(p.ws + WS_AFFC); float* selw = (float*)(p.ws + WS_SELW); int* slot_of = (int*)(p.ws + WS_SLOT);
    int* selrow = (int*)(p.ws + WS_SELR);
    unsigned* a = (unsigned*)lds; unsigned* hist = (unsigned*)(lds + 2048 + 256); int* wsum = (int*)(lds + 2048 + 512); unsigned* ctl = (unsigned*)(lds + 2048 + 512 + 32);
    const int tid = tidx(), lane = tid & 63, wave = tid >> 6;
    const int nitems = (l == 0) ? 512 : 256;
    __syncthreads();
    for (int it = bidx(); it < nitems; it += gridDim.x) {
        const bool lat = it < 256; const int be = lat ? it : it - 256; const int b = be >> 4, e = be & 15; const int n = lat ? 2048 : 256, cap = lat ? CAPL : CAPC;
        const float* src = lat ? affL + (size_t)be * 2048 : affC + (size_t)be * 256;
        for (int i = tid; i < n; i += NTHREADS) a[i] = __float_as_uint(src[i]);
        unsigned prefix = 0u, pmask = 0u; int remaining = cap;
        for (int pass = 0; pass < 4; ++pass) {
            const int shift = 24 - 8 * pass;
            if (tid < 256) hist[tid] = 0u;
            __syncthreads();
            for (int i = tid; i < n; i += NTHREADS) { const unsigned u = a[i]; if ((u & pmask) == prefix) atomicAdd(&hist[(u >> shift) & 255u], 1u); }
            __syncthreads();
            if (tid < 64) {
                unsigned c4[4]; unsigned s4 = 0;
#pragma unroll
                for (int q = 0; q < 4; ++q) { c4[q] = hist[255 - (lane * 4 + q)]; s4 += c4[q]; }
                unsigned incl = s4;
#pragma unroll
                for (int o = 1; o < 64; o <<= 1) { const unsigned t = __shfl_up(incl, o); if (lane >= o) incl += t; }
                unsigned excl = incl - s4;
                const bool mine = (excl < (unsigned)remaining) && (incl >= (unsigned)remaining);
                if (mine) { unsigned cum = excl; int bin = 0; unsigned above = 0;
#pragma unroll
                    for (int q = 0; q < 4; ++q) { if (cum < (unsigned)remaining && cum + c4[q] >= (unsigned)remaining) { bin = 255 - (lane * 4 + q); above = cum; } cum += c4[q]; }
                    ctl[0] = (unsigned)bin; ctl[1] = above; }
            }
            __syncthreads();
            prefix |= ctl[0] << shift; pmask |= 255u << shift; remaining -= (int)ctl[1];
            __syncthreads();
        }
        const unsigned T = prefix; const int need_eq = remaining;
        const int i0 = tid * 4; int ngt = 0, neq = 0; unsigned u4[4];
#pragma unroll
        for (int q = 0; q < 4; ++q) { const int i = i0 + q; u4[q] = (i < n) ? a[i] : 0u; ngt += (i < n && u4[q] > T) ? 1 : 0; neq += (i < n && u4[q] == T) ? 1 : 0; }
        int ieq = neq;
#pragma unroll
        for (int o = 1; o < 64; o <<= 1) { const int t = __shfl_up(ieq, o); if (lane >= o) ieq += t; }
        if (lane == 63) wsum[wave] = ieq;
        __syncthreads();
        int eqbase = 0;
#pragma unroll
        for (int wv = 0; wv < 8; ++wv) eqbase += (wv < wave) ? wsum[wv] : 0;
        int eqrank = eqbase + ieq - neq;
        int nsel = 0; bool sel[4];
#pragma unroll
        for (int q = 0; q < 4; ++q) { const int i = i0 + q; const bool gt = (i < n) && (u4[q] > T); const bool eq = (i < n) && (u4[q] == T); sel[q] = gt || (eq && eqrank < need_eq); eqrank += eq ? 1 : 0; nsel += sel[q] ? 1 : 0; }
        __syncthreads();
        int isel = nsel;
#pragma unroll
        for (int o = 1; o < 64; o <<= 1) { const int t = __shfl_up(isel, o); if (lane >= o) isel += t; }
        if (lane == 63) wsum[wave] = isel;
        __syncthreads();
        int sbase = 0;
#pragma unroll
        for (int wv = 0; wv < 8; ++wv) sbase += (wv < wave) ? wsum[wv] : 0;
        int slot = sbase + isel - nsel;
        const int gbase = lat ? be * 256 : GL + e * 512 + b * 32;
#pragma unroll
        for (int q = 0; q < 4; ++q) { const int i = i0 + q; if (i < n) { const int R = lat ? b * 2048 + i : TL + b * 256 + i;
            if (sel[q]) { selrow[gbase + slot] = R; selw[gbase + slot] = __uint_as_float(u4[q]); slot_of[(size_t)R * 16 + e] = gbase + slot; ++slot; } else slot_of[(size_t)R * 16 + e] = -1; } }
        __syncthreads();
    }
}

struct Ln2S { int sl; float m, r; };
__device__ __forceinline__ Ln2S ln2_ldS(const int* slot_of, const float* stat, int R, int lane) { Ln2S s; s.sl = slot_of[(size_t)R * 16 + (lane & 15)]; s.m = stat[(size_t)R * 2]; s.r = stat[(size_t)R * 2 + 1]; return s; }
__device__ __forceinline__ void ln2_issue(const h16* Y, const float* hB, int R, int sl, int lane, h16x4 (&yv)[4][4], f32x4 (&h)[4]) {
    unsigned long long msk = __ballot(sl >= 0) & 0xFFFFull;
#pragma unroll
    for (int q = 0; q < 4; ++q) { if (msk) { const int e = __builtin_ctzll(msk); msk &= msk - 1; const int sr = __builtin_amdgcn_readlane(sl, e);
#pragma unroll
            for (int j = 0; j < 4; ++j) yv[q][j] = *(const h16x4*)(Y + (size_t)sr * DM + lane * 4 + 256 * j); }
        else {
#pragma unroll
            for (int j = 0; j < 4; ++j) yv[q][j] = (h16x4){(h16)0.f, (h16)0.f, (h16)0.f, (h16)0.f}; } }
#pragma unroll
    for (int j = 0; j < 4; ++j) h[j] = *(const f32x4*)(hB + (size_t)R * DM + lane * 4 + 256 * j);
}
__device__ __forceinline__ void ln2_rows(const Params& p, int l, const float* ldsv, int R0, int nrows, int mv, int lane) {
    float* hB = (float*)(p.ws + WS_HB); h16* u16 = (h16*)(p.ws + WS_U16); const h16* Y = (const h16*)(p.ws + WS_XG); const int* slot_of = (const int*)(p.ws + WS_SLOT);
    const float* mvp = (const float*)(p.ws + WS_MODV) + ((size_t)l * 17 + mv) * NMOD; const float* mvn = mvp + (size_t)17 * NMOD; const float* stat = (const float*)(p.ws + WS_STAT);
    const bool nextu = (l < DEPTH - 1);
    f32x4 gate[4], nsh[4], nsc[4];
#pragma unroll
    for (int j = 0; j < 4; ++j) { const int col = lane * 4 + 256 * j; gate[j] = *(const f32x4*)(mvp + 5 * DM + col); nsh[j] = (f32x4){0.f, 0.f, 0.f, 0.f}; nsc[j] = nsh[j];
        if (nextu) { nsh[j] = *(const f32x4*)(mvn + col); nsc[j] = *(const f32x4*)(mvn + DM + col); } }
    Ln2S sA = ln2_ldS(slot_of, stat, R0, lane), sB = sA, sC = sA, sD = sA;
    if (nrows > 1) sB = ln2_ldS(slot_of, stat, R0 + 1, lane);
    if (nrows > 2) sC = ln2_ldS(slot_of, stat, R0 + 2, lane);
    h16x4 yv0[4][4], yv1[4][4]; f32x4 h0[4], h1b[4];
    ln2_issue(Y, hB, R0, sA.sl, lane, yv0, h0);
    for (int i = 0; i < nrows; ++i) {
        const int R = R0 + i;
        MEMFENCE();
        if (i + 1 < nrows) ln2_issue(Y, hB, R + 1, sB.sl, lane, yv1, h1b);
        if (i + 3 < nrows) sD = ln2_ldS(slot_of, stat, R + 3, lane);
        MEMFENCE();
        f32x4 f[4];
#pragma unroll
        for (int j = 0; j < 4; ++j) { f[j] = (f32x4){0.f, 0.f, 0.f, 0.f};
#pragma unroll
            for (int q = 0; q < 4; ++q) { f[j][0] += (float)yv0[q][j][0]; f[j][1] += (float)yv0[q][j][1]; f[j][2] += (float)yv0[q][j][2]; f[j][3] += (float)yv0[q][j][3]; } }
        { unsigned long long msk = __ballot(sA.sl >= 0) & 0xFFFFull;
#pragma unroll
          for (int q = 0; q < 4; ++q) msk &= msk - 1;
          while (msk) { const int e = __builtin_ctzll(msk); msk &= msk - 1; const int sr = __builtin_amdgcn_readlane(sA.sl, e);
#pragma unroll
            for (int j = 0; j < 4; ++j) { const h16x4 y = *(const h16x4*)(Y + (size_t)sr * DM + lane * 4 + 256 * j); f[j][0] += (float)y[0]; f[j][1] += (float)y[1]; f[j][2] += (float)y[2]; f[j][3] += (float)y[3]; } } }
        f32x4 v[4]; float s = 0.f;
#pragma unroll
        for (int j = 0; j < 4; ++j) { const f32x4 g1v = *(const f32x4*)(ldsv + lane * 4 + 256 * j), b1v = *(const f32x4*)(ldsv + 1024 + lane * 4 + 256 * j);
            const f32x4 hh = (h0[j] - sA.m) * sA.r * g1v + b1v;
            v[j] = ALPHA * hh + gate[j] * f[j]; s += (v[j][0] + v[j][1]) + (v[j][2] + v[j][3]); }
        const float mean = wave_sum(s) * (1.f / DM); float q = 0.f;
#pragma unroll
        for (int j = 0; j < 4; ++j) { v[j] = v[j] - mean; q += (v[j][0] * v[j][0] + v[j][1] * v[j][1]) + (v[j][2] * v[j][2] + v[j][3] * v[j][3]); }
        const float rstd = rsqrtf(wave_sum(q) * (1.f / DM) + LN_EPS);
        float* orow = (l == DEPTH - 1) ? p.out + (size_t)R * DM : hB + (size_t)R * DM;
#pragma unroll
        for (int j = 0; j < 4; ++j) { const int col = lane * 4 + 256 * j; const f32x4 g2v = *(const f32x4*)(ldsv + 2048 + col), b2v = *(const f32x4*)(ldsv + 3072 + col);
            const f32x4 h2 = v[j] * rstd * g2v + b2v; if (l == DEPTH - 1) __builtin_nontemporal_store(h2, (f32x4*)(orow + col)); else *(f32x4*)(orow + col) = h2;
            if (nextu) { const f32x4 u = h2 * (1.f + nsc[j]) + nsh[j];
                *(unsigned long long*)(u16 + (size_t)R * DM + col) = (unsigned long long)pk_h2(u[0], u[1]) | ((unsigned long long)pk_h2(u[2], u[3]) << 32); } }
#pragma unroll
        for (int q2 = 0; q2 < 4; ++q2)
#pragma unroll
            for (int j = 0; j < 4; ++j) yv0[q2][j] = yv1[q2][j];
#pragma unroll
        for (int j = 0; j < 4; ++j) h0[j] = h1b[j];
        sA = sB; sB = sC; sC = sD;
    }
}
__device__ __forceinline__ void phase_ln2(const Params& p, int l, float* lds) {
    const int tid = tidx(), lane = tid & 63, w = tid >> 6, c = bidx();
    __syncthreads();
    for (int e = tid; e < 1024; e += NTHREADS) { const int k = e >> 8, col = (e & 255) * 4; const float* src = (k == 0 ? p.ln1_g : k == 1 ? p.ln1_b : k == 2 ? p.ln2_g : p.ln2_b) + l * DM + col;
        *(f32x4*)(lds + k * 1024 + col) = *(const f32x4*)src; }
    __syncthreads();
    ln2_rows(p, l, lds, c * 128 + w * 16, 16, c >> 4, lane);
    if (l == 0) ln2_rows(p, l, lds, TL + c * 16 + 2 * w, 2, 16, lane);
    __syncthreads();
}

namespace fg {
#define FG_LAS __attribute__((address_space(3)))
constexpr int BM = 256, BK = 64, HALF = 128, HTB = HALF * BK * 2, STAGE_BYTES = 8 * HTB;
__host__ __device__ __forceinline__ int lds_byte(int r, int c) { const int st = (r >> 4) * 2 + (c >> 5), rr = r & 15, cc = c & 31, ob = rr * 64 + cc * 2; return st * 1024 + (ob ^ (((ob >> 9) & 1) << 5)); }
__host__ __device__ __forceinline__ void stage_rc(int b, int& R, int& C) { const int st = b / 1024, sb = b % 1024, swz = sb ^ (((sb >> 9) & 1) << 5); R = (st >> 1) * 16 + swz / 64; C = (st & 1) * 32 + (swz % 64) / 2; }
__host__ __device__ __forceinline__ int perm32(int rho) { const int n = rho >> 4, i = rho & 15; return 8 * (i >> 2) + 4 * n + (i & 3); }
struct Unit { const char* A; const char* B; int nt; int pm, pn, aux; const int* rows; };
template <class Epi, class Sched, int LD, bool BF = false, bool GATHER = false>
__device__ __forceinline__ void gemm_phase(FG_LAS unsigned char* lds, const Sched& S, const Epi& E) {
    const int tid = tidx(), wid = __builtin_amdgcn_readfirstlane(tid >> 6), lane = tid & 63, wr = wid >> 2, wc = wid & 3, fr = lane & 15, fq = lane >> 4;
    unsigned voffA[2], voffB[2]; int rowA[2], colA[2];
#pragma unroll
    for (int i = 0; i < 2; ++i) { int R, C; stage_rc(tid * 16 + i * 8192, R, C); const int Rb = Epi::PERM ? ((R & ~31) + perm32(R & 31)) : R;
        voffA[i] = (unsigned)(R * LD + C) * 2u; voffB[i] = (unsigned)(Rb * LD + C) * 2u; rowA[i] = R; colA[i] = C; }
    const size_t kstep = (size_t)(BK * 2);
    const size_t hstep = GATHER ? (size_t)0 : (size_t)HALF * LD * 2;
    const unsigned ldsw = (unsigned)wid * 1024u;
    const int aoff = lds_byte(wr * 64 + fr, fq * 8), boff = lds_byte(wc * 32 + fr, fq * 8);
#define FG_SA(b, h) (((b) * 2 + (h)) * HTB)
#define FG_SB(b, h) ((4 + (b) * 2 + (h)) * HTB)
#define FG_STAGE(bufoff, gbase, voff) do { _Pragma("unroll") for (int _i = 0; _i < 2; ++_i) \
        __builtin_amdgcn_global_load_lds((const unsigned*)((const char*)(gbase) + (voff)[_i]), (FG_LAS unsigned*)(lds + (bufoff) + ldsw + _i * 8192), 16, 0, 0); } while (0)
#define FG_STAGEA(bufoff, gbase, h, cur_) do { if (GATHER) { if (cur_) FG_STAGE(bufoff, gbase, cvA[h]); else FG_STAGE(bufoff, gbase, nvA[h]); } else FG_STAGE(bufoff, (gbase) + (h) * ((size_t)HALF * LD * 2), voffA); } while (0)
#define FG_LDA(dst, b, h) do { _Pragma("unroll") for (int m = 0; m < 4; ++m) _Pragma("unroll") for (int k = 0; k < 2; ++k) dst[m][k] = *(const FG_LAS h16x8*)(lds + FG_SA(b, h) + aoff + m * 2048 + k * 1024); } while (0)
#define FG_LDB(dst, b, h) do { _Pragma("unroll") for (int n = 0; n < 2; ++n) _Pragma("unroll") for (int k = 0; k < 2; ++k) dst[n][k] = *(const FG_LAS h16x8*)(lds + FG_SB(b, h) + boff + n * 2048 + k * 1024); } while (0)
#define FG_MMA(ai, bj, At, Bt) do { __builtin_amdgcn_s_setprio(1); _Pragma("unroll") for (int m = 0; m < 4; ++m) _Pragma("unroll") for (int n = 0; n < 2; ++n) _Pragma("unroll") for (int k = 0; k < 2; ++k) \
        acc[ai][bj][m][n] = BF ? __builtin_amdgcn_mfma_f32_16x16x32_bf16(__builtin_bit_cast(bf16x8_t, Bt[n][k]), __builtin_bit_cast(bf16x8_t, At[m][k]), acc[ai][bj][m][n], 0, 0, 0) : __builtin_amdgcn_mfma_f32_16x16x32_f16(Bt[n][k], At[m][k], acc[ai][bj][m][n], 0, 0, 0); __builtin_amdgcn_s_setprio(0); } while (0)
#define FG_WAIT_V(n) asm volatile("s_waitcnt vmcnt(" #n ")" ::: "memory")
#define FG_WAIT_L(n) asm volatile("s_waitcnt lgkmcnt(" #n ")" ::: "memory")
#define FG_BAR __builtin_amdgcn_s_barrier()
#define FG_SCHED __builtin_amdgcn_sched_barrier(0)
    Unit cur, nxt; int ui = 0;
    __syncthreads();
    if (!S.next(0, cur)) return;
    f32x4 acc[2][2][4][2];
#pragma unroll
    for (int a = 0; a < 2; ++a)
#pragma unroll
        for (int b = 0; b < 2; ++b)
#pragma unroll
            for (int m = 0; m < 4; ++m)
#pragma unroll
                for (int n = 0; n < 2; ++n) acc[a][b][m][n] = (f32x4){0.f, 0.f, 0.f, 0.f};
    h16x8 At[4][2], B0[2][2], B1[2][2];
    const char* cA = cur.A; const char* cB = cur.B;
    const size_t hstepB = (size_t)HALF * LD * 2;
    unsigned cvA[2][2], nvA[2][2];
    if (GATHER) {
#pragma unroll
        for (int h = 0; h < 2; ++h)
#pragma unroll
            for (int i = 0; i < 2; ++i) { cvA[h][i] = (unsigned)(cur.rows[h * HALF + rowA[i]] * LD + colA[i]) * 2u; nvA[h][i] = cvA[h][i]; } }
    FG_STAGE(FG_SB(0, 0), cB, voffB); FG_STAGE(FG_SB(0, 1), cB + hstepB, voffB); FG_STAGEA(FG_SA(0, 0), cA, 0, true); FG_STAGEA(FG_SA(0, 1), cA, 1, true);
    if (wr == 1) FG_BAR;
    FG_WAIT_V(2); FG_BAR;
    FG_STAGE(FG_SB(1, 0), cB + kstep, voffB); FG_STAGEA(FG_SA(1, 0), cA + kstep, 0, true); FG_STAGE(FG_SB(1, 1), cB + hstepB + kstep, voffB);
    FG_WAIT_V(6); FG_BAR;
    for (;;) {
        const bool has_next = S.next(ui + 1, nxt);
        const char* nA = has_next ? nxt.A : cA; const char* nB = has_next ? nxt.B : cB;
        if (GATHER && has_next) {
#pragma unroll
            for (int h = 0; h < 2; ++h)
#pragma unroll
                for (int i = 0; i < 2; ++i) nvA[h][i] = (unsigned)(nxt.rows[h * HALF + rowA[i]] * LD + colA[i]) * 2u; }
        const int nt = cur.nt;
        for (int t = 0; t < nt; t += 2) {
            const bool last = (t == nt - 2);
            const char* a1 = cA + (size_t)(t + 1) * kstep;
            const char* a2 = last ? nA : cA + (size_t)(t + 2) * kstep; const char* b2 = last ? nB : cB + (size_t)(t + 2) * kstep;
            const char* a3 = a2 + kstep; const char* b3 = b2 + kstep;
            FG_LDB(B0, 0, 0); FG_LDB(B1, 0, 1); FG_SCHED; FG_LDA(At, 0, 0); FG_STAGEA(FG_SA(1, 1), a1, 1, true);
            FG_WAIT_V(8); FG_WAIT_L(0); FG_BAR; FG_MMA(0, 0, At, B0); FG_MMA(0, 1, At, B1); FG_BAR; FG_SCHED;
            FG_LDA(At, 0, 1); FG_STAGE(FG_SB(0, 0), b2, voffB); FG_STAGE(FG_SB(0, 1), b2 + hstepB, voffB); FG_STAGEA(FG_SA(0, 0), a2, 0, !last);
            FG_WAIT_V(8); FG_WAIT_L(0); FG_BAR; FG_MMA(1, 0, At, B0); FG_MMA(1, 1, At, B1); FG_BAR; FG_SCHED;
            FG_LDB(B0, 1, 0); FG_LDB(B1, 1, 1); FG_SCHED; FG_LDA(At, 1, 0); FG_STAGEA(FG_SA(0, 1), a2, 1, !last);
            FG_WAIT_V(8); FG_WAIT_L(0); FG_BAR; FG_MMA(0, 0, At, B0); FG_MMA(0, 1, At, B1); FG_BAR; FG_SCHED;
            FG_LDA(At, 1, 1); FG_STAGE(FG_SB(1, 0), b3, voffB); FG_STAGE(FG_SB(1, 1), b3 + hstepB, voffB); FG_STAGEA(FG_SA(1, 0), a3, 0, !last);
            FG_WAIT_V(8); FG_WAIT_L(0); FG_BAR; FG_MMA(1, 0, At, B0); FG_MMA(1, 1, At, B1); FG_BAR; FG_SCHED;
        }
        if (wr == 0) FG_BAR;
        { const int t2_ = tidx(); E(acc, cur, wr, wc, t2_ & 15, (t2_ >> 4) & 3); }
        if (!has_next) break;
#pragma unroll
        for (int a = 0; a < 2; ++a)
#pragma unroll
            for (int b = 0; b < 2; ++b)
#pragma unroll
                for (int m = 0; m < 4; ++m)
#pragma unroll
                    for (int n = 0; n < 2; ++n) acc[a][b][m][n] = (f32x4){0.f, 0.f, 0.f, 0.f};
        cur = nxt; cA = nA; cB = nB; ++ui;
        if (GATHER) {
#pragma unroll
            for (int h = 0; h < 2; ++h)
#pragma unroll
                for (int i = 0; i < 2; ++i) cvA[h][i] = nvA[h][i]; }
        if (wr == 1) FG_BAR;
    }
    FG_WAIT_V(0);
    FG_BAR;
#undef FG_SA
#undef FG_SB
#undef FG_STAGE
#undef FG_LDA
#undef FG_STAGEA
#undef FG_LDB
#undef FG_MMA
#undef FG_WAIT_V
#undef FG_WAIT_L
#undef FG_BAR
#undef FG_SCHED
}
}
typedef FG_LAS unsigned char* ldsp_t;

template <bool BF = false>
__device__ __forceinline__ void transpose_item(const float* W, int ldw, h16* WT, int ldt, float* scr, int lane, float scl = 1.f) {
    f32x4 t[16];
#pragma unroll
    for (int i = 0; i < 16; ++i) t[i] = __builtin_nontemporal_load((const f32x4*)(W + (size_t)(i * 4 + (lane >> 4)) * ldw + (lane & 15) * 4));
#pragma unroll
    for (int i = 0; i < 16; ++i) { float* d = scr + (i * 4 + (lane >> 4)) * 65 + (lane & 15) * 4; d[0] = t[i][0]; d[1] = t[i][1]; d[2] = t[i][2]; d[3] = t[i][3]; }
    __builtin_amdgcn_wave_barrier();
    const int c = lane & 7;
#pragma unroll
    for (int j = 0; j < 8; ++j) { const int n = (lane >> 3) + 8 * j; const float* sp = scr + (8 * c) * 65 + n;
        u32x4 o; if (BF) { o.x = pk_b2(sp[0 * 65], sp[1 * 65]); o.y = pk_b2(sp[2 * 65], sp[3 * 65]); o.z = pk_b2(sp[4 * 65], sp[5 * 65]); o.w = pk_b2(sp[6 * 65], sp[7 * 65]); }
        else { o.x = pk_h2(sp[0 * 65] * scl, sp[1 * 65] * scl); o.y = pk_h2(sp[2 * 65] * scl, sp[3 * 65] * scl); o.z = pk_h2(sp[4 * 65] * scl, sp[5 * 65] * scl); o.w = pk_h2(sp[6 * 65] * scl, sp[7 * 65] * scl); }
        *(u32x4*)(WT + (size_t)n * ldt + 8 * c) = o; }
    __builtin_amdgcn_wave_barrier();
}
struct SchedWF {
    const char* BDT; const char* WFIN; int c;
    __device__ __forceinline__ bool next(int i, fg::Unit& u) const {
        if (i != 0 || c >= 16) return false;
        u.aux = c >> 3; u.pm = (c >> 2) & 1; u.pn = c & 3; u.nt = 4;
        u.A = BDT + (size_t)u.pm * 256 * 256 * 2; u.B = WFIN + ((size_t)u.aux * 1024 + u.pn * 256) * 256 * 2; return true;
    }
};
struct EpiWF {
    static constexpr bool PERM = true;
    h16* WinT;
    __device__ __forceinline__ void operator()(const f32x4 (&acc)[2][2][4][2], const fg::Unit& u, int wr, int wc, int fr, int fq) const {
        h16* base = WinT + ((size_t)u.aux * 6144 + 5632 + u.pm * 256 + 64 * wr + fr) * DM + u.pn * 256 + 32 * wc + 8 * fq;
#pragma unroll
        for (int ai = 0; ai < 2; ++ai)
#pragma unroll
            for (int m = 0; m < 4; ++m)
#pragma unroll
                for (int bj = 0; bj < 2; ++bj) { const f32x4 v0 = acc[ai][bj][m][0], v1 = acc[ai][bj][m][1];
                    *(u32x4*)(base + (size_t)(128 * ai + 16 * m) * DM + 128 * bj) = (u32x4){pk_h2(v0[0], v0[1]), pk_h2(v0[2], v0[3]), pk_h2(v1[0], v1[1]), pk_h2(v1[2], v1[3])}; }
    }
};
__device__ __forceinline__ void phase_convert_dense(const Params& p, float* lds, ldsp_t ldsf) {
    { SchedWF S{(const char*)(p.ws + WS_BDT), (const char*)(p.ws + WS_WFIN), bidx()}; EpiWF E{(h16*)(p.ws + WS_WINT)};
      fg::gemm_phase<EpiWF, SchedWF, 256>(ldsf, S, E); }
    __syncthreads();
}
__device__ __forceinline__ void dense_transposes(const Params& p, float* lds) {
    if (bidx() < 192) return;
    __syncthreads();
    const int lane = tidx() & 63, wave = tidx() >> 6, gw = (bidx() - 192) * NWAVES + wave, NGW = (gridDim.x - 192) * NWAVES;
    float* scr = lds + wave * (64 * 65);
    h16* WinT = (h16*)(p.ws + WS_WINT); h16* WbT = (h16*)(p.ws + WS_WBT); h16* WoT = (h16*)(p.ws + WS_WOT);
    constexpr int I_IN = 16 * 88, I_BR = 4 * 4 * 16, I_OUT = 16 * 16, I_L = I_IN + I_BR + I_OUT;
    for (int it = gw; it < 2 * I_L; it += NGW) {
        const int l = it / I_L; int r = it % I_L;
        if (r < I_IN) { const int kb = r / 88, db = r % 88; const int d0 = db * 64; const int sc0 = d0 < 512 ? d0 : d0 + 256;
            transpose_item(p.w_in + ((size_t)l * DM + kb * 64) * INW + sc0, INW, WinT + ((size_t)l * 6144 + d0) * DM + kb * 64, DM, scr, lane, d0 >= 1536 ? -1.4426950408889634f : 1.f); continue; }
        r -= I_IN;
        if (r < I_BR) { const int i = r >> 6, kb = (r >> 4) & 3, nb = r & 15;
            transpose_item(p.w_branch + (((size_t)l * 4 + i) * 256 + kb * 64) * DM + nb * 64, DM, WbT + ((size_t)l * DM + nb * 64) * DM + i * 256 + kb * 64, DM, scr, lane); continue; }
        r -= I_BR;
        { const int kb = r >> 4, nb = r & 15;
            transpose_item(p.w_out + ((size_t)l * DM + kb * 64) * DM + nb * 64, DM, WoT + ((size_t)l * DM + nb * 64) * DM + kb * 64, DM, scr, lane); }
    }
    __syncthreads();
}
__device__ __forceinline__ h16* wgu_of(const Params& p, int l) { return l == 0 ? (h16*)((unsigned char*)p.out + DO_WGU) : (h16*)(p.ws + WS_WGU1); }
__device__ __forceinline__ h16* wd_of(const Params& p, int l) { return (h16*)((unsigned char*)p.out + (l == 0 ? DO_WD : DO_WD1)); }
__device__ __forceinline__ void bg_convert(const Params& p, int l, float* lds, int budget, bool spread = false) {
    const int lane = tidx() & 63, wave = tidx() >> 6;
    float* scr = lds + wave * (64 * 65);
    h16* Wgu = wgu_of(p, l); h16* Wd = wd_of(p, l);
    const int x = spread ? ((bidx() >> 3) + (bidx() & 7)) & 7 : (bidx() & 7);
    unsigned* ctr = (unsigned*)(p.ws + WS_CTL) + 3072 + 64 * (l * 8 + x);
    constexpr int I_GU = 2 * 16 * 16, I_D = 16 * 16, I_E = I_GU + I_D, NIT = 16 * I_E, NPG = NIT / 8, BATCH = 4;
    __syncthreads();
    for (int n = 0; n < budget; ++n) {
        unsigned i0 = 0; if (lane == 0) i0 = __hip_atomic_fetch_add(ctr, (unsigned)BATCH, __ATOMIC_RELAXED, __HIP_MEMORY_SCOPE_AGENT);
        i0 = __builtin_amdgcn_readfirstlane(i0);
        if (i0 >= (unsigned)NPG) break;
        for (int q = 0; q < BATCH; ++q) { const int it = x * NPG + (int)i0 + q;
            const int e = it / I_E; int r = it % I_E;
            if (r < I_GU) { const int h = r >> 8, kb = (r >> 4) & 15, nb = r & 15; const int n0 = nb * 64; const int drow = (n0 >> 7) * 256 + h * 128 + (n0 & 127);
                const float* src = (h ? p.w_up : p.w_gate) + (((size_t)l * NEXP + e) * DM + kb * 64) * FF + n0;
                transpose_item<true>(src, FF, Wgu + ((size_t)e * 2048 + drow) * DM + kb * 64, DM, scr, lane); }
            else { r -= I_GU; const int kb = r >> 4, nb = r & 15;
                transpose_item<true>(p.w_down + (((size_t)l * NEXP + e) * FF + kb * 64) * DM + nb * 64, DM, Wd + ((size_t)e * DM + nb * 64) * FF + kb * 64, FF, scr, lane); } }
    }
    __syncthreads();
}

struct SchedG1 {
    const char* u16; const char* WinT; int l, c, G;
    __device__ __forceinline__ bool next(int i, fg::Unit& u) const {
        const int nsup_full = (l == 0) ? 36 : 32;
        const int L = (i * 8 + (c & 7)) * 32 + (c >> 3); const int s = L >> 5;
        if (s < nsup_full) { u.pm = s * 4 + ((L >> 3) & 3); u.pn = L & 7; }
        else { if (l == 0) return false; const int r = i - 4; if (r != 0 || c >= 48) return false; u.pm = 128 + c / 3; u.pn = 1 + 2 * (c % 3); }
        u.nt = 16; u.aux = 0;
        if (u.pn < 6) { u.A = u16 + (size_t)u.pm * 256 * DM * 2; u.B = WinT + (size_t)u.pn * 256 * DM * 2; }
        else { u.A = WinT + (size_t)(5632 + (u.pn - 6) * 256) * DM * 2; u.B = u16 + (size_t)u.pm * 256 * DM * 2; }
        return true;
    }
};
struct EpiG1 {
    static constexpr bool PERM = true;
    unsigned char* QI; unsigned char* KI; unsigned char* VI; h16* ZTL; h16* ZTC;
    const float* gain; const float* ropeC; const float* ropeS; FG_LAS float* xs; int lastlayer;
    __device__ __forceinline__ void operator()(const f32x4 (&acc)[2][2][4][2], const fg::Unit& u, int wr, int wc, int fr, int fq) const {
        if (u.pn < 6) {
            const int mixer = u.pn >> 1; const bool lat = u.pm < 128; const int b = lat ? (u.pm >> 3) : (u.pm - 128); const int tile0 = lat ? 4 + 4 * (u.pm & 7) : 0;
            const bool isq = (u.pn & 1) == 0; const int half = wc & 1; const int chunk = 4 * half + fq;
            const bool do_rms = (mixer == 0); const bool do_rope = lat && (mixer < 2);
            float rs[2][2][4];
            if (do_rms) {
#pragma unroll
                for (int bj = 0; bj < 2; ++bj)
#pragma unroll
                    for (int ai = 0; ai < 2; ++ai)
#pragma unroll
                        for (int m = 0; m < 4; ++m) { const f32x4 v0 = acc[ai][bj][m][0], v1 = acc[ai][bj][m][1];
                            float ss = (v0[0] * v0[0] + v0[1] * v0[1]) + (v0[2] * v0[2] + v0[3] * v0[3]) + (v1[0] * v1[0] + v1[1] * v1[1]) + (v1[2] * v1[2] + v1[3] * v1[3]);
                            ss = xor16_sum(ss); ss = xor32_sum(ss); rs[bj][ai][m] = ss;
                            if (fq == 0) xs[(half * 256 + 128 * ai + 64 * wr + 16 * m + fr) * 4 + 2 * bj + (wc >> 1)] = ss; }
                asm volatile("s_waitcnt lgkmcnt(0)" ::: "memory"); __builtin_amdgcn_s_barrier(); asm volatile("" ::: "memory");
#pragma unroll
                for (int bj = 0; bj < 2; ++bj)
#pragma unroll
                    for (int ai = 0; ai < 2; ++ai)
#pragma unroll
                        for (int m = 0; m < 4; ++m) { const float so = xs[((half ^ 1) * 256 + 128 * ai + 64 * wr + 16 * m + fr) * 4 + 2 * bj + (wc >> 1)];
                            rs[bj][ai][m] = rsqrtf((rs[bj][ai][m] + so) * (1.f / 64.f) + RMS_EPS); }
            }
            f32x4 g0 = {1.f, 1.f, 1.f, 1.f}, g1 = {1.f, 1.f, 1.f, 1.f};
            if (do_rms) { const float* gp = gain + (isq ? 0 : 64) + chunk * 8; g0 = *(const f32x4*)gp; g1 = *(const f32x4*)(gp + 4); }
            const int j0 = (fq & 1) * 8;
            const bool upper = (fq & 2) != 0;
            auto body = [&](auto HC) {
                constexpr bool H1 = decltype(HC)::value;
#pragma unroll
                for (int mh = 0; mh < 2; ++mh) {
                    f32x4 tc0[2], tc1[2], ts0[2], ts1[2];
                    if (do_rope) {
#pragma unroll
                        for (int k = 0; k < 2; ++k) { const int pos = H1 ? (16 * (2 * mh + k) + fr) : (4 * (u.pm & 7) + 2 * k + wr);
                            tc0[k] = *(const f32x4*)(ropeC + pos * 16 + j0); tc1[k] = *(const f32x4*)(ropeC + pos * 16 + j0 + 4); ts0[k] = *(const f32x4*)(ropeS + pos * 16 + j0); ts1[k] = *(const f32x4*)(ropeS + pos * 16 + j0 + 4); }
                        asm volatile("" ::: "memory"); }
#pragma unroll
                    for (int bj = 0; bj < 2; ++bj) { const int hh = 2 * bj + (wc >> 1);
                        const bool isv = !isq && bj == 1; const bool proc = !isv && (isq || mixer < 2);
                        unsigned char* base; int rstride;
                        if (isq) { base = QI + ((size_t)((mixer * 16 + b) * 4 + hh) * 36 + tile0) * 8192 + chunk * 1024; rstride = 16; }
                        else if (bj == 0) { base = KI + ((size_t)((mixer * 16 + b) * 2 + hh) * 36 + tile0) * 8192 + chunk * 1024; rstride = 16; }
                        else { base = VI + ((size_t)((mixer * 16 + b) * 2 + (hh - 2)) * 36 + tile0) * 8192 + half * 4096 + fq * 16; rstride = 64; }
#pragma unroll
                        for (int ai = 0; ai < 2; ++ai)
#pragma unroll
                            for (int mm = 0; mm < 2; ++mm) { const int m = 2 * mh + mm; f32x4 v0 = acc[ai][bj][m][0], v1 = acc[ai][bj][m][1];
                                if (proc) {
                                    if (do_rms) { const float r_ = rs[bj][ai][m]; v0 = v0 * r_ * g0; v1 = v1 * r_ * g1; }
                                    if (do_rope) { const int k = H1 ? mm : ai;
                                        const f32x4 c0 = tc0[k], c1 = tc1[k], s0 = ts0[k], s1 = ts1[k];
                                        f32x4 p0, p1;
#pragma unroll
                                        for (int e = 0; e < 4; ++e) { const auto r0 = __builtin_amdgcn_permlane32_swap(__float_as_uint(v0[e]), __float_as_uint(v0[e]), false, false); p0[e] = __uint_as_float(upper ? r0[0] : r0[1]);
                                            const auto r1 = __builtin_amdgcn_permlane32_swap(__float_as_uint(v1[e]), __float_as_uint(v1[e]), false, false); p1[e] = __uint_as_float(upper ? r1[0] : r1[1]); }
                                        if (upper) { v0 = p0 * s0 + v0 * c0; v1 = p1 * s1 + v1 * c1; } else { v0 = v0 * c0 - p0 * s0; v1 = v1 * c1 - p1 * s1; } }
                                    if (isq) { v0 = v0 * QSCALE; v1 = v1 * QSCALE; } }
                                *(u32x4*)(base + (size_t)(2 * ai + wr) * 8192 + (16 * m + fr) * rstride) = (u32x4){pk_h2(v0[0], v0[1]), pk_h2(v0[2], v0[3]), pk_h2(v1[0], v1[1]), pk_h2(v1[2], v1[3])}; } }
                }
            };
            if (half) body(std::true_type{}); else body(std::false_type{});
            __builtin_amdgcn_s_waitcnt(0x0F70);
        } else {
            const int R0 = u.pm * 256 + 32 * wc + 8 * fq;
            h16* zb; size_t pitch; int cstride;
            if (R0 < TL) { const int b = R0 >> 11; zb = ZTL + (size_t)b * 256 * 4096 + (R0 & 2047); pitch = 4096; cstride = 2048; }
            else { const int rr = R0 - TL; const int b = rr >> 8; zb = ZTC + (size_t)b * 256 * 512 + (rr & 255); pitch = 512; cstride = 256; }
#pragma unroll
            for (int ai = 0; ai < 2; ++ai)
#pragma unroll
                for (int m = 0; m < 4; ++m) { const int zc = (u.pn - 6) * 256 + 128 * ai + 64 * wr + 16 * m + fr; const int g = zc >> 7, cs = (zc >> 6) & 1, mm = zc & 63;
                    h16* rowp = zb + (size_t)(g * 64 + mm) * pitch + cs * cstride;
#pragma unroll
                    for (int bj = 0; bj < 2; ++bj) { const f32x4 v0 = acc[ai][bj][m][0], v1 = acc[ai][bj][m][1];
                        *(u32x4*)(rowp + 128 * bj) = (u32x4){pk_h2(v0[0], v0[1]), pk_h2(v0[2], v0[3]), pk_h2(v1[0], v1[1]), pk_h2(v1[2], v1[3])}; } }
        }
    }
};
__device__ __forceinline__ void phase_g1_fast(const Params& p, int l, ldsp_t lds) {
    SchedG1 S{(const char*)(p.ws + WS_U16), (const char*)(p.ws + WS_WINT) + (size_t)l * 6144 * DM * 2, l, (int)bidx(), (int)gridDim.x};
    const float* tab = (const float*)(p.ws + WS_TAB);
    EpiG1 E{p.ws + WS_QI, p.ws + WS_KI, p.ws + WS_VI, (h16*)(p.ws + WS_ZTL), (h16*)(p.ws + WS_ZTC), p.qk_gain + l * 128, tab + 4096, tab + 4096 + 1024, (FG_LAS float*)(lds + 131072), l == DEPTH - 1};
    fg::gemm_phase<EpiG1, SchedG1, DM>(lds, S, E);
}

struct SchedOut {
    const char* A; const char* B; int l, c, i0, i1;
    __device__ __forceinline__ bool next(int i, fg::Unit& u) const {
        i += i0; if (i >= i1) return false;
        const int nsup = (l == 0) ? 18 : 16;
        const int L = (i * 8 + (c & 7)) * 32 + (c >> 3); const int s = L >> 5; if (s >= nsup) return false;
        u.pm = s * 8 + ((L >> 2) & 7); u.pn = L & 3; u.nt = 16; u.aux = 0;
        u.A = A + (size_t)u.pm * 256 * DM * 2; u.B = B + (size_t)u.pn * 256 * DM * 2; return true;
    }
};
struct EpiOut {
    static constexpr bool PERM = false;
    const float* x; const float* ctx; float* hB; const float* modv; int l;
    __device__ __forceinline__ void operator()(const f32x4 (&acc)[2][2][4][2], const fg::Unit& u, int wr, int wc, int fr, int fq) const {
        const int mv = u.pm < 128 ? (u.pm >> 3) : 16; const float* g1p = modv + (size_t)mv * NMOD + 2 * DM;
        const int R0 = u.pm * 256 + 64 * wr + fr; const int c0 = u.pn * 256 + 32 * wc + 4 * fq;
        const float* hbase = (l == 0 ? (R0 < TL ? x + (size_t)R0 * DM : ctx + (size_t)(R0 - TL) * DM) : hB + (size_t)R0 * DM) + c0;
        float* obase = hB + (size_t)R0 * DM + c0;
        f32x4 g1[2][2];
#pragma unroll
        for (int bj = 0; bj < 2; ++bj)
#pragma unroll
            for (int n = 0; n < 2; ++n) g1[bj][n] = *(const f32x4*)(g1p + c0 + 128 * bj + 16 * n);
#pragma unroll
        for (int ai = 0; ai < 2; ++ai) {
            f32x4 hv[4][2][2];
#pragma unroll
            for (int m = 0; m < 4; ++m)
#pragma unroll
                for (int bj = 0; bj < 2; ++bj)
#pragma unroll
                    for (int n = 0; n < 2; ++n) hv[m][bj][n] = *(const f32x4*)(hbase + (size_t)(128 * ai + 16 * m) * DM + 128 * bj + 16 * n);
            asm volatile("" ::: "memory");
#pragma unroll
            for (int m = 0; m < 4; ++m)
#pragma unroll
                for (int bj = 0; bj < 2; ++bj)
#pragma unroll
                    for (int n = 0; n < 2; ++n) *(f32x4*)(obase + (size_t)(128 * ai + 16 * m) * DM + 128 * bj + 16 * n) = ALPHA * hv[m][bj][n] + g1[bj][n] * acc[ai][bj][m][n];
            asm volatile("" ::: "memory");
        }
    }
};
__device__ __forceinline__ void phase_out_fast(const Params& p, int l, ldsp_t lds, int i0, int i1) {
    SchedOut S{(const char*)(p.ws + WS_PM), (const char*)(p.ws + WS_WOT) + (size_t)l * DM * DM * 2, l, (int)bidx(), i0, i1};
    EpiOut E{p.x, p.ctx, (float*)(p.ws + WS_HB), (const float*)(p.ws + WS_MODV) + (size_t)l * 17 * NMOD, l};
    fg::gemm_phase<EpiOut, SchedOut, DM>(lds, S, E);
}

__device__ __forceinline__ int expert_of_rtile(int rt) { return rt < 256 ? (rt & 15) : ((rt - 256) >> 1); }
struct SchedUp {
    const char* u16; const char* Wgu; const int* selrow; int l, c;
    __device__ __forceinline__ bool next(int i, fg::Unit& u) const {
        const int nsup = (l == 0) ? 72 : 64;
        const int L = (i * 8 + (c & 7)) * 32 + (c >> 3); const int s = L >> 5; if (s >= nsup) return false;
        const int o = s * 4 + ((L >> 3) & 3); const int rt = o < 256 ? ((o & 15) * 16 + (o >> 4)) : o;
        u.pm = rt; u.pn = L & 7; u.nt = 16; u.aux = expert_of_rtile(rt);
        u.A = u16; u.rows = selrow + rt * 256; u.B = Wgu + ((size_t)u.aux * 2048 + u.pn * 256) * DM * 2; return true;
    }
};
struct EpiUp {
    static constexpr bool PERM = true;
    h16* H;
    __device__ __forceinline__ void operator()(const f32x4 (&acc)[2][2][4][2], const fg::Unit& u, int wr, int wc, int fr, int fq) const {
#pragma unroll
        for (int ai = 0; ai < 2; ++ai)
#pragma unroll
            for (int m = 0; m < 4; ++m) { const int R = u.pm * 256 + 128 * ai + 64 * wr + 16 * m + fr; const int col = u.pn * 128 + 32 * wc + 8 * fq; float o[8];
#pragma unroll
                for (int n = 0; n < 2; ++n)
#pragma unroll
                    for (int j = 0; j < 4; ++j) o[n * 4 + j] = silu_f(acc[ai][0][m][n][j]) * acc[ai][1][m][n][j];
                *(u32x4*)(H + (size_t)R * FF + col) = (u32x4){pk_b2(o[0], o[1]), pk_b2(o[2], o[3]), pk_b2(o[4], o[5]), pk_b2(o[6], o[7])}; }
    }
};
__device__ __forceinline__ void phase_up_fast(const Params& p, int l, ldsp_t lds) {
    SchedUp S{(const char*)(p.ws + WS_U16), (const char*)wgu_of(p, l), (const int*)(p.ws + WS_SELR), l, (int)bidx()};
    EpiUp E{(h16*)(p.ws + WS_H16)};
    fg::gemm_phase<EpiUp, SchedUp, DM, true, true>(lds, S, E);
}
struct SchedDown {
    const char* H; const char* Wd; int l, c;
    __device__ __forceinline__ bool next(int i, fg::Unit& u) const {
        const int nsup = (l == 0) ? 36 : 32;
        const int L = (i * 8 + (c & 7)) * 32 + (c >> 3); const int s = L >> 5; if (s >= nsup) return false;
        const int o = s * 8 + ((L >> 2) & 7); const int rt = o < 256 ? ((o & 15) * 16 + (o >> 4)) : o;
        u.pm = rt; u.pn = L & 3; u.nt = 16; u.aux = expert_of_rtile(rt);
        u.A = H + (size_t)rt * 256 * FF * 2; u.B = Wd + ((size_t)u.aux * DM + u.pn * 256) * FF * 2; return true;
    }
};
struct EpiDown {
    static constexpr bool PERM = true;
    h16* Y; const float* selw;
    __device__ __forceinline__ void operator()(const f32x4 (&acc)[2][2][4][2], const fg::Unit& u, int wr, int wc, int fr, int fq) const {
        const int R0 = u.pm * 256 + 64 * wr + fr;
        float w[2][4];
#pragma unroll
        for (int ai = 0; ai < 2; ++ai)
#pragma unroll
            for (int m = 0; m < 4; ++m) w[ai][m] = selw[R0 + 128 * ai + 16 * m];
        asm volatile("" ::: "memory");
        h16* base = Y + (size_t)R0 * DM + u.pn * 256 + 32 * wc + 8 * fq;
#pragma unroll
        for (int ai = 0; ai < 2; ++ai)
#pragma unroll
            for (int m = 0; m < 4; ++m)
#pragma unroll
                for (int bj = 0; bj < 2; ++bj) { const f32x4 v0 = acc[ai][bj][m][0] * w[ai][m], v1 = acc[ai][bj][m][1] * w[ai][m];
                    *(u32x4*)(base + (size_t)(128 * ai + 16 * m) * DM + 128 * bj) = (u32x4){pk_h2(v0[0], v0[1]), pk_h2(v0[2], v0[3]), pk_h2(v1[0], v1[1]), pk_h2(v1[2], v1[3])}; }
    }
};
__device__ __forceinline__ void phase_down_fast(const Params& p, int l, ldsp_t lds) {
    SchedDown S{(const char*)(p.ws + WS_H16), (const char*)wd_of(p, l), l, (int)bidx()};
    EpiDown E{(h16*)(p.ws + WS_XG), (const float*)(p.ws + WS_SELW)};
    fg::gemm_phase<EpiDown, SchedDown, DM, true>(lds, S, E);
}


struct SchedMerge {
    const char* u16; const char* br; const char* WinT; const char* WbT; int l, c, i0, i1;
    __device__ __forceinline__ bool next(int i, fg::Unit& u) const {
        i += i0; if (i >= i1) return false;
        int ib, sub;
        if (i < 16) { const int ti = i >> 3; sub = i & 7; ib = sub >> 1;
            const int L = (ti * 8 + (c & 7)) * 32 + (c >> 3); const int s = L >> 5;
            u.pm = s * 8 + ((L >> 2) & 7); u.pn = L & 3; u.aux = sub; }
        else { if (l != 0 || i >= 18) return false; const int tct = c >> 2; ib = c & 3; sub = 2 * ib + (i & 1);
            u.pm = 128 + (tct >> 2); u.pn = tct & 3; u.aux = sub | 8; }
        if ((sub & 1) == 0) { u.nt = 16; u.A = u16 + (size_t)u.pm * 256 * DM * 2; u.B = WinT + (size_t)(1536 + ib * 1024 + u.pn * 256) * DM * 2; }
        else { u.nt = 4; u.A = br + (size_t)u.pm * 256 * DM * 2 + ib * 512; u.B = WbT + (size_t)u.pn * 256 * DM * 2 + ib * 512; }
        return true;
    }
};
struct EpiMerge {
    static constexpr bool PERM = true;
    h16* mg; h16* part; unsigned char* scr;
    __device__ __forceinline__ void operator()(const f32x4 (&acc)[2][2][4][2], const fg::Unit& u, int wr, int wc, int fr, int fq) const {
        const int tid = tidx();
        if ((u.aux & 1) == 0) {
#pragma unroll
            for (int ai = 0; ai < 2; ++ai)
#pragma unroll
                for (int m = 0; m < 4; ++m)
#pragma unroll
                    for (int bj = 0; bj < 2; ++bj) { const int q = (ai * 4 + m) * 2 + bj; const f32x4 v0 = acc[ai][bj][m][0], v1 = acc[ai][bj][m][1];
                        *(u32x4*)(scr + ((size_t)q * 512 + tid) * 16) = (u32x4){pk_h2(sig2_f(v0[0]), sig2_f(v0[1])), pk_h2(sig2_f(v0[2]), sig2_f(v0[3])), pk_h2(sig2_f(v1[0]), sig2_f(v1[1])), pk_h2(sig2_f(v1[2]), sig2_f(v1[3]))}; }
        } else {
            const bool partial = (u.aux & 8) != 0; const bool first = partial || ((u.aux & 7) == 1);
            h16* base = partial ? part + ((size_t)((u.aux & 7) >> 1) * TC + (size_t)(u.pm - 128) * 256) * DM : mg + (size_t)u.pm * 256 * DM;
            base += (size_t)(64 * wr + fr) * DM + u.pn * 256 + 32 * wc + 8 * fq;
#pragma unroll
            for (int ai = 0; ai < 2; ++ai) {
                h16x8 gv[8], pr[8];
#pragma unroll
                for (int m = 0; m < 4; ++m)
#pragma unroll
                    for (int bj = 0; bj < 2; ++bj) { const int q = (ai * 4 + m) * 2 + bj; gv[m * 2 + bj] = *(const h16x8*)(scr + ((size_t)q * 512 + tid) * 16);
                        if (!first) pr[m * 2 + bj] = *(const h16x8*)(base + (size_t)(128 * ai + 16 * m) * DM + 128 * bj); }
                asm volatile("" ::: "memory");
#pragma unroll
                for (int m = 0; m < 4; ++m)
#pragma unroll
                    for (int bj = 0; bj < 2; ++bj) { const h16x8 g = gv[m * 2 + bj]; const f32x4 v0 = acc[ai][bj][m][0], v1 = acc[ai][bj][m][1];
                        float o[8] = {(float)g[0] * v0[0], (float)g[1] * v0[1], (float)g[2] * v0[2], (float)g[3] * v0[3], (float)g[4] * v1[0], (float)g[5] * v1[1], (float)g[6] * v1[2], (float)g[7] * v1[3]};
                        if (!first) { const h16x8 pp = pr[m * 2 + bj];
#pragma unroll
                            for (int e = 0; e < 8; ++e) o[e] += (float)pp[e]; }
                        *(u32x4*)(base + (size_t)(128 * ai + 16 * m) * DM + 128 * bj) = (u32x4){pk_h2(o[0], o[1]), pk_h2(o[2], o[3]), pk_h2(o[4], o[5]), pk_h2(o[6], o[7])}; }
                asm volatile("" ::: "memory");
            }
        }
    }
};
__device__ __forceinline__ void phase_merge_fast(const Params& p, int l, ldsp_t lds, int i0, int i1) {
    SchedMerge S{(const char*)(p.ws + WS_U16), (const char*)(p.ws + WS_BR), (const char*)(p.ws + WS_WINT) + (size_t)l * 6144 * DM * 2, (const char*)(p.ws + WS_WBT) + (size_t)l * DM * DM * 2, l, bidx(), i0, i1};
    EpiMerge E{(h16*)(p.ws + WS_PM), (h16*)(p.ws + WS_MPART), (l == 0 ? p.ws + WS_WGU1 : (unsigned char*)p.out + DO_WGU) + (size_t)bidx() * 131072};
    fg::gemm_phase<EpiMerge, SchedMerge, DM>(lds, S, E);
}
__device__ __forceinline__ void phase_merge_sum(const Params& p) {
    const h16* part = (const h16*)(p.ws + WS_MPART); h16* mg = (h16*)(p.ws + WS_PM) + (size_t)TL * DM;
    const int gt = bidx() * NTHREADS + tidx(), NG = gridDim.x * NTHREADS;
    for (int o = gt; o < TC * DM / 8; o += NG) { float acc[8];
#pragma unroll
        for (int e = 0; e < 8; ++e) acc[e] = 0.f;
#pragma unroll
        for (int i = 0; i < 4; ++i) { const h16x8 v = *(const h16x8*)(part + (size_t)i * TC * DM + (size_t)o * 8);
#pragma unroll
            for (int e = 0; e < 8; ++e) acc[e] += (float)v[e]; }
        *(u32x4*)(mg + (size_t)o * 8) = (u32x4){pk_h2(acc[0], acc[1]), pk_h2(acc[2], acc[3]), pk_h2(acc[4], acc[5]), pk_h2(acc[6], acc[7])}; }
}

struct EpiDft {
    static constexpr bool PERM = true;
    h16* br; int row0, rows_per_b; float scl;
    __device__ __forceinline__ void operator()(const f32x4 (&acc)[2][2][4][2], const fg::Unit& u, int wr, int wc, int fr, int fq) const {
#pragma unroll
        for (int ai = 0; ai < 2; ++ai)
#pragma unroll
            for (int m = 0; m < 4; ++m) { const int kr = u.pm * 256 + 128 * ai + 64 * wr + 16 * m + fr; const size_t R = (size_t)row0 + (size_t)u.pn * rows_per_b + kr;
#pragma unroll
                for (int bj = 0; bj < 2; ++bj) { const int col = 128 * bj + 32 * wc + 8 * fq; const f32x4 v0 = acc[ai][bj][m][0] * scl, v1 = acc[ai][bj][m][1] * scl;
                    *(u32x4*)(br + R * DM + 256 + col) = (u32x4){pk_h2(v0[0], v0[1]), pk_h2(v0[2], v0[3]), pk_h2(v1[0], v1[1]), pk_h2(v1[2], v1[3])}; } }
    }
};

namespace fa {
typedef float f32x16 __attribute__((ext_vector_type(16)));
typedef short v4i16_t __attribute__((ext_vector_type(4)));
typedef short s16x4 __attribute__((ext_vector_type(4)));
constexpr float LOG2E = 1.4426950408889634f;
constexpr int NSLOT = 3, SLOTB = 8192;
constexpr int LDS_K = 0, LDS_V = NSLOT * SLOTB, LDS_WS = 2 * NSLOT * SLOTB, LDS_OST = LDS_WS + 8 * 64 * 4, LDS_RPB = LDS_OST + 8 * 4096;
__device__ __forceinline__ int crow(int r, int hi) { return (r & 3) + 8 * (r >> 2) + 4 * hi; }
#define SBAR() __builtin_amdgcn_sched_barrier(0)
__device__ __forceinline__ void glds16(const void* gsrc, unsigned lds_dst) { unsigned keep;
    asm volatile("s_mov_b32 %0, m0\n\ts_mov_b32 m0, %2\n\ts_nop 0\n\tglobal_load_lds_dwordx4 %1, off\n\ts_mov_b32 m0, %0" : "=&s"(keep) : "v"(gsrc), "s"(lds_dst) : "memory"); }
__device__ __forceinline__ float max3f(float a, float b, float c) { float r; asm("v_max3_f32 %0, %1, %2, %3" : "=v"(r) : "v"(a), "v"(b), "v"(c)); return r; }
__device__ __forceinline__ float max2f(float a, float b) { float r; asm("v_max_f32_e32 %0, %1, %2" : "=v"(r) : "v"(a), "v"(b)); return r; }
__device__ __forceinline__ float fadd_s(float a, float b) { float r; asm("v_add_f32_e32 %0, %1, %2" : "=v"(r) : "v"(a), "v"(b)); return r; }
__device__ __forceinline__ float fsub_s(float a, float b) { float r; asm("v_sub_f32_e32 %0, %1, %2" : "=v"(r) : "v"(a), "v"(b)); return r; }
#define WAIT_BAR(N) asm volatile("s_waitcnt vmcnt(" #N ") lgkmcnt(0)\n\ts_barrier" ::: "memory")
typedef __attribute__((address_space(3))) const char* lds_cptr;
__device__ __forceinline__ void kload8(h16x8* kf, lds_cptr kp) {
    kf[0] = *(const FG_LAS h16x8*)(kp);        kf[1] = *(const FG_LAS h16x8*)(kp + 512);
    kf[2] = *(const FG_LAS h16x8*)(kp + 2048); kf[3] = *(const FG_LAS h16x8*)(kp + 2560);
    kf[4] = *(const FG_LAS h16x8*)(kp + 4096); kf[5] = *(const FG_LAS h16x8*)(kp + 4608);
    kf[6] = *(const FG_LAS h16x8*)(kp + 6144); kf[7] = *(const FG_LAS h16x8*)(kp + 6656);
}
__device__ __forceinline__ void kload2(h16x8* kf, lds_cptr kp, int j) { kf[2 * j] = *(const FG_LAS h16x8*)(kp + j * 2048); kf[2 * j + 1] = *(const FG_LAS h16x8*)(kp + j * 2048 + 512); }
__device__ __forceinline__ s16x4 vtr(lds_cptr p) { return __builtin_bit_cast(s16x4, __builtin_amdgcn_ds_read_tr16_b64_v4i16((FG_LAS v4i16_t*)p)); }
__device__ __forceinline__ void qkt(f32x16& p0, f32x16& p1, lds_cptr Kslot, const h16x8* qr, const f32x16& negm, int r32, int hi) {
    lds_cptr kb = Kslot + hi * 1024 + r32 * 16;
#pragma unroll
    for (int d0 = 0; d0 < 4; ++d0) {
        const h16x8 b0 = *(const FG_LAS h16x8*)(kb + d0 * 2048), b1 = *(const FG_LAS h16x8*)(kb + d0 * 2048 + 512);
        if (d0 == 0) { p0 = __builtin_amdgcn_mfma_f32_32x32x16_f16(b0, qr[0], negm, 0, 0, 0); p1 = __builtin_amdgcn_mfma_f32_32x32x16_f16(b1, qr[0], negm, 0, 0, 0); }
        else { p0 = __builtin_amdgcn_mfma_f32_32x32x16_f16(b0, qr[d0], p0, 0, 0, 0); p1 = __builtin_amdgcn_mfma_f32_32x32x16_f16(b1, qr[d0], p1, 0, 0, 0); } }
}
__device__ __forceinline__ float rowmax(const f32x16& p0, const f32x16& p1) {
    float a = max3f(p0[0], p0[1], p1[0]), b = max3f(p0[2], p0[3], p1[1]); a = max3f(a, p1[2], p1[3]);
#pragma unroll
    for (int r = 4; r < 16; r += 4) { a = max3f(a, p0[r], p0[r + 1]); b = max3f(b, p0[r + 2], p0[r + 3]); a = max3f(a, p1[r], p1[r + 1]); b = max3f(b, p1[r + 2], p1[r + 3]); }
    const float m = max2f(a, b);
    auto rr = __builtin_amdgcn_permlane32_swap(__float_as_uint(m), __float_as_uint(m), false, false);
    return max2f(__uint_as_float(rr[0]), __uint_as_float(rr[1]));
}
__device__ __forceinline__ void pv(f32x16* o, lds_cptr vb, h16x8 pa0, h16x8 pa1, h16x8 pa2, h16x8 pa3) {
    typedef short s8 __attribute__((ext_vector_type(8)));
#pragma unroll
    for (int d0 = 0; d0 < 2; ++d0) { s16x4 lo[4], hh[4];
#pragma unroll
        for (int ks = 0; ks < 4; ++ks) { lo[ks] = vtr(vb + d0 * 4096 + ks * 1024); hh[ks] = vtr(vb + d0 * 4096 + ks * 1024 + 512); }
#define PKV(k) __builtin_bit_cast(h16x8, (s8){lo[k][0], lo[k][1], lo[k][2], lo[k][3], hh[k][0], hh[k][1], hh[k][2], hh[k][3]})
        o[d0] = __builtin_amdgcn_mfma_f32_32x32x16_f16(pa0, PKV(0), o[d0], 0, 0, 0);
        o[d0] = __builtin_amdgcn_mfma_f32_32x32x16_f16(pa1, PKV(1), o[d0], 0, 0, 0);
        o[d0] = __builtin_amdgcn_mfma_f32_32x32x16_f16(pa2, PKV(2), o[d0], 0, 0, 0);
        o[d0] = __builtin_amdgcn_mfma_f32_32x32x16_f16(pa3, PKV(3), o[d0], 0, 0, 0);
#undef PKV
    }
}
template <int MIXER, int THRL>
__device__ __forceinline__ void attn_unit(const unsigned char* QI, const unsigned char* KI, const unsigned char* VI, h16* br, const float* sinkp, const float* rpb, int mixer, int b, int kvh, int qb, bool isctx, ldsp_t lds, unsigned* qctr, volatile FG_LAS unsigned* qw) {
    const int tid = tidx(), lane = tid & 63, wid = __builtin_amdgcn_readfirstlane(tid >> 6), r32 = lane & 31, hi = lane >> 5, g = wid >> 2, qsub = wid & 3, hq = kvh * 2 + g;
    const int brcol = (mixer == 0 ? 0 : mixer == 1 ? 512 : 768) + hq * 64;
    const int q0 = (isctx ? TL + b * 256 + qb * 128 : b * 2048 + qb * 128) + qsub * 32;
    int jlo = 0, nlat = 0;
    if (!isctx) {
        if (MIXER == 0) { jlo = 0; nlat = 32; }
        else if (MIXER == 1) { jlo = max(0, 2 * qb - 2); nlat = min(31, 2 * qb + 3) - jlo + 1; }
        else { jlo = min(max(2 * qb - 4, 0), 24); nlat = min(max(2 * qb - 3, 0), 24) + 7 - jlo + 1; }
    }
    const int nreal = 4 + nlat; const int NT = (nreal + 1) & ~1;
#define FA_TILE(s) ((s) < 4 ? (s) : 4 + jlo + min((s), nreal - 1) - 4)
    const unsigned lds0 = (unsigned)(size_t)lds;
    FG_LAS float* wsf = (FG_LAS float*)(lds + LDS_WS) + wid * 64;
    const unsigned char* ksrc = KI + ((size_t)((mixer * 16 + b) * 2 + kvh) * 36) * 8192 + wid * 1024 + lane * 16;
    const unsigned char* vsrc = VI + ((size_t)((mixer * 16 + b) * 2 + kvh) * 36) * 8192 + wid * 1024 + lane * 16;
    const unsigned kdst = lds0 + LDS_K + wid * 1024, vdst = lds0 + LDS_V + wid * 1024;
#define DMA_K(t, slot) glds16(ksrc + (size_t)FA_TILE(t) * 8192, (unsigned)__builtin_amdgcn_readfirstlane(kdst + (slot)))
#define DMA_V(t, slot) glds16(vsrc + (size_t)FA_TILE(t) * 8192, (unsigned)__builtin_amdgcn_readfirstlane(vdst + (slot)))
    h16x8 kf[8];
    const lds_cptr shm3 = (lds_cptr)lds; const lds_cptr kp0 = shm3 + LDS_K + hi * 1024 + r32 * 16;
    const lds_cptr vp0 = shm3 + LDS_V + ((lane >> 4) & 1) * 32 + (lane & 3) * 8 + (4 * hi + ((lane & 15) >> 2)) * 64;
    DMA_K(0, 0); DMA_V(0, 0); DMA_K(1, SLOTB);
    if (MIXER == 2) { FG_LAS float* tb = (FG_LAS float*)(lds + LDS_RPB); for (int i = tid; i < 930; i += NTHREADS) tb[i] = rpb[(size_t)(kvh * 2) * 465 + i] * LOG2E; }
    h16x8 qr[4];
    { const int qtile = (isctx ? 0 : 4) + 2 * qb + (qsub >> 1);
      const unsigned char* qp = QI + (((size_t)((mixer * 16 + b) * 4 + hq) * 36) + qtile) * 8192 + hi * 1024 + ((qsub & 1) * 32 + r32) * 16;
#pragma unroll
      for (int d0 = 0; d0 < 4; ++d0) qr[d0] = *(const h16x8*)(qp + d0 * 2048); }
    float mhat = 0.f, l_reg = 0.f; f32x16 o[2]; o[0] = f32x16{}; o[1] = f32x16{}; f32x16 negm = f32x16{}; asm volatile("" : "+v"(negm));
    const int tq = qb * 128 + qsub * 32 + r32;
    const int qrow = 2 * qb + (qsub >> 1);
    const int qcl = tq & 63; const int r0w = min(max(qrow - 4, 0), 24), c0q = min(max(qcl - 8, 0), 48);
#define CMASK(P0, P1, s) do { if (MIXER != 0 && (s) >= 4) { const float NEGI = -INFINITY; const int j_ = jlo + (s) - 4; \
        if ((s) >= nreal) { _Pragma("unroll") for (int r = 0; r < 16; ++r) { P0[r] = NEGI; P1[r] = NEGI; } } \
        else if (MIXER == 1) { const int dt = tq - 64 * j_; \
            _Pragma("unroll") for (int r = 0; r < 16; ++r) { const int kk = crow(r, hi); P0[r] = ((unsigned)(kk - dt + 128) <= 256u) ? P0[r] : NEGI; P1[r] = ((unsigned)(kk + 32 - dt + 128) <= 256u) ? P1[r] : NEGI; } } \
        else { const bool rowok = (j_ >= r0w) && (j_ <= r0w + 7); const int jr_ = rowok ? j_ : r0w; \
            const FG_LAS float* tb = (const FG_LAS float*)(lds + LDS_RPB) + g * 465 + (jr_ - qrow + 7) * 31 + (15 - qcl); \
            _Pragma("unroll") for (int r = 0; r < 16; ++r) { const int kc = crow(r, hi); \
                { const bool ok = rowok && ((unsigned)(kc - c0q) < 16u); const float bv = tb[ok ? kc : qcl]; P0[r] = ok ? P0[r] + bv : NEGI; } \
                { const int kc1 = kc + 32; const bool ok = rowok && ((unsigned)(kc1 - c0q) < 16u); const float bv = tb[ok ? kc1 : qcl]; P1[r] = ok ? P1[r] + bv : NEGI; } } } } } while (0)
    bool resc = false;
#define START(P0, P1) do { const float rm = rowmax(P0, P1); resc = false; \
    { const float dl = rm; mhat = fadd_s(mhat, dl); \
      _Pragma("unroll") for (int r = 0; r < 16; ++r) { P0[r] = fsub_s(P0[r], dl); P1[r] = fsub_s(P1[r], dl); } \
      _Pragma("unroll") for (int r = 0; r < 16; ++r) negm[r] = -mhat; asm volatile("" : "+v"(negm)); } \
    _Pragma("unroll") for (int r = 0; r < 16; ++r) P0[r] = __builtin_amdgcn_exp2f(P0[r]); } while (0)
#define RESC() do { if (resc) { asm volatile("s_waitcnt lgkmcnt(0)" ::: "memory"); \
      _Pragma("unroll") for (int d_ = 0; d_ < 2; ++d_) _Pragma("unroll") for (int r = 0; r < 16; ++r) o[d_][r] *= wsf[crow(r, hi)]; } } while (0)
    f32x16 pA0, pA1, pB0, pB1;
    int sl_prev = 0, sl_cur = 0, sl_next = SLOTB;
#define ROT() do { sl_prev = sl_cur; sl_cur = sl_next; sl_next = (sl_next == (NSLOT - 1) * SLOTB) ? 0 : sl_next + SLOTB; } while (0)
    DMA_K(2, 2 * SLOTB);
    WAIT_BAR(3);
    qkt(pA0, pA1, shm3 + LDS_K, qr, negm, r32, hi); asm volatile("s_nop 15\n\ts_nop 7" : "+v"(pA0), "+v"(pA1));
    START(pA0, pA1);
#pragma unroll
    for (int r = 0; r < 16; ++r) pA1[r] = __builtin_amdgcn_exp2f(pA1[r]);
    WAIT_BAR(0);
    DMA_K(3, 0); DMA_V(1, SLOTB);
    ROT();
    kload8(kf, kp0 + sl_cur);
    WAIT_BAR(2);
    s16x4 vlo[8], vhi[8]; u32x4 pw0, pw1, pw2, pw3;
    typedef short s8v __attribute__((ext_vector_type(8)));
#define PKW(P, B) pk_h2(P[B], P[B + 1])
#define PAF(k) __builtin_bit_cast(h16x8, pw##k)
#define VFR(i) __builtin_bit_cast(h16x8, (s8v){vlo[i][0], vlo[i][1], vlo[i][2], vlo[i][3], vhi[i][0], vhi[i][1], vhi[i][2], vhi[i][3]})
#define PIN(x) asm volatile("" : "+v"(x))
#define MX3(a, b, c) __builtin_fmaxf(__builtin_fmaxf((a), (b)), (c))
#define GAPA(MF, A0, A1, A2, A3, W0, W1, PW) do { MF; sacc += A0; sacc += A1; sacc += A2; sacc += A3; PIN(sacc); W0; W1; PIN(PW); SBAR(); } while (0)
#define EX(v) __builtin_amdgcn_exp2f(v)
#define GAPB(MF, X, B) do { MF; X[B] = EX(X[B]); X[B + 1] = EX(X[B + 1]); X[B + 2] = EX(X[B + 2]); X[B + 3] = EX(X[B + 3]); PIN(X); SBAR(); } while (0)
#define VRD(i) do { vlo[i] = vtr(vp_ + (((i) >> 2) * 4096 + ((i) & 3) * 1024)); vhi[i] = vtr(vp_ + (((i) >> 2) * 4096 + ((i) & 3) * 1024 + 512)); } while (0)
#define KRD(G, j) do { if (G) { kload2(kf, kp0 + sl_next, j); SBAR(); } } while (0)
#define MF32(a, b, c) __builtin_amdgcn_mfma_f32_32x32x16_f16(a, b, c, 0, 0, 0)
#define STEP(C0, C1, P0, P1, t, GK, GV, GL) do { SBAR(); \
    const lds_cptr vp_ = vp0 + sl_prev; \
    VRD(0); SBAR(); float sacc = (P0[0] + P0[1]); \
    GAPA(C0 = MF32(kf[0], qr[0], negm), P0[2], P0[3], P0[4], P0[5],     pw0[0] = PKW(P0, 0), pw0[1] = PKW(P0, 2), pw0); \
    VRD(4); SBAR(); GAPA(C1 = MF32(kf[1], qr[0], negm), P0[6], P0[7], P0[8], P0[9],     pw0[2] = PKW(P0, 4), pw0[3] = PKW(P0, 6), pw0); \
    VRD(1); SBAR(); GAPA(C0 = MF32(kf[2], qr[1], C0),   P0[10], P0[11], P0[12], P0[13], pw1[0] = PKW(P0, 8), pw1[1] = PKW(P0, 10), pw1); \
    VRD(5); SBAR(); GAPA(C1 = MF32(kf[3], qr[1], C1),   P0[14], P0[15], P1[0], P1[1],   pw1[2] = PKW(P0, 12), pw1[3] = PKW(P0, 14), pw1); \
    VRD(2); SBAR(); GAPA(C0 = MF32(kf[4], qr[2], C0),   P1[2], P1[3], P1[4], P1[5],     pw2[0] = PKW(P1, 0), pw2[1] = PKW(P1, 2), pw2); \
    VRD(6); SBAR(); GAPA(C1 = MF32(kf[5], qr[2], C1),   P1[6], P1[7], P1[8], P1[9],     pw2[2] = PKW(P1, 4), pw2[3] = PKW(P1, 6), pw2); \
    VRD(3); SBAR(); GAPA(C0 = MF32(kf[6], qr[3], C0),   P1[10], P1[11], P1[12], P1[13], pw3[0] = PKW(P1, 8), pw3[1] = PKW(P1, 10), pw3); \
    VRD(7); SBAR(); GAPA(C1 = MF32(kf[7], qr[3], C1),   P1[14], P1[15], 0.f, 0.f,       pw3[2] = PKW(P1, 12), pw3[3] = PKW(P1, 14), pw3); \
    l_reg += sacc; \
    if (GK) { DMA_K((t) + 3, sl_cur); } if (GV) { DMA_V((t) + 1, sl_next); } \
    CMASK(C0, C1, t); \
    { float a = MX3(C0[0], C0[1], C1[0]), b_ = MX3(C0[2], C0[3], C1[1]); a = MX3(a, C1[2], C1[3]); \
      _Pragma("unroll") for (int r = 4; r < 16; r += 4) { a = MX3(a, C0[r], C0[r + 1]); b_ = MX3(b_, C0[r + 2], C0[r + 3]); a = MX3(a, C1[r], C1[r + 1]); b_ = MX3(b_, C1[r + 2], C1[r + 3]); } \
      float rm = __builtin_fmaxf(a, b_); { auto rr = __builtin_amdgcn_permlane32_swap(__float_as_uint(rm), __float_as_uint(rm), false, false); rm = __builtin_fmaxf(__uint_as_float(rr[0]), __uint_as_float(rr[1])); } \
      resc = false; \
      if (__builtin_expect(__any(rm > (float)THRL), 0)) { const float dl = __builtin_fmaxf(rm, 0.f); mhat += dl; \
        _Pragma("unroll") for (int r = 0; r < 16; ++r) { C0[r] -= dl; C1[r] -= dl; } \
        _Pragma("unroll") for (int r = 0; r < 16; ++r) negm[r] = -mhat; asm volatile("" : "+v"(negm)); \
        const float f = __builtin_amdgcn_exp2f(-dl); l_reg *= f; if (hi == 0) wsf[r32] = f; resc = true; } } \
    SBAR(); \
    GAPB(o[0] = MF32(PAF(0), VFR(0), o[0]), C0, 0); \
    GAPB(o[1] = MF32(PAF(0), VFR(4), o[1]), C0, 4); \
    KRD(GL, 0); GAPB(o[0] = MF32(PAF(1), VFR(1), o[0]), C0, 8); \
    KRD(GL, 1); GAPB(o[1] = MF32(PAF(1), VFR(5), o[1]), C0, 12); \
    KRD(GL, 2); GAPB(o[0] = MF32(PAF(2), VFR(2), o[0]), C1, 0); \
    KRD(GL, 3); GAPB(o[1] = MF32(PAF(2), VFR(6), o[1]), C1, 4); \
    GAPB(o[0] = MF32(PAF(3), VFR(3), o[0]), C1, 8); \
    GAPB(o[1] = MF32(PAF(3), VFR(7), o[1]), C1, 12); \
    } while (0)
    int t = 1;
    for (; t + 5 < NT; t += 2) {
        STEP(pB0, pB1, pA0, pA1, t, true, true, true);     WAIT_BAR(2); RESC(); ROT();
        STEP(pA0, pA1, pB0, pB1, t + 1, true, true, true); WAIT_BAR(2); RESC(); ROT();
    }
#define ENDW(tt) do { if ((tt) + 3 < NT) { WAIT_BAR(2); } else if ((tt) + 2 < NT) { WAIT_BAR(1); } else { WAIT_BAR(0); } } while (0)
    for (; t + 1 < NT; t += 2) {
        STEP(pB0, pB1, pA0, pA1, t, (t + 3 < NT), (t + 1 < NT), (t + 1 < NT));         ENDW(t);     RESC(); ROT();
        STEP(pA0, pA1, pB0, pB1, t + 1, (t + 4 < NT), (t + 2 < NT), (t + 2 < NT));     ENDW(t + 1); RESC(); ROT();
    }
    STEP(pB0, pB1, pA0, pA1, NT - 1, false, false, false); RESC();
    unsigned nraw = 0u; if (tid == 0) nraw = __hip_atomic_fetch_add(qctr, 1u, __ATOMIC_RELAXED, __HIP_MEMORY_SCOPE_AGENT);
    { float sacc = pB0[0] + pB0[1];
#pragma unroll
      for (int r = 2; r < 16; ++r) sacc += pB0[r];
#pragma unroll
      for (int r = 0; r < 16; ++r) sacc += pB1[r];
      l_reg += sacc;
      pw0 = (u32x4){PKW(pB0, 0), PKW(pB0, 2), PKW(pB0, 4), PKW(pB0, 6)}; pw1 = (u32x4){PKW(pB0, 8), PKW(pB0, 10), PKW(pB0, 12), PKW(pB0, 14)};
      pw2 = (u32x4){PKW(pB1, 0), PKW(pB1, 2), PKW(pB1, 4), PKW(pB1, 6)}; pw3 = (u32x4){PKW(pB1, 8), PKW(pB1, 10), PKW(pB1, 12), PKW(pB1, 14)};
      SBAR(); pv(o, vp0 + sl_cur, PAF(0), PAF(1), PAF(2), PAF(3)); }
    { auto rr = __builtin_amdgcn_permlane32_swap(__float_as_uint(l_reg), __float_as_uint(l_reg), false, false); l_reg = __uint_as_float(rr[0]) + __uint_as_float(rr[1]); }
    if (mixer == 1) l_reg += __builtin_amdgcn_exp2f(sinkp[hq] * LOG2E - mhat);
    if (hi == 0) wsf[32 + r32] = l_reg; asm volatile("s_waitcnt lgkmcnt(0)" ::: "memory");
    float rli[16];
#pragma unroll
    for (int r = 0; r < 16; ++r) rli[r] = __builtin_amdgcn_rcpf(wsf[32 + crow(r, hi)]);
    h16* Ow = br + (size_t)q0 * DM + brcol;
    { FG_LAS h16* stg = (FG_LAS h16*)(lds + LDS_OST) + wid * 2048;
#pragma unroll
      for (int r = 0; r < 16; ++r) { const int orow = crow(r, hi);
#pragma unroll
          for (int d0 = 0; d0 < 2; ++d0) stg[orow * 64 + d0 * 32 + r32] = (h16)(o[d0][r] * rli[r]); }
      asm volatile("s_waitcnt lgkmcnt(0)" ::: "memory");
#pragma unroll
      for (int i = 0; i < 4; ++i) { const int row = i * 8 + (lane >> 3), ch = lane & 7; const u32x4 v = *(const FG_LAS u32x4*)(stg + row * 64 + ch * 8); *(u32x4*)(Ow + (size_t)row * DM + ch * 8) = v; } }
    if (tid == 0) qw[0] = nraw;
    asm volatile("s_waitcnt lgkmcnt(0)\n\ts_barrier" ::: "memory");
#undef FA_TILE
#undef DMA_K
#undef DMA_V
#undef CMASK
#undef START
#undef RESC
#undef ROT
#undef PKW
#undef PAF
#undef VFR
#undef PIN
#undef MX3
#undef GAPA
#undef GAPB
#undef EX
#undef VRD
#undef KRD
#undef MF32
#undef STEP
#undef ENDW
}
#undef SBAR
#undef WAIT_BAR
}
struct SchedTwo { fg::Unit u0, u1; __device__ __forceinline__ bool next(int i, fg::Unit& o) const { if (i == 0) { o = u0; return true; } if (i == 1) { o = u1; return true; } return false; } };
struct EpiDftSym {
    static constexpr bool PERM = true;
    h16* br; unsigned char* scr;
    __device__ __forceinline__ void operator()(const f32x4 (&acc)[2][2][4][2], const fg::Unit& u, int wr, int wc, int fr, int fq) const {
        const int tid = tidx(); const float scl = 0.022097086912079608f;
        if (u.aux == 0) {
#pragma unroll
            for (int ai = 0; ai < 2; ++ai)
#pragma unroll
                for (int m = 0; m < 4; ++m)
#pragma unroll
                    for (int bj = 0; bj < 2; ++bj)
#pragma unroll
                        for (int n = 0; n < 2; ++n) { const int q = ((ai * 4 + m) * 2 + bj) * 2 + n; *(f32x4*)(scr + ((size_t)q * 512 + tid) * 16) = acc[ai][bj][m][n]; }
        } else {
#pragma unroll
            for (int ai = 0; ai < 2; ++ai) {
                f32x4 pv[4][2][2];
#pragma unroll
                for (int m = 0; m < 4; ++m)
#pragma unroll
                    for (int bj = 0; bj < 2; ++bj)
#pragma unroll
                        for (int n = 0; n < 2; ++n) { const int q = ((ai * 4 + m) * 2 + bj) * 2 + n; pv[m][bj][n] = *(const f32x4*)(scr + ((size_t)q * 512 + tid) * 16); }
                asm volatile("" ::: "memory");
#pragma unroll
                for (int m = 0; m < 4; ++m) { const int k = u.pm * 256 + 128 * ai + 64 * wr + 16 * m + fr + 1;
                    h16* lo = br + ((size_t)u.pn * 2048 + k) * DM + 256; h16* hi = br + ((size_t)u.pn * 2048 + (2048 - k)) * DM + 256;
#pragma unroll
                    for (int bj = 0; bj < 2; ++bj) { const int col = 128 * bj + 32 * wc + 8 * fq;
                        const f32x4 p0 = pv[m][bj][0], p1 = pv[m][bj][1];
                        const f32x4 q0v = acc[ai][bj][m][0], q1v = acc[ai][bj][m][1];
                        const f32x4 a0 = (p0 - q0v) * scl, a1 = (p1 - q1v) * scl, b0 = (p0 + q0v) * scl, b1 = (p1 + q1v) * scl;
                        *(u32x4*)(lo + col) = (u32x4){pk_h2(a0[0], a0[1]), pk_h2(a0[2], a0[3]), pk_h2(a1[0], a1[1]), pk_h2(a1[2], a1[3])};
                        *(u32x4*)(hi + col) = (u32x4){pk_h2(b0[0], b0[1]), pk_h2(b0[2], b0[3]), pk_h2(b1[0], b1[1]), pk_h2(b1[2], b1[3])}; } }
                asm volatile("" ::: "memory");
            }
        }
    }
};
struct SchedOne { fg::Unit u; __device__ __forceinline__ bool next(int i, fg::Unit& o) const { if (i != 0) return false; o = u; return true; } };
__device__ __forceinline__ void phase_mixers(const Params& p, int l, ldsp_t lds, int rep = 0) {
    const unsigned char* QI = p.ws + WS_QI; const unsigned char* KI = p.ws + WS_KI; const unsigned char* VI = p.ws + WS_VI; h16* br = (h16*)(p.ws + WS_BR);
    const float* sinkp = p.sink + l * 4; const float* rpb = p.rpb + (size_t)l * 4 * 465;
    const int x = bidx() & 7;
    unsigned* qctr = (unsigned*)(p.ws + WS_CTL) + 64 * (rep * 16 + l * 8 + x) + 32;
    volatile FG_LAS unsigned* qw = (volatile FG_LAS unsigned*)(lds + LDS_BYTES - 512);
    const int nq = (l == 0) ? 226 : 200;
    const int tid = tidx();
    if (rep == 0) fourier_row0(p);
    __syncthreads();
    bool have = false;
    for (;;) {
        if (!have && tid == 0) qw[0] = __hip_atomic_fetch_add(qctr, 1u, __ATOMIC_RELAXED, __HIP_MEMORY_SCOPE_AGENT);
        __syncthreads();
        int idx = (int)qw[0];
        have = false;
        if (idx >= nq) break;
        if (l == 0 && idx >= 72) idx = idx < 74 ? idx + 152 : idx - 2;
        if (rep > 0) { const bool isdft = idx < 8 || idx >= 224; if ((PROBE_MODE == 1 && isdft) || (PROBE_MODE == 2 && !isdft)) continue; }
        if (idx < 8) {
            const int id = idx;
            SchedTwo S; S.u0.pm = id & 3; S.u0.pn = 2 * x + (id >> 2); S.u0.nt = 32; S.u0.aux = 0;
            S.u0.A = (const char*)(p.ws + WS_DFT) + (size_t)S.u0.pm * 256 * 4096 * 2; S.u0.B = (const char*)(p.ws + WS_ZTL) + (size_t)S.u0.pn * 256 * 4096 * 2;
            S.u1 = S.u0; S.u1.aux = 1; S.u1.A += 4096; S.u1.B += 4096;
            EpiDftSym E{br, p.ws + WS_GSCR + (size_t)bidx() * 262144};
            fg::gemm_phase<EpiDftSym, SchedTwo, 4096>(lds, S, E);
        } else if (idx < 200) {
            const int w = (idx - 8) & 63; const int ty = (idx - 8) >> 6;
            if (ty == 0) { fa::attn_unit<0, 8>(QI, KI, VI, br, sinkp, rpb, 0, 2 * x + (w >> 5), (w >> 4) & 1, w & 15, false, lds, qctr, qw); }
            else if (ty == 1) { fa::attn_unit<2, 8>(QI, KI, VI, br, sinkp, rpb, 2, 2 * x + (w >> 5), (w >> 4) & 1, w & 15, false, lds, qctr, qw); }
            else { fa::attn_unit<1, 8>(QI, KI, VI, br, sinkp, rpb, 1, 2 * x + (w >> 5), (w >> 4) & 1, w & 15, false, lds, qctr, qw); }
            have = true;
        } else if (idx < 224) {
            const int w = idx - 200; const int mixer = w >> 3, rest = w & 7;
            fa::attn_unit<0, 8>(QI, KI, VI, br, sinkp, rpb, mixer, 2 * x + (rest >> 2), (rest >> 1) & 1, rest & 1, true, lds, qctr, qw); have = true;
        } else {
            SchedOne S; S.u.pm = 0; S.u.pn = 2 * x + (idx - 224); S.u.nt = 8; S.u.aux = 0;
            S.u.A = (const char*)(p.ws + WS_DFTC); S.u.B = (const char*)(p.ws + WS_ZTC) + (size_t)S.u.pn * 256 * 512 * 2;
            EpiDft E{br, TL, 256, 0.0625f};
            fg::gemm_phase<EpiDft, SchedOne, 512>(lds, S, E);
        }
    }
    __syncthreads();
}

#define XB_TMO      128
#define XB_XCNT(j)  (256  + 64 * (j))
#define XB_XSUB(j)  (1280 + 64 * (j))
#define XB_XGEN(j)  (2304 + 64 * (j))
#define XB_TOP      3328
#define XB_TOPGEN   3392
#define XB_SPIN_CAP (1u << 22)
__device__ __forceinline__ unsigned xb_ld(unsigned* p)              { return __hip_atomic_load(p, __ATOMIC_RELAXED, __HIP_MEMORY_SCOPE_AGENT); }
__device__ __forceinline__ unsigned xb_add(unsigned* p, unsigned v) { return __hip_atomic_fetch_add(p, v, __ATOMIC_RELAXED, __HIP_MEMORY_SCOPE_AGENT); }
__device__ __forceinline__ unsigned xb_xcc_id() { return (unsigned)__builtin_amdgcn_s_getreg((3 << 11) | 20) & 0xFu; }
#define XB_SPIN(cond, bar) do { unsigned _sp = 0; while (cond) { __builtin_amdgcn_s_sleep(1); \
    if ((++_sp & 255u) == 0u) { if (xb_ld(&(bar)[XB_TMO])) break; if (_sp > XB_SPIN_CAP) { atomicAdd(&(bar)[XB_TMO], 1u); break; } } } } while (0)
struct XcdBarrier { unsigned* bar; unsigned x; volatile FG_LAS unsigned* st; };
__device__ __forceinline__ XcdBarrier xcd_barrier_post(unsigned* bar, volatile FG_LAS unsigned* st) {
    XcdBarrier b; b.bar = bar; b.x = xb_xcc_id(); b.st = st;
    if (threadIdx.x == 0) (void)xb_add(&bar[XB_XCNT(b.x)], 1u);
    return b;
}
__device__ __forceinline__ void xcd_barrier_complete(unsigned* bar, unsigned x, unsigned& nloc, unsigned& nx) {
    const unsigned G = gridDim.x * gridDim.y * gridDim.z;
    unsigned sum, cnt, mine, sp = 0u;
    for (;;) {
        sum = 0u; cnt = 0u; mine = 0u;
#pragma unroll
        for (unsigned j = 0; j < 16; ++j) { const unsigned c = xb_ld(&bar[XB_XCNT(j)]); sum += c; cnt += (c > 0u) ? 1u : 0u; mine = (j == x) ? c : mine; }
        if (sum == G) break;
        __builtin_amdgcn_s_sleep(1);
        if ((++sp & 255u) == 0u) { if (xb_ld(&bar[XB_TMO])) break; if (sp > XB_SPIN_CAP) { atomicAdd(&bar[XB_TMO], 1u); break; } }
    }
    nloc = mine > 0u ? mine : 1u; nx = cnt > 0u ? cnt : 1u;
}
__device__ __forceinline__ void xcd_barrier(const XcdBarrier& b) {
    asm volatile("s_waitcnt vmcnt(0)" ::: "memory");
    unsigned* bar = b.bar; unsigned bx = __builtin_amdgcn_readfirstlane(b.x); asm volatile("" : "+s"(bar), "+s"(bx));
    __syncthreads();
    if (tidx() == 0) {
        __builtin_amdgcn_s_waitcnt(0);
        unsigned nloc = b.st[0], nx = b.st[1];
        if (nloc == 0u) { xcd_barrier_complete(bar, bx, nloc, nx); b.st[0] = nloc; b.st[1] = nx; }
        const unsigned old = xb_add(&bar[XB_XSUB(bx)], 1u);
        const unsigned gen = old / nloc;
        if (old + 1u == (gen + 1u) * nloc) {
            __builtin_amdgcn_fence(__ATOMIC_RELEASE, "agent");
            asm volatile("s_waitcnt vmcnt(0)" ::: "memory");
            const unsigned og = xb_add(&bar[XB_TOP], 1u);
            const unsigned tg = og / nx;
            if (og + 1u == (tg + 1u) * nx) xb_add(&bar[XB_TOPGEN], 1u);
            else XB_SPIN(xb_ld(&bar[XB_TOPGEN]) == tg, bar);
            __builtin_amdgcn_fence(__ATOMIC_ACQUIRE, "agent");
            xb_add(&bar[XB_XGEN(bx)], 1u);
            asm volatile("s_waitcnt vmcnt(0)" ::: "memory");
        } else {
            XB_SPIN(xb_ld(&bar[XB_XGEN(bx)]) == gen, bar);
            __builtin_amdgcn_fence(__ATOMIC_ACQUIRE, "agent");
            asm volatile("s_waitcnt vmcnt(0)" ::: "memory");
        }
    }
    __syncthreads();
}

__device__ __forceinline__ void xcd_barrier_arrive(const XcdBarrier& b) {
    asm volatile("s_waitcnt vmcnt(0)" ::: "memory");
    unsigned* bar = b.bar; unsigned bx = __builtin_amdgcn_readfirstlane(b.x); asm volatile("" : "+s"(bar), "+s"(bx));
    __syncthreads();
    if (tidx() == 0) {
        __builtin_amdgcn_s_waitcnt(0);
        unsigned nloc = b.st[0], nx = b.st[1];
        if (nloc == 0u) { xcd_barrier_complete(bar, bx, nloc, nx); b.st[0] = nloc; b.st[1] = nx; }
        const unsigned old = xb_add(&bar[XB_XSUB(bx)], 1u);
        const unsigned gen = old / nloc;
        unsigned mode = 0u, tg = 0u;
        if (old + 1u == (gen + 1u) * nloc) {
            __builtin_amdgcn_fence(__ATOMIC_RELEASE, "agent");
            asm volatile("s_waitcnt vmcnt(0)" ::: "memory");
            const unsigned og = xb_add(&bar[XB_TOP], 1u);
            tg = og / nx; mode = 1u;
            if (og + 1u == (tg + 1u) * nx) { xb_add(&bar[XB_TOPGEN], 1u); mode = 2u; }
            xb_add(&bar[XB_XGEN(bx)], 1u);
        }
        b.st[2] = mode; b.st[3] = gen; b.st[4] = tg;
    }
    __syncthreads();
}
__device__ __forceinline__ void xcd_barrier_wait(const XcdBarrier& b) {
    unsigned* bar = b.bar; unsigned bx = __builtin_amdgcn_readfirstlane(b.x); asm volatile("" : "+s"(bar), "+s"(bx));
    __syncthreads();
    if (tidx() == 0) {
        const unsigned mode = b.st[2], gen = b.st[3];
        if (mode != 2u) XB_SPIN(xb_ld(&bar[XB_TOPGEN]) == gen, bar);
        __builtin_amdgcn_fence(__ATOMIC_ACQUIRE, "agent");
        asm volatile("s_waitcnt vmcnt(0)" ::: "memory");
    }
    __syncthreads();
}

__global__ void __launch_bounds__(NTHREADS) mk_fwd(Params p_in) {
    extern __shared__ __attribute__((aligned(16))) unsigned char lds_raw[];
    float* lds = (float*)lds_raw; ldsp_t ldsf = (ldsp_t)lds_raw;
    cg::grid_group grid = cg::this_grid();
    volatile FG_LAS unsigned* misc = (volatile FG_LAS unsigned*)(ldsf + LDS_BYTES - 256);
    if (threadIdx.x < 32) misc[threadIdx.x] = (threadIdx.x == 16) ? blockIdx.x : 0u;
    __syncthreads();
    XcdBarrier xbar = xcd_barrier_post((unsigned*)(ldp().ws + WS_CTL) + 4096, misc + 8);
#define GSYNC() do { xcd_barrier_arrive(xbar); xcd_barrier_wait(xbar); } while (0)
    unsigned* cen = (unsigned*)(ldp().ws + WS_CTL) + 2048;
    if (threadIdx.x == 0) misc[17] = __hip_atomic_fetch_add(cen + 64 * xb_xcc_id(), 1u, __ATOMIC_RELAXED, __HIP_MEMORY_SCOPE_AGENT);
    for (int r_ = 0; r_ < RP_P0; ++r_) phase0(ldp(), lds);
    dense_transposes(ldp(), lds);
    if (ldp().ws == nullptr) grid.sync();
    GSYNC();
    if (threadIdx.x == 0) { bool ok = (gridDim.x == 256);
        for (int j = 0; j < 16; ++j) { const unsigned cj = __hip_atomic_load(cen + 64 * j, __ATOMIC_RELAXED, __HIP_MEMORY_SCOPE_AGENT); ok = ok && (cj == (j < 8 ? 32u : 0u)); }
        if (ok) misc[16] = misc[17] * 8u + xb_xcc_id(); }
    __syncthreads();
    phase_convert_dense(ldp(), lds, ldsf);
    phase_wg(ldp());
    for (int r_ = 0; r_ < RP_U; ++r_) phase_u(ldp(), 0);
    GSYNC();
    for (int l = 0; l < DEPTH; ++l) {
        for (int r_ = 0; r_ < RP_G1; ++r_) phase_g1_fast(ldp(), l, ldsf);
        if (l == 0 ? ((bidx() & 7) >= 4) : (bidx() >= 48)) bg_convert(ldp(), l, lds, BG_G1, true);
        GSYNC();
        for (int r_ = 0; r_ < RP_ATT; ++r_) phase_mixers(ldp(), l, ldsf, r_);
        xcd_barrier_arrive(xbar);
        phase_merge_fast(ldp(), l, ldsf, 0, 1);
        xcd_barrier_wait(xbar);
        phase_merge_fast(ldp(), l, ldsf, 1, 18);
        GSYNC();
        if (l == 0) { phase_merge_sum(ldp()); xcd_barrier_arrive(xbar); }
        phase_out_fast(ldp(), l, ldsf, 0, 2);
        if (l == 0) {
            if ((bidx() & 7) >= 2) bg_convert(ldp(), 0, lds, BG_OUT, true);
            xcd_barrier_wait(xbar);
            phase_out_fast(ldp(), l, ldsf, 2, 3); }
        xcd_barrier_arrive(xbar);
        phase_ln1_fill(ldp(), l, lds);
        xcd_barrier_wait(xbar);
        phase_ln1(ldp(), l, lds);
        GSYNC();
        for (int r_ = 0; r_ < RP_TOPK; ++r_) phase_topk(ldp(), l, lds);
        xcd_barrier_arrive(xbar);
        bg_convert(ldp(), l, lds, 1 << 20);
        xcd_barrier_wait(xbar);
        for (int r_ = 0; r_ < RP_UP; ++r_) phase_up_fast(ldp(), l, ldsf);
        GSYNC();
        for (int r_ = 0; r_ < RP_DN; ++r_) phase_down_fast(ldp(), l, ldsf);
        if (l == 0 && (bidx() & 7) >= 4) bg_convert(ldp(), 1, lds, BG_DN, true);
        GSYNC();
        for (int r_ = 0; r_ < (l == 1 ? RP_LN2 : 1); ++r_) phase_ln2(ldp(), l, lds);
        if (l == 0) GSYNC();
    }
}

extern "C" void kernel_launch(void* const* d_in, const int* in_sizes, int n_in, void* d_out, int out_size, void* d_ws, size_t ws_size, hipStream_t stream) {
    static int grid = 0;
    if (grid == 0) {
        if (n_in != 20 || ws_size < WS_END) { fprintf(stderr, "kernel_launch: unexpected n_in %d or ws_size %zu (need %zu)\n", n_in, ws_size, (size_t)WS_END); grid = -1; return; }
        int dev = 0, cus = 0, per_cu = 0;
        hipGetDevice(&dev); hipDeviceGetAttribute(&cus, hipDeviceAttributeMultiprocessorCount, dev);
        hipFuncSetAttribute((const void*)mk_fwd, hipFuncAttributeMaxDynamicSharedMemorySize, LDS_BYTES);
        hipOccupancyMaxActiveBlocksPerMultiprocessor(&per_cu, (const void*)mk_fwd, NTHREADS, LDS_BYTES);
        if (per_cu < 1) { fprintf(stderr, "kernel_launch: occupancy query says %d blocks per CU\n", per_cu); per_cu = 1; }
        (void)hipGetLastError();
        if (cus * per_cu < 256) { fprintf(stderr, "kernel_launch: needs 256 co-resident workgroups, device offers %d x %d\n", cus, per_cu); grid = -1; return; }
        grid = 256;
    }
    if (grid < 0) return;
    hipMemsetAsync((char*)d_ws + WS_CTL, 0, 64 * 1024, stream);
    Params p{};
    const float** pp = (const float**)&p;
    for (int i = 0; i < 20; ++i) pp[i] = (const float*)d_in[i];
    p.out = (float*)d_out; p.ws = (unsigned char*)d_ws;
    void* args[] = {&p};
    hipError_t e = hipLaunchCooperativeKernel((const void*)mk_fwd, dim3(grid), dim3(NTHREADS), args, LDS_BYTES, stream);
    if (e != hipSuccess) fprintf(stderr, "cooperative launch failed: %s (grid %d)\n", hipGetErrorString(e), grid);
}
```

```cpp
#include <hip/hip_runtime.h>
#include <hip/hip_cooperative_groups.h>
#include <cstdio>
#include <cstdint>
#include <type_traits>
namespace cg = cooperative_groups;

typedef _Float16 h16;
typedef _Float16 h16x8 __attribute__((ext_vector_type(8)));
typedef _Float16 h16x4 __attribute__((ext_vector_type(4)));
typedef float f32x4 __attribute__((ext_vector_type(4)));

constexpr int DM = 1024, NBATCH = 16, SEQ = 2048, CTX = 256, DEPTH = 2;
constexpr int TL = NBATCH * SEQ;
constexpr int TC = NBATCH * CTX;
constexpr int TT = TL + TC;
constexpr int INW = 5888, NMOD = 6 * DM, PMW = 1536;
constexpr int NEXP = 16, FF = 1024, CAPL = 256, CAPC = 32;
constexpr int GL = NBATCH * NEXP * CAPL;
constexpr int GC = NBATCH * NEXP * CAPC;
constexpr int GT = GL + GC;
constexpr float ALPHA = 1.4142135623730951f;
constexpr float LN_EPS = 1e-6f, RMS_EPS = 1e-6f;
constexpr int NTHREADS = 512, NWAVES = 8;
constexpr int LDS_BYTES = 147456;
constexpr int BG_G1 = 2, BG_OUT = 3, BG_DN = 2;
constexpr int PROBE_MODE = 0, RP_P0 = 1, RP_LN2 = 1;
constexpr int RP_G1 = 1, RP_FOU = 1, RP_MRG = 1, RP_OUT = 1, RP_UP = 1, RP_DN = 1, RP_ATT = 1, RP_U = 1, RP_TOPK = 1;


constexpr size_t MiB = 1u << 20;
constexpr size_t WS_CTL = 0;
constexpr size_t WS_MODV = 1 * MiB;
constexpr size_t WS_WFIN = 2 * MiB;
constexpr size_t WS_BDT = 3 * MiB;
constexpr size_t WS_TAB = 6 * MiB;
constexpr size_t WS_AFFL = 7 * MiB;
constexpr size_t WS_AFFC = 9 * MiB;
constexpr size_t WS_SELW = 10 * MiB;
constexpr size_t WS_STAT = 9 * MiB + 512 * 1024;
constexpr size_t WS_SELR = 10 * MiB + 512 * 1024;
constexpr size_t WS_SLOT = 11 * MiB;
constexpr size_t WS_WG = 13 * MiB + 512 * 1024;
constexpr size_t WS_SGB = 15 * MiB + 768 * 1024;
constexpr size_t WS_HB = 16 * MiB;
constexpr size_t WS_S = 160 * MiB;
constexpr size_t WS_U16 = WS_S;
constexpr size_t WS_PM = WS_S + 72 * MiB;
constexpr size_t WS_QI = WS_PM;
constexpr size_t WS_KI = WS_PM + 54 * MiB;
constexpr size_t WS_VI = WS_PM + 81 * MiB;
constexpr size_t WS_ZTL = WS_PM + 108 * MiB;
constexpr size_t WS_ZTC = WS_ZTL + 32 * MiB;
constexpr size_t WS_XG = WS_S + 72 * MiB;
constexpr size_t WS_BR = WS_S + 216 * MiB;
constexpr size_t WS_H16 = WS_S + 216 * MiB;
constexpr size_t WS_GSCR = WS_S + 288 * MiB;
constexpr size_t WS_MPART = WS_S + 320 * MiB;
constexpr size_t WS_WINT = WS_S + 360 * MiB;
constexpr size_t WS_WBT = WS_WINT + 24 * MiB;
constexpr size_t WS_WOT = WS_WBT + 4 * MiB;
constexpr size_t WS_DFT = WS_WOT + 4 * MiB;
constexpr size_t WS_DFTC = WS_DFT + 16 * MiB;
constexpr size_t WS_WGU1 = WS_DFTC + 1 * MiB;
constexpr size_t WS_END = WS_WGU1 + 64 * MiB;
constexpr size_t DO_WGU = 0;
constexpr size_t DO_WD = 64 * MiB;
constexpr size_t DO_WD1 = 96 * MiB;

struct Params {
    const float *x, *c, *ctx, *c_ctx, *w_mod, *b_mod, *w_in, *qk_gain, *sink, *rpb, *w_branch, *w_out, *ln1_g, *ln1_b, *w_router, *w_gate, *w_up, *w_down, *ln2_g, *ln2_b;
    float* out; unsigned char* ws;
};
typedef const __attribute__((address_space(4))) Params* kargp_t;
#if defined(__HIP_DEVICE_COMPILE__)
__device__ __forceinline__ Params ldp() { kargp_t q = (kargp_t)__builtin_amdgcn_kernarg_segment_ptr(); asm volatile("" : "+s"(q)); return *q; }
#else
__device__ __forceinline__ Params ldp() { return Params{}; }
#endif

#define VCU_LDS_ADDR (LDS_BYTES - 256 + 64)
__device__ __forceinline__ int bidx() { const unsigned v = *(volatile __attribute__((address_space(3))) unsigned*)(VCU_LDS_ADDR); int b = __builtin_amdgcn_readfirstlane((int)v); asm volatile("" : "+s"(b)); return b; }
__device__ __forceinline__ int tidx() { int t = threadIdx.x; asm volatile("" : "+v"(t)); return t; }
template <int CTRL> __device__ __forceinline__ float dpp_f(float v) { return __builtin_bit_cast(float, __builtin_amdgcn_update_dpp(0, __builtin_bit_cast(int, v), CTRL, 0xf, 0xf, true)); }
__device__ __forceinline__ float xor16_sum(float v) { const auto r = __builtin_amdgcn_permlane16_swap(__float_as_uint(v), __float_as_uint(v), false, false); return __uint_as_float(r[0]) + __uint_as_float(r[1]); }
__device__ __forceinline__ float xor32_sum(float v) { const auto r = __builtin_amdgcn_permlane32_swap(__float_as_uint(v), __float_as_uint(v), false, false); return __uint_as_float(r[0]) + __uint_as_float(r[1]); }
__device__ __forceinline__ float xor16_max(float v) { const auto r = __builtin_amdgcn_permlane16_swap(__float_as_uint(v), __float_as_uint(v), false, false); return fmaxf(__uint_as_float(r[0]), __uint_as_float(r[1])); }
__device__ __forceinline__ float xor32_max(float v) { const auto r = __builtin_amdgcn_permlane32_swap(__float_as_uint(v), __float_as_uint(v), false, false); return fmaxf(__uint_as_float(r[0]), __uint_as_float(r[1])); }
__device__ __forceinline__ float wave_sum(float v) {
    v += dpp_f<0xB1>(v);
    v += dpp_f<0x4E>(v);
    v += dpp_f<0x141>(v);
    v += dpp_f<0x140>(v);
    v = xor16_sum(v); v = xor32_sum(v);
    return v;
}
__device__ __forceinline__ float wave_max(float v) {
    v = fmaxf(v, dpp_f<0xB1>(v)); v = fmaxf(v, dpp_f<0x4E>(v)); v = fmaxf(v, dpp_f<0x141>(v)); v = fmaxf(v, dpp_f<0x140>(v));
    v = xor16_max(v); v = xor32_max(v);
    return v;
}
typedef unsigned u32x4 __attribute__((ext_vector_type(4)));
__device__ __forceinline__ unsigned pk_h2(float lo, float hi) { typedef _Float16 h2 __attribute__((ext_vector_type(2))); h2 v = {(h16)lo, (h16)hi}; return __builtin_bit_cast(unsigned, v); }
typedef __bf16 bf16x2_t __attribute__((ext_vector_type(2)));
typedef float f32x2_t __attribute__((ext_vector_type(2)));
typedef short bf16x8_t __attribute__((ext_vector_type(8)));
__device__ __forceinline__ unsigned pk_b2(float lo, float hi) { f32x2_t v = {lo, hi}; bf16x2_t b = __builtin_convertvector(v, bf16x2_t); return __builtin_bit_cast(unsigned, b); }
__device__ __forceinline__ float sigmoid_f(float v) { return __builtin_amdgcn_rcpf(1.f + __builtin_amdgcn_exp2f(v * -1.4426950408889634f)); }
__device__ __forceinline__ float silu_f(float v) { return v * sigmoid_f(v); }
__device__ __forceinline__ float sig2_f(float t) { return __builtin_amdgcn_rcpf(1.f + __builtin_amdgcn_exp2f(t)); }
__device__ __forceinline__ int mv_of(int R) { return R < TL ? (R >> 11) : 16; }

__device__ __forceinline__ void phase0(const Params& p, float* lds) {
    float* modv = (float*)(p.ws + WS_MODV); float* tab = (float*)(p.ws + WS_TAB);
    const int tid = tidx(), lane = tid & 63, wave = tid >> 6, c = bidx(), G = gridDim.x;
    if (c < 192) {
        float* sc = lds;
        float* red = lds + 17 * 1024;
        for (int e = tid; e < 17 * 1024; e += NTHREADS) { const int mv = e >> 10, k = e & 1023; const float v = mv < 16 ? p.c[mv * 1024 + k] : p.c_ctx[k]; sc[e] = silu_f(v); }
        __syncthreads();
        const int col0 = c * 64; const int l = col0 / NMOD, n0 = col0 % NMOD; const int rg = lane >> 4, cq = lane & 15;
        f32x4 acc[17];
#pragma unroll
        for (int m = 0; m < 17; ++m) acc[m] = (f32x4){0.f, 0.f, 0.f, 0.f};
        const float* w = p.w_mod + ((size_t)l * DM + wave * 128 + rg) * NMOD + n0 + cq * 4;
#pragma unroll 4
        for (int i = 0; i < 32; ++i) { const f32x4 wv = *(const f32x4*)(w + (size_t)(4 * i) * NMOD);
#pragma unroll
            for (int m = 0; m < 17; ++m) acc[m] += wv * sc[m * 1024 + wave * 128 + rg + 4 * i]; }
#pragma unroll
        for (int m = 0; m < 17; ++m) {
#pragma unroll
            for (int e = 0; e < 4; ++e) { float v = acc[m][e]; v += __shfl_xor(v, 16); v += __shfl_xor(v, 32); acc[m][e] = v; }
            if (rg == 0) *(f32x4*)(red + (wave * 17 + m) * 64 + cq * 4) = acc[m]; }
        __syncthreads();
        for (int e = tid; e < 17 * 64; e += NTHREADS) { const int m = e >> 6, ln = e & 63; float sacc = 0.f;
#pragma unroll
            for (int wv = 0; wv < 8; ++wv) sacc += red[(wv * 17 + m) * 64 + ln];
            const int nn = n0 + ln; modv[((size_t)l * 17 + m) * NMOD + nn] = sacc + p.b_mod[l * NMOD + nn]; }
        __syncthreads();
    }
    float* cT = lds; float* sT = lds + 2048;
    __syncthreads();
    for (int j = tid; j < 2048; j += NTHREADS) { cT[j] = cospif((float)j / 1024.f); sT[j] = sinpif((float)j / 1024.f); }
    if (c == G - 1) for (int e = tid; e < 64 * 16; e += NTHREADS) { const int pos = e >> 4, j = e & 15; const float inv = powf(10000.f, -(float)j / 16.f); const float ang = (float)pos * inv;
        tab[4096 + e] = cosf(ang); tab[4096 + 1024 + e] = sinf(ang); }
    __syncthreads();
    const int gt = c * NTHREADS + tid, NG = G * NTHREADS;
    { h16* DFT = (h16*)(p.ws + WS_DFT); h16* DFTC = (h16*)(p.ws + WS_DFTC);
      for (int o = gt; o < 1024 * 512 + 256 * 64; o += NG) {
        unsigned w[4];
        if (o < 1024 * 512) { const int k = (o >> 9) + 1, j0 = (o & 511) * 8;
#pragma unroll
            for (int q = 0; q < 4; ++q) { float v[2];
#pragma unroll
                for (int h = 0; h < 2; ++h) { const int j = j0 + q * 2 + h; const int idx = (k * (j & 2047)) & 2047; v[h] = (j >> 11) ? sT[idx] : cT[idx]; }
                w[q] = pk_h2(v[0], v[1]); }
            *(u32x4*)(DFT + (size_t)(k - 1) * 4096 + j0) = (u32x4){w[0], w[1], w[2], w[3]}; }
        else { const int oo = o - 1024 * 512; const int k = oo >> 6, j0 = (oo & 63) * 8;
#pragma unroll
            for (int q = 0; q < 4; ++q) { float v[2];
#pragma unroll
                for (int h = 0; h < 2; ++h) { const int j = j0 + q * 2 + h; const int idx = ((k * (j & 255)) & 255) * 8; v[h] = (j >> 8) ? -sT[idx] : cT[idx]; }
                w[q] = pk_h2(v[0], v[1]); }
            *(u32x4*)(DFTC + (size_t)k * 512 + j0) = (u32x4){w[0], w[1], w[2], w[3]}; } } }
    { h16* BDT = (h16*)(p.ws + WS_BDT);
      for (int o = gt; o < 512 * 256; o += NG) { const int zc = o >> 8, gc = o & 255; const int g = zc >> 7, cs = (zc >> 6) & 1, m = zc & 63; const int idx = ((m * (gc & 63)) & 63) * 32;
          BDT[o] = (h16)(((gc >> 6) == g) ? (cs ? sT[idx] : cT[idx]) * 0.125f : 0.f); } }
    { h16* WFIN = (h16*)(p.ws + WS_WFIN);
      for (int o = gt; o < 2 * 1024 * 64; o += NG) { const int gc4 = (o & 63) * 4, lk = o >> 6; const f32x4 v = *(const f32x4*)(p.w_in + (size_t)lk * INW + 512 + gc4);
          h16x4 hv = {(h16)v[0], (h16)v[1], (h16)v[2], (h16)v[3]}; *(h16x4*)(WFIN + (size_t)lk * 256 + gc4) = hv; } }
    __syncthreads();
}

__device__ __forceinline__ const float* hrow_of(const Params& p, const float* hB, int l, int R) { return l == 0 ? (R < TL ? p.x + (size_t)R * DM : p.ctx + (size_t)(R - TL) * DM) : hB + (size_t)R * DM; }
__device__ __forceinline__ void phase_u(const Params& p, int l) {
    const float* modv = (const float*)(p.ws + WS_MODV) + (size_t)l * 17 * NMOD; h16* u16 = (h16*)(p.ws + WS_U16); const float* hB = (const float*)(p.ws + WS_HB);
    const int lane = tidx() & 63, gw = bidx() * NWAVES + (tidx() >> 6);
    constexpr int rpw = TT / 2048;
    f32x4 sh[4], sc[4], h[4], hn[4]; int curmv = -1;
    const int R0 = gw * rpw;
    { const float* hr = hrow_of(p, hB, l, R0);
#pragma unroll
      for (int j = 0; j < 4; ++j) h[j] = *(const f32x4*)(hr + lane * 4 + 256 * j); }
    for (int i = 0; i < rpw; ++i) {
        const int R = R0 + i; const int mv = mv_of(R);
        if (mv != curmv) { const float* mvp = modv + (size_t)mv * NMOD; curmv = mv;
#pragma unroll
            for (int j = 0; j < 4; ++j) { const int col = lane * 4 + 256 * j; sh[j] = *(const f32x4*)(mvp + col); sc[j] = *(const f32x4*)(mvp + DM + col); } }
        asm volatile("" ::: "memory");
        if (i + 1 < rpw) { const float* hr = hrow_of(p, hB, l, R + 1);
#pragma unroll
            for (int j = 0; j < 4; ++j) hn[j] = *(const f32x4*)(hr + lane * 4 + 256 * j); }
        asm volatile("" ::: "memory");
#pragma unroll
        for (int j = 0; j < 4; ++j) { const int col = lane * 4 + 256 * j; const f32x4 u = h[j] * (1.f + sc[j]) + sh[j];
            *(unsigned long long*)(u16 + (size_t)R * DM + col) = (unsigned long long)pk_h2(u[0], u[1]) | ((unsigned long long)pk_h2(u[2], u[3]) << 32); }
#pragma unroll
        for (int j = 0; j < 4; ++j) h[j] = hn[j];
    }
}

constexpr float QSCALE = 0.125f * 1.4426950408889634f;
__device__ __forceinline__ void fourier_row0(const Params& p) {
    {
      const h16* ZTL = (const h16*)(p.ws + WS_ZTL); h16* brp = (h16*)(p.ws + WS_BR);
      const int lane_ = tidx() & 63, gw_ = bidx() * NWAVES + (tidx() >> 6), NGW_ = gridDim.x * NWAVES;
      for (int col = gw_; col < 4096; col += NGW_) { float sa = 0.f;
#pragma unroll
          for (int q = 0; q < 4; ++q) { const h16x8 v = *(const h16x8*)(ZTL + (size_t)col * 4096 + q * 512 + lane_ * 8);
#pragma unroll
              for (int e = 0; e < 8; ++e) sa += (float)v[e]; }
          sa = wave_sum(sa);
          if (lane_ == 0) brp[(size_t)((col >> 8) * 2048) * DM + 256 + (col & 255)] = (h16)(sa * 0.022097086912079608f); } }
}

#define MEMFENCE() asm volatile("" ::: "memory")
__device__ __forceinline__ void phase_wg(const Params& p) {
    const float* modv = (const float*)(p.ws + WS_MODV); float* wg = (float*)(p.ws + WS_WG); float* sgb = (float*)(p.ws + WS_SGB);
    const int tid = tidx(), lane = tid & 63, gw = bidx() * NWAVES + (tid >> 6), NGW = gridDim.x * NWAVES;
    for (int it = bidx() * NTHREADS + tid; it < 2 * 17 * 1024; it += gridDim.x * NTHREADS) {
        const int k = it & 1023, lm = it >> 10, l = lm / 17;
        const float G = p.ln1_g[l * DM + k] * (1.f + modv[(size_t)lm * NMOD + 4 * DM + k]);
        const float* w = p.w_router + ((size_t)l * DM + k) * 16; float* o = wg + (size_t)lm * 16384 + (size_t)((k >> 2) * 16) * 4 + (k & 3);
#pragma unroll
        for (int e4 = 0; e4 < 4; ++e4) { const f32x4 wv = *(const f32x4*)(w + e4 * 4);
#pragma unroll
            for (int c = 0; c < 4; ++c) o[(e4 * 4 + c) * 4] = G * wv[c]; } }
    for (int lm = gw; lm < 34; lm += NGW) { const int l = lm / 17;
        float sg[16], sb[16];
#pragma unroll
        for (int e = 0; e < 16; ++e) { sg[e] = 0.f; sb[e] = 0.f; }
        for (int q = 0; q < 16; ++q) { const int k = lane + 64 * q; const float sc = modv[(size_t)lm * NMOD + 4 * DM + k], sh = modv[(size_t)lm * NMOD + 3 * DM + k];
            const float G = p.ln1_g[l * DM + k] * (1.f + sc), Bp = p.ln1_b[l * DM + k] * (1.f + sc) + sh; const float* w = p.w_router + ((size_t)l * DM + k) * 16;
#pragma unroll
            for (int e4 = 0; e4 < 4; ++e4) { const f32x4 wv = *(const f32x4*)(w + e4 * 4);
#pragma unroll
                for (int c = 0; c < 4; ++c) { sg[e4 * 4 + c] += G * wv[c]; sb[e4 * 4 + c] += Bp * wv[c]; } } }
#pragma unroll
        for (int e = 0; e < 16; ++e) { const float a = wave_sum(sg[e]), b = wave_sum(sb[e]); if (lane == 0) { sgb[lm * 32 + e] = a; sgb[lm * 32 + 16 + e] = b; } } }
}
__device__ __forceinline__ void ln1_rows(const float* hB, h16* u16, float* stat, const float* mvp, const float* g, const float* bb, int R0, int nrows, int ioff, int lane, float& mu, float& rho, float* cst) {
    f32x4 gg[4], bv[4], sh[4], sc[4];
#pragma unroll
    for (int j = 0; j < 4; ++j) { const int col = lane * 4 + 256 * j; gg[j] = *(const f32x4*)(g + col); bv[j] = *(const f32x4*)(bb + col); sh[j] = *(const f32x4*)(mvp + 3 * DM + col); sc[j] = *(const f32x4*)(mvp + 4 * DM + col); }
    f32x4 v[4], vn[4];
#pragma unroll
    for (int j = 0; j < 4; ++j) v[j] = *(const f32x4*)(hB + (size_t)R0 * DM + lane * 4 + 256 * j);
    for (int i = 0; i < nrows; ++i) {
        const int R = R0 + i;
        MEMFENCE();
        if (i + 1 < nrows) {
#pragma unroll
            for (int j = 0; j < 4; ++j) vn[j] = *(const f32x4*)(hB + (size_t)(R + 1) * DM + lane * 4 + 256 * j); }
        MEMFENCE();
        float s = 0.f;
#pragma unroll
        for (int j = 0; j < 4; ++j) s += (v[j][0] + v[j][1]) + (v[j][2] + v[j][3]);
        const float mean = wave_sum(s) * (1.f / DM); float q = 0.f;
#pragma unroll
        for (int j = 0; j < 4; ++j) { v[j] = v[j] - mean; q += (v[j][0] * v[j][0] + v[j][1] * v[j][1]) + (v[j][2] * v[j][2] + v[j][3] * v[j][3]); }
        const float rstd = rsqrtf(wave_sum(q) * (1.f / DM) + LN_EPS);
        if (lane == 0) { float* st = stat + (size_t)R * 2; st[0] = mean; st[1] = rstd; if (cst) { cst[(ioff + i) * 2] = mean; cst[(ioff + i) * 2 + 1] = rstd; } }
        if ((lane & 15) == ioff + i) { mu = mean; rho = rstd; }
#pragma unroll
        for (int j = 0; j < 4; ++j) { const int col = lane * 4 + 256 * j;
            const f32x4 h1 = v[j] * rstd * gg[j] + bv[j];
            const f32x4 u2 = h1 * (1.f + sc[j]) + sh[j];
            *(unsigned long long*)(u16 + (size_t)R * DM + col) = (unsigned long long)pk_b2(u2[0], u2[1]) | ((unsigned long long)pk_b2(u2[2], u2[3]) << 32); }
#pragma unroll
        for (int j = 0; j < 4; ++j) v[j] = vn[j];
    }
}
__device__ __forceinline__ f32x4 ln1_router_mfma(const float* vrow, const float* wgl, int t0, int t1) {
    f32x4 a0 = {0.f, 0.f, 0.f, 0.f}, a1 = {0.f, 0.f, 0.f, 0.f};
    f32x4 b[8], bn[8];
#pragma unroll
    for (int u = 0; u < 8; ++u) b[u] = *(const f32x4*)(vrow + 16 * (t0 + u));
    for (int t = t0; t < t1; t += 8) {
        if (t + 8 < t1) {
#pragma unroll
            for (int u = 0; u < 8; ++u) bn[u] = *(const f32x4*)(vrow + 16 * (t + 8 + u)); }
#pragma unroll
        for (int u = 0; u < 8; ++u) { const f32x4 a = *(const f32x4*)(wgl + (t + u) * 256);
#pragma unroll
            for (int i = 0; i < 4; ++i) { if (u & 1) a1 = __builtin_amdgcn_mfma_f32_16x16x4f32(a[i], b[u][i], a1, 0, 0, 0); else a0 = __builtin_amdgcn_mfma_f32_16x16x4f32(a[i], b[u][i], a0, 0, 0, 0); } }
#pragma unroll
        for (int u = 0; u < 8; ++u) b[u] = bn[u];
    }
    return a0 + a1;
}
__device__ __forceinline__ void ln1_finish(const Params& p, const float* sgbm, const f32x4 D, float mu, float rho, int R, int lane) {
    float* affL = (float*)(p.ws + WS_AFFL); float* affC = (float*)(p.ws + WS_AFFC);
    const int eq = lane >> 4; const f32x4 sg = *(const f32x4*)(sgbm + 4 * eq), sb = *(const f32x4*)(sgbm + 16 + 4 * eq);
    const float rm = rho * mu; float lg[4];
#pragma unroll
    for (int r = 0; r < 4; ++r) lg[r] = rho * D[r] - rm * sg[r] + sb[r];
    float mx = fmaxf(fmaxf(lg[0], lg[1]), fmaxf(lg[2], lg[3])); mx = xor16_max(mx); mx = xor32_max(mx);
    float ex[4], se = 0.f;
#pragma unroll
    for (int r = 0; r < 4; ++r) { ex[r] = __builtin_amdgcn_exp2f((lg[r] - mx) * 1.4426950408889634f); se += ex[r]; }
    se = xor16_sum(se); se = xor32_sum(se);
#pragma unroll
    for (int r = 0; r < 4; ++r) { const float a = ex[r] / se; const int e = 4 * eq + r;
        if (R < TL) affL[((size_t)((R >> 11) * 16 + e)) * 2048 + (R & 2047)] = a; else { const int rr = R - TL; affC[((size_t)((rr >> 8) * 16 + e)) * 256 + (rr & 255)] = a; } }
}
__device__ __forceinline__ void phase_ln1_fill(const Params& p, int l, float* lds) {
    const float* wg = (const float*)(p.ws + WS_WG) + (size_t)l * 17 * 16384; const int tid = tidx(), bt = bidx() >> 4;
    __syncthreads();
    for (int e = tid; e < 4096; e += NTHREADS) *(f32x4*)(lds + e * 4) = *(const f32x4*)(wg + (size_t)bt * 16384 + e * 4);
    if (l == 0) for (int e = tid; e < 4096; e += NTHREADS) *(f32x4*)(lds + 16384 + e * 4) = *(const f32x4*)(wg + (size_t)16 * 16384 + e * 4);
    __syncthreads();
}
__device__ __forceinline__ void phase_ln1(const Params& p, int l, float* lds) {
    float* hB = (float*)(p.ws + WS_HB); h16* u16 = (h16*)(p.ws + WS_U16); const float* modv = (const float*)(p.ws + WS_MODV) + (size_t)l * 17 * NMOD;
    float* stat = (float*)(p.ws + WS_STAT); const float* wg = (const float*)(p.ws + WS_WG) + (size_t)l * 17 * 16384; const float* sgb = (const float*)(p.ws + WS_SGB) + l * 17 * 32;
    const float* g = p.ln1_g + l * DM; const float* bb = p.ln1_b + l * DM;
    const int tid = tidx(), lane = tid & 63, w = tid >> 6, c = bidx();
    const int bt = c >> 4;
    float* cst = lds + 32768; float* part = lds + 32768 + 64;
    __syncthreads();
    { const int Rg = c * 128 + w * 16; float mu = 0.f, rho = 0.f;
      ln1_rows(hB, u16, stat, modv + (size_t)bt * NMOD, g, bb, Rg, 16, 0, lane, mu, rho, nullptr);
      const f32x4 D = ln1_router_mfma(hB + (size_t)(Rg + (lane & 15)) * DM + 4 * (lane >> 4), lds + lane * 4, 0, 64);
      ln1_finish(p, sgb + bt * 32, D, mu, rho, Rg + (lane & 15), lane); }
    if (l == 0) { const int Cg = TL + c * 16; float mu = 0.f, rho = 0.f;
      ln1_rows(hB, u16, stat, modv + (size_t)16 * NMOD, g, bb, Cg + 2 * w, 2, 2 * w, lane, mu, rho, cst);
      __syncthreads();
      const f32x4 D = ln1_router_mfma(hB + (size_t)(Cg + (lane & 15)) * DM + 4 * (lane >> 4), lds + 16384 + lane * 4, 8 * w, 8 * w + 8);
      *(f32x4*)(part + (w * 64 + lane) * 4) = D;
      __syncthreads();
      if (w == 0) { f32x4 Ds = *(const f32x4*)(part + lane * 4);
#pragma unroll
          for (int q = 1; q < 8; ++q) Ds += *(const f32x4*)(part + (q * 64 + lane) * 4);
          ln1_finish(p, sgb + 16 * 32, Ds, cst[(lane & 15) * 2], cst[(lane & 15) * 2 + 1], Cg + (lane & 15), lane); } }
    __syncthreads();
}

__device__ __forceinline__ void phase_topk(const Params& p, int l, float* lds) {
    const float* affL = (const float*)(p.ws + WS_AFFL); const float* affC = (const float*)(p.ws + WS_AFFC); float* selw = (float*)(p.ws + WS_SELW); int* slot_of = (int*)(p.ws + WS_SLOT);
    int* selrow = (int*)(p.ws + WS_SELR);
    unsigned* a = (unsigned*)lds; unsigned* hist = (unsigned*)(lds + 2048 + 256); int* wsum = (int*)(lds + 2048 + 512); unsigned* ctl = (unsigned*)(lds + 2048 + 512 + 32);
    const int tid = tidx(), lane = tid & 63, wave = tid >> 6;
    const int nitems = (l == 0) ? 512 : 256;
    __syncthreads();
    for (int it = bidx(); it < nitems; it += gridDim.x) {
        const bool lat = it < 256; const int be = lat ? it : it - 256; const int b = be >> 4, e = be & 15; const int n = lat ? 2048 : 256, cap = lat ? CAPL : CAPC;
        const float* src = lat ? affL + (size_t)be * 2048 : affC + (size_t)be * 256;
        for (int i = tid; i < n; i += NTHREADS) a[i] = __float_as_uint(src[i]);
        unsigned prefix = 0u, pmask = 0u; int remaining = cap;
        for (int pass = 0; pass < 4; ++pass) {
            const int shift = 24 - 8 * pass;
            if (tid < 256) hist[tid] = 0u;
            __syncthreads();
            for (int i = tid; i < n; i += NTHREADS) { const unsigned u = a[i]; if ((u & pmask) == prefix) atomicAdd(&hist[(u >> shift) & 255u], 1u); }
            __syncthreads();
            if (tid < 64) {
                unsigned c4[4]; unsigned s4 = 0;
#pragma unroll
                for (int q = 0; q < 4; ++q) { c4[q] = hist[255 - (lane * 4 + q)]; s4 += c4[q]; }
                unsigned incl = s4;
#pragma unroll
                for (int o = 1; o < 64; o <<= 1) { const unsigned t = __shfl_up(incl, o); if (lane >= o) incl += t; }
                unsigned excl = incl - s4;
                const bool mine = (excl < (unsigned)remaining) && (incl >= (unsigned)remaining);
                if (mine) { unsigned cum = excl; int bin = 0; unsigned above = 0;
#pragma unroll
                    for (int q = 0; q < 4; ++q) { if (cum < (unsigned)remaining && cum + c4[q] >= (unsigned)remaining) { bin = 255 - (lane * 4 + q); above = cum; } cum += c4[q]; }
                    ctl[0] = (unsigned)bin; ctl[1] = above; }
            }
            __syncthreads();
            prefix |= ctl[0] << shift; pmask |= 255u << shift; remaining -= (int)ctl[1];
            __syncthreads();
        }
        const unsigned T = prefix; const int need_eq = remaining;
        const int i0 = tid * 4; int ngt = 0, neq = 0; unsigned u4[4];
#pragma unroll
        for (int q = 0; q < 4; ++q) { const int i = i0 + q; u4[q] = (i < n) ? a[i] : 0u; ngt += (i < n && u4[q] > T) ? 1 : 0; neq += (i < n && u4[q] == T) ? 1 : 0; }
        int ieq = neq;
#pragma unroll
        for (int o = 1; o < 64; o <<= 1) { const int t = __shfl_up(ieq, o); if (lane >= o) ieq += t; }
        if (lane == 63) wsum[wave] = ieq;
        __syncthreads();
        int eqbase = 0;
#pragma unroll
        for (int wv = 0; wv < 8; ++wv) eqbase += (wv < wave) ? wsum[wv] : 0;
        int eqrank = eqbase + ieq - neq;
        int nsel = 0; bool sel[4];
#pragma unroll
        for (int q = 0; q < 4; ++q) { const int i = i0 + q; const bool gt = (i < n) && (u4[q] > T); const bool eq = (i < n) && (u4[q] == T); sel[q] = gt || (eq && eqrank < need_eq); eqrank += eq ? 1 : 0; nsel += sel[q] ? 1 : 0; }
        __syncthreads();
        int isel = nsel;
#pragma unroll
        for (int o = 1; o < 64; o <<= 1) { const int t = __shfl_up(isel, o); if (lane >= o) isel += t; }
        if (lane == 63) wsum[wave] = isel;
        __syncthreads();
        int sbase = 0;
#pragma unroll
        for (int wv = 0; wv < 8; ++wv) sbase += (wv < wave) ? wsum[wv] : 0;
        int slot = sbase + isel - nsel;
        const int gbase = lat ? be * 256 : GL + e * 512 + b * 32;
#pragma unroll
        for (int q = 0; q < 4; ++q) { const int i = i0 + q; if (i < n) { const int R = lat ? b * 2048 + i : TL + b * 256 + i;
            if (sel[q]) { selrow[gbase + slot] = R; selw[gbase + slot] = __uint_as_float(u4[q]); slot_of[(size_t)R * 16 + e] = gbase + slot; ++slot; } else slot_of[(size_t)R * 16 + e] = -1; } }
        __syncthreads();
    }
}

struct Ln2S { int sl; float m, r; };
__device__ __forceinline__ Ln2S ln2_ldS(const int* slot_of, const float* stat, int R, int lane) { Ln2S s; s.sl = slot_of[(size_t)R * 16 + (lane & 15)]; s.m = stat[(size_t)R * 2]; s.r = stat[(size_t)R * 2 + 1]; return s; }
__device__ __forceinline__ void ln2_issue(const h16* Y, const float* hB, int R, int sl, int lane, h16x4 (&yv)[4][4], f32x4 (&h)[4]) {
    unsigned long long msk = __ballot(sl >= 0) & 0xFFFFull;
#pragma unroll
    for (int q = 0; q < 4; ++q) { if (msk) { const int e = __builtin_ctzll(msk); msk &= msk - 1; const int sr = __builtin_amdgcn_readlane(sl, e);
#pragma unroll
            for (int j = 0; j < 4; ++j) yv[q][j] = *(const h16x4*)(Y + (size_t)sr * DM + lane * 4 + 256 * j); }
        else {
#pragma unroll
            for (int j = 0; j < 4; ++j) yv[q][j] = (h16x4){(h16)0.f, (h16)0.f, (h16)0.f, (h16)0.f}; } }
#pragma unroll
    for (int j = 0; j < 4; ++j) h[j] = *(const f32x4*)(hB + (size_t)R * DM + lane * 4 + 256 * j);
}
__device__ __forceinline__ void ln2_rows(const Params& p, int l, const float* ldsv, int R0, int nrows, int mv, int lane) {
    float* hB = (float*)(p.ws + WS_HB); h16* u16 = (h16*)(p.ws + WS_U16); const h16* Y = (const h16*)(p.ws + WS_XG); const int* slot_of = (const int*)(p.ws + WS_SLOT);
    const float* mvp = (const float*)(p.ws + WS_MODV) + ((size_t)l * 17 + mv) * NMOD; const float* mvn = mvp + (size_t)17 * NMOD; const float* stat = (const float*)(p.ws + WS_STAT);
    const bool nextu = (l < DEPTH - 1);
    f32x4 gate[4], nsh[4], nsc[4];
#pragma unroll
    for (int j = 0; j < 4; ++j) { const int col = lane * 4 + 256 * j; gate[j] = *(const f32x4*)(mvp + 5 * DM + col); nsh[j] = (f32x4){0.f, 0.f, 0.f, 0.f}; nsc[j] = nsh[j];
        if (nextu) { nsh[j] = *(const f32x4*)(mvn + col); nsc[j] = *(const f32x4*)(mvn + DM + col); } }
    Ln2S sA = ln2_ldS(slot_of, stat, R0, lane), sB = sA, sC = sA, sD = sA;
    if (nrows > 1) sB = ln2_ldS(slot_of, stat, R0 + 1, lane);
    if (nrows > 2) sC = ln2_ldS(slot_of, stat, R0 + 2, lane);
    h16x4 yv0[4][4], yv1[4][4]; f32x4 h0[4], h1b[4];
    ln2_issue(Y, hB, R0, sA.sl, lane, yv0, h0);
    for (int i = 0; i < nrows; ++i) {
        const int R = R0 + i;
        MEMFENCE();
        if (i + 1 < nrows) ln2_issue(Y, hB, R + 1, sB.sl, lane, yv1, h1b);
        if (i + 3 < nrows) sD = ln2_ldS(slot_of, stat, R + 3, lane);
        MEMFENCE();
        f32x4 f[4];
#pragma unroll
        for (int j = 0; j < 4; ++j) { f[j] = (f32x4){0.f, 0.f, 0.f, 0.f};
#pragma unroll
            for (int q = 0; q < 4; ++q) { f[j][0] += (float)yv0[q][j][0]; f[j][1] += (float)yv0[q][j][1]; f[j][2] += (float)yv0[q][j][2]; f[j][3] += (float)yv0[q][j][3]; } }
        { unsigned long long msk = __ballot(sA.sl >= 0) & 0xFFFFull;
#pragma unroll
          for (int q = 0; q < 4; ++q) msk &= msk - 1;
          while (msk) { const int e = __builtin_ctzll(msk); msk &= msk - 1; const int sr = __builtin_amdgcn_readlane(sA.sl, e);
#pragma unroll
            for (int j = 0; j < 4; ++j) { const h16x4 y = *(const h16x4*)(Y + (size_t)sr * DM + lane * 4 + 256 * j); f[j][0] += (float)y[0]; f[j][1] += (float)y[1]; f[j][2] += (float)y[2]; f[j][3] += (float)y[3]; } } }
        f32x4 v[4]; float s = 0.f;
#pragma unroll
        for (int j = 0; j < 4; ++j) { const f32x4 g1v = *(const f32x4*)(ldsv + lane * 4 + 256 * j), b1v = *(const f32x4*)(ldsv + 1024 + lane * 4 + 256 * j);
            const f32x4 hh = (h0[j] - sA.m) * sA.r * g1v + b1v;
            v[j] = ALPHA * hh + gate[j] * f[j]; s += (v[j][0] + v[j][1]) + (v[j][2] + v[j][3]); }
        const float mean = wave_sum(s) * (1.f / DM); float q = 0.f;
#pragma unroll
        for (int j = 0; j < 4; ++j) { v[j] = v[j] - mean; q += (v[j][0] * v[j][0] + v[j][1] * v[j][1]) + (v[j][2] * v[j][2] + v[j][3] * v[j][3]); }
        const float rstd = rsqrtf(wave_sum(q) * (1.f / DM) + LN_EPS);
        float* orow = (l == DEPTH - 1) ? p.out + (size_t)R * DM : hB + (size_t)R * DM;
#pragma unroll
        for (int j = 0; j < 4; ++j) { const int col = lane * 4 + 256 * j; const f32x4 g2v = *(const f32x4*)(ldsv + 2048 + col), b2v = *(const f32x4*)(ldsv + 3072 + col);
            const f32x4 h2 = v[j] * rstd * g2v + b2v; if (l == DEPTH - 1) __builtin_nontemporal_store(h2, (f32x4*)(orow + col)); else *(f32x4*)(orow + col) = h2;
            if (nextu) { const f32x4 u = h2 * (1.f + nsc[j]) + nsh[j];
                *(unsigned long long*)(u16 + (size_t)R * DM + col) = (unsigned long long)pk_h2(u[0], u[1]) | ((unsigned long long)pk_h2(u[2], u[3]) << 32); } }
#pragma unroll
        for (int q2 = 0; q2 < 4; ++q2)
#pragma unroll
            for (int j = 0; j < 4; ++j) yv0[q2][j] = yv1[q2][j];
#pragma unroll
        for (int j = 0; j < 4; ++j) h0[j] = h1b[j];
        sA = sB; sB = sC; sC = sD;
    }
}
__device__ __forceinline__ void phase_ln2(const Params& p, int l, float* lds) {
    const int tid = tidx(), lane = tid & 63, w = tid >> 6, c = bidx();
    __syncthreads();
    for (int e = tid; e < 1024; e += NTHREADS) { const int k = e >> 8, col = (e & 255) * 4; const float* src = (k == 0 ? p.ln1_g : k == 1 ? p.ln1_b : k == 2 ? p.ln2_g : p.ln2_b) + l * DM + col;
        *(f32x4*)(lds + k * 1024 + col) = *(const f32x4*)src; }
    __syncthreads();
    ln2_rows(p, l, lds, c * 128 + w * 16, 16, c >> 4, lane);
    if (l == 0) ln2_rows(p, l, lds, TL + c * 16 + 2 * w, 2, 16, lane);
    __syncthreads();
}

namespace fg {
#define FG_LAS __attribute__((address_space(3)))
constexpr int BM = 256, BK = 64, HALF = 128, HTB = HALF * BK * 2, STAGE_BYTES = 8 * HTB;
__host__ __device__ __forceinline__ int lds_byte(int r, int c) { const int st = (r >> 4) * 2 + (c >> 5), rr = r & 15, cc = c & 31, ob = rr * 64 + cc * 2; return st * 1024 + (ob ^ (((ob >> 9) & 1) << 5)); }
__host__ __device__ __forceinline__ void stage_rc(int b, int& R, int& C) { const int st = b / 1024, sb = b % 1024, swz = sb ^ (((sb >> 9) & 1) << 5); R = (st >> 1) * 16 + swz / 64; C = (st & 1) * 32 + (swz % 64) / 2; }
__host__ __device__ __forceinline__ int perm32(int rho) { const int n = rho >> 4, i = rho & 15; return 8 * (i >> 2) + 4 * n + (i & 3); }
struct Unit { const char* A; const char* B; int nt; int pm, pn, aux; const int* rows; };
template <class Epi, class Sched, int LD, bool BF = false, bool GATHER = false>
__device__ __forceinline__ void gemm_phase(FG_LAS unsigned char* lds, const Sched& S, const Epi& E) {
    const int tid = tidx(), wid = __builtin_amdgcn_readfirstlane(tid >> 6), lane = tid & 63, wr = wid >> 2, wc = wid & 3, fr = lane & 15, fq = lane >> 4;
    unsigned voffA[2], voffB[2]; int rowA[2], colA[2];
#pragma unroll
    for (int i = 0; i < 2; ++i) { int R, C; stage_rc(tid * 16 + i * 8192, R, C); const int Rb = Epi::PERM ? ((R & ~31) + perm32(R & 31)) : R;
        voffA[i] = (unsigned)(R * LD + C) * 2u; voffB[i] = (unsigned)(Rb * LD + C) * 2u; rowA[i] = R; colA[i] = C; }
    const size_t kstep = (size_t)(BK * 2);
    const size_t hstep = GATHER ? (size_t)0 : (size_t)HALF * LD * 2;
    const unsigned ldsw = (unsigned)wid * 1024u;
    const int aoff = lds_byte(wr * 64 + fr, fq * 8), boff = lds_byte(wc * 32 + fr, fq * 8);
#define FG_SA(b, h) (((b) * 2 + (h)) * HTB)
#define FG_SB(b, h) ((4 + (b) * 2 + (h)) * HTB)
#define FG_STAGE(bufoff, gbase, voff) do { _Pragma("unroll") for (int _i = 0; _i < 2; ++_i) \
        __builtin_amdgcn_global_load_lds((const unsigned*)((const char*)(gbase) + (voff)[_i]), (FG_LAS unsigned*)(lds + (bufoff) + ldsw + _i * 8192), 16, 0, 0); } while (0)
#define FG_STAGEA(bufoff, gbase, h, cur_) do { if (GATHER) { if (cur_) FG_STAGE(bufoff, gbase, cvA[h]); else FG_STAGE(bufoff, gbase, nvA[h]); } else FG_STAGE(bufoff, (gbase) + (h) * ((size_t)HALF * LD * 2), voffA); } while (0)
#define FG_LDA(dst, b, h) do { _Pragma("unroll") for (int m = 0; m < 4; ++m) _Pragma("unroll") for (int k = 0; k < 2; ++k) dst[m][k] = *(const FG_LAS h16x8*)(lds + FG_SA(b, h) + aoff + m * 2048 + k * 1024); } while (0)
#define FG_LDB(dst, b, h) do { _Pragma("unroll") for (int n = 0; n < 2; ++n) _Pragma("unroll") for (int k = 0; k < 2; ++k) dst[n][k] = *(const FG_LAS h16x8*)(lds + FG_SB(b, h) + boff + n * 2048 + k * 1024); } while (0)
#define FG_MMA(ai, bj, At, Bt) do { __builtin_amdgcn_s_setprio(1); _Pragma("unroll") for (int m = 0; m < 4; ++m) _Pragma("unroll") for (int n = 0; n < 2; ++n) _Pragma("unroll") for (int k = 0; k < 2; ++k) \
        acc[ai][bj][m][n] = BF ? __builtin_amdgcn_mfma_f32_16x16x32_bf16(__builtin_bit_cast(bf16x8_t, Bt[n][k]), __builtin_bit_cast(bf16x8_t, At[m][k]), acc[ai][bj][m][n], 0, 0, 0) : __builtin_amdgcn_mfma_f32_16x16x32_f16(Bt[n][k], At[m][k], acc[ai][bj][m][n], 0, 0, 0); __builtin_amdgcn_s_setprio(0); } while (0)
#define FG_WAIT_V(n) asm volatile("s_waitcnt vmcnt(" #n ")" ::: "memory")
#define FG_WAIT_L(n) asm volatile("s_waitcnt lgkmcnt(" #n ")" ::: "memory")
#define FG_BAR __builtin_amdgcn_s_barrier()
#define FG_SCHED __builtin_amdgcn_sched_barrier(0)
    Unit cur, nxt; int ui = 0;
    __syncthreads();
    if (!S.next(0, cur)) return;
    f32x4 acc[2][2][4][2];
#pragma unroll
    for (int a = 0; a < 2; ++a)
#pragma unroll
        for (int b = 0; b < 2; ++b)
#pragma unroll
            for (int m = 0; m < 4; ++m)
#pragma unroll
                for (int n = 0; n < 2; ++n) acc[a][b][m][n] = (f32x4){0.f, 0.f, 0.f, 0.f};
    h16x8 At[4][2], B0[2][2], B1[2][2];
    const char* cA = cur.A; const char* cB = cur.B;
    const size_t hstepB = (size_t)HALF * LD * 2;
    unsigned cvA[2][2], nvA[2][2];
    if (GATHER) {
#pragma unroll
        for (int h = 0; h < 2; ++h)
#pragma unroll
            for (int i = 0; i < 2; ++i) { cvA[h][i] = (unsigned)(cur.rows[h * HALF + rowA[i]] * LD + colA[i]) * 2u; nvA[h][i] = cvA[h][i]; } }
    FG_STAGE(FG_SB(0, 0), cB, voffB); FG_STAGE(FG_SB(0, 1), cB + hstepB, voffB); FG_STAGEA(FG_SA(0, 0), cA, 0, true); FG_STAGEA(FG_SA(0, 1), cA, 1, true);
    if (wr == 1) FG_BAR;
    FG_WAIT_V(2); FG_BAR;
    FG_STAGE(FG_SB(1, 0), cB + kstep, voffB); FG_STAGEA(FG_SA(1, 0), cA + kstep, 0, true); FG_STAGE(FG_SB(1, 1), cB + hstepB + kstep, voffB);
    FG_WAIT_V(6); FG_BAR;
    for (;;) {
        const bool has_next = S.next(ui + 1, nxt);
        const char* nA = has_next ? nxt.A : cA; const char* nB = has_next ? nxt.B : cB;
        if (GATHER && has_next) {
#pragma unroll
            for (int h = 0; h < 2; ++h)
#pragma unroll
                for (int i = 0; i < 2; ++i) nvA[h][i] = (unsigned)(nxt.rows[h * HALF + rowA[i]] * LD + colA[i]) * 2u; }
        const int nt = cur.nt;
        for (int t = 0; t < nt; t += 2) {
            const bool last = (t == nt - 2);
            const char* a1 = cA + (size_t)(t + 1) * kstep;
            const char* a2 = last ? nA : cA + (size_t)(t + 2) * kstep; const char* b2 = last ? nB : cB + (size_t)(t + 2) * kstep;
            const char* a3 = a2 + kstep; const char* b3 = b2 + kstep;
            FG_LDB(B0, 0, 0); FG_LDB(B1, 0, 1); FG_SCHED; FG_LDA(At, 0, 0); FG_STAGEA(FG_SA(1, 1), a1, 1, true);
            FG_WAIT_V(8); FG_WAIT_L(0); FG_BAR; FG_MMA(0, 0, At, B0); FG_MMA(0, 1, At, B1); FG_BAR; FG_SCHED;
            FG_LDA(At, 0, 1); FG_STAGE(FG_SB(0, 0), b2, voffB); FG_STAGE(FG_SB(0, 1), b2 + hstepB, voffB); FG_STAGEA(FG_SA(0, 0), a2, 0, !last);
            FG_WAIT_V(8); FG_WAIT_L(0); FG_BAR; FG_MMA(1, 0, At, B0); FG_MMA(1, 1, At, B1); FG_BAR; FG_SCHED;
            FG_LDB(B0, 1, 0); FG_LDB(B1, 1, 1); FG_SCHED; FG_LDA(At, 1, 0); FG_STAGEA(FG_SA(0, 1), a2, 1, !last);
            FG_WAIT_V(8); FG_WAIT_L(0); FG_BAR; FG_MMA(0, 0, At, B0); FG_MMA(0, 1, At, B1); FG_BAR; FG_SCHED;
            FG_LDA(At, 1, 1); FG_STAGE(FG_SB(1, 0), b3, voffB); FG_STAGE(FG_SB(1, 1), b3 + hstepB, voffB); FG_STAGEA(FG_SA(1, 0), a3, 0, !last);
            FG_WAIT_V(8); FG_WAIT_L(0); FG_BAR; FG_MMA(1, 0, At, B0); FG_MMA(1, 1, At, B1); FG_BAR; FG_SCHED;
        }
        if (wr == 0) FG_BAR;
        { const int t2_ = tidx(); E(acc, cur, wr, wc, t2_ & 15, (t2_ >> 4) & 3); }
        if (!has_next) break;
#pragma unroll
        for (int a = 0; a < 2; ++a)
#pragma unroll
            for (int b = 0; b < 2; ++b)
#pragma unroll
                for (int m = 0; m < 4; ++m)
#pragma unroll
                    for (int n = 0; n < 2; ++n) acc[a][b][m][n] = (f32x4){0.f, 0.f, 0.f, 0.f};
        cur = nxt; cA = nA; cB = nB; ++ui;
        if (GATHER) {
#pragma unroll
            for (int h = 0; h < 2; ++h)
#pragma unroll
                for (int i = 0; i < 2; ++i) cvA[h][i] = nvA[h][i]; }
        if (wr == 1) FG_BAR;
    }
    FG_WAIT_V(0);
    FG_BAR;
#undef FG_SA
#undef FG_SB
#undef FG_STAGE
#undef FG_LDA
#undef FG_STAGEA
#undef FG_LDB
#undef FG_MMA
#undef FG_WAIT_V
#undef FG_WAIT_L
#undef FG_BAR
#undef FG_SCHED
}
}
typedef FG_LAS unsigned char* ldsp_t;

template <bool BF = false>
__device__ __forceinline__ void transpose_item(const float* W, int ldw, h16* WT, int ldt, float* scr, int lane, float scl = 1.f) {
    f32x4 t[16];
#pragma unroll
    for (int i = 0; i < 16; ++i) t[i] = __builtin_nontemporal_load((const f32x4*)(W + (size_t)(i * 4 + (lane >> 4)) * ldw + (lane & 15) * 4));
#pragma unroll
    for (int i = 0; i < 16; ++i) { float* d = scr + (i * 4 + (lane >> 4)) * 65 + (lane & 15) * 4; d[0] = t[i][0]; d[1] = t[i][1]; d[2] = t[i][2]; d[3] = t[i][3]; }
    __builtin_amdgcn_wave_barrier();
    const int c = lane & 7;
#pragma unroll
    for (int j = 0; j < 8; ++j) { const int n = (lane >> 3) + 8 * j; const float* sp = scr + (8 * c) * 65 + n;
        u32x4 o; if (BF) { o.x = pk_b2(sp[0 * 65], sp[1 * 65]); o.y = pk_b2(sp[2 * 65], sp[3 * 65]); o.z = pk_b2(sp[4 * 65], sp[5 * 65]); o.w = pk_b2(sp[6 * 65], sp[7 * 65]); }
        else { o.x = pk_h2(sp[0 * 65] * scl, sp[1 * 65] * scl); o.y = pk_h2(sp[2 * 65] * scl, sp[3 * 65] * scl); o.z = pk_h2(sp[4 * 65] * scl, sp[5 * 65] * scl); o.w = pk_h2(sp[6 * 65] * scl, sp[7 * 65] * scl); }
        *(u32x4*)(WT + (size_t)n * ldt + 8 * c) = o; }
    __builtin_amdgcn_wave_barrier();
}
struct SchedWF {
    const char* BDT; const char* WFIN; int c;
    __device__ __forceinline__ bool next(int i, fg::Unit& u) const {
        if (i != 0 || c >= 16) return false;
        u.aux = c >> 3; u.pm = (c >> 2) & 1; u.pn = c & 3; u.nt = 4;
        u.A = BDT + (size_t)u.pm * 256 * 256 * 2; u.B = WFIN + ((size_t)u.aux * 1024 + u.pn * 256) * 256 * 2; return true;
    }
};
struct EpiWF {
    static constexpr bool PERM = true;
    h16* WinT;
    __device__ __forceinline__ void operator()(const f32x4 (&acc)[2][2][4][2], const fg::Unit& u, int wr, int wc, int fr, int fq) const {
        h16* base = WinT + ((size_t)u.aux * 6144 + 5632 + u.pm * 256 + 64 * wr + fr) * DM + u.pn * 256 + 32 * wc + 8 * fq;
#pragma unroll
        for (int ai = 0; ai < 2; ++ai)
#pragma unroll
            for (int m = 0; m < 4; ++m)
#pragma unroll
                for (int bj = 0; bj < 2; ++bj) { const f32x4 v0 = acc[ai][bj][m][0], v1 = acc[ai][bj][m][1];
                    *(u32x4*)(base + (size_t)(128 * ai + 16 * m) * DM + 128 * bj) = (u32x4){pk_h2(v0[0], v0[1]), pk_h2(v0[2], v0[3]), pk_h2(v1[0], v1[1]), pk_h2(v1[2], v1[3])}; }
    }
};
__device__ __forceinline__ void phase_convert_dense(const Params& p, float* lds, ldsp_t ldsf) {
    { SchedWF S{(const char*)(p.ws + WS_BDT), (const char*)(p.ws + WS_WFIN), bidx()}; EpiWF E{(h16*)(p.ws + WS_WINT)};
      fg::gemm_phase<EpiWF, SchedWF, 256>(ldsf, S, E); }
    __syncthreads();
}
__device__ __forceinline__ void dense_transposes(const Params& p, float* lds) {
    if (bidx() < 192) return;
    __syncthreads();
    const int lane = tidx() & 63, wave = tidx() >> 6, gw = (bidx() - 192) * NWAVES + wave, NGW = (gridDim.x - 192) * NWAVES;
    float* scr = lds + wave * (64 * 65);
    h16* WinT = (h16*)(p.ws + WS_WINT); h16* WbT = (h16*)(p.ws + WS_WBT); h16* WoT = (h16*)(p.ws + WS_WOT);
    constexpr int I_IN = 16 * 88, I_BR = 4 * 4 * 16, I_OUT = 16 * 16, I_L = I_IN + I_BR + I_OUT;
    for (int it = gw; it < 2 * I_L; it += NGW) {
        const int l = it / I_L; int r = it % I_L;
        if (r < I_IN) { const int kb = r / 88, db = r % 88; const int d0 = db * 64; const int sc0 = d0 < 512 ? d0 : d0 + 256;
            transpose_item(p.w_in + ((size_t)l * DM + kb * 64) * INW + sc0, INW, WinT + ((size_t)l * 6144 + d0) * DM + kb * 64, DM, scr, lane, d0 >= 1536 ? -1.4426950408889634f : 1.f); continue; }
        r -= I_IN;
        if (r < I_BR) { const int i = r >> 6, kb = (r >> 4) & 3, nb = r & 15;
            transpose_item(p.w_branch + (((size_t)l * 4 + i) * 256 + kb * 64) * DM + nb * 64, DM, WbT + ((size_t)l * DM + nb * 64) * DM + i * 256 + kb * 64, DM, scr, lane); continue; }
        r -= I_BR;
        { const int kb = r >> 4, nb = r & 15;
            transpose_item(p.w_out + ((size_t)l * DM + kb * 64) * DM + nb * 64, DM, WoT + ((size_t)l * DM + nb * 64) * DM + kb * 64, DM, scr, lane); }
    }
    __syncthreads();
}
__device__ __forceinline__ h16* wgu_of(const Params& p, int l) { return l == 0 ? (h16*)((unsigned char*)p.out + DO_WGU) : (h16*)(p.ws + WS_WGU1); }
__device__ __forceinline__ h16* wd_of(const Params& p, int l) { return (h16*)((unsigned char*)p.out + (l == 0 ? DO_WD : DO_WD1)); }
__device__ __forceinline__ void bg_convert(const Params& p, int l, float* lds, int budget, bool spread = false) {
    const int lane = tidx() & 63, wave = tidx() >> 6;
    float* scr = lds + wave * (64 * 65);
    h16* Wgu = wgu_of(p, l); h16* Wd = wd_of(p, l);
    const int x = spread ? ((bidx() >> 3) + (bidx() & 7)) & 7 : (bidx() & 7);
    unsigned* ctr = (unsigned*)(p.ws + WS_CTL) + 3072 + 64 * (l * 8 + x);
    constexpr int I_GU = 2 * 16 * 16, I_D = 16 * 16, I_E = I_GU + I_D, NIT = 16 * I_E, NPG = NIT / 8, BATCH = 4;
    __syncthreads();
    for (int n = 0; n < budget; ++n) {
        unsigned i0 = 0; if (lane == 0) i0 = __hip_atomic_fetch_add(ctr, (unsigned)BATCH, __ATOMIC_RELAXED, __HIP_MEMORY_SCOPE_AGENT);
        i0 = __builtin_amdgcn_readfirstlane(i0);
        if (i0 >= (unsigned)NPG) break;
        for (int q = 0; q < BATCH; ++q) { const int it = x * NPG + (int)i0 + q;
            const int e = it / I_E; int r = it % I_E;
            if (r < I_GU) { const int h = r >> 8, kb = (r >> 4) & 15, nb = r & 15; const int n0 = nb * 64; const int drow = (n0 >> 7) * 256 + h * 128 + (n0 & 127);
                const float* src = (h ? p.w_up : p.w_gate) + (((size_t)l * NEXP + e) * DM + kb * 64) * FF + n0;
                transpose_item<true>(src, FF, Wgu + ((size_t)e * 2048 + drow) * DM + kb * 64, DM, scr, lane); }
            else { r -= I_GU; const int kb = r >> 4, nb = r & 15;
                transpose_item<true>(p.w_down + (((size_t)l * NEXP + e) * FF + kb * 64) * DM + nb * 64, DM, Wd + ((size_t)e * DM + nb * 64) * FF + kb * 64, FF, scr, lane); } }
    }
    __syncthreads();
}

struct SchedG1 {
    const char* u16; const char* WinT; int l, c, G;
    __device__ __forceinline__ bool next(int i, fg::Unit& u) const {
        const int nsup_full = (l == 0) ? 36 : 32;
        const int L = (i * 8 + (c & 7)) * 32 + (c >> 3); const int s = L >> 5;
        if (s < nsup_full) { u.pm = s * 4 + ((L >> 3) & 3); u.pn = L & 7; }
        else { if (l == 0) return false; const int r = i - 4; if (r != 0 || c >= 48) return false; u.pm = 128 + c / 3; u.pn = 1 + 2 * (c % 3); }
        u.nt = 16; u.aux = 0;
        if (u.pn < 6) { u.A = u16 + (size_t)u.pm * 256 * DM * 2; u.B = WinT + (size_t)u.pn * 256 * DM * 2; }
        else { u.A = WinT + (size_t)(5632 + (u.pn - 6) * 256) * DM * 2; u.B = u16 + (size_t)u.pm * 256 * DM * 2; }
        return true;
    }
};
struct EpiG1 {
    static constexpr bool PERM = true;
    unsigned char* QI; unsigned char* KI; unsigned char* VI; h16* ZTL; h16* ZTC;
    const float* gain; const float* ropeC; const float* ropeS; FG_LAS float* xs; int lastlayer;
    __device__ __forceinline__ void operator()(const f32x4 (&acc)[2][2][4][2], const fg::Unit& u, int wr, int wc, int fr, int fq) const {
        if (u.pn < 6) {
            const int mixer = u.pn >> 1; const bool lat = u.pm < 128; const int b = lat ? (u.pm >> 3) : (u.pm - 128); const int tile0 = lat ? 4 + 4 * (u.pm & 7) : 0;
            const bool isq = (u.pn & 1) == 0; const int half = wc & 1; const int chunk = 4 * half + fq;
            const bool do_rms = (mixer == 0); const bool do_rope = lat && (mixer < 2);
            float rs[2][2][4];
            if (do_rms) {
#pragma unroll
                for (int bj = 0; bj < 2; ++bj)
#pragma unroll
                    for (int ai = 0; ai < 2; ++ai)
#pragma unroll
                        for (int m = 0; m < 4; ++m) { const f32x4 v0 = acc[ai][bj][m][0], v1 = acc[ai][bj][m][1];
                            float ss = (v0[0] * v0[0] + v0[1] * v0[1]) + (v0[2] * v0[2] + v0[3] * v0[3]) + (v1[0] * v1[0] + v1[1] * v1[1]) + (v1[2] * v1[2] + v1[3] * v1[3]);
                            ss = xor16_sum(ss); ss = xor32_sum(ss); rs[bj][ai][m] = ss;
                            if (fq == 0) xs[(half * 256 + 128 * ai + 64 * wr + 16 * m + fr) * 4 + 2 * bj + (wc >> 1)] = ss; }
                asm volatile("s_waitcnt lgkmcnt(0)" ::: "memory"); __builtin_amdgcn_s_barrier(); asm volatile("" ::: "memory");
#pragma unroll
                for (int bj = 0; bj < 2; ++bj)
#pragma unroll
                    for (int ai = 0; ai < 2; ++ai)
#pragma unroll
                        for (int m = 0; m < 4; ++m) { const float so = xs[((half ^ 1) * 256 + 128 * ai + 64 * wr + 16 * m + fr) * 4 + 2 * bj + (wc >> 1)];
                            rs[bj][ai][m] = rsqrtf((rs[bj][ai][m] + so) * (1.f / 64.f) + RMS_EPS); }
            }
            f32x4 g0 = {1.f, 1.f, 1.f, 1.f}, g1 = {1.f, 1.f, 1.f, 1.f};
            if (do_rms) { const float* gp = gain + (isq ? 0 : 64) + chunk * 8; g0 = *(const f32x4*)gp; g1 = *(const f32x4*)(gp + 4); }
            const int j0 = (fq & 1) * 8;
            const bool upper = (fq & 2) != 0;
            auto body = [&](auto HC) {
                constexpr bool H1 = decltype(HC)::value;
#pragma unroll
                for (int mh = 0; mh < 2; ++mh) {
                    f32x4 tc0[2], tc1[2], ts0[2], ts1[2];
                    if (do_rope) {
#pragma unroll
                        for (int k = 0; k < 2; ++k) { const int pos = H1 ? (16 * (2 * mh + k) + fr) : (4 * (u.pm & 7) + 2 * k + wr);
                            tc0[k] = *(const f32x4*)(ropeC + pos * 16 + j0); tc1[k] = *(const f32x4*)(ropeC + pos * 16 + j0 + 4); ts0[k] = *(const f32x4*)(ropeS + pos * 16 + j0); ts1[k] = *(const f32x4*)(ropeS + pos * 16 + j0 + 4); }
                        asm volatile("" ::: "memory"); }
#pragma unroll
                    for (int bj = 0; bj < 2; ++bj) { const int hh = 2 * bj + (wc >> 1);
                        const bool isv = !isq && bj == 1; const bool proc = !isv && (isq || mixer < 2);
                        unsigned char* base; int rstride;
                        if (isq) { base = QI + ((size_t)((mixer * 16 + b) * 4 + hh) * 36 + tile0) * 8192 + chunk * 1024; rstride = 16; }
                        else if (bj == 0) { base = KI + ((size_t)((mixer * 16 + b) * 2 + hh) * 36 + tile0) * 8192 + chunk * 1024; rstride = 16; }
                        else { base = VI + ((size_t)((mixer * 16 + b) * 2 + (hh - 2)) * 36 + tile0) * 8192 + half * 4096 + fq * 16; rstride = 64; }
#pragma unroll
                        for (int ai = 0; ai < 2; ++ai)
#pragma unroll
                            for (int mm = 0; mm < 2; ++mm) { const int m = 2 * mh + mm; f32x4 v0 = acc[ai][bj][m][0], v1 = acc[ai][bj][m][1];
                                if (proc) {
                                    if (do_rms) { const float r_ = rs[bj][ai][m]; v0 = v0 * r_ * g0; v1 = v1 * r_ * g1; }
                                    if (do_rope) { const int k = H1 ? mm : ai;
                                        const f32x4 c0 = tc0[k], c1 = tc1[k], s0 = ts0[k], s1 = ts1[k];
                                        f32x4 p0, p1;
#pragma unroll
                                        for (int e = 0; e < 4; ++e) { const auto r0 = __builtin_amdgcn_permlane32_swap(__float_as_uint(v0[e]), __float_as_uint(v0[e]), false, false); p0[e] = __uint_as_float(upper ? r0[0] : r0[1]);
                                            const auto r1 = __builtin_amdgcn_permlane32_swap(__float_as_uint(v1[e]), __float_as_uint(v1[e]), false, false); p1[e] = __uint_as_float(upper ? r1[0] : r1[1]); }
                                        if (upper) { v0 = p0 * s0 + v0 * c0; v1 = p1 * s1 + v1 * c1; } else { v0 = v0 * c0 - p0 * s0; v1 = v1 * c1 - p1 * s1; } }
                                    if (isq) { v0 = v0 * QSCALE; v1 = v1 * QSCALE; } }
                                *(u32x4*)(base + (size_t)(2 * ai + wr) * 8192 + (16 * m + fr) * rstride) = (u32x4){pk_h2(v0[0], v0[1]), pk_h2(v0[2], v0[3]), pk_h2(v1[0], v1[1]), pk_h2(v1[2], v1[3])}; } }
                }
            };
            if (half) body(std::true_type{}); else body(std::false_type{});
            __builtin_amdgcn_s_waitcnt(0x0F70);
        } else {
            const int R0 = u.pm * 256 + 32 * wc + 8 * fq;
            h16* zb; size_t pitch; int cstride;
            if (R0 < TL) { const int b = R0 >> 11; zb = ZTL + (size_t)b * 256 * 4096 + (R0 & 2047); pitch = 4096; cstride = 2048; }
            else { const int rr = R0 - TL; const int b = rr >> 8; zb = ZTC + (size_t)b * 256 * 512 + (rr & 255); pitch = 512; cstride = 256; }
#pragma unroll
            for (int ai = 0; ai < 2; ++ai)
#pragma unroll
                for (int m = 0; m < 4; ++m) { const int zc = (u.pn - 6) * 256 + 128 * ai + 64 * wr + 16 * m + fr; const int g = zc >> 7, cs = (zc >> 6) & 1, mm = zc & 63;
                    h16* rowp = zb + (size_t)(g * 64 + mm) * pitch + cs * cstride;
#pragma unroll
                    for (int bj = 0; bj < 2; ++bj) { const f32x4 v0 = acc[ai][bj][m][0], v1 = acc[ai][bj][m][1];
                        *(u32x4*)(rowp + 128 * bj) = (u32x4){pk_h2(v0[0], v0[1]), pk_h2(v0[2], v0[3]), pk_h2(v1[0], v1[1]), pk_h2(v1[2], v1[3])}; } }
        }
    }
};
__device__ __forceinline__ void phase_g1_fast(const Params& p, int l, ldsp_t lds) {
    SchedG1 S{(const char*)(p.ws + WS_U16), (const char*)(p.ws + WS_WINT) + (size_t)l * 6144 * DM * 2, l, (int)bidx(), (int)gridDim.x};
    const float* tab = (const float*)(p.ws + WS_TAB);
    EpiG1 E{p.ws + WS_QI, p.ws + WS_KI, p.ws + WS_VI, (h16*)(p.ws + WS_ZTL), (h16*)(p.ws + WS_ZTC), p.qk_gain + l * 128, tab + 4096, tab + 4096 + 1024, (FG_LAS float*)(lds + 131072), l == DEPTH - 1};
    fg::gemm_phase<EpiG1, SchedG1, DM>(lds, S, E);
}

struct SchedOut {
    const char* A; const char* B; int l, c, i0, i1;
    __device__ __forceinline__ bool next(int i, fg::Unit& u) const {
        i += i0; if (i >= i1) return false;
        const int nsup = (l == 0) ? 18 : 16;
        const int L = (i * 8 + (c & 7)) * 32 + (c >> 3); const int s = L >> 5; if (s >= nsup) return false;
        u.pm = s * 8 + ((L >> 2) & 7); u.pn = L & 3; u.nt = 16; u.aux = 0;
        u.A = A + (size_t)u.pm * 256 * DM * 2; u.B = B + (size_t)u.pn * 256 * DM * 2; return true;
    }
};
struct EpiOut {
    static constexpr bool PERM = false;
    const float* x; const float* ctx; float* hB; const float* modv; int l;
    __device__ __forceinline__ void operator()(const f32x4 (&acc)[2][2][4][2], const fg::Unit& u, int wr, int wc, int fr, int fq) const {
        const int mv = u.pm < 128 ? (u.pm >> 3) : 16; const float* g1p = modv + (size_t)mv * NMOD + 2 * DM;
        const int R0 = u.pm * 256 + 64 * wr + fr; const int c0 = u.pn * 256 + 32 * wc + 4 * fq;
        const float* hbase = (l == 0 ? (R0 < TL ? x + (size_t)R0 * DM : ctx + (size_t)(R0 - TL) * DM) : hB + (size_t)R0 * DM) + c0;
        float* obase = hB + (size_t)R0 * DM + c0;
        f32x4 g1[2][2];
#pragma unroll
        for (int bj = 0; bj < 2; ++bj)
#pragma unroll
            for (int n = 0; n < 2; ++n) g1[bj][n] = *(const f32x4*)(g1p + c0 + 128 * bj + 16 * n);
#pragma unroll
        for (int ai = 0; ai < 2; ++ai) {
            f32x4 hv[4][2][2];
#pragma unroll
            for (int m = 0; m < 4; ++m)
#pragma unroll
                for (int bj = 0; bj < 2; ++bj)
#pragma unroll
                    for (int n = 0; n < 2; ++n) hv[m][bj][n] = *(const f32x4*)(hbase + (size_t)(128 * ai + 16 * m) * DM + 128 * bj + 16 * n);
            asm volatile("" ::: "memory");
#pragma unroll
            for (int m = 0; m < 4; ++m)
#pragma unroll
                for (int bj = 0; bj < 2; ++bj)
#pragma unroll
                    for (int n = 0; n < 2; ++n) *(f32x4*)(obase + (size_t)(128 * ai + 16 * m) * DM + 128 * bj + 16 * n) = ALPHA * hv[m][bj][n] + g1[bj][n] * acc[ai][bj][m][n];
            asm volatile("" ::: "memory");
        }
    }
};
__device__ __forceinline__ void phase_out_fast(const Params& p, int l, ldsp_t lds, int i0, int i1) {
    SchedOut S{(const char*)(p.ws + WS_PM), (const char*)(p.ws + WS_WOT) + (size_t)l * DM * DM * 2, l, (int)bidx(), i0, i1};
    EpiOut E{p.x, p.ctx, (float*)(p.ws + WS_HB), (const float*)(p.ws + WS_MODV) + (size_t)l * 17 * NMOD, l};
    fg::gemm_phase<EpiOut, SchedOut, DM>(lds, S, E);
}

__device__ __forceinline__ int expert_of_rtile(int rt) { return rt < 256 ? (rt & 15) : ((rt - 256) >> 1); }
struct SchedUp {
    const char* u16; const char* Wgu; const int* selrow; int l, c;
    __device__ __forceinline__ bool next(int i, fg::Unit& u) const {
        const int nsup = (l == 0) ? 72 : 64;
        const int L = (i * 8 + (c & 7)) * 32 + (c >> 3); const int s = L >> 5; if (s >= nsup) return false;
        const int o = s * 4 + ((L >> 3) & 3); const int rt = o < 256 ? ((o & 15) * 16 + (o >> 4)) : o;
        u.pm = rt; u.pn = L & 7; u.nt = 16; u.aux = expert_of_rtile(rt);
        u.A = u16; u.rows = selrow + rt * 256; u.B = Wgu + ((size_t)u.aux * 2048 + u.pn * 256) * DM * 2; return true;
    }
};
struct EpiUp {
    static constexpr bool PERM = true;
    h16* H;
    __device__ __forceinline__ void operator()(const f32x4 (&acc)[2][2][4][2], const fg::Unit& u, int wr, int wc, int fr, int fq) const {
#pragma unroll
        for (int ai = 0; ai < 2; ++ai)
#pragma unroll
            for (int m = 0; m < 4; ++m) { const int R = u.pm * 256 + 128 * ai + 64 * wr + 16 * m + fr; const int col = u.pn * 128 + 32 * wc + 8 * fq; float o[8];
#pragma unroll
                for (int n = 0; n < 2; ++n)
#pragma unroll
                    for (int j = 0; j < 4; ++j) o[n * 4 + j] = silu_f(acc[ai][0][m][n][j]) * acc[ai][1][m][n][j];
                *(u32x4*)(H + (size_t)R * FF + col) = (u32x4){pk_b2(o[0], o[1]), pk_b2(o[2], o[3]), pk_b2(o[4], o[5]), pk_b2(o[6], o[7])}; }
    }
};
__device__ __forceinline__ void phase_up_fast(const Params& p, int l, ldsp_t lds) {
    SchedUp S{(const char*)(p.ws + WS_U16), (const char*)wgu_of(p, l), (const int*)(p.ws + WS_SELR), l, (int)bidx()};
    EpiUp E{(h16*)(p.ws + WS_H16)};
    fg::gemm_phase<EpiUp, SchedUp, DM, true, true>(lds, S, E);
}
struct SchedDown {
    const char* H; const char* Wd; int l, c;
    __device__ __forceinline__ bool next(int i, fg::Unit& u) const {
        const int nsup = (l == 0) ? 36 : 32;
        const int L = (i * 8 + (c & 7)) * 32 + (c >> 3); const int s = L >> 5; if (s >= nsup) return false;
        const int o = s * 8 + ((L >> 2) & 7); const int rt = o < 256 ? ((o & 15) * 16 + (o >> 4)) : o;
        u.pm = rt; u.pn = L & 3; u.nt = 16; u.aux = expert_of_rtile(rt);
        u.A = H + (size_t)rt * 256 * FF * 2; u.B = Wd + ((size_t)u.aux * DM + u.pn * 256) * FF * 2; return true;
    }
};
struct EpiDown {
    static constexpr bool PERM = true;
    h16* Y; const float* selw;
    __device__ __forceinline__ void operator()(const f32x4 (&acc)[2][2][4][2], const fg::Unit& u, int wr, int wc, int fr, int fq) const {
        const int R0 = u.pm * 256 + 64 * wr + fr;
        float w[2][4];
#pragma unroll
        for (int ai = 0; ai < 2; ++ai)
#pragma unroll
            for (int m = 0; m < 4; ++m) w[ai][m] = selw[R0 + 128 * ai + 16 * m];
        asm volatile("" ::: "memory");
        h16* base = Y + (size_t)R0 * DM + u.pn * 256 + 32 * wc + 8 * fq;
#pragma unroll
        for (int ai = 0; ai < 2; ++ai)
#pragma unroll
            for (int m = 0; m < 4; ++m)
#pragma unroll
                for (int bj = 0; bj < 2; ++bj) { const f32x4 v0 = acc[ai][bj][m][0] * w[ai][m], v1 = acc[ai][bj][m][1] * w[ai][m];
                    *(u32x4*)(base + (size_t)(128 * ai + 16 * m) * DM + 128 * bj) = (u32x4){pk_h2(v0[0], v0[1]), pk_h2(v0[2], v0[3]), pk_h2(v1[0], v1[1]), pk_h2(v1[2], v1[3])}; }
    }
};
__device__ __forceinline__ void phase_down_fast(const Params& p, int l, ldsp_t lds) {
    SchedDown S{(const char*)(p.ws + WS_H16), (const char*)wd_of(p, l), l, (int)bidx()};
    EpiDown E{(h16*)(p.ws + WS_XG), (const float*)(p.ws + WS_SELW)};
    fg::gemm_phase<EpiDown, SchedDown, DM, true>(lds, S, E);
}


struct SchedMerge {
    const char* u16; const char* br; const char* WinT; const char* WbT; int l, c, i0, i1;
    __device__ __forceinline__ bool next(int i, fg::Unit& u) const {
        i += i0; if (i >= i1) return false;
        int ib, sub;
        if (i < 16) { const int ti = i >> 3; sub = i & 7; ib = sub >> 1;
            const int L = (ti * 8 + (c & 7)) * 32 + (c >> 3); const int s = L >> 5;
            u.pm = s * 8 + ((L >> 2) & 7); u.pn = L & 3; u.aux = sub; }
        else { if (l != 0 || i >= 18) return false; const int tct = c >> 2; ib = c & 3; sub = 2 * ib + (i & 1);
            u.pm = 128 + (tct >> 2); u.pn = tct & 3; u.aux = sub | 8; }
        if ((sub & 1) == 0) { u.nt = 16; u.A = u16 + (size_t)u.pm * 256 * DM * 2; u.B = WinT + (size_t)(1536 + ib * 1024 + u.pn * 256) * DM * 2; }
        else { u.nt = 4; u.A = br + (size_t)u.pm * 256 * DM * 2 + ib * 512; u.B = WbT + (size_t)u.pn * 256 * DM * 2 + ib * 512; }
        return true;
    }
};
struct EpiMerge {
    static constexpr bool PERM = true;
    h16* mg; h16* part; unsigned char* scr;
    __device__ __forceinline__ void operator()(const f32x4 (&acc)[2][2][4][2], const fg::Unit& u, int wr, int wc, int fr, int fq) const {
        const int tid = tidx();
        if ((u.aux & 1) == 0) {
#pragma unroll
            for (int ai = 0; ai < 2; ++ai)
#pragma unroll
                for (int m = 0; m < 4; ++m)
#pragma unroll
                    for (int bj = 0; bj < 2; ++bj) { const int q = (ai * 4 + m) * 2 + bj; const f32x4 v0 = acc[ai][bj][m][0], v1 = acc[ai][bj][m][1];
                        *(u32x4*)(scr + ((size_t)q * 512 + tid) * 16) = (u32x4){pk_h2(sig2_f(v0[0]), sig2_f(v0[1])), pk_h2(sig2_f(v0[2]), sig2_f(v0[3])), pk_h2(sig2_f(v1[0]), sig2_f(v1[1])), pk_h2(sig2_f(v1[2]), sig2_f(v1[3]))}; }
        } else {
            const bool partial = (u.aux & 8) != 0; const bool first = partial || ((u.aux & 7) == 1);
            h16* base = partial ? part + ((size_t)((u.aux & 7) >> 1) * TC + (size_t)(u.pm - 128) * 256) * DM : mg + (size_t)u.pm * 256 * DM;
            base += (size_t)(64 * wr + fr) * DM + u.pn * 256 + 32 * wc + 8 * fq;
#pragma unroll
            for (int ai = 0; ai < 2; ++ai) {
                h16x8 gv[8], pr[8];
#pragma unroll
                for (int m = 0; m < 4; ++m)
#pragma unroll
                    for (int bj = 0; bj < 2; ++bj) { const int q = (ai * 4 + m) * 2 + bj; gv[m * 2 + bj] = *(const h16x8*)(scr + ((size_t)q * 512 + tid) * 16);
                        if (!first) pr[m * 2 + bj] = *(const h16x8*)(base + (size_t)(128 * ai + 16 * m) * DM + 128 * bj); }
                asm volatile("" ::: "memory");
#pragma unroll
                for (int m = 0; m < 4; ++m)
#pragma unroll
                    for (int bj = 0; bj < 2; ++bj) { const h16x8 g = gv[m * 2 + bj]; const f32x4 v0 = acc[ai][bj][m][0], v1 = acc[ai][bj][m][1];
                        float o[8] = {(float)g[0] * v0[0], (float)g[1] * v0[1], (float)g[2] * v0[2], (float)g[3] * v0[3], (float)g[4] * v1[0], (float)g[5] * v1[1], (float)g[6] * v1[2], (float)g[7] * v1[3]};
                        if (!first) { const h16x8 pp = pr[m * 2 + bj];
#pragma unroll
                            for (int e = 0; e < 8; ++e) o[e] += (float)pp[e]; }
                        *(u32x4*)(base + (size_t)(128 * ai + 16 * m) * DM + 128 * bj) = (u32x4){pk_h2(o[0], o[1]), pk_h2(o[2], o[3]), pk_h2(o[4], o[5]), pk_h2(o[6], o[7])}; }
                asm volatile("" ::: "memory");
            }
        }
    }
};
__device__ __forceinline__ void phase_merge_fast(const Params& p, int l, ldsp_t lds, int i0, int i1) {
    SchedMerge S{(const char*)(p.ws + WS_U16), (const char*)(p.ws + WS_BR), (const char*)(p.ws + WS_WINT) + (size_t)l * 6144 * DM * 2, (const char*)(p.ws + WS_WBT) + (size_t)l * DM * DM * 2, l, bidx(), i0, i1};
    EpiMerge E{(h16*)(p.ws + WS_PM), (h16*)(p.ws + WS_MPART), (l == 0 ? p.ws + WS_WGU1 : (unsigned char*)p.out + DO_WGU) + (size_t)bidx() * 131072};
    fg::gemm_phase<EpiMerge, SchedMerge, DM>(lds, S, E);
}
__device__ __forceinline__ void phase_merge_sum(const Params& p) {
    const h16* part = (const h16*)(p.ws + WS_MPART); h16* mg = (h16*)(p.ws + WS_PM) + (size_t)TL * DM;
    const int gt = bidx() * NTHREADS + tidx(), NG = gridDim.x * NTHREADS;
    for (int o = gt; o < TC * DM / 8; o += NG) { float acc[8];
#pragma unroll
        for (int e = 0; e < 8; ++e) acc[e] = 0.f;
#pragma unroll
        for (int i = 0; i < 4; ++i) { const h16x8 v = *(const h16x8*)(part + (size_t)i * TC * DM + (size_t)o * 8);
#pragma unroll
            for (int e = 0; e < 8; ++e) acc[e] += (float)v[e]; }
        *(u32x4*)(mg + (size_t)o * 8) = (u32x4){pk_h2(acc[0], acc[1]), pk_h2(acc[2], acc[3]), pk_h2(acc[4], acc[5]), pk_h2(acc[6], acc[7])}; }
}

struct EpiDft {
    static constexpr bool PERM = true;
    h16* br; int row0, rows_per_b; float scl;
    __device__ __forceinline__ void operator()(const f32x4 (&acc)[2][2][4][2], const fg::Unit& u, int wr, int wc, int fr, int fq) const {
#pragma unroll
        for (int ai = 0; ai < 2; ++ai)
#pragma unroll
            for (int m = 0; m < 4; ++m) { const int kr = u.pm * 256 + 128 * ai + 64 * wr + 16 * m + fr; const size_t R = (size_t)row0 + (size_t)u.pn * rows_per_b + kr;
#pragma unroll
                for (int bj = 0; bj < 2; ++bj) { const int col = 128 * bj + 32 * wc + 8 * fq; const f32x4 v0 = acc[ai][bj][m][0] * scl, v1 = acc[ai][bj][m][1] * scl;
                    *(u32x4*)(br + R * DM + 256 + col) = (u32x4){pk_h2(v0[0], v0[1]), pk_h2(v0[2], v0[3]), pk_h2(v1[0], v1[1]), pk_h2(v1[2], v1[3])}; } }
    }
};

namespace fa {
typedef float f32x16 __attribute__((ext_vector_type(16)));
typedef short v4i16_t __attribute__((ext_vector_type(4)));
typedef short s16x4 __attribute__((ext_vector_type(4)));
constexpr float LOG2E = 1.4426950408889634f;
constexpr int NSLOT = 3, SLOTB = 8192;
constexpr int LDS_K = 0, LDS_V = NSLOT * SLOTB, LDS_WS = 2 * NSLOT * SLOTB, LDS_OST = LDS_WS + 8 * 64 * 4, LDS_RPB = LDS_OST + 8 * 4096;
__device__ __forceinline__ int crow(int r, int hi) { return (r & 3) + 8 * (r >> 2) + 4 * hi; }
#define SBAR() __builtin_amdgcn_sched_barrier(0)
__device__ __forceinline__ void glds16(const void* gsrc, unsigned lds_dst) { unsigned keep;
    asm volatile("s_mov_b32 %0, m0\n\ts_mov_b32 m0, %2\n\ts_nop 0\n\tglobal_load_lds_dwordx4 %1, off\n\ts_mov_b32 m0, %0" : "=&s"(keep) : "v"(gsrc), "s"(lds_dst) : "memory"); }
__device__ __forceinline__ float max3f(float a, float b, float c) { float r; asm("v_max3_f32 %0, %1, %2, %3" : "=v"(r) : "v"(a), "v"(b), "v"(c)); return r; }
__device__ __forceinline__ float max2f(float a, float b) { float r; asm("v_max_f32_e32 %0, %1, %2" : "=v"(r) : "v"(a), "v"(b)); return r; }
__device__ __forceinline__ float fadd_s(float a, float b) { float r; asm("v_add_f32_e32 %0, %1, %2" : "=v"(r) : "v"(a), "v"(b)); return r; }
__device__ __forceinline__ float fsub_s(float a, float b) { float r; asm("v_sub_f32_e32 %0, %1, %2" : "=v"(r) : "v"(a), "v"(b)); return r; }
#define WAIT_BAR(N) asm volatile("s_waitcnt vmcnt(" #N ") lgkmcnt(0)\n\ts_barrier" ::: "memory")
typedef __attribute__((address_space(3))) const char* lds_cptr;
__device__ __forceinline__ void kload8(h16x8* kf, lds_cptr kp) {
    kf[0] = *(const FG_LAS h16x8*)(kp);        kf[1] = *(const FG_LAS h16x8*)(kp + 512);
    kf[2] = *(const FG_LAS h16x8*)(kp + 2048); kf[3] = *(const FG_LAS h16x8*)(kp + 2560);
    kf[4] = *(const FG_LAS h16x8*)(kp + 4096); kf[5] = *(const FG_LAS h16x8*)(kp + 4608);
    kf[6] = *(const FG_LAS h16x8*)(kp + 6144); kf[7] = *(const FG_LAS h16x8*)(kp + 6656);
}
__device__ __forceinline__ void kload2(h16x8* kf, lds_cptr kp, int j) { kf[2 * j] = *(const FG_LAS h16x8*)(kp + j * 2048); kf[2 * j + 1] = *(const FG_LAS h16x8*)(kp + j * 2048 + 512); }
__device__ __forceinline__ s16x4 vtr(lds_cptr p) { return __builtin_bit_cast(s16x4, __builtin_amdgcn_ds_read_tr16_b64_v4i16((FG_LAS v4i16_t*)p)); }
__device__ __forceinline__ void qkt(f32x16& p0, f32x16& p1, lds_cptr Kslot, const h16x8* qr, const f32x16& negm, int r32, int hi) {
    lds_cptr kb = Kslot + hi * 1024 + r32 * 16;
#pragma unroll
    for (int d0 = 0; d0 < 4; ++d0) {
        const h16x8 b0 = *(const FG_LAS h16x8*)(kb + d0 * 2048), b1 = *(const FG_LAS h16x8*)(kb + d0 * 2048 + 512);
        if (d0 == 0) { p0 = __builtin_amdgcn_mfma_f32_32x32x16_f16(b0, qr[0], negm, 0, 0, 0); p1 = __builtin_amdgcn_mfma_f32_32x32x16_f16(b1, qr[0], negm, 0, 0, 0); }
        else { p0 = __builtin_amdgcn_mfma_f32_32x32x16_f16(b0, qr[d0], p0, 0, 0, 0); p1 = __builtin_amdgcn_mfma_f32_32x32x16_f16(b1, qr[d0], p1, 0, 0, 0); } }
}
__device__ __forceinline__ float rowmax(const f32x16& p0, const f32x16& p1) {
    float a = max3f(p0[0], p0[1], p1[0]), b = max3f(p0[2], p0[3], p1[1]); a = max3f(a, p1[2], p1[3]);
#pragma unroll
    for (int r = 4; r < 16; r += 4) { a = max3f(a, p0[r], p0[r + 1]); b = max3f(b, p0[r + 2], p0[r + 3]); a = max3f(a, p1[r], p1[r + 1]); b = max3f(b, p1[r + 2], p1[r + 3]); }
    const float m = max2f(a, b);
    auto rr = __builtin_amdgcn_permlane32_swap(__float_as_uint(m), __float_as_uint(m), false, false);
    return max2f(__uint_as_float(rr[0]), __uint_as_float(rr[1]));
}
__device__ __forceinline__ void pv(f32x16* o, lds_cptr vb, h16x8 pa0, h16x8 pa1, h16x8 pa2, h16x8 pa3) {
    typedef short s8 __attribute__((ext_vector_type(8)));
#pragma unroll
    for (int d0 = 0; d0 < 2; ++d0) { s16x4 lo[4], hh[4];
#pragma unroll
        for (int ks = 0; ks < 4; ++ks) { lo[ks] = vtr(vb + d0 * 4096 + ks * 1024); hh[ks] = vtr(vb + d0 * 4096 + ks * 1024 + 512); }
#define PKV(k) __builtin_bit_cast(h16x8, (s8){lo[k][0], lo[k][1], lo[k][2], lo[k][3], hh[k][0], hh[k][1], hh[k][2], hh[k][3]})
        o[d0] = __builtin_amdgcn_mfma_f32_32x32x16_f16(pa0, PKV(0), o[d0], 0, 0, 0);
        o[d0] = __builtin_amdgcn_mfma_f32_32x32x16_f16(pa1, PKV(1), o[d0], 0, 0, 0);
        o[d0] = __builtin_amdgcn_mfma_f32_32x32x16_f16(pa2, PKV(2), o[d0], 0, 0, 0);
        o[d0] = __builtin_amdgcn_mfma_f32_32x32x16_f16(pa3, PKV(3), o[d0], 0, 0, 0);
#undef PKV
    }
}
template <int MIXER, int THRL>
__device__ __forceinline__ void attn_unit(const unsigned char* QI, const unsigned char* KI, const unsigned char* VI, h16* br, const float* sinkp, const float* rpb, int mixer, int b, int kvh, int qb, bool isctx, ldsp_t lds, unsigned* qctr, volatile FG_LAS unsigned* qw) {
    const int tid = tidx(), lane = tid & 63, wid = __builtin_amdgcn_readfirstlane(tid >> 6), r32 = lane & 31, hi = lane >> 5, g = wid >> 2, qsub = wid & 3, hq = kvh * 2 + g;
    const int brcol = (mixer == 0 ? 0 : mixer == 1 ? 512 : 768) + hq * 64;
    const int q0 = (isctx ? TL + b * 256 + qb * 128 : b * 2048 + qb * 128) + qsub * 32;
    int jlo = 0, nlat = 0;
    if (!isctx) {
        if (MIXER == 0) { jlo = 0; nlat = 32; }
        else if (MIXER == 1) { jlo = max(0, 2 * qb - 2); nlat = min(31, 2 * qb + 3) - jlo + 1; }
        else { jlo = min(max(2 * qb - 4, 0), 24); nlat = min(max(2 * qb - 3, 0), 24) + 7 - jlo + 1; }
    }
    const int nreal = 4 + nlat; const int NT = (nreal + 1) & ~1;
#define FA_TILE(s) ((s) < 4 ? (s) : 4 + jlo + min((s), nreal - 1) - 4)
    const unsigned lds0 = (unsigned)(size_t)lds;
    FG_LAS float* wsf = (FG_LAS float*)(lds + LDS_WS) + wid * 64;
    const unsigned char* ksrc = KI + ((size_t)((mixer * 16 + b) * 2 + kvh) * 36) * 8192 + wid * 1024 + lane * 16;
    const unsigned char* vsrc = VI + ((size_t)((mixer * 16 + b) * 2 + kvh) * 36) * 8192 + wid * 1024 + lane * 16;
    const unsigned kdst = lds0 + LDS_K + wid * 1024, vdst = lds0 + LDS_V + wid * 1024;
#define DMA_K(t, slot) glds16(ksrc + (size_t)FA_TILE(t) * 8192, (unsigned)__builtin_amdgcn_readfirstlane(kdst + (slot)))
#define DMA_V(t, slot) glds16(vsrc + (size_t)FA_TILE(t) * 8192, (unsigned)__builtin_amdgcn_readfirstlane(vdst + (slot)))
    h16x8 kf[8];
    const lds_cptr shm3 = (lds_cptr)lds; const lds_cptr kp0 = shm3 + LDS_K + hi * 1024 + r32 * 16;
    const lds_cptr vp0 = shm3 + LDS_V + ((lane >> 4) & 1) * 32 + (lane & 3) * 8 + (4 * hi + ((lane & 15) >> 2)) * 64;
    DMA_K(0, 0); DMA_V(0, 0); DMA_K(1, SLOTB);
    if (MIXER == 2) { FG_LAS float* tb = (FG_LAS float*)(lds + LDS_RPB); for (int i = tid; i < 930; i += NTHREADS) tb[i] = rpb[(size_t)(kvh * 2) * 465 + i] * LOG2E; }
    h16x8 qr[4];
    { const int qtile = (isctx ? 0 : 4) + 2 * qb + (qsub >> 1);
      const unsigned char* qp = QI + (((size_t)((mixer * 16 + b) * 4 + hq) * 36) + qtile) * 8192 + hi * 1024 + ((qsub & 1) * 32 + r32) * 16;
#pragma unroll
      for (int d0 = 0; d0 < 4; ++d0) qr[d0] = *(const h16x8*)(qp + d0 * 2048); }
    float mhat = 0.f, l_reg = 0.f; f32x16 o[2]; o[0] = f32x16{}; o[1] = f32x16{}; f32x16 negm = f32x16{}; asm volatile("" : "+v"(negm));
    const int tq = qb * 128 + qsub * 32 + r32;
    const int qrow = 2 * qb + (qsub >> 1);
    const int qcl = tq & 63; const int r0w = min(max(qrow - 4, 0), 24), c0q = min(max(qcl - 8, 0), 48);
#define CMASK(P0, P1, s) do { if (MIXER != 0 && (s) >= 4) { const float NEGI = -INFINITY; const int j_ = jlo + (s) - 4; \
        if ((s) >= nreal) { _Pragma("unroll") for (int r = 0; r < 16; ++r) { P0[r] = NEGI; P1[r] = NEGI; } } \
        else if (MIXER == 1) { const int dt = tq - 64 * j_; \
            _Pragma("unroll") for (int r = 0; r < 16; ++r) { const int kk = crow(r, hi); P0[r] = ((unsigned)(kk - dt + 128) <= 256u) ? P0[r] : NEGI; P1[r] = ((unsigned)(kk + 32 - dt + 128) <= 256u) ? P1[r] : NEGI; } } \
        else { const bool rowok = (j_ >= r0w) && (j_ <= r0w + 7); const int jr_ = rowok ? j_ : r0w; \
            const FG_LAS float* tb = (const FG_LAS float*)(lds + LDS_RPB) + g * 465 + (jr_ - qrow + 7) * 31 + (15 - qcl); \
            _Pragma("unroll") for (int r = 0; r < 16; ++r) { const int kc = crow(r, hi); \
                { const bool ok = rowok && ((unsigned)(kc - c0q) < 16u); const float bv = tb[ok ? kc : qcl]; P0[r] = ok ? P0[r] + bv : NEGI; } \
                { const int kc1 = kc + 32; const bool ok = rowok && ((unsigned)(kc1 - c0q) < 16u); const float bv = tb[ok ? kc1 : qcl]; P1[r] = ok ? P1[r] + bv : NEGI; } } } } } while (0)
    bool resc = false;
#define START(P0, P1) do { const float rm = rowmax(P0, P1); resc = false; \
    { const float dl = rm; mhat = fadd_s(mhat, dl); \
      _Pragma("unroll") for (int r = 0; r < 16; ++r) { P0[r] = fsub_s(P0[r], dl); P1[r] = fsub_s(P1[r], dl); } \
      _Pragma("unroll") for (int r = 0; r < 16; ++r) negm[r] = -mhat; asm volatile("" : "+v"(negm)); } \
    _Pragma("unroll") for (int r = 0; r < 16; ++r) P0[r] = __builtin_amdgcn_exp2f(P0[r]); } while (0)
#define RESC() do { if (resc) { asm volatile("s_waitcnt lgkmcnt(0)" ::: "memory"); \
      _Pragma("unroll") for (int d_ = 0; d_ < 2; ++d_) _Pragma("unroll") for (int r = 0; r < 16; ++r) o[d_][r] *= wsf[crow(r, hi)]; } } while (0)
    f32x16 pA0, pA1, pB0, pB1;
    int sl_prev = 0, sl_cur = 0, sl_next = SLOTB;
#define ROT() do { sl_prev = sl_cur; sl_cur = sl_next; sl_next = (sl_next == (NSLOT - 1) * SLOTB) ? 0 : sl_next + SLOTB; } while (0)
    DMA_K(2, 2 * SLOTB);
    WAIT_BAR(3);
    qkt(pA0, pA1, shm3 + LDS_K, qr, negm, r32, hi); asm volatile("s_nop 15\n\ts_nop 7" : "+v"(pA0), "+v"(pA1));
    START(pA0, pA1);
#pragma unroll
    for (int r = 0; r < 16; ++r) pA1[r] = __builtin_amdgcn_exp2f(pA1[r]);
    WAIT_BAR(0);
    DMA_K(3, 0); DMA_V(1, SLOTB);
    ROT();
    kload8(kf, kp0 + sl_cur);
    WAIT_BAR(2);
    s16x4 vlo[8], vhi[8]; u32x4 pw0, pw1, pw2, pw3;
    typedef short s8v __attribute__((ext_vector_type(8)));
#define PKW(P, B) pk_h2(P[B], P[B + 1])
#define PAF(k) __builtin_bit_cast(h16x8, pw##k)
#define VFR(i) __builtin_bit_cast(h16x8, (s8v){vlo[i][0], vlo[i][1], vlo[i][2], vlo[i][3], vhi[i][0], vhi[i][1], vhi[i][2], vhi[i][3]})
#define PIN(x) asm volatile("" : "+v"(x))
#define MX3(a, b, c) __builtin_fmaxf(__builtin_fmaxf((a), (b)), (c))
#define GAPA(MF, A0, A1, A2, A3, W0, W1, PW) do { MF; sacc += A0; sacc += A1; sacc += A2; sacc += A3; PIN(sacc); W0; W1; PIN(PW); SBAR(); } while (0)
#define EX(v) __builtin_amdgcn_exp2f(v)
#define GAPB(MF, X, B) do { MF; X[B] = EX(X[B]); X[B + 1] = EX(X[B + 1]); X[B + 2] = EX(X[B + 2]); X[B + 3] = EX(X[B + 3]); PIN(X); SBAR(); } while (0)
#define VRD(i) do { vlo[i] = vtr(vp_ + (((i) >> 2) * 4096 + ((i) & 3) * 1024)); vhi[i] = vtr(vp_ + (((i) >> 2) * 4096 + ((i) & 3) * 1024 + 512)); } while (0)
#define KRD(G, j) do { if (G) { kload2(kf, kp0 + sl_next, j); SBAR(); } } while (0)
#define MF32(a, b, c) __builtin_amdgcn_mfma_f32_32x32x16_f16(a, b, c, 0, 0, 0)
#define STEP(C0, C1, P0, P1, t, GK, GV, GL) do { SBAR(); \
    const lds_cptr vp_ = vp0 + sl_prev; \
    VRD(0); SBAR(); float sacc = (P0[0] + P0[1]); \
    GAPA(C0 = MF32(kf[0], qr[0], negm), P0[2], P0[3], P0[4], P0[5],     pw0[0] = PKW(P0, 0), pw0[1] = PKW(P0, 2), pw0); \
    VRD(4); SBAR(); GAPA(C1 = MF32(kf[1], qr[0], negm), P0[6], P0[7], P0[8], P0[9],     pw0[2] = PKW(P0, 4), pw0[3] = PKW(P0, 6), pw0); \
    VRD(1); SBAR(); GAPA(C0 = MF32(kf[2], qr[1], C0),   P0[10], P0[11], P0[12], P0[13], pw1[0] = PKW(P0, 8), pw1[1] = PKW(P0, 10), pw1); \
    VRD(5); SBAR(); GAPA(C1 = MF32(kf[3], qr[1], C1),   P0[14], P0[15], P1[0], P1[1],   pw1[2] = PKW(P0, 12), pw1[3] = PKW(P0, 14), pw1); \
    VRD(2); SBAR(); GAPA(C0 = MF32(kf[4], qr[2], C0),   P1[2], P1[3], P1[4], P1[5],     pw2[0] = PKW(P1, 0), pw2[1] = PKW(P1, 2), pw2); \
    VRD(6); SBAR(); GAPA(C1 = MF32(kf[5], qr[2], C1),   P1[6], P1[7], P1[8], P1[9],     pw2[2] = PKW(P1, 4), pw2[3] = PKW(P1, 6), pw2); \
    VRD(3); SBAR(); GAPA(C0 = MF32(kf[6], qr[3], C0),   P1[10], P1[11], P1[12], P1[13], pw3[0] = PKW(P1, 8), pw3[1] = PKW(P1, 10), pw3); \
    VRD(7); SBAR(); GAPA(C1 = MF32(kf[7], qr[3], C1),   P1[14], P1[15], 0.f, 0.f,       pw3[2] = PKW(P1, 12), pw3[3] = PKW(P1, 14), pw3); \
    l_reg += sacc; \
    if (GK) { DMA_K((t) + 3, sl_cur); } if (GV) { DMA_V((t) + 1, sl_next); } \
    CMASK(C0, C1, t); \
    { float a = MX3(C0[0], C0[1], C1[0]), b_ = MX3(C0[2], C0[3], C1[1]); a = MX3(a, C1[2], C1[3]); \
      _Pragma("unroll") for (int r = 4; r < 16; r += 4) { a = MX3(a, C0[r], C0[r + 1]); b_ = MX3(b_, C0[r + 2], C0[r + 3]); a = MX3(a, C1[r], C1[r + 1]); b_ = MX3(b_, C1[r + 2], C1[r + 3]); } \
      float rm = __builtin_fmaxf(a, b_); { auto rr = __builtin_amdgcn_permlane32_swap(__float_as_uint(rm), __float_as_uint(rm), false, false); rm = __builtin_fmaxf(__uint_as_float(rr[0]), __uint_as_float(rr[1])); } \
      resc = false; \
      if (__builtin_expect(__any(rm > (float)THRL), 0)) { const float dl = __builtin_fmaxf(rm, 0.f); mhat += dl; \
        _Pragma("unroll") for (int r = 0; r < 16; ++r) { C0[r] -= dl; C1[r] -= dl; } \
        _Pragma("unroll") for (int r = 0; r < 16; ++r) negm[r] = -mhat; asm volatile("" : "+v"(negm)); \
        const float f = __builtin_amdgcn_exp2f(-dl); l_reg *= f; if (hi == 0) wsf[r32] = f; resc = true; } } \
    SBAR(); \
    GAPB(o[0] = MF32(PAF(0), VFR(0), o[0]), C0, 0); \
    GAPB(o[1] = MF32(PAF(0), VFR(4), o[1]), C0, 4); \
    KRD(GL, 0); GAPB(o[0] = MF32(PAF(1), VFR(1), o[0]), C0, 8); \
    KRD(GL, 1); GAPB(o[1] = MF32(PAF(1), VFR(5), o[1]), C0, 12); \
    KRD(GL, 2); GAPB(o[0] = MF32(PAF(2), VFR(2), o[0]), C1, 0); \
    KRD(GL, 3); GAPB(o[1] = MF32(PAF(2), VFR(6), o[1]), C1, 4); \
    GAPB(o[0] = MF32(PAF(3), VFR(3), o[0]), C1, 8); \
    GAPB(o[1] = MF32(PAF(3), VFR(7), o[1]), C1, 12); \
    } while (0)
    int t = 1;
    for (; t + 5 < NT; t += 2) {
        STEP(pB0, pB1, pA0, pA1, t, true, true, true);     WAIT_BAR(2); RESC(); ROT();
        STEP(pA0, pA1, pB0, pB1, t + 1, true, true, true); WAIT_BAR(2); RESC(); ROT();
    }
#define ENDW(tt) do { if ((tt) + 3 < NT) { WAIT_BAR(2); } else if ((tt) + 2 < NT) { WAIT_BAR(1); } else { WAIT_BAR(0); } } while (0)
    for (; t + 1 < NT; t += 2) {
        STEP(pB0, pB1, pA0, pA1, t, (t + 3 < NT), (t + 1 < NT), (t + 1 < NT));         ENDW(t);     RESC(); ROT();
        STEP(pA0, pA1, pB0, pB1, t + 1, (t + 4 < NT), (t + 2 < NT), (t + 2 < NT));     ENDW(t + 1); RESC(); ROT();
    }
    STEP(pB0, pB1, pA0, pA1, NT - 1, false, false, false); RESC();
    unsigned nraw = 0u; if (tid == 0) nraw = __hip_atomic_fetch_add(qctr, 1u, __ATOMIC_RELAXED, __HIP_MEMORY_SCOPE_AGENT);
    { float sacc = pB0[0] + pB0[1];
#pragma unroll
      for (int r = 2; r < 16; ++r) sacc += pB0[r];
#pragma unroll
      for (int r = 0; r < 16; ++r) sacc += pB1[r];
      l_reg += sacc;
      pw0 = (u32x4){PKW(pB0, 0), PKW(pB0, 2), PKW(pB0, 4), PKW(pB0, 6)}; pw1 = (u32x4){PKW(pB0, 8), PKW(pB0, 10), PKW(pB0, 12), PKW(pB0, 14)};
      pw2 = (u32x4){PKW(pB1, 0), PKW(pB1, 2), PKW(pB1, 4), PKW(pB1, 6)}; pw3 = (u32x4){PKW(pB1, 8), PKW(pB1, 10), PKW(pB1, 12), PKW(pB1, 14)};
      SBAR(); pv(o, vp0 + sl_cur, PAF(0), PAF(1), PAF(2), PAF(3)); }
    { auto rr = __builtin_amdgcn_permlane32_swap(__float_as_uint(l_reg), __float_as_uint(l_reg), false, false); l_reg = __uint_as_float(rr[0]) + __uint_as_float(rr[1]); }
    if (mixer == 1) l_reg += __builtin_amdgcn_exp2f(sinkp[hq] * LOG2E - mhat);
    if (hi == 0) wsf[32 + r32] = l_reg; asm volatile("s_waitcnt lgkmcnt(0)" ::: "memory");
    float rli[16];
#pragma unroll
    for (int r = 0; r < 16; ++r) rli[r] = __builtin_amdgcn_rcpf(wsf[32 + crow(r, hi)]);
    h16* Ow = br + (size_t)q0 * DM + brcol;
    { FG_LAS h16* stg = (FG_LAS h16*)(lds + LDS_OST) + wid * 2048;
#pragma unroll
      for (int r = 0; r < 16; ++r) { const int orow = crow(r, hi);
#pragma unroll
          for (int d0 = 0; d0 < 2; ++d0) stg[orow * 64 + d0 * 32 + r32] = (h16)(o[d0][r] * rli[r]); }
      asm volatile("s_waitcnt lgkmcnt(0)" ::: "memory");
#pragma unroll
      for (int i = 0; i < 4; ++i) { const int row = i * 8 + (lane >> 3), ch = lane & 7; const u32x4 v = *(const FG_LAS u32x4*)(stg + row * 64 + ch * 8); *(u32x4*)(Ow + (size_t)row * DM + ch * 8) = v; } }
    if (tid == 0) qw[0] = nraw;
    asm volatile("s_waitcnt lgkmcnt(0)\n\ts_barrier" ::: "memory");
#undef FA_TILE
#undef DMA_K
#undef DMA_V
#undef CMASK
#undef START
#undef RESC
#undef ROT
#undef PKW
#undef PAF
#undef VFR
#undef PIN
#undef MX3
#undef GAPA
#undef GAPB
#undef EX
#undef VRD
#undef KRD
#undef MF32
#undef STEP
#undef ENDW
}
#undef SBAR
#undef WAIT_BAR
}
struct SchedTwo { fg::Unit u0, u1; __device__ __forceinline__ bool next(int i, fg::Unit& o) const { if (i == 0) { o = u0; return true; } if (i == 1) { o = u1; return true; } return false; } };
struct EpiDftSym {
    static constexpr bool PERM = true;
    h16* br; unsigned char* scr;
    __device__ __forceinline__ void operator()(const f32x4 (&acc)[2][2][4][2], const fg::Unit& u, int wr, int wc, int fr, int fq) const {
        const int tid = tidx(); const float scl = 0.022097086912079608f;
        if (u.aux == 0) {
#pragma unroll
            for (int ai = 0; ai < 2; ++ai)
#pragma unroll
                for (int m = 0; m < 4; ++m)
#pragma unroll
                    for (int bj = 0; bj < 2; ++bj)
#pragma unroll
                        for (int n = 0; n < 2; ++n) { const int q = ((ai * 4 + m) * 2 + bj) * 2 + n; *(f32x4*)(scr + ((size_t)q * 512 + tid) * 16) = acc[ai][bj][m][n]; }
        } else {
#pragma unroll
            for (int ai = 0; ai < 2; ++ai) {
                f32x4 pv[4][2][2];
#pragma unroll
                for (int m = 0; m < 4; ++m)
#pragma unroll
                    for (int bj = 0; bj < 2; ++bj)
#pragma unroll
                        for (int n = 0; n < 2; ++n) { const int q = ((ai * 4 + m) * 2 + bj) * 2 + n; pv[m][bj][n] = *(const f32x4*)(scr + ((size_t)q * 512 + tid) * 16); }
                asm volatile("" ::: "memory");
#pragma unroll
                for (int m = 0; m < 4; ++m) { const int k = u.pm * 256 + 128 * ai + 64 * wr + 16 * m + fr + 1;
                    h16* lo = br + ((size_t)u.pn * 2048 + k) * DM + 256; h16* hi = br + ((size_t)u.pn * 2048 + (2048 - k)) * DM + 256;
#pragma unroll
                    for (int bj = 0; bj < 2; ++bj) { const int col = 128 * bj + 32 * wc + 8 * fq;
                        const f32x4 p0 = pv[m][bj][0], p1 = pv[m][bj][1];
                        const f32x4 q0v = acc[ai][bj][m][0], q1v = acc[ai][bj][m][1];
                        const f32x4 a0 = (p0 - q0v) * scl, a1 = (p1 - q1v) * scl, b0 = (p0 + q0v) * scl, b1 = (p1 + q1v) * scl;
                        *(u32x4*)(lo + col) = (u32x4){pk_h2(a0[0], a0[1]), pk_h2(a0[2], a0[3]), pk_h2(a1[0], a1[1]), pk_h2(a1[2], a1[3])};
                        *(u32x4*)(hi + col) = (u32x4){pk_h2(b0[0], b0[1]), pk_h2(b0[2], b0[3]), pk_h2(b1[0], b1[1]), pk_h2(b1[2], b1[3])}; } }
                asm volatile("" ::: "memory");
            }
        }
    }
};
struct SchedOne { fg::Unit u; __device__ __forceinline__ bool next(int i, fg::Unit& o) const { if (i != 0) return false; o = u; return true; } };
__device__ __forceinline__ void phase_mixers(const Params& p, int l, ldsp_t lds, int rep = 0) {
    const unsigned char* QI = p.ws + WS_QI; const unsigned char* KI = p.ws + WS_KI; const unsigned char* VI = p.ws + WS_VI; h16* br = (h16*)(p.ws + WS_BR);
    const float* sinkp = p.sink + l * 4; const float* rpb = p.rpb + (size_t)l * 4 * 465;
    const int x = bidx() & 7;
    unsigned* qctr = (unsigned*)(p.ws + WS_CTL) + 64 * (rep * 16 + l * 8 + x) + 32;
    volatile FG_LAS unsigned* qw = (volatile FG_LAS unsigned*)(lds + LDS_BYTES - 512);
    const int nq = (l == 0) ? 226 : 200;
    const int tid = tidx();
    if (rep == 0) fourier_row0(p);
    __syncthreads();
    bool have = false;
    for (;;) {
        if (!have && tid == 0) qw[0] = __hip_atomic_fetch_add(qctr, 1u, __ATOMIC_RELAXED, __HIP_MEMORY_SCOPE_AGENT);
        __syncthreads();
        int idx = (int)qw[0];
        have = false;
        if (idx >= nq) break;
        if (l == 0 && idx >= 72) idx = idx < 74 ? idx + 152 : idx - 2;
        if (rep > 0) { const bool isdft = idx < 8 || idx >= 224; if ((PROBE_MODE == 1 && isdft) || (PROBE_MODE == 2 && !isdft)) continue; }
        if (idx < 8) {
            const int id = idx;
            SchedTwo S; S.u0.pm = id & 3; S.u0.pn = 2 * x + (id >> 2); S.u0.nt = 32; S.u0.aux = 0;
            S.u0.A = (const char*)(p.ws + WS_DFT) + (size_t)S.u0.pm * 256 * 4096 * 2; S.u0.B = (const char*)(p.ws + WS_ZTL) + (size_t)S.u0.pn * 256 * 4096 * 2;
            S.u1 = S.u0; S.u1.aux = 1; S.u1.A += 4096; S.u1.B += 4096;
            EpiDftSym E{br, p.ws + WS_GSCR + (size_t)bidx() * 262144};
            fg::gemm_phase<EpiDftSym, SchedTwo, 4096>(lds, S, E);
        } else if (idx < 200) {
            const int w = (idx - 8) & 63; const int ty = (idx - 8) >> 6;
            if (ty == 0) { fa::attn_unit<0, 8>(QI, KI, VI, br, sinkp, rpb, 0, 2 * x + (w >> 5), (w >> 4) & 1, w & 15, false, lds, qctr, qw); }
            else if (ty == 1) { fa::attn_unit<2, 8>(QI, KI, VI, br, sinkp, rpb, 2, 2 * x + (w >> 5), (w >> 4) & 1, w & 15, false, lds, qctr, qw); }
            else { fa::attn_unit<1, 8>(QI, KI, VI, br, sinkp, rpb, 1, 2 * x + (w >> 5), (w >> 4) & 1, w & 15, false, lds, qctr, qw); }
            have = true;
        } else if (idx < 224) {
            const int w = idx - 200; const int mixer = w >> 3, rest = w & 7;
            fa::attn_unit<0, 8>(QI, KI, VI, br, sinkp, rpb, mixer, 2 * x + (rest >> 2), (rest >> 1) & 1, rest & 1, true, lds, qctr, qw); have = true;
        } else {
            SchedOne S; S.u.pm = 0; S.u.pn = 2 * x + (idx - 224); S.u.nt = 8; S.u.aux = 0;
            S.u.A = (const char*)(p.ws + WS_DFTC); S.u.B = (const char*)(p.ws + WS_ZTC) + (size_t)S.u.pn * 256 * 512 * 2;
            EpiDft E{br, TL, 256, 0.0625f};
            fg::gemm_phase<EpiDft, SchedOne, 512>(lds, S, E);
        }
    }
    __syncthreads();
}

#define XB_TMO      128
#define XB_XCNT(j)  (256  + 64 * (j))
#define XB_XSUB(j)  (1280 + 64 * (j))
#define XB_XGEN(j)  (2304 + 64 * (j))
#define XB_TOP      3328
#define XB_TOPGEN   3392
#define XB_SPIN_CAP (1u << 22)
__device__ __forceinline__ unsigned xb_ld(unsigned* p)              { return __hip_atomic_load(p, __ATOMIC_RELAXED, __HIP_MEMORY_SCOPE_AGENT); }
__device__ __forceinline__ unsigned xb_add(unsigned* p, unsigned v) { return __hip_atomic_fetch_add(p, v, __ATOMIC_RELAXED, __HIP_MEMORY_SCOPE_AGENT); }
__device__ __forceinline__ unsigned xb_xcc_id() { return (unsigned)__builtin_amdgcn_s_getreg((3 << 11) | 20) & 0xFu; }
#define XB_SPIN(cond, bar) do { unsigned _sp = 0; while (cond) { __builtin_amdgcn_s_sleep(1); \
    if ((++_sp & 255u) == 0u) { if (xb_ld(&(bar)[XB_TMO])) break; if (_sp > XB_SPIN_CAP) { atomicAdd(&(bar)[XB_TMO], 1u); break; } } } } while (0)
struct XcdBarrier { unsigned* bar; unsigned x; volatile FG_LAS unsigned* st; };
__device__ __forceinline__ XcdBarrier xcd_barrier_post(unsigned* bar, volatile FG_LAS unsigned* st) {
    XcdBarrier b; b.bar = bar; b.x = xb_xcc_id(); b.st = st;
    if (threadIdx.x == 0) (void)xb_add(&bar[XB_XCNT(b.x)], 1u);
    return b;
}
__device__ __forceinline__ void xcd_barrier_complete(unsigned* bar, unsigned x, unsigned& nloc, unsigned& nx) {
    const unsigned G = gridDim.x * gridDim.y * gridDim.z;
    unsigned sum, cnt, mine, sp = 0u;
    for (;;) {
        sum = 0u; cnt = 0u; mine = 0u;
#pragma unroll
        for (unsigned j = 0; j < 16; ++j) { const unsigned c = xb_ld(&bar[XB_XCNT(j)]); sum += c; cnt += (c > 0u) ? 1u : 0u; mine = (j == x) ? c : mine; }
        if (sum == G) break;
        __builtin_amdgcn_s_sleep(1);
        if ((++sp & 255u) == 0u) { if (xb_ld(&bar[XB_TMO])) break; if (sp > XB_SPIN_CAP) { atomicAdd(&bar[XB_TMO], 1u); break; } }
    }
    nloc = mine > 0u ? mine : 1u; nx = cnt > 0u ? cnt : 1u;
}
__device__ __forceinline__ void xcd_barrier(const XcdBarrier& b) {
    asm volatile("s_waitcnt vmcnt(0)" ::: "memory");
    unsigned* bar = b.bar; unsigned bx = __builtin_amdgcn_readfirstlane(b.x); asm volatile("" : "+s"(bar), "+s"(bx));
    __syncthreads();
    if (tidx() == 0) {
        __builtin_amdgcn_s_waitcnt(0);
        unsigned nloc = b.st[0], nx = b.st[1];
        if (nloc == 0u) { xcd_barrier_complete(bar, bx, nloc, nx); b.st[0] = nloc; b.st[1] = nx; }
        const unsigned old = xb_add(&bar[XB_XSUB(bx)], 1u);
        const unsigned gen = old / nloc;
        if (old + 1u == (gen + 1u) * nloc) {
            __builtin_amdgcn_fence(__ATOMIC_RELEASE, "agent");
            asm volatile("s_waitcnt vmcnt(0)" ::: "memory");
            const unsigned og = xb_add(&bar[XB_TOP], 1u);
            const unsigned tg = og / nx;
            if (og + 1u == (tg + 1u) * nx) xb_add(&bar[XB_TOPGEN], 1u);
            else XB_SPIN(xb_ld(&bar[XB_TOPGEN]) == tg, bar);
            __builtin_amdgcn_fence(__ATOMIC_ACQUIRE, "agent");
            xb_add(&bar[XB_XGEN(bx)], 1u);
            asm volatile("s_waitcnt vmcnt(0)" ::: "memory");
        } else {
            XB_SPIN(xb_ld(&bar[XB_XGEN(bx)]) == gen, bar);
            __builtin_amdgcn_fence(__ATOMIC_ACQUIRE, "agent");
            asm volatile("s_waitcnt vmcnt(0)" ::: "memory");
        }
    }
    __syncthreads();
}

__device__ __forceinline__ void xcd_barrier_arrive(const XcdBarrier& b) {
    asm volatile("s_waitcnt vmcnt(0)" ::: "memory");
    unsigned* bar = b.bar; unsigned bx = __builtin_amdgcn_readfirstlane(b.x); asm volatile("" : "+s"(bar), "+s"(bx));
    __syncthreads();
    if (tidx() == 0) {
        __builtin_amdgcn_s_waitcnt(0);
        unsigned nloc = b.st[0], nx = b.st[1];
        if (nloc == 0u) { xcd_barrier_complete(bar, bx, nloc, nx); b.st[0] = nloc; b.st[1] = nx; }
        const unsigned old = xb_add(&bar[XB_XSUB(bx)], 1u);
        const unsigned gen = old / nloc;
        unsigned mode = 0u, tg = 0u;
        if (old + 1u == (gen + 1u) * nloc) {
            __builtin_amdgcn_fence(__ATOMIC_RELEASE, "agent");
            asm volatile("s_waitcnt vmcnt(0)" ::: "memory");
            const unsigned og = xb_add(&bar[XB_TOP], 1u);
            tg = og / nx; mode = 1u;
            if (og + 1u == (tg + 1u) * nx) { xb_add(&bar[XB_TOPGEN], 1u); mode = 2u; }
            xb_add(&bar[XB_XGEN(bx)], 1u);
        }
        b.st[2] = mode; b.st[3] = gen; b.st[4] = tg;
    }
    __syncthreads();
}
__device__ __forceinline__ void xcd_barrier_wait(const XcdBarrier& b) {
    unsigned* bar = b.bar; unsigned bx = __builtin_amdgcn_readfirstlane(b.x); asm volatile("" : "+s"(bar), "+s"(bx));
    __syncthreads();
    if (tidx() == 0) {
        const unsigned mode = b.st[2], gen = b.st[3];
        if (mode != 2u) XB_SPIN(xb_ld(&bar[XB_TOPGEN]) == gen, bar);
        __builtin_amdgcn_fence(__ATOMIC_ACQUIRE, "agent");
        asm volatile("s_waitcnt vmcnt(0)" ::: "memory");
    }
    __syncthreads();
}

__global__ void __launch_bounds__(NTHREADS) mk_fwd(Params p_in) {
    extern __shared__ __attribute__((aligned(16))) unsigned char lds_raw[];
    float* lds = (float*)lds_raw; ldsp_t ldsf = (ldsp_t)lds_raw;
    cg::grid_group grid = cg::this_grid();
    volatile FG_LAS unsigned* misc = (volatile FG_LAS unsigned*)(ldsf + LDS_BYTES - 256);
    if (threadIdx.x < 32) misc[threadIdx.x] = (threadIdx.x == 16) ? blockIdx.x : 0u;
    __syncthreads();
    XcdBarrier xbar = xcd_barrier_post((unsigned*)(ldp().ws + WS_CTL) + 4096, misc + 8);
#define GSYNC() do { xcd_barrier_arrive(xbar); xcd_barrier_wait(xbar); } while (0)
    unsigned* cen = (unsigned*)(ldp().ws + WS_CTL) + 2048;
    if (threadIdx.x == 0) misc[17] = __hip_atomic_fetch_add(cen + 64 * xb_xcc_id(), 1u, __ATOMIC_RELAXED, __HIP_MEMORY_SCOPE_AGENT);
    for (int r_ = 0; r_ < RP_P0; ++r_) phase0(ldp(), lds);
    dense_transposes(ldp(), lds);
    if (ldp().ws == nullptr) grid.sync();
    GSYNC();
    if (threadIdx.x == 0) { bool ok = (gridDim.x == 256);
        for (int j = 0; j < 16; ++j) { const unsigned cj = __hip_atomic_load(cen + 64 * j, __ATOMIC_RELAXED, __HIP_MEMORY_SCOPE_AGENT); ok = ok && (cj == (j < 8 ? 32u : 0u)); }
        if (ok) misc[16] = misc[17] * 8u + xb_xcc_id(); }
    __syncthreads();
    phase_convert_dense(ldp(), lds, ldsf);
    phase_wg(ldp());
    for (int r_ = 0; r_ < RP_U; ++r_) phase_u(ldp(), 0);
    GSYNC();
    for (int l = 0; l < DEPTH; ++l) {
        for (int r_ = 0; r_ < RP_G1; ++r_) phase_g1_fast(ldp(), l, ldsf);
        xcd_barrier_arrive(xbar);
        if (l == 0 ? ((bidx() & 7) >= 4) : (bidx() >= 48)) bg_convert(ldp(), l, lds, BG_G1, true);
        xcd_barrier_wait(xbar);
        for (int r_ = 0; r_ < RP_ATT; ++r_) phase_mixers(ldp(), l, ldsf, r_);
        xcd_barrier_arrive(xbar);
        phase_merge_fast(ldp(), l, ldsf, 0, 1);
        xcd_barrier_wait(xbar);
        phase_merge_fast(ldp(), l, ldsf, 1, 18);
        GSYNC();
        if (l == 0) { phase_merge_sum(ldp()); xcd_barrier_arrive(xbar); }
        phase_out_fast(ldp(), l, ldsf, 0, 2);
        if (l == 0) {
            if ((bidx() & 7) >= 2) bg_convert(ldp(), 0, lds, BG_OUT, true);
            xcd_barrier_wait(xbar);
            phase_out_fast(ldp(), l, ldsf, 2, 3); }
        xcd_barrier_arrive(xbar);
        phase_ln1_fill(ldp(), l, lds);
        xcd_barrier_wait(xbar);
        phase_ln1(ldp(), l, lds);
        GSYNC();
        for (int r_ = 0; r_ < RP_TOPK; ++r_) phase_topk(ldp(), l, lds);
        xcd_barrier_arrive(xbar);
        bg_convert(ldp(), l, lds, 1 << 20);
        xcd_barrier_wait(xbar);
        for (int r_ = 0; r_ < RP_UP; ++r_) phase_up_fast(ldp(), l, ldsf);
        GSYNC();
        for (int r_ = 0; r_ < RP_DN; ++r_) phase_down_fast(ldp(), l, ldsf);
        if (l == 0 && (bidx() & 7) >= 4) bg_convert(ldp(), 1, lds, BG_DN, true);
        GSYNC();
        for (int r_ = 0; r_ < (l == 1 ? RP_LN2 : 1); ++r_) phase_ln2(ldp(), l, lds);
        if (l == 0) GSYNC();
    }
}

extern "C" void kernel_launch(void* const* d_in, const int* in_sizes, int n_in, void* d_out, int out_size, void* d_ws, size_t ws_size, hipStream_t stream) {
    static int grid = 0;
    if (grid == 0) {
        if (n_in != 20 || ws_size < WS_END) { fprintf(stderr, "kernel_launch: unexpected n_in %d or ws_size %zu (need %zu)\n", n_in, ws_size, (size_t)WS_END); grid = -1; return; }
        int dev = 0, cus = 0, per_cu = 0;
        hipGetDevice(&dev); hipDeviceGetAttribute(&cus, hipDeviceAttributeMultiprocessorCount, dev);
        hipFuncSetAttribute((const void*)mk_fwd, hipFuncAttributeMaxDynamicSharedMemorySize, LDS_BYTES);
        hipOccupancyMaxActiveBlocksPerMultiprocessor(&per_cu, (const void*)mk_fwd, NTHREADS, LDS_BYTES);
        if (per_cu < 1) { fprintf(stderr, "kernel_launch: occupancy query says %d blocks per CU\n", per_cu); per_cu = 1; }
        (void)hipGetLastError();
        if (cus * per_cu < 256) { fprintf(stderr, "kernel_launch: needs 256 co-resident workgroups, device offers %d x %d\n", cus, per_cu); grid = -1; return; }
        grid = 256;
    }
    if (grid < 0) return;
    hipMemsetAsync((char*)d_ws + WS_CTL, 0, 64 * 1024, stream);
    Params p{};
    const float** pp = (const float**)&p;
    for (int i = 0; i < 20; ++i) pp[i] = (const float*)d_in[i];
    p.out = (float*)d_out; p.ws = (unsigned char*)d_ws;
    void* args[] = {&p};
    hipError_t e = hipLaunchCooperativeKernel((const void*)mk_fwd, dim3(grid), dim3(NTHREADS), args, LDS_BYTES, stream);
    if (e != hipSuccess) fprintf(stderr, "cooperative launch failed: %s (grid %d)\n", hipGetErrorString(e), grid);
}
```

```cpp
#include <hip/hip_runtime.h>
#include <hip/hip_cooperative_groups.h>
#include <cstdio>
#include <cstdint>
#include <type_traits>
namespace cg = cooperative_groups;

typedef _Float16 h16;
typedef _Float16 h16x8 __attribute__((ext_vector_type(8)));
typedef _Float16 h16x4 __attribute__((ext_vector_type(4)));
typedef float f32x4 __attribute__((ext_vector_type(4)));

constexpr int DM = 1024, NBATCH = 16, SEQ = 2048, CTX = 256, DEPTH = 2;
constexpr int TL = NBATCH * SEQ;
constexpr int TC = NBATCH * CTX;
constexpr int TT = TL + TC;
constexpr int INW = 5888, NMOD = 6 * DM, PMW = 1536;
constexpr int NEXP = 16, FF = 1024, CAPL = 256, CAPC = 32;
constexpr int GL = NBATCH * NEXP * CAPL;
constexpr int GC = NBATCH * NEXP * CAPC;
constexpr int GT = GL + GC;
constexpr float ALPHA = 1.4142135623730951f;
constexpr float LN_EPS = 1e-6f, RMS_EPS = 1e-6f;
constexpr int NTHREADS = 512, NWAVES = 8;
constexpr int LDS_BYTES = 147456;
constexpr int BG_G1 = 2, BG_OUT = 3, BG_DN = 1;
constexpr int PROBE_MODE = 0, RP_P0 = 1, RP_LN2 = 1;
constexpr int RP_G1 = 1, RP_FOU = 1, RP_MRG = 1, RP_OUT = 1, RP_UP = 1, RP_DN = 1, RP_ATT = 1, RP_U = 1, RP_TOPK = 1;


constexpr size_t MiB = 1u << 20;
constexpr size_t WS_CTL = 0;
constexpr size_t WS_MODV = 1 * MiB;
constexpr size_t WS_WFIN = 2 * MiB;
constexpr size_t WS_BDT = 3 * MiB;
constexpr size_t WS_TAB = 6 * MiB;
constexpr size_t WS_AFFL = 7 * MiB;
constexpr size_t WS_AFFC = 9 * MiB;
constexpr size_t WS_SELW = 10 * MiB;
constexpr size_t WS_STAT = 9 * MiB + 512 * 1024;
constexpr size_t WS_SELR = 10 * MiB + 512 * 1024;
constexpr size_t WS_SLOT = 11 * MiB;
constexpr size_t WS_WG = 13 * MiB + 512 * 1024;
constexpr size_t WS_SGB = 15 * MiB + 768 * 1024;
constexpr size_t WS_HB = 16 * MiB;
constexpr size_t WS_S = 160 * MiB;
constexpr size_t WS_U16 = WS_S;
constexpr size_t WS_PM = WS_S + 72 * MiB;
constexpr size_t WS_QI = WS_PM;
constexpr size_t WS_KI = WS_PM + 54 * MiB;
constexpr size_t WS_VI = WS_PM + 81 * MiB;
constexpr size_t WS_ZTL = WS_PM + 108 * MiB;
constexpr size_t WS_ZTC = WS_ZTL + 32 * MiB;
constexpr size_t WS_XG = WS_S + 72 * MiB;
constexpr size_t WS_BR = WS_S + 216 * MiB;
constexpr size_t WS_H16 = WS_S + 216 * MiB;
constexpr size_t WS_GSCR = WS_S + 288 * MiB;
constexpr size_t WS_MPART = WS_S + 320 * MiB;
constexpr size_t WS_WINT = WS_S + 360 * MiB;
constexpr size_t WS_WBT = WS_WINT + 24 * MiB;
constexpr size_t WS_WOT = WS_WBT + 4 * MiB;
constexpr size_t WS_DFT = WS_WOT + 4 * MiB;
constexpr size_t WS_DFTC = WS_DFT + 16 * MiB;
constexpr size_t WS_WGU1 = WS_DFTC + 1 * MiB;
constexpr size_t WS_END = WS_WGU1 + 64 * MiB;
constexpr size_t DO_WGU = 0;
constexpr size_t DO_WD = 64 * MiB;
constexpr size_t DO_WD1 = 96 * MiB;

struct Params {
    const float *x, *c, *ctx, *c_ctx, *w_mod, *b_mod, *w_in, *qk_gain, *sink, *rpb, *w_branch, *w_out, *ln1_g, *ln1_b, *w_router, *w_gate, *w_up, *w_down, *ln2_g, *ln2_b;
    float* out; unsigned char* ws;
};
typedef const __attribute__((address_space(4))) Params* kargp_t;
#if defined(__HIP_DEVICE_COMPILE__)
__device__ __forceinline__ Params ldp() { kargp_t q = (kargp_t)__builtin_amdgcn_kernarg_segment_ptr(); asm volatile("" : "+s"(q)); return *q; }
#else
__device__ __forceinline__ Params ldp() { return Params{}; }
#endif

#define VCU_LDS_ADDR (LDS_BYTES - 256 + 64)
__device__ __forceinline__ int bidx() { const unsigned v = *(volatile __attribute__((address_space(3))) unsigned*)(VCU_LDS_ADDR); int b = __builtin_amdgcn_readfirstlane((int)v); asm volatile("" : "+s"(b)); return b; }
__device__ __forceinline__ int tidx() { int t = threadIdx.x; asm volatile("" : "+v"(t)); return t; }
template <int CTRL> __device__ __forceinline__ float dpp_f(float v) { return __builtin_bit_cast(float, __builtin_amdgcn_update_dpp(0, __builtin_bit_cast(int, v), CTRL, 0xf, 0xf, true)); }
__device__ __forceinline__ float xor16_sum(float v) { const auto r = __builtin_amdgcn_permlane16_swap(__float_as_uint(v), __float_as_uint(v), false, false); return __uint_as_float(r[0]) + __uint_as_float(r[1]); }
__device__ __forceinline__ float xor32_sum(float v) { const auto r = __builtin_amdgcn_permlane32_swap(__float_as_uint(v), __float_as_uint(v), false, false); return __uint_as_float(r[0]) + __uint_as_float(r[1]); }
__device__ __forceinline__ float xor16_max(float v) { const auto r = __builtin_amdgcn_permlane16_swap(__float_as_uint(v), __float_as_uint(v), false, false); return fmaxf(__uint_as_float(r[0]), __uint_as_float(r[1])); }
__device__ __forceinline__ float xor32_max(float v) { const auto r = __builtin_amdgcn_permlane32_swap(__float_as_uint(v), __float_as_uint(v), false, false); return fmaxf(__uint_as_float(r[0]), __uint_as_float(r[1])); }
__device__ __forceinline__ float wave_sum(float v) {
    v += dpp_f<0xB1>(v);
    v += dpp_f<0x4E>(v);
    v += dpp_f<0x141>(v);
    v += dpp_f<0x140>(v);
    v = xor16_sum(v); v = xor32_sum(v);
    return v;
}
__device__ __forceinline__ float wave_max(float v) {
    v = fmaxf(v, dpp_f<0xB1>(v)); v = fmaxf(v, dpp_f<0x4E>(v)); v = fmaxf(v, dpp_f<0x141>(v)); v = fmaxf(v, dpp_f<0x140>(v));
    v = xor16_max(v); v = xor32_max(v);
    return v;
}
typedef unsigned u32x4 __attribute__((ext_vector_type(4)));
__device__ __forceinline__ unsigned pk_h2(float lo, float hi) { typedef _Float16 h2 __attribute__((ext_vector_type(2))); h2 v = {(h16)lo, (h16)hi}; return __builtin_bit_cast(unsigned, v); }
typedef __bf16 bf16x2_t __attribute__((ext_vector_type(2)));
typedef float f32x2_t __attribute__((ext_vector_type(2)));
typedef short bf16x8_t __attribute__((ext_vector_type(8)));
__device__ __forceinline__ unsigned pk_b2(float lo, float hi) { f32x2_t v = {lo, hi}; bf16x2_t b = __builtin_convertvector(v, bf16x2_t); return __builtin_bit_cast(unsigned, b); }
__device__ __forceinline__ float sigmoid_f(float v) { return __builtin_amdgcn_rcpf(1.f + __builtin_amdgcn_exp2f(v * -1.4426950408889634f)); }
__device__ __forceinline__ float silu_f(float v) { return v * sigmoid_f(v); }
__device__ __forceinline__ float sig2_f(float t) { return __builtin_amdgcn_rcpf(1.f + __builtin_amdgcn_exp2f(t)); }
__device__ __forceinline__ int mv_of(int R) { return R < TL ? (R >> 11) : 16; }

__device__ __forceinline__ void phase0(const Params& p, float* lds) {
    float* modv = (float*)(p.ws + WS_MODV); float* tab = (float*)(p.ws + WS_TAB);
    const int tid = tidx(), lane = tid & 63, wave = tid >> 6, c = bidx(), G = gridDim.x;
    if (c < 192) {
        float* sc = lds;
        float* red = lds + 17 * 1024;
        for (int e = tid; e < 17 * 1024; e += NTHREADS) { const int mv = e >> 10, k = e & 1023; const float v = mv < 16 ? p.c[mv * 1024 + k] : p.c_ctx[k]; sc[e] = silu_f(v); }
        __syncthreads();
        const int col0 = c * 64; const int l = col0 / NMOD, n0 = col0 % NMOD; const int rg = lane >> 4, cq = lane & 15;
        f32x4 acc[17];
#pragma unroll
        for (int m = 0; m < 17; ++m) acc[m] = (f32x4){0.f, 0.f, 0.f, 0.f};
        const float* w = p.w_mod + ((size_t)l * DM + wave * 128 + rg) * NMOD + n0 + cq * 4;
#pragma unroll 4
        for (int i = 0; i < 32; ++i) { const f32x4 wv = *(const f32x4*)(w + (size_t)(4 * i) * NMOD);
#pragma unroll
            for (int m = 0; m < 17; ++m) acc[m] += wv * sc[m * 1024 + wave * 128 + rg + 4 * i]; }
#pragma unroll
        for (int m = 0; m < 17; ++m) {
#pragma unroll
            for (int e = 0; e < 4; ++e) { float v = acc[m][e]; v += __shfl_xor(v, 16); v += __shfl_xor(v, 32); acc[m][e] = v; }
            if (rg == 0) *(f32x4*)(red + (wave * 17 + m) * 64 + cq * 4) = acc[m]; }
        __syncthreads();
        for (int e = tid; e < 17 * 64; e += NTHREADS) { const int m = e >> 6, ln = e & 63; float sacc = 0.f;
#pragma unroll
            for (int wv = 0; wv < 8; ++wv) sacc += red[(wv * 17 + m) * 64 + ln];
            const int nn = n0 + ln; modv[((size_t)l * 17 + m) * NMOD + nn] = sacc + p.b_mod[l * NMOD + nn]; }
        __syncthreads();
    }
    float* cT = lds; float* sT = lds + 2048;
    __syncthreads();
    for (int j = tid; j < 2048; j += NTHREADS) { cT[j] = cospif((float)j / 1024.f); sT[j] = sinpif((float)j / 1024.f); }
    if (c == G - 1) for (int e = tid; e < 64 * 16; e += NTHREADS) { const int pos = e >> 4, j = e & 15; const float inv = powf(10000.f, -(float)j / 16.f); const float ang = (float)pos * inv;
        tab[4096 + e] = cosf(ang); tab[4096 + 1024 + e] = sinf(ang); }
    __syncthreads();
    const int gt = c * NTHREADS + tid, NG = G * NTHREADS;
    { h16* DFT = (h16*)(p.ws + WS_DFT); h16* DFTC = (h16*)(p.ws + WS_DFTC);
      for (int o = gt; o < 1024 * 512 + 256 * 64; o += NG) {
        unsigned w[4];
        if (o < 1024 * 512) { const int k = (o >> 9) + 1, j0 = (o & 511) * 8;
#pragma unroll
            for (int q = 0; q < 4; ++q) { float v[2];
#pragma unroll
                for (int h = 0; h < 2; ++h) { const int j = j0 + q * 2 + h; const int idx = (k * (j & 2047)) & 2047; v[h] = (j >> 11) ? sT[idx] : cT[idx]; }
                w[q] = pk_h2(v[0], v[1]); }
            *(u32x4*)(DFT + (size_t)(k - 1) * 4096 + j0) = (u32x4){w[0], w[1], w[2], w[3]}; }
        else { const int oo = o - 1024 * 512; const int k = oo >> 6, j0 = (oo & 63) * 8;
#pragma unroll
            for (int q = 0; q < 4; ++q) { float v[2];
#pragma unroll
                for (int h = 0; h < 2; ++h) { const int j = j0 + q * 2 + h; const int idx = ((k * (j & 255)) & 255) * 8; v[h] = (j >> 8) ? -sT[idx] : cT[idx]; }
                w[q] = pk_h2(v[0], v[1]); }
            *(u32x4*)(DFTC + (size_t)k * 512 + j0) = (u32x4){w[0], w[1], w[2], w[3]}; } } }
    { h16* BDT = (h16*)(p.ws + WS_BDT);
      for (int o = gt; o < 512 * 256; o += NG) { const int zc = o >> 8, gc = o & 255; const int g = zc >> 7, cs = (zc >> 6) & 1, m = zc & 63; const int idx = ((m * (gc & 63)) & 63) * 32;
          BDT[o] = (h16)(((gc >> 6) == g) ? (cs ? sT[idx] : cT[idx]) * 0.125f : 0.f); } }
    { h16* WFIN = (h16*)(p.ws + WS_WFIN);
      for (int o = gt; o < 2 * 1024 * 64; o += NG) { const int gc4 = (o & 63) * 4, lk = o >> 6; const f32x4 v = *(const f32x4*)(p.w_in + (size_t)lk * INW + 512 + gc4);
          h16x4 hv = {(h16)v[0], (h16)v[1], (h16)v[2], (h16)v[3]}; *(h16x4*)(WFIN + (size_t)lk * 256 + gc4) = hv; } }
    __syncthreads();
}

__device__ __forceinline__ const float* hrow_of(const Params& p, const float* hB, int l, int R) { return l == 0 ? (R < TL ? p.x + (size_t)R * DM : p.ctx + (size_t)(R - TL) * DM) : hB + (size_t)R * DM; }
__device__ __forceinline__ void phase_u(const Params& p, int l) {
    const float* modv = (const float*)(p.ws + WS_MODV) + (size_t)l * 17 * NMOD; h16* u16 = (h16*)(p.ws + WS_U16); const float* hB = (const float*)(p.ws + WS_HB);
    const int lane = tidx() & 63, gw = bidx() * NWAVES + (tidx() >> 6);
    constexpr int rpw = TT / 2048;
    f32x4 sh[4], sc[4], h[4], hn[4]; int curmv = -1;
    const int R0 = gw * rpw;
    { const float* hr = hrow_of(p, hB, l, R0);
#pragma unroll
      for (int j = 0; j < 4; ++j) h[j] = *(const f32x4*)(hr + lane * 4 + 256 * j); }
    for (int i = 0; i < rpw; ++i) {
        const int R = R0 + i; const int mv = mv_of(R);
        if (mv != curmv) { const float* mvp = modv + (size_t)mv * NMOD; curmv = mv;
#pragma unroll
            for (int j = 0; j < 4; ++j) { const int col = lane * 4 + 256 * j; sh[j] = *(const f32x4*)(mvp + col); sc[j] = *(const f32x4*)(mvp + DM + col); } }
        asm volatile("" ::: "memory");
        if (i + 1 < rpw) { const float* hr = hrow_of(p, hB, l, R + 1);
#pragma unroll
            for (int j = 0; j < 4; ++j) hn[j] = *(const f32x4*)(hr + lane * 4 + 256 * j); }
        asm volatile("" ::: "memory");
#pragma unroll
        for (int j = 0; j < 4; ++j) { const int col = lane * 4 + 256 * j; const f32x4 u = h[j] * (1.f + sc[j]) + sh[j];
            *(unsigned long long*)(u16 + (size_t)R * DM + col) = (unsigned long long)pk_h2(u[0], u[1]) | ((unsigned long long)pk_h2(u[2], u[3]) << 32); }
#pragma unroll
        for (int j = 0; j < 4; ++j) h[j] = hn[j];
    }
}

constexpr float QSCALE = 0.125f * 1.4426950408889634f;
__device__ __forceinline__ void fourier_row0(const Params& p) {
    {
      const h16* ZTL = (const h16*)(p.ws + WS_ZTL); h16* brp = (h16*)(p.ws + WS_BR);
      const int lane_ = tidx() & 63, gw_ = bidx() * NWAVES + (tidx() >> 6), NGW_ = gridDim.x * NWAVES;
      for (int col = gw_; col < 4096; col += NGW_) { float sa = 0.f;
#pragma unroll
          for (int q = 0; q < 4; ++q) { const h16x8 v = *(const h16x8*)(ZTL + (size_t)col * 4096 + q * 512 + lane_ * 8);
#pragma unroll
              for (int e = 0; e < 8; ++e) sa += (float)v[e]; }
          sa = wave_sum(sa);
          if (lane_ == 0) brp[(size_t)((col >> 8) * 2048) * DM + 256 + (col & 255)] = (h16)(sa * 0.022097086912079608f); } }
}

#define MEMFENCE() asm volatile("" ::: "memory")
__device__ __forceinline__ void phase_wg(const Params& p) {
    const float* modv = (const float*)(p.ws + WS_MODV); float* wg = (float*)(p.ws + WS_WG); float* sgb = (float*)(p.ws + WS_SGB);
    const int tid = tidx(), lane = tid & 63, gw = bidx() * NWAVES + (tid >> 6), NGW = gridDim.x * NWAVES;
    for (int it = bidx() * NTHREADS + tid; it < 2 * 17 * 1024; it += gridDim.x * NTHREADS) {
        const int k = it & 1023, lm = it >> 10, l = lm / 17;
        const float G = p.ln1_g[l * DM + k] * (1.f + modv[(size_t)lm * NMOD + 4 * DM + k]);
        const float* w = p.w_router + ((size_t)l * DM + k) * 16; float* o = wg + (size_t)lm * 16384 + (size_t)((k >> 2) * 16) * 4 + (k & 3);
#pragma unroll
        for (int e4 = 0; e4 < 4; ++e4) { const f32x4 wv = *(const f32x4*)(w + e4 * 4);
#pragma unroll
            for (int c = 0; c < 4; ++c) o[(e4 * 4 + c) * 4] = G * wv[c]; } }
    for (int lm = gw; lm < 34; lm += NGW) { const int l = lm / 17;
        float sg[16], sb[16];
#pragma unroll
        for (int e = 0; e < 16; ++e) { sg[e] = 0.f; sb[e] = 0.f; }
        for (int q = 0; q < 16; ++q) { const int k = lane + 64 * q; const float sc = modv[(size_t)lm * NMOD + 4 * DM + k], sh = modv[(size_t)lm * NMOD + 3 * DM + k];
            const float G = p.ln1_g[l * DM + k] * (1.f + sc), Bp = p.ln1_b[l * DM + k] * (1.f + sc) + sh; const float* w = p.w_router + ((size_t)l * DM + k) * 16;
#pragma unroll
            for (int e4 = 0; e4 < 4; ++e4) { const f32x4 wv = *(const f32x4*)(w + e4 * 4);
#pragma unroll
                for (int c = 0; c < 4; ++c) { sg[e4 * 4 + c] += G * wv[c]; sb[e4 * 4 + c] += Bp * wv[c]; } } }
#pragma unroll
        for (int e = 0; e < 16; ++e) { const float a = wave_sum(sg[e]), b = wave_sum(sb[e]); if (lane == 0) { sgb[lm * 32 + e] = a; sgb[lm * 32 + 16 + e] = b; } } }
}
__device__ __forceinline__ void ln1_rows(const float* hB, h16* u16, float* stat, const float* mvp, const float* g, const float* bb, int R0, int nrows, int ioff, int lane, float& mu, float& rho, float* cst) {
    f32x4 gg[4], bv[4], sh[4], sc[4];
#pragma unroll
    for (int j = 0; j < 4; ++j) { const int col = lane * 4 + 256 * j; gg[j] = *(const f32x4*)(g + col); bv[j] = *(const f32x4*)(bb + col); sh[j] = *(const f32x4*)(mvp + 3 * DM + col); sc[j] = *(const f32x4*)(mvp + 4 * DM + col); }
    f32x4 v[4], vn[4];
#pragma unroll
    for (int j = 0; j < 4; ++j) v[j] = *(const f32x4*)(hB + (size_t)R0 * DM + lane * 4 + 256 * j);
    for (int i = 0; i < nrows; ++i) {
        const int R = R0 + i;
        MEMFENCE();
        if (i + 1 < nrows) {
#pragma unroll
            for (int j = 0; j < 4; ++j) vn[j] = *(const f32x4*)(hB + (size_t)(R + 1) * DM + lane * 4 + 256 * j); }
        MEMFENCE();
        float s = 0.f;
#pragma unroll
        for (int j = 0; j < 4; ++j) s += (v[j][0] + v[j][1]) + (v[j][2] + v[j][3]);
        const float mean = wave_sum(s) * (1.f / DM); float q = 0.f;
#pragma unroll
        for (int j = 0; j < 4; ++j) { v[j] = v[j] - mean; q += (v[j][0] * v[j][0] + v[j][1] * v[j][1]) + (v[j][2] * v[j][2] + v[j][3] * v[j][3]); }
        const float rstd = rsqrtf(wave_sum(q) * (1.f / DM) + LN_EPS);
        if (lane == 0) { float* st = stat + (size_t)R * 2; st[0] = mean; st[1] = rstd; if (cst) { cst[(ioff + i) * 2] = mean; cst[(ioff + i) * 2 + 1] = rstd; } }
        if ((lane & 15) == ioff + i) { mu = mean; rho = rstd; }
#pragma unroll
        for (int j = 0; j < 4; ++j) { const int col = lane * 4 + 256 * j;
            const f32x4 h1 = v[j] * rstd * gg[j] + bv[j];
            const f32x4 u2 = h1 * (1.f + sc[j]) + sh[j];
            *(unsigned long long*)(u16 + (size_t)R * DM + col) = (unsigned long long)pk_b2(u2[0], u2[1]) | ((unsigned long long)pk_b2(u2[2], u2[3]) << 32); }
#pragma unroll
        for (int j = 0; j < 4; ++j) v[j] = vn[j];
    }
}
__device__ __forceinline__ f32x4 ln1_router_mfma(const float* vrow, const float* wgl, int t0, int t1) {
    f32x4 a0 = {0.f, 0.f, 0.f, 0.f}, a1 = {0.f, 0.f, 0.f, 0.f};
    f32x4 b[8], bn[8];
#pragma unroll
    for (int u = 0; u < 8; ++u) b[u] = *(const f32x4*)(vrow + 16 * (t0 + u));
    for (int t = t0; t < t1; t += 8) {
        if (t + 8 < t1) {
#pragma unroll
            for (int u = 0; u < 8; ++u) bn[u] = *(const f32x4*)(vrow + 16 * (t + 8 + u)); }
#pragma unroll
        for (int u = 0; u < 8; ++u) { const f32x4 a = *(const f32x4*)(wgl + (t + u) * 256);
#pragma unroll
            for (int i = 0; i < 4; ++i) { if (u & 1) a1 = __builtin_amdgcn_mfma_f32_16x16x4f32(a[i], b[u][i], a1, 0, 0, 0); else a0 = __builtin_amdgcn_mfma_f32_16x16x4f32(a[i], b[u][i], a0, 0, 0, 0); } }
#pragma unroll
        for (int u = 0; u < 8; ++u) b[u] = bn[u];
    }
    return a0 + a1;
}
__device__ __forceinline__ void ln1_finish(const Params& p, const float* sgbm, const f32x4 D, float mu, float rho, int R, int lane) {
    float* affL = (float*)(p.ws + WS_AFFL); float* affC = (float*)(p.ws + WS_AFFC);
    const int eq = lane >> 4; const f32x4 sg = *(const f32x4*)(sgbm + 4 * eq), sb = *(const f32x4*)(sgbm + 16 + 4 * eq);
    const float rm = rho * mu; float lg[4];
#pragma unroll
    for (int r = 0; r < 4; ++r) lg[r] = rho * D[r] - rm * sg[r] + sb[r];
    float mx = fmaxf(fmaxf(lg[0], lg[1]), fmaxf(lg[2], lg[3])); mx = xor16_max(mx); mx = xor32_max(mx);
    float ex[4], se = 0.f;
#pragma unroll
    for (int r = 0; r < 4; ++r) { ex[r] = __builtin_amdgcn_exp2f((lg[r] - mx) * 1.4426950408889634f); se += ex[r]; }
    se = xor16_sum(se); se = xor32_sum(se);
#pragma unroll
    for (int r = 0; r < 4; ++r) { const float a = ex[r] / se; const int e = 4 * eq + r;
        if (R < TL) affL[((size_t)((R >> 11) * 16 + e)) * 2048 + (R & 2047)] = a; else { const int rr = R - TL; affC[((size_t)((rr >> 8) * 16 + e)) * 256 + (rr & 255)] = a; } }
}
__device__ __forceinline__ void phase_ln1_fill(const Params& p, int l, float* lds) {
    const float* wg = (const float*)(p.ws + WS_WG) + (size_t)l * 17 * 16384; const int tid = tidx(), bt = bidx() >> 4;
    __syncthreads();
    for (int e = tid; e < 4096; e += NTHREADS) *(f32x4*)(lds + e * 4) = *(const f32x4*)(wg + (size_t)bt * 16384 + e * 4);
    if (l == 0) for (int e = tid; e < 4096; e += NTHREADS) *(f32x4*)(lds + 16384 + e * 4) = *(const f32x4*)(wg + (size_t)16 * 16384 + e * 4);
    __syncthreads();
}
__device__ __forceinline__ void phase_ln1(const Params& p, int l, float* lds) {
    float* hB = (float*)(p.ws + WS_HB); h16* u16 = (h16*)(p.ws + WS_U16); const float* modv = (const float*)(p.ws + WS_MODV) + (size_t)l * 17 * NMOD;
    float* stat = (float*)(p.ws + WS_STAT); const float* wg = (const float*)(p.ws + WS_WG) + (size_t)l * 17 * 16384; const float* sgb = (const float*)(p.ws + WS_SGB) + l * 17 * 32;
    const float* g = p.ln1_g + l * DM; const float* bb = p.ln1_b + l * DM;
    const int tid = tidx(), lane = tid & 63, w = tid >> 6, c = bidx();
    const int bt = c >> 4;
    float* cst = lds + 32768; float* part = lds + 32768 + 64;
    __syncthreads();
    { const int Rg = c * 128 + w * 16; float mu = 0.f, rho = 0.f;
      ln1_rows(hB, u16, stat, modv + (size_t)bt * NMOD, g, bb, Rg, 16, 0, lane, mu, rho, nullptr);
      const f32x4 D = ln1_router_mfma(hB + (size_t)(Rg + (lane & 15)) * DM + 4 * (lane >> 4), lds + lane * 4, 0, 64);
      ln1_finish(p, sgb + bt * 32, D, mu, rho, Rg + (lane & 15), lane); }
    if (l == 0) { const int Cg = TL + c * 16; float mu = 0.f, rho = 0.f;
      ln1_rows(hB, u16, stat, modv + (size_t)16 * NMOD, g, bb, Cg + 2 * w, 2, 2 * w, lane, mu, rho, cst);
      __syncthreads();
      const f32x4 D = ln1_router_mfma(hB + (size_t)(Cg + (lane & 15)) * DM + 4 * (lane >> 4), lds + 16384 + lane * 4, 8 * w, 8 * w + 8);
      *(f32x4*)(part + (w * 64 + lane) * 4) = D;
      __syncthreads();
      if (w == 0) { f32x4 Ds = *(const f32x4*)(part + lane * 4);
#pragma unroll
          for (int q = 1; q < 8; ++q) Ds += *(const f32x4*)(part + (q * 64 + lane) * 4);
          ln1_finish(p, sgb + 16 * 32, Ds, cst[(lane & 15) * 2], cst[(lane & 15) * 2 + 1], Cg + (lane & 15), lane); } }
    __syncthreads();
}

__device__ __forceinline__ void phase_topk(const Params& p, int l, float* lds) {
    const float* affL = (const float*)(p.ws + WS_AFFL); const float* affC = (const float*)(p.ws + WS_AFFC); float* selw = (float*)(p.ws + WS_SELW); int* slot_of = (int*)(p.ws + WS_SLOT);
    int* selrow = (int*)(p.ws + WS_SELR);
    unsigned* a = (unsigned*)lds; unsigned* hist = (unsigned*)(lds + 2048 + 256); int* wsum = (int*)(lds + 2048 + 512); unsigned* ctl = (unsigned*)(lds + 2048 + 512 + 32);
    const int tid = tidx(), lane = tid & 63, wave = tid >> 6;
    const int nitems = (l == 0) ? 512 : 256;
    __syncthreads();
    for (int it = bidx(); it < nitems; it += gridDim.x) {
        const bool lat = it < 256; const int be = lat ? it : it - 256; const int b = be >> 4, e = be & 15; const int n = lat ? 2048 : 256, cap = lat ? CAPL : CAPC;
        const float* src = lat ? affL + (size_t)be * 2048 : affC + (size_t)be * 256;
        for (int i = tid; i < n; i += NTHREADS) a[i] = __float_as_uint(src[i]);
        unsigned prefix = 0u, pmask = 0u; int remaining = cap;
        for (int pass = 0; pass < 4; ++pass) {
            const int shift = 24 - 8 * pass;
            if (tid < 256) hist[tid] = 0u;
            __syncthreads();
            for (int i = tid; i < n; i += NTHREADS) { const unsigned u = a[i]; if ((u & pmask) == prefix) atomicAdd(&hist[(u >> shift) & 255u], 1u); }
            __syncthreads();
            if (tid < 64) {
                unsigned c4[4]; unsigned s4 = 0;
#pragma unroll
                for (int q = 0; q < 4; ++q) { c4[q] = hist[255 - (lane * 4 + q)]; s4 += c4[q]; }
                unsigned incl = s4;
#pragma unroll
                for (int o = 1; o < 64; o <<= 1) { const unsigned t = __shfl_up(incl, o); if (lane >= o) incl += t; }
                unsigned excl = incl - s4;
                const bool mine = (excl < (unsigned)remaining) && (incl >= (unsigned)remaining);
                if (mine) { unsigned cum = excl; int bin = 0; unsigned above = 0;
#pragma unroll
                    for (int q = 0; q < 4; ++q) { if (cum < (unsigned)remaining && cum + c4[q] >= (unsigned)remaining) { bin = 255 - (lane * 4 + q); above = cum; } cum += c4[q]; }
                    ctl[0] = (unsigned)bin; ctl[1] = above; }
            }
            __syncthreads();
            prefix |= ctl[0] << shift; pmask |= 255u << shift; remaining -= (int)ctl[1];
            __syncthreads();
        }
        const unsigned T = prefix; const int need_eq = remaining;
        const int i0 = tid * 4; int ngt = 0, neq = 0; unsigned u4[4];
#pragma unroll
        for (int q = 0; q < 4; ++q) { const int i = i0 + q; u4[q] = (i < n) ? a[i] : 0u; ngt += (i < n && u4[q] > T) ? 1 : 0; neq += (i < n && u4[q] == T) ? 1 : 0; }
        int ieq = neq;
#pragma unroll
        for (int o = 1; o < 64; o <<= 1) { const int t = __shfl_up(ieq, o); if (lane >= o) ieq += t; }
        if (lane == 63) wsum[wave] = ieq;
        __syncthreads();
        int eqbase = 0;
#pragma unroll
        for (int wv = 0; wv < 8; ++wv) eqbase += (wv < wave) ? wsum[wv] : 0;
        int eqrank = eqbase + ieq - neq;
        int nsel = 0; bool sel[4];
#pragma unroll
        for (int q = 0; q < 4; ++q) { const int i = i0 + q; const bool gt = (i < n) && (u4[q] > T); const bool eq = (i < n) && (u4[q] == T); sel[q] = gt || (eq && eqrank < need_eq); eqrank += eq ? 1 : 0; nsel += sel[q] ? 1 : 0; }
        __syncthreads();
        int isel = nsel;
#pragma unroll
        for (int o = 1; o < 64; o <<= 1) { const int t = __shfl_up(isel, o); if (lane >= o) isel += t; }
        if (lane == 63) wsum[wave] = isel;
        __syncthreads();
        int sbase = 0;
#pragma unroll
        for (int wv = 0; wv < 8; ++wv) sbase += (wv < wave) ? wsum[wv] : 0;
        int slot = sbase + isel - nsel;
        const int gbase = lat ? be * 256 : GL + e * 512 + b * 32;
#pragma unroll
        for (int q = 0; q < 4; ++q) { const int i = i0 + q; if (i < n) { const int R = lat ? b * 2048 + i : TL + b * 256 + i;
            if (sel[q]) { selrow[gbase + slot] = R; selw[gbase + slot] = __uint_as_float(u4[q]); slot_of[(size_t)R * 16 + e] = gbase + slot; ++slot; } else slot_of[(size_t)R * 16 + e] = -1; } }
        __syncthreads();
    }
}

struct Ln2S { int sl; float m, r; };
__device__ __forceinline__ Ln2S ln2_ldS(const int* slot_of, const float* stat, int R, int lane) { Ln2S s; s.sl = slot_of[(size_t)R * 16 + (lane & 15)]; s.m = stat[(size_t)R * 2]; s.r = stat[(size_t)R * 2 + 1]; return s; }
__device__ __forceinline__ void ln2_issue(const h16* Y, const float* hB, int R, int sl, int lane, h16x4 (&yv)[4][4], f32x4 (&h)[4]) {
    unsigned long long msk = __ballot(sl >= 0) & 0xFFFFull;
#pragma unroll
    for (int q = 0; q < 4; ++q) { if (msk) { const int e = __builtin_ctzll(msk); msk &= msk - 1; const int sr = __builtin_amdgcn_readlane(sl, e);
#pragma unroll
            for (int j = 0; j < 4; ++j) yv[q][j] = *(const h16x4*)(Y + (size_t)sr * DM + lane * 4 + 256 * j); }
        else {
#pragma unroll
            for (int j = 0; j < 4; ++j) yv[q][j] = (h16x4){(h16)0.f, (h16)0.f, (h16)0.f, (h16)0.f}; } }
#pragma unroll
    for (int j = 0; j < 4; ++j) h[j] = *(const f32x4*)(hB + (size_t)R * DM + lane * 4 + 256 * j);
}
__device__ __forceinline__ void ln2_rows(const Params& p, int l, const float* ldsv, int R0, int nrows, int mv, int lane) {
    float* hB = (float*)(p.ws + WS_HB); h16* u16 = (h16*)(p.ws + WS_U16); const h16* Y = (const h16*)(p.ws + WS_XG); const int* slot_of = (const int*)(p.ws + WS_SLOT);
    const float* mvp = (const float*)(p.ws + WS_MODV) + ((size_t)l * 17 + mv) * NMOD; const float* mvn = mvp + (size_t)17 * NMOD; const float* stat = (const float*)(p.ws + WS_STAT);
    const bool nextu = (l < DEPTH - 1);
    f32x4 gate[4], nsh[4], nsc[4];
#pragma unroll
    for (int j = 0; j < 4; ++j) { const int col = lane * 4 + 256 * j; gate[j] = *(const f32x4*)(mvp + 5 * DM + col); nsh[j] = (f32x4){0.f, 0.f, 0.f, 0.f}; nsc[j] = nsh[j];
        if (nextu) { nsh[j] = *(const f32x4*)(mvn + col); nsc[j] = *(const f32x4*)(mvn + DM + col); } }
    Ln2S sA = ln2_ldS(slot_of, stat, R0, lane), sB = sA, sC = sA, sD = sA;
    if (nrows > 1) sB = ln2_ldS(slot_of, stat, R0 + 1, lane);
    if (nrows > 2) sC = ln2_ldS(slot_of, stat, R0 + 2, lane);
    h16x4 yv0[4][4], yv1[4][4]; f32x4 h0[4], h1b[4];
    ln2_issue(Y, hB, R0, sA.sl, lane, yv0, h0);
    for (int i = 0; i < nrows; ++i) {
        const int R = R0 + i;
        MEMFENCE();
        if (i + 1 < nrows) ln2_issue(Y, hB, R + 1, sB.sl, lane, yv1, h1b);
        if (i + 3 < nrows) sD = ln2_ldS(slot_of, stat, R + 3, lane);
        MEMFENCE();
        f32x4 f[4];
#pragma unroll
        for (int j = 0; j < 4; ++j) { f[j] = (f32x4){0.f, 0.f, 0.f, 0.f};
#pragma unroll
            for (int q = 0; q < 4; ++q) { f[j][0] += (float)yv0[q][j][0]; f[j][1] += (float)yv0[q][j][1]; f[j][2] += (float)yv0[q][j][2]; f[j][3] += (float)yv0[q][j][3]; } }
        { unsigned long long msk = __ballot(sA.sl >= 0) & 0xFFFFull;
#pragma unroll
          for (int q = 0; q < 4; ++q) msk &= msk - 1;
          while (msk) { const int e = __builtin_ctzll(msk); msk &= msk - 1; const int sr = __builtin_amdgcn_readlane(sA.sl, e);
#pragma unroll
            for (int j = 0; j < 4; ++j) { const h16x4 y = *(const h16x4*)(Y + (size_t)sr * DM + lane * 4 + 256 * j); f[j][0] += (float)y[0]; f[j][1] += (float)y[1]; f[j][2] += (float)y[2]; f[j][3] += (float)y[3]; } } }
        f32x4 v[4]; float s = 0.f;
#pragma unroll
        for (int j = 0; j < 4; ++j) { const f32x4 g1v = *(const f32x4*)(ldsv + lane * 4 + 256 * j), b1v = *(const f32x4*)(ldsv + 1024 + lane * 4 + 256 * j);
            const f32x4 hh = (h0[j] - sA.m) * sA.r * g1v + b1v;
            v[j] = ALPHA * hh + gate[j] * f[j]; s += (v[j][0] + v[j][1]) + (v[j][2] + v[j][3]); }
        const float mean = wave_sum(s) * (1.f / DM); float q = 0.f;
#pragma unroll
        for (int j = 0; j < 4; ++j) { v[j] = v[j] - mean; q += (v[j][0] * v[j][0] + v[j][1] * v[j][1]) + (v[j][2] * v[j][2] + v[j][3] * v[j][3]); }
        const float rstd = rsqrtf(wave_sum(q) * (1.f / DM) + LN_EPS);
        float* orow = (l == DEPTH - 1) ? p.out + (size_t)R * DM : hB + (size_t)R * DM;
#pragma unroll
        for (int j = 0; j < 4; ++j) { const int col = lane * 4 + 256 * j; const f32x4 g2v = *(const f32x4*)(ldsv + 2048 + col), b2v = *(const f32x4*)(ldsv + 3072 + col);
            const f32x4 h2 = v[j] * rstd * g2v + b2v; if (l == DEPTH - 1) __builtin_nontemporal_store(h2, (f32x4*)(orow + col)); else *(f32x4*)(orow + col) = h2;
            if (nextu) { const f32x4 u = h2 * (1.f + nsc[j]) + nsh[j];
                *(unsigned long long*)(u16 + (size_t)R * DM + col) = (unsigned long long)pk_h2(u[0], u[1]) | ((unsigned long long)pk_h2(u[2], u[3]) << 32); } }
#pragma unroll
        for (int q2 = 0; q2 < 4; ++q2)
#pragma unroll
            for (int j = 0; j < 4; ++j) yv0[q2][j] = yv1[q2][j];
#pragma unroll
        for (int j = 0; j < 4; ++j) h0[j] = h1b[j];
        sA = sB; sB = sC; sC = sD;
    }
}
__device__ __forceinline__ void phase_ln2(const Params& p, int l, float* lds) {
    const int tid = tidx(), lane = tid & 63, w = tid >> 6, c = bidx();
    __syncthreads();
    for (int e = tid; e < 1024; e += NTHREADS) { const int k = e >> 8, col = (e & 255) * 4; const float* src = (k == 0 ? p.ln1_g : k == 1 ? p.ln1_b : k == 2 ? p.ln2_g : p.ln2_b) + l * DM + col;
        *(f32x4*)(lds + k * 1024 + col) = *(const f32x4*)src; }
    __syncthreads();
    ln2_rows(p, l, lds, c * 128 + w * 16, 16, c >> 4, lane);
    if (l == 0) ln2_rows(p, l, lds, TL + c * 16 + 2 * w, 2, 16, lane);
    __syncthreads();
}

namespace fg {
#define FG_LAS __attribute__((address_space(3)))
constexpr int BM = 256, BK = 64, HALF = 128, HTB = HALF * BK * 2, STAGE_BYTES = 8 * HTB;
__host__ __device__ __forceinline__ int lds_byte(int r, int c) { const int st = (r >> 4) * 2 + (c >> 5), rr = r & 15, cc = c & 31, ob = rr * 64 + cc * 2; return st * 1024 + (ob ^ (((ob >> 9) & 1) << 5)); }
__host__ __device__ __forceinline__ void stage_rc(int b, int& R, int& C) { const int st = b / 1024, sb = b % 1024, swz = sb ^ (((sb >> 9) & 1) << 5); R = (st >> 1) * 16 + swz / 64; C = (st & 1) * 32 + (swz % 64) / 2; }
__host__ __device__ __forceinline__ int perm32(int rho) { const int n = rho >> 4, i = rho & 15; return 8 * (i >> 2) + 4 * n + (i & 3); }
struct Unit { const char* A; const char* B; int nt; int pm, pn, aux; const int* rows; };
template <class Epi, class Sched, int LD, bool BF = false, bool GATHER = false>
__device__ __forceinline__ void gemm_phase(FG_LAS unsigned char* lds, const Sched& S, const Epi& E) {
    const int tid = tidx(), wid = __builtin_amdgcn_readfirstlane(tid >> 6), lane = tid & 63, wr = wid >> 2, wc = wid & 3, fr = lane & 15, fq = lane >> 4;
    unsigned voffA[2], voffB[2]; int rowA[2], colA[2];
#pragma unroll
    for (int i = 0; i < 2; ++i) { int R, C; stage_rc(tid * 16 + i * 8192, R, C); const int Rb = Epi::PERM ? ((R & ~31) + perm32(R & 31)) : R;
        voffA[i] = (unsigned)(R * LD + C) * 2u; voffB[i] = (unsigned)(Rb * LD + C) * 2u; rowA[i] = R; colA[i] = C; }
    const size_t kstep = (size_t)(BK * 2);
    const size_t hstep = GATHER ? (size_t)0 : (size_t)HALF * LD * 2;
    const unsigned ldsw = (unsigned)wid * 1024u;
    const int aoff = lds_byte(wr * 64 + fr, fq * 8), boff = lds_byte(wc * 32 + fr, fq * 8);
#define FG_SA(b, h) (((b) * 2 + (h)) * HTB)
#define FG_SB(b, h) ((4 + (b) * 2 + (h)) * HTB)
#define FG_STAGE(bufoff, gbase, voff) do { _Pragma("unroll") for (int _i = 0; _i < 2; ++_i) \
        __builtin_amdgcn_global_load_lds((const unsigned*)((const char*)(gbase) + (voff)[_i]), (FG_LAS unsigned*)(lds + (bufoff) + ldsw + _i * 8192), 16, 0, 0); } while (0)
#define FG_STAGEA(bufoff, gbase, h, cur_) do { if (GATHER) { if (cur_) FG_STAGE(bufoff, gbase, cvA[h]); else FG_STAGE(bufoff, gbase, nvA[h]); } else FG_STAGE(bufoff, (gbase) + (h) * ((size_t)HALF * LD * 2), voffA); } while (0)
#define FG_LDA(dst, b, h) do { _Pragma("unroll") for (int m = 0; m < 4; ++m) _Pragma("unroll") for (int k = 0; k < 2; ++k) dst[m][k] = *(const FG_LAS h16x8*)(lds + FG_SA(b, h) + aoff + m * 2048 + k * 1024); } while (0)
#define FG_LDB(dst, b, h) do { _Pragma("unroll") for (int n = 0; n < 2; ++n) _Pragma("unroll") for (int k = 0; k < 2; ++k) dst[n][k] = *(const FG_LAS h16x8*)(lds + FG_SB(b, h) + boff + n * 2048 + k * 1024); } while (0)
#define FG_MMA(ai, bj, At, Bt) do { __builtin_amdgcn_s_setprio(1); _Pragma("unroll") for (int m = 0; m < 4; ++m) _Pragma("unroll") for (int n = 0; n < 2; ++n) _Pragma("unroll") for (int k = 0; k < 2; ++k) \
        acc[ai][bj][m][n] = BF ? __builtin_amdgcn_mfma_f32_16x16x32_bf16(__builtin_bit_cast(bf16x8_t, Bt[n][k]), __builtin_bit_cast(bf16x8_t, At[m][k]), acc[ai][bj][m][n], 0, 0, 0) : __builtin_amdgcn_mfma_f32_16x16x32_f16(Bt[n][k], At[m][k], acc[ai][bj][m][n], 0, 0, 0); __builtin_amdgcn_s_setprio(0); } while (0)
#define FG_WAIT_V(n) asm volatile("s_waitcnt vmcnt(" #n ")" ::: "memory")
#define FG_WAIT_L(n) asm volatile("s_waitcnt lgkmcnt(" #n ")" ::: "memory")
#define FG_BAR __builtin_amdgcn_s_barrier()
#define FG_SCHED __builtin_amdgcn_sched_barrier(0)
    Unit cur, nxt; int ui = 0;
    __syncthreads();
    if (!S.next(0, cur)) return;
    f32x4 acc[2][2][4][2];
#pragma unroll
    for (int a = 0; a < 2; ++a)
#pragma unroll
        for (int b = 0; b < 2; ++b)
#pragma unroll
            for (int m = 0; m < 4; ++m)
#pragma unroll
                for (int n = 0; n < 2; ++n) acc[a][b][m][n] = (f32x4){0.f, 0.f, 0.f, 0.f};
    h16x8 At[4][2], B0[2][2], B1[2][2];
    const char* cA = cur.A; const char* cB = cur.B;
    const size_t hstepB = (size_t)HALF * LD * 2;
    unsigned cvA[2][2], nvA[2][2];
    if (GATHER) {
#pragma unroll
        for (int h = 0; h < 2; ++h)
#pragma unroll
            for (int i = 0; i < 2; ++i) { cvA[h][i] = (unsigned)(cur.rows[h * HALF + rowA[i]] * LD + colA[i]) * 2u; nvA[h][i] = cvA[h][i]; } }
    FG_STAGE(FG_SB(0, 0), cB, voffB); FG_STAGE(FG_SB(0, 1), cB + hstepB, voffB); FG_STAGEA(FG_SA(0, 0), cA, 0, true); FG_STAGEA(FG_SA(0, 1), cA, 1, true);
    if (wr == 1) FG_BAR;
    FG_WAIT_V(2); FG_BAR;
    FG_STAGE(FG_SB(1, 0), cB + kstep, voffB); FG_STAGEA(FG_SA(1, 0), cA + kstep, 0, true); FG_STAGE(FG_SB(1, 1), cB + hstepB + kstep, voffB);
    FG_WAIT_V(6); FG_BAR;
    for (;;) {
        const bool has_next = S.next(ui + 1, nxt);
        const char* nA = has_next ? nxt.A : cA; const char* nB = has_next ? nxt.B : cB;
        if (GATHER && has_next) {
#pragma unroll
            for (int h = 0; h < 2; ++h)
#pragma unroll
                for (int i = 0; i < 2; ++i) nvA[h][i] = (unsigned)(nxt.rows[h * HALF + rowA[i]] * LD + colA[i]) * 2u; }
        const int nt = cur.nt;
        for (int t = 0; t < nt; t += 2) {
            const bool last = (t == nt - 2);
            const char* a1 = cA + (size_t)(t + 1) * kstep;
            const char* a2 = last ? nA : cA + (size_t)(t + 2) * kstep; const char* b2 = last ? nB : cB + (size_t)(t + 2) * kstep;
            const char* a3 = a2 + kstep; const char* b3 = b2 + kstep;
            FG_LDB(B0, 0, 0); FG_LDB(B1, 0, 1); FG_SCHED; FG_LDA(At, 0, 0); FG_STAGEA(FG_SA(1, 1), a1, 1, true);
            FG_WAIT_V(8); FG_WAIT_L(0); FG_BAR; FG_MMA(0, 0, At, B0); FG_MMA(0, 1, At, B1); FG_BAR; FG_SCHED;
            FG_LDA(At, 0, 1); FG_STAGE(FG_SB(0, 0), b2, voffB); FG_STAGE(FG_SB(0, 1), b2 + hstepB, voffB); FG_STAGEA(FG_SA(0, 0), a2, 0, !last);
            FG_WAIT_V(8); FG_WAIT_L(0); FG_BAR; FG_MMA(1, 0, At, B0); FG_MMA(1, 1, At, B1); FG_BAR; FG_SCHED;
            FG_LDB(B0, 1, 0); FG_LDB(B1, 1, 1); FG_SCHED; FG_LDA(At, 1, 0); FG_STAGEA(FG_SA(0, 1), a2, 1, !last);
            FG_WAIT_V(8); FG_WAIT_L(0); FG_BAR; FG_MMA(0, 0, At, B0); FG_MMA(0, 1, At, B1); FG_BAR; FG_SCHED;
            FG_LDA(At, 1, 1); FG_STAGE(FG_SB(1, 0), b3, voffB); FG_STAGE(FG_SB(1, 1), b3 + hstepB, voffB); FG_STAGEA(FG_SA(1, 0), a3, 0, !last);
            FG_WAIT_V(8); FG_WAIT_L(0); FG_BAR; FG_MMA(1, 0, At, B0); FG_MMA(1, 1, At, B1); FG_BAR; FG_SCHED;
        }
        if (wr == 0) FG_BAR;
        { const int t2_ = tidx(); E(acc, cur, wr, wc, t2_ & 15, (t2_ >> 4) & 3); }
        if (!has_next) break;
#pragma unroll
        for (int a = 0; a < 2; ++a)
#pragma unroll
            for (int b = 0; b < 2; ++b)
#pragma unroll
                for (int m = 0; m < 4; ++m)
#pragma unroll
                    for (int n = 0; n < 2; ++n) acc[a][b][m][n] = (f32x4){0.f, 0.f, 0.f, 0.f};
        cur = nxt; cA = nA; cB = nB; ++ui;
        if (GATHER) {
#pragma unroll
            for (int h = 0; h < 2; ++h)
#pragma unroll
                for (int i = 0; i < 2; ++i) cvA[h][i] = nvA[h][i]; }
        if (wr == 1) FG_BAR;
    }
    FG_WAIT_V(0);
    FG_BAR;
#undef FG_SA
#undef FG_SB
#undef FG_STAGE
#undef FG_LDA
#undef FG_STAGEA
#undef FG_LDB
#undef FG_MMA
#undef FG_WAIT_V
#undef FG_WAIT_L
#undef FG_BAR
#undef FG_SCHED
}
}
typedef FG_LAS unsigned char* ldsp_t;

template <bool BF = false>
__device__ __forceinline__ void transpose_item(const float* W, int ldw, h16* WT, int ldt, float* scr, int lane, float scl = 1.f) {
    f32x4 t[16];
#pragma unroll
    for (int i = 0; i < 16; ++i) t[i] = __builtin_nontemporal_load((const f32x4*)(W + (size_t)(i * 4 + (lane >> 4)) * ldw + (lane & 15) * 4));
#pragma unroll
    for (int i = 0; i < 16; ++i) { float* d = scr + (i * 4 + (lane >> 4)) * 65 + (lane & 15) * 4; d[0] = t[i][0]; d[1] = t[i][1]; d[2] = t[i][2]; d[3] = t[i][3]; }
    __builtin_amdgcn_wave_barrier();
    const int c = lane & 7;
#pragma unroll
    for (int j = 0; j < 8; ++j) { const int n = (lane >> 3) + 8 * j; const float* sp = scr + (8 * c) * 65 + n;
        u32x4 o; if (BF) { o.x = pk_b2(sp[0 * 65], sp[1 * 65]); o.y = pk_b2(sp[2 * 65], sp[3 * 65]); o.z = pk_b2(sp[4 * 65], sp[5 * 65]); o.w = pk_b2(sp[6 * 65], sp[7 * 65]); }
        else { o.x = pk_h2(sp[0 * 65] * scl, sp[1 * 65] * scl); o.y = pk_h2(sp[2 * 65] * scl, sp[3 * 65] * scl); o.z = pk_h2(sp[4 * 65] * scl, sp[5 * 65] * scl); o.w = pk_h2(sp[6 * 65] * scl, sp[7 * 65] * scl); }
        *(u32x4*)(WT + (size_t)n * ldt + 8 * c) = o; }
    __builtin_amdgcn_wave_barrier();
}
struct SchedWF {
    const char* BDT; const char* WFIN; int c;
    __device__ __forceinline__ bool next(int i, fg::Unit& u) const {
        if (i != 0 || c >= 16) return false;
        u.aux = c >> 3; u.pm = (c >> 2) & 1; u.pn = c & 3; u.nt = 4;
        u.A = BDT + (size_t)u.pm * 256 * 256 * 2; u.B = WFIN + ((size_t)u.aux * 1024 + u.pn * 256) * 256 * 2; return true;
    }
};
struct EpiWF {
    static constexpr bool PERM = true;
    h16* WinT;
    __device__ __forceinline__ void operator()(const f32x4 (&acc)[2][2][4][2], const fg::Unit& u, int wr, int wc, int fr, int fq) const {
        h16* base = WinT + ((size_t)u.aux * 6144 + 5632 + u.pm * 256 + 64 * wr + fr) * DM + u.pn * 256 + 32 * wc + 8 * fq;
#pragma unroll
        for (int ai = 0; ai < 2; ++ai)
#pragma unroll
            for (int m = 0; m < 4; ++m)
#pragma unroll
                for (int bj = 0; bj < 2; ++bj) { const f32x4 v0 = acc[ai][bj][m][0], v1 = acc[ai][bj][m][1];
                    *(u32x4*)(base + (size_t)(128 * ai + 16 * m) * DM + 128 * bj) = (u32x4){pk_h2(v0[0], v0[1]), pk_h2(v0[2], v0[3]), pk_h2(v1[0], v1[1]), pk_h2(v1[2], v1[3])}; }
    }
};
__device__ __forceinline__ void phase_convert_dense(const Params& p, float* lds, ldsp_t ldsf) {
    { SchedWF S{(const char*)(p.ws + WS_BDT), (const char*)(p.ws + WS_WFIN), bidx()}; EpiWF E{(h16*)(p.ws + WS_WINT)};
      fg::gemm_phase<EpiWF, SchedWF, 256>(ldsf, S, E); }
    __syncthreads();
}
__device__ __forceinline__ void dense_transposes(const Params& p, float* lds) {
    if (bidx() < 192) return;
    __syncthreads();
    const int lane = tidx() & 63, wave = tidx() >> 6, gw = (bidx() - 192) * NWAVES + wave, NGW = (gridDim.x - 192) * NWAVES;
    float* scr = lds + wave * (64 * 65);
    h16* WinT = (h16*)(p.ws + WS_WINT); h16* WbT = (h16*)(p.ws + WS_WBT); h16* WoT = (h16*)(p.ws + WS_WOT);
    constexpr int I_IN = 16 * 88, I_BR = 4 * 4 * 16, I_OUT = 16 * 16, I_L = I_IN + I_BR + I_OUT;
    for (int it = gw; it < 2 * I_L; it += NGW) {
        const int l = it / I_L; int r = it % I_L;
        if (r < I_IN) { const int kb = r / 88, db = r % 88; const int d0 = db * 64; const int sc0 = d0 < 512 ? d0 : d0 + 256;
            transpose_item(p.w_in + ((size_t)l * DM + kb * 64) * INW + sc0, INW, WinT + ((size_t)l * 6144 + d0) * DM + kb * 64, DM, scr, lane, d0 >= 1536 ? -1.4426950408889634f : 1.f); continue; }
        r -= I_IN;
        if (r < I_BR) { const int i = r >> 6, kb = (r >> 4) & 3, nb = r & 15;
            transpose_item(p.w_branch + (((size_t)l * 4 + i) * 256 + kb * 64) * DM + nb * 64, DM, WbT + ((size_t)l * DM + nb * 64) * DM + i * 256 + kb * 64, DM, scr, lane); continue; }
        r -= I_BR;
        { const int kb = r >> 4, nb = r & 15;
            transpose_item(p.w_out + ((size_t)l * DM + kb * 64) * DM + nb * 64, DM, WoT + ((size_t)l * DM + nb * 64) * DM + kb * 64, DM, scr, lane); }
    }
    __syncthreads();
}
__device__ __forceinline__ h16* wgu_of(const Params& p, int l) { return l == 0 ? (h16*)((unsigned char*)p.out + DO_WGU) : (h16*)(p.ws + WS_WGU1); }
__device__ __forceinline__ h16* wd_of(const Params& p, int l) { return (h16*)((unsigned char*)p.out + (l == 0 ? DO_WD : DO_WD1)); }
__device__ __forceinline__ void bg_convert(const Params& p, int l, float* lds, int budget, bool spread = false) {
    const int lane = tidx() & 63, wave = tidx() >> 6;
    float* scr = lds + wave * (64 * 65);
    h16* Wgu = wgu_of(p, l); h16* Wd = wd_of(p, l);
    const int x = spread ? ((bidx() >> 3) + (bidx() & 7)) & 7 : (bidx() & 7);
    unsigned* ctr = (unsigned*)(p.ws + WS_CTL) + 3072 + 64 * (l * 8 + x);
    constexpr int I_GU = 2 * 16 * 16, I_D = 16 * 16, I_E = I_GU + I_D, NIT = 16 * I_E, NPG = NIT / 8, BATCH = 4;
    __syncthreads();
    for (int n = 0; n < budget; ++n) {
        unsigned i0 = 0; if (lane == 0) i0 = __hip_atomic_fetch_add(ctr, (unsigned)BATCH, __ATOMIC_RELAXED, __HIP_MEMORY_SCOPE_AGENT);
        i0 = __builtin_amdgcn_readfirstlane(i0);
        if (i0 >= (unsigned)NPG) break;
        for (int q = 0; q < BATCH; ++q) { const int it = x * NPG + (int)i0 + q;
            const int e = it / I_E; int r = it % I_E;
            if (r < I_GU) { const int h = r >> 8, kb = (r >> 4) & 15, nb = r & 15; const int n0 = nb * 64; const int drow = (n0 >> 7) * 256 + h * 128 + (n0 & 127);
                const float* src = (h ? p.w_up : p.w_gate) + (((size_t)l * NEXP + e) * DM + kb * 64) * FF + n0;
                transpose_item<true>(src, FF, Wgu + ((size_t)e * 2048 + drow) * DM + kb * 64, DM, scr, lane); }
            else { r -= I_GU; const int kb = r >> 4, nb = r & 15;
                transpose_item<true>(p.w_down + (((size_t)l * NEXP + e) * FF + kb * 64) * DM + nb * 64, DM, Wd + ((size_t)e * DM + nb * 64) * FF + kb * 64, FF, scr, lane); } }
    }
    __syncthreads();
}

struct SchedG1 {
    const char* u16; const char* WinT; int l, c, G;
    __device__ __forceinline__ bool next(int i, fg::Unit& u) const {
        const int nsup_full = (l == 0) ? 36 : 32;
        const int L = (i * 8 + (c & 7)) * 32 + (c >> 3); const int s = L >> 5;
        if (s < nsup_full) { u.pm = s * 4 + ((L >> 3) & 3); u.pn = L & 7; }
        else { if (l == 0) return false; const int r = i - 4; if (r != 0 || c >= 48) return false; u.pm = 128 + c / 3; u.pn = 1 + 2 * (c % 3); }
        u.nt = 16; u.aux = 0;
        if (u.pn < 6) { u.A = u16 + (size_t)u.pm * 256 * DM * 2; u.B = WinT + (size_t)u.pn * 256 * DM * 2; }
        else { u.A = WinT + (size_t)(5632 + (u.pn - 6) * 256) * DM * 2; u.B = u16 + (size_t)u.pm * 256 * DM * 2; }
        return true;
    }
};
struct EpiG1 {
    static constexpr bool PERM = true;
    unsigned char* QI; unsigned char* KI; unsigned char* VI; h16* ZTL; h16* ZTC;
    const float* gain; const float* ropeC; const float* ropeS; FG_LAS float* xs; int lastlayer;
    __device__ __forceinline__ void operator()(const f32x4 (&acc)[2][2][4][2], const fg::Unit& u, int wr, int wc, int fr, int fq) const {
        if (u.pn < 6) {
            const int mixer = u.pn >> 1; const bool lat = u.pm < 128; const int b = lat ? (u.pm >> 3) : (u.pm - 128); const int tile0 = lat ? 4 + 4 * (u.pm & 7) : 0;
            const bool isq = (u.pn & 1) == 0; const int half = wc & 1; const int chunk = 4 * half + fq;
            const bool do_rms = (mixer == 0); const bool do_rope = lat && (mixer < 2);
            float rs[2][2][4];
            if (do_rms) {
#pragma unroll
                for (int bj = 0; bj < 2; ++bj)
#pragma unroll
                    for (int ai = 0; ai < 2; ++ai)
#pragma unroll
                        for (int m = 0; m < 4; ++m) { const f32x4 v0 = acc[ai][bj][m][0], v1 = acc[ai][bj][m][1];
                            float ss = (v0[0] * v0[0] + v0[1] * v0[1]) + (v0[2] * v0[2] + v0[3] * v0[3]) + (v1[0] * v1[0] + v1[1] * v1[1]) + (v1[2] * v1[2] + v1[3] * v1[3]);
                            ss = xor16_sum(ss); ss = xor32_sum(ss); rs[bj][ai][m] = ss;
                            if (fq == 0) xs[(half * 256 + 128 * ai + 64 * wr + 16 * m + fr) * 4 + 2 * bj + (wc >> 1)] = ss; }
                asm volatile("s_waitcnt lgkmcnt(0)" ::: "memory"); __builtin_amdgcn_s_barrier(); asm volatile("" ::: "memory");
#pragma unroll
                for (int bj = 0; bj < 2; ++bj)
#pragma unroll
                    for (int ai = 0; ai < 2; ++ai)
#pragma unroll
                        for (int m = 0; m < 4; ++m) { const float so = xs[((half ^ 1) * 256 + 128 * ai + 64 * wr + 16 * m + fr) * 4 + 2 * bj + (wc >> 1)];
                            rs[bj][ai][m] = rsqrtf((rs[bj][ai][m] + so) * (1.f / 64.f) + RMS_EPS); }
            }
            f32x4 g0 = {1.f, 1.f, 1.f, 1.f}, g1 = {1.f, 1.f, 1.f, 1.f};
            if (do_rms) { const float* gp = gain + (isq ? 0 : 64) + chunk * 8; g0 = *(const f32x4*)gp; g1 = *(const f32x4*)(gp + 4); }
            const int j0 = (fq & 1) * 8;
            const bool upper = (fq & 2) != 0;
            auto body = [&](auto HC) {
                constexpr bool H1 = decltype(HC)::value;
#pragma unroll
                for (int mh = 0; mh < 2; ++mh) {
                    f32x4 tc0[2], tc1[2], ts0[2], ts1[2];
                    if (do_rope) {
#pragma unroll
                        for (int k = 0; k < 2; ++k) { const int pos = H1 ? (16 * (2 * mh + k) + fr) : (4 * (u.pm & 7) + 2 * k + wr);
                            tc0[k] = *(const f32x4*)(ropeC + pos * 16 + j0); tc1[k] = *(const f32x4*)(ropeC + pos * 16 + j0 + 4); ts0[k] = *(const f32x4*)(ropeS + pos * 16 + j0); ts1[k] = *(const f32x4*)(ropeS + pos * 16 + j0 + 4); }
                        asm volatile("" ::: "memory"); }
#pragma unroll
                    for (int bj = 0; bj < 2; ++bj) { const int hh = 2 * bj + (wc >> 1);
                        const bool isv = !isq && bj == 1; const bool proc = !isv && (isq || mixer < 2);
                        unsigned char* base; int rstride;
                        if (isq) { base = QI + ((size_t)((mixer * 16 + b) * 4 + hh) * 36 + tile0) * 8192 + chunk * 1024; rstride = 16; }
                        else if (bj == 0) { base = KI + ((size_t)((mixer * 16 + b) * 2 + hh) * 36 + tile0) * 8192 + chunk * 1024; rstride = 16; }
                        else { base = VI + ((size_t)((mixer * 16 + b) * 2 + (hh - 2)) * 36 + tile0) * 8192 + half * 4096 + fq * 16; rstride = 64; }
#pragma unroll
                        for (int ai = 0; ai < 2; ++ai)
#pragma unroll
                            for (int mm = 0; mm < 2; ++mm) { const int m = 2 * mh + mm; f32x4 v0 = acc[ai][bj][m][0], v1 = acc[ai][bj][m][1];
                                if (proc) {
                                    if (do_rms) { const float r_ = rs[bj][ai][m]; v0 = v0 * r_ * g0; v1 = v1 * r_ * g1; }
                                    if (do_rope) { const int k = H1 ? mm : ai;
                                        const f32x4 c0 = tc0[k], c1 = tc1[k], s0 = ts0[k], s1 = ts1[k];
                                        f32x4 p0, p1;
#pragma unroll
                                        for (int e = 0; e < 4; ++e) { const auto r0 = __builtin_amdgcn_permlane32_swap(__float_as_uint(v0[e]), __float_as_uint(v0[e]), false, false); p0[e] = __uint_as_float(upper ? r0[0] : r0[1]);
                                            const auto r1 = __builtin_amdgcn_permlane32_swap(__float_as_uint(v1[e]), __float_as_uint(v1[e]), false, false); p1[e] = __uint_as_float(upper ? r1[0] : r1[1]); }
                                        if (upper) { v0 = p0 * s0 + v0 * c0; v1 = p1 * s1 + v1 * c1; } else { v0 = v0 * c0 - p0 * s0; v1 = v1 * c1 - p1 * s1; } }
                                    if (isq) { v0 = v0 * QSCALE; v1 = v1 * QSCALE; } }
                                *(u32x4*)(base + (size_t)(2 * ai + wr) * 8192 + (16 * m + fr) * rstride) = (u32x4){pk_h2(v0[0], v0[1]), pk_h2(v0[2], v0[3]), pk_h2(v1[0], v1[1]), pk_h2(v1[2], v1[3])}; } }
                }
            };
            if (half) body(std::true_type{}); else body(std::false_type{});
            __builtin_amdgcn_s_waitcnt(0x0F70);
        } else {
            const int R0 = u.pm * 256 + 32 * wc + 8 * fq;
            h16* zb; size_t pitch; int cstride;
            if (R0 < TL) { const int b = R0 >> 11; zb = ZTL + (size_t)b * 256 * 4096 + (R0 & 2047); pitch = 4096; cstride = 2048; }
            else { const int rr = R0 - TL; const int b = rr >> 8; zb = ZTC + (size_t)b * 256 * 512 + (rr & 255); pitch = 512; cstride = 256; }
#pragma unroll
            for (int ai = 0; ai < 2; ++ai)
#pragma unroll
                for (int m = 0; m < 4; ++m) { const int zc = (u.pn - 6) * 256 + 128 * ai + 64 * wr + 16 * m + fr; const int g = zc >> 7, cs = (zc >> 6) & 1, mm = zc & 63;
                    h16* rowp = zb + (size_t)(g * 64 + mm) * pitch + cs * cstride;
#pragma unroll
                    for (int bj = 0; bj < 2; ++bj) { const f32x4 v0 = acc[ai][bj][m][0], v1 = acc[ai][bj][m][1];
                        *(u32x4*)(rowp + 128 * bj) = (u32x4){pk_h2(v0[0], v0[1]), pk_h2(v0[2], v0[3]), pk_h2(v1[0], v1[1]), pk_h2(v1[2], v1[3])}; } }
        }
    }
};
__device__ __forceinline__ void phase_g1_fast(const Params& p, int l, ldsp_t lds) {
    SchedG1 S{(const char*)(p.ws + WS_U16), (const char*)(p.ws + WS_WINT) + (size_t)l * 6144 * DM * 2, l, (int)bidx(), (int)gridDim.x};
    const float* tab = (const float*)(p.ws + WS_TAB);
    EpiG1 E{p.ws + WS_QI, p.ws + WS_KI, p.ws + WS_VI, (h16*)(p.ws + WS_ZTL), (h16*)(p.ws + WS_ZTC), p.qk_gain + l * 128, tab + 4096, tab + 4096 + 1024, (FG_LAS float*)(lds + 131072), l == DEPTH - 1};
    fg::gemm_phase<EpiG1, SchedG1, DM>(lds, S, E);
}

struct SchedOut {
    const char* A; const char* B; int l, c, i0, i1;
    __device__ __forceinline__ bool next(int i, fg::Unit& u) const {
        i += i0; if (i >= i1) return false;
        const int nsup = (l == 0) ? 18 : 16;
        const int L = (i * 8 + (c & 7)) * 32 + (c >> 3); const int s = L >> 5; if (s >= nsup) return false;
        u.pm = s * 8 + ((L >> 2) & 7); u.pn = L & 3; u.nt = 16; u.aux = 0;
        u.A = A + (size_t)u.pm * 256 * DM * 2; u.B = B + (size_t)u.pn * 256 * DM * 2; return true;
    }
};
struct EpiOut {
    static constexpr bool PERM = false;
    const float* x; const float* ctx; float* hB; const float* modv; int l;
    __device__ __forceinline__ void operator()(const f32x4 (&acc)[2][2][4][2], const fg::Unit& u, int wr, int wc, int fr, int fq) const {
        const int mv = u.pm < 128 ? (u.pm >> 3) : 16; const float* g1p = modv + (size_t)mv * NMOD + 2 * DM;
        const int R0 = u.pm * 256 + 64 * wr + fr; const int c0 = u.pn * 256 + 32 * wc + 4 * fq;
        const float* hbase = (l == 0 ? (R0 < TL ? x + (size_t)R0 * DM : ctx + (size_t)(R0 - TL) * DM) : hB + (size_t)R0 * DM) + c0;
        float* obase = hB + (size_t)R0 * DM + c0;
        f32x4 g1[2][2];
#pragma unroll
        for (int bj = 0; bj < 2; ++bj)
#pragma unroll
            for (int n = 0; n < 2; ++n) g1[bj][n] = *(const f32x4*)(g1p + c0 + 128 * bj + 16 * n);
#pragma unroll
        for (int ai = 0; ai < 2; ++ai) {
            f32x4 hv[4][2][2];
#pragma unroll
            for (int m = 0; m < 4; ++m)
#pragma unroll
                for (int bj = 0; bj < 2; ++bj)
#pragma unroll
                    for (int n = 0; n < 2; ++n) hv[m][bj][n] = *(const f32x4*)(hbase + (size_t)(128 * ai + 16 * m) * DM + 128 * bj + 16 * n);
            asm volatile("" ::: "memory");
#pragma unroll
            for (int m = 0; m < 4; ++m)
#pragma unroll
                for (int bj = 0; bj < 2; ++bj)
#pragma unroll
                    for (int n = 0; n < 2; ++n) *(f32x4*)(obase + (size_t)(128 * ai + 16 * m) * DM + 128 * bj + 16 * n) = ALPHA * hv[m][bj][n] + g1[bj][n] * acc[ai][bj][m][n];
            asm volatile("" ::: "memory");
        }
    }
};
__device__ __forceinline__ void phase_out_fast(const Params& p, int l, ldsp_t lds, int i0, int i1) {
    SchedOut S{(const char*)(p.ws + WS_PM), (const char*)(p.ws + WS_WOT) + (size_t)l * DM * DM * 2, l, (int)bidx(), i0, i1};
    EpiOut E{p.x, p.ctx, (float*)(p.ws + WS_HB), (const float*)(p.ws + WS_MODV) + (size_t)l * 17 * NMOD, l};
    fg::gemm_phase<EpiOut, SchedOut, DM>(lds, S, E);
}

__device__ __forceinline__ int expert_of_rtile(int rt) { return rt < 256 ? (rt & 15) : ((rt - 256) >> 1); }
struct SchedUp {
    const char* u16; const char* Wgu; const int* selrow; int l, c;
    __device__ __forceinline__ bool next(int i, fg::Unit& u) const {
        const int nsup = (l == 0) ? 72 : 64;
        const int L = (i * 8 + (c & 7)) * 32 + (c >> 3); const int s = L >> 5; if (s >= nsup) return false;
        const int o = s * 4 + ((L >> 3) & 3); const int rt = o < 256 ? ((o & 15) * 16 + (o >> 4)) : o;
        u.pm = rt; u.pn = L & 7; u.nt = 16; u.aux = expert_of_rtile(rt);
        u.A = u16; u.rows = selrow + rt * 256; u.B = Wgu + ((size_t)u.aux * 2048 + u.pn * 256) * DM * 2; return true;
    }
};
struct EpiUp {
    static constexpr bool PERM = true;
    h16* H;
    __device__ __forceinline__ void operator()(const f32x4 (&acc)[2][2][4][2], const fg::Unit& u, int wr, int wc, int fr, int fq) const {
#pragma unroll
        for (int ai = 0; ai < 2; ++ai)
#pragma unroll
            for (int m = 0; m < 4; ++m) { const int R = u.pm * 256 + 128 * ai + 64 * wr + 16 * m + fr; const int col = u.pn * 128 + 32 * wc + 8 * fq; float o[8];
#pragma unroll
                for (int n = 0; n < 2; ++n)
#pragma unroll
                    for (int j = 0; j < 4; ++j) o[n * 4 + j] = silu_f(acc[ai][0][m][n][j]) * acc[ai][1][m][n][j];
                *(u32x4*)(H + (size_t)R * FF + col) = (u32x4){pk_b2(o[0], o[1]), pk_b2(o[2], o[3]), pk_b2(o[4], o[5]), pk_b2(o[6], o[7])}; }
    }
};
__device__ __forceinline__ void phase_up_fast(const Params& p, int l, ldsp_t lds) {
    SchedUp S{(const char*)(p.ws + WS_U16), (const char*)wgu_of(p, l), (const int*)(p.ws + WS_SELR), l, (int)bidx()};
    EpiUp E{(h16*)(p.ws + WS_H16)};
    fg::gemm_phase<EpiUp, SchedUp, DM, true, true>(lds, S, E);
}
struct SchedDown {
    const char* H; const char* Wd; int l, c;
    __device__ __forceinline__ bool next(int i, fg::Unit& u) const {
        const int nsup = (l == 0) ? 36 : 32;
        const int L = (i * 8 + (c & 7)) * 32 + (c >> 3); const int s = L >> 5; if (s >= nsup) return false;
        const int o = s * 8 + ((L >> 2) & 7); const int rt = o < 256 ? ((o & 15) * 16 + (o >> 4)) : o;
        u.pm = rt; u.pn = L & 3; u.nt = 16; u.aux = expert_of_rtile(rt);
        u.A = H + (size_t)rt * 256 * FF * 2; u.B = Wd + ((size_t)u.aux * DM + u.pn * 256) * FF * 2; return true;
    }
};
struct EpiDown {
    static constexpr bool PERM = true;
    h16* Y; const float* selw;
    __device__ __forceinline__ void operator()(const f32x4 (&acc)[2][2][4][2], const fg::Unit& u, int wr, int wc, int fr, int fq) const {
        const int R0 = u.pm * 256 + 64 * wr + fr;
        float w[2][4];
#pragma unroll
        for (int ai = 0; ai < 2; ++ai)
#pragma unroll
            for (int m = 0; m < 4; ++m) w[ai][m] = selw[R0 + 128 * ai + 16 * m];
        asm volatile("" ::: "memory");
        h16* base = Y + (size_t)R0 * DM + u.pn * 256 + 32 * wc + 8 * fq;
#pragma unroll
        for (int ai = 0; ai < 2; ++ai)
#pragma unroll
            for (int m = 0; m < 4; ++m)
#pragma unroll
                for (int bj = 0; bj < 2; ++bj) { const f32x4 v0 = acc[ai][bj][m][0] * w[ai][m], v1 = acc[ai][bj][m][1] * w[ai][m];
                    *(u32x4*)(base + (size_t)(128 * ai + 16 * m) * DM + 128 * bj) = (u32x4){pk_h2(v0[0], v0[1]), pk_h2(v0[2], v0[3]), pk_h2(v1[0], v1[1]), pk_h2(v1[2], v1[3])}; }
    }
};
__device__ __forceinline__ void phase_down_fast(const Params& p, int l, ldsp_t lds) {
    SchedDown S{(const char*)(p.ws + WS_H16), (const char*)wd_of(p, l), l, (int)bidx()};
    EpiDown E{(h16*)(p.ws + WS_XG), (const float*)(p.ws + WS_SELW)};
    fg::gemm_phase<EpiDown, SchedDown, DM, true>(lds, S, E);
}


struct SchedMerge {
    const char* u16; const char* br; const char* WinT; const char* WbT; int l, c, i0, i1;
    __device__ __forceinline__ bool next(int i, fg::Unit& u) const {
        i += i0; if (i >= i1) return false;
        int ib, sub;
        if (i < 16) { const int ti = i >> 3; sub = i & 7; ib = sub >> 1;
            const int L = (ti * 8 + (c & 7)) * 32 + (c >> 3); const int s = L >> 5;
            u.pm = s * 8 + ((L >> 2) & 7); u.pn = L & 3; u.aux = sub; }
        else { if (l != 0 || i >= 18) return false; const int tct = c >> 2; ib = c & 3; sub = 2 * ib + (i & 1);
            u.pm = 128 + (tct >> 2); u.pn = tct & 3; u.aux = sub | 8; }
        if ((sub & 1) == 0) { u.nt = 16; u.A = u16 + (size_t)u.pm * 256 * DM * 2; u.B = WinT + (size_t)(1536 + ib * 1024 + u.pn * 256) * DM * 2; }
        else { u.nt = 4; u.A = br + (size_t)u.pm * 256 * DM * 2 + ib * 512; u.B = WbT + (size_t)u.pn * 256 * DM * 2 + ib * 512; }
        return true;
    }
};
struct EpiMerge {
    static constexpr bool PERM = true;
    h16* mg; h16* part; unsigned char* scr;
    __device__ __forceinline__ void operator()(const f32x4 (&acc)[2][2][4][2], const fg::Unit& u, int wr, int wc, int fr, int fq) const {
        const int tid = tidx();
        if ((u.aux & 1) == 0) {
#pragma unroll
            for (int ai = 0; ai < 2; ++ai)
#pragma unroll
                for (int m = 0; m < 4; ++m)
#pragma unroll
                    for (int bj = 0; bj < 2; ++bj) { const int q = (ai * 4 + m) * 2 + bj; const f32x4 v0 = acc[ai][bj][m][0], v1 = acc[ai][bj][m][1];
                        *(u32x4*)(scr + ((size_t)q * 512 + tid) * 16) = (u32x4){pk_h2(sig2_f(v0[0]), sig2_f(v0[1])), pk_h2(sig2_f(v0[2]), sig2_f(v0[3])), pk_h2(sig2_f(v1[0]), sig2_f(v1[1])), pk_h2(sig2_f(v1[2]), sig2_f(v1[3]))}; }
        } else {
            const bool partial = (u.aux & 8) != 0; const bool first = partial || ((u.aux & 7) == 1);
            h16* base = partial ? part + ((size_t)((u.aux & 7) >> 1) * TC + (size_t)(u.pm - 128) * 256) * DM : mg + (size_t)u.pm * 256 * DM;
            base += (size_t)(64 * wr + fr) * DM + u.pn * 256 + 32 * wc + 8 * fq;
#pragma unroll
            for (int ai = 0; ai < 2; ++ai) {
                h16x8 gv[8], pr[8];
#pragma unroll
                for (int m = 0; m < 4; ++m)
#pragma unroll
                    for (int bj = 0; bj < 2; ++bj) { const int q = (ai * 4 + m) * 2 + bj; gv[m * 2 + bj] = *(const h16x8*)(scr + ((size_t)q * 512 + tid) * 16);
                        if (!first) pr[m * 2 + bj] = *(const h16x8*)(base + (size_t)(128 * ai + 16 * m) * DM + 128 * bj); }
                asm volatile("" ::: "memory");
#pragma unroll
                for (int m = 0; m < 4; ++m)
#pragma unroll
                    for (int bj = 0; bj < 2; ++bj) { const h16x8 g = gv[m * 2 + bj]; const f32x4 v0 = acc[ai][bj][m][0], v1 = acc[ai][bj][m][1];
                        float o[8] = {(float)g[0] * v0[0], (float)g[1] * v0[1], (float)g[2] * v0[2], (float)g[3] * v0[3], (float)g[4] * v1[0], (float)g[5] * v1[1], (float)g[6] * v1[2], (float)g[7] * v1[3]};
                        if (!first) { const h16x8 pp = pr[m * 2 + bj];
#pragma unroll
                            for (int e = 0; e < 8; ++e) o[e] += (float)pp[e]; }
                        *(u32x4*)(base + (size_t)(128 * ai + 16 * m) * DM + 128 * bj) = (u32x4){pk_h2(o[0], o[1]), pk_h2(o[2], o[3]), pk_h2(o[4], o[5]), pk_h2(o[6], o[7])}; }
                asm volatile("" ::: "memory");
            }
        }
    }
};
__device__ __forceinline__ void phase_merge_fast(const Params& p, int l, ldsp_t lds, int i0, int i1) {
    SchedMerge S{(const char*)(p.ws + WS_U16), (const char*)(p.ws + WS_BR), (const char*)(p.ws + WS_WINT) + (size_t)l * 6144 * DM * 2, (const char*)(p.ws + WS_WBT) + (size_t)l * DM * DM * 2, l, bidx(), i0, i1};
    EpiMerge E{(h16*)(p.ws + WS_PM), (h16*)(p.ws + WS_MPART), (l == 0 ? p.ws + WS_WGU1 : (unsigned char*)p.out + DO_WGU) + (size_t)bidx() * 131072};
    fg::gemm_phase<EpiMerge, SchedMerge, DM>(lds, S, E);
}
__device__ __forceinline__ void phase_merge_sum(const Params& p) {
    const h16* part = (const h16*)(p.ws + WS_MPART); h16* mg = (h16*)(p.ws + WS_PM) + (size_t)TL * DM;
    const int gt = bidx() * NTHREADS + tidx(), NG = gridDim.x * NTHREADS;
    for (int o = gt; o < TC * DM / 8; o += NG) { float acc[8];
#pragma unroll
        for (int e = 0; e < 8; ++e) acc[e] = 0.f;
#pragma unroll
        for (int i = 0; i < 4; ++i) { const h16x8 v = *(const h16x8*)(part + (size_t)i * TC * DM + (size_t)o * 8);
#pragma unroll
            for (int e = 0; e < 8; ++e) acc[e] += (float)v[e]; }
        *(u32x4*)(mg + (size_t)o * 8) = (u32x4){pk_h2(acc[0], acc[1]), pk_h2(acc[2], acc[3]), pk_h2(acc[4], acc[5]), pk_h2(acc[6], acc[7])}; }
}

struct EpiDft {
    static constexpr bool PERM = true;
    h16* br; int row0, rows_per_b; float scl;
    __device__ __forceinline__ void operator()(const f32x4 (&acc)[2][2][4][2], const fg::Unit& u, int wr, int wc, int fr, int fq) const {
#pragma unroll
        for (int ai = 0; ai < 2; ++ai)
#pragma unroll
            for (int m = 0; m < 4; ++m) { const int kr = u.pm * 256 + 128 * ai + 64 * wr + 16 * m + fr; const size_t R = (size_t)row0 + (size_t)u.pn * rows_per_b + kr;
#pragma unroll
                for (int bj = 0; bj < 2; ++bj) { const int col = 128 * bj + 32 * wc + 8 * fq; const f32x4 v0 = acc[ai][bj][m][0] * scl, v1 = acc[ai][bj][m][1] * scl;
                    *(u32x4*)(br + R * DM + 256 + col) = (u32x4){pk_h2(v0[0], v0[1]), pk_h2(v0[2], v0[3]), pk_h2(v1[0], v1[1]), pk_h2(v1[2], v1[3])}; } }
    }
};

namespace fa {
typedef float f32x16 __attribute__((ext_vector_type(16)));
typedef short v4i16_t __attribute__((ext_vector_type(4)));
typedef short s16x4 __attribute__((ext_vector_type(4)));
constexpr float LOG2E = 1.4426950408889634f;
constexpr int NSLOT = 3, SLOTB = 8192;
constexpr int LDS_K = 0, LDS_V = NSLOT * SLOTB, LDS_WS = 2 * NSLOT * SLOTB, LDS_OST = LDS_WS + 8 * 64 * 4, LDS_RPB = LDS_OST + 8 * 4096;
__device__ __forceinline__ int crow(int r, int hi) { return (r & 3) + 8 * (r >> 2) + 4 * hi; }
#define SBAR() __builtin_amdgcn_sched_barrier(0)
__device__ __forceinline__ void glds16(const void* gsrc, unsigned lds_dst) { unsigned keep;
    asm volatile("s_mov_b32 %0, m0\n\ts_mov_b32 m0, %2\n\ts_nop 0\n\tglobal_load_lds_dwordx4 %1, off\n\ts_mov_b32 m0, %0" : "=&s"(keep) : "v"(gsrc), "s"(lds_dst) : "memory"); }
__device__ __forceinline__ float max3f(float a, float b, float c) { float r; asm("v_max3_f32 %0, %1, %2, %3" : "=v"(r) : "v"(a), "v"(b), "v"(c)); return r; }
__device__ __forceinline__ float max2f(float a, float b) { float r; asm("v_max_f32_e32 %0, %1, %2" : "=v"(r) : "v"(a), "v"(b)); return r; }
__device__ __forceinline__ float fadd_s(float a, float b) { float r; asm("v_add_f32_e32 %0, %1, %2" : "=v"(r) : "v"(a), "v"(b)); return r; }
__device__ __forceinline__ float fsub_s(float a, float b) { float r; asm("v_sub_f32_e32 %0, %1, %2" : "=v"(r) : "v"(a), "v"(b)); return r; }
#define WAIT_BAR(N) asm volatile("s_waitcnt vmcnt(" #N ") lgkmcnt(0)\n\ts_barrier" ::: "memory")
typedef __attribute__((address_space(3))) const char* lds_cptr;
__device__ __forceinline__ void kload8(h16x8* kf, lds_cptr kp) {
    kf[0] = *(const FG_LAS h16x8*)(kp);        kf[1] = *(const FG_LAS h16x8*)(kp + 512);
    kf[2] = *(const FG_LAS h16x8*)(kp + 2048); kf[3] = *(const FG_LAS h16x8*)(kp + 2560);
    kf[4] = *(const FG_LAS h16x8*)(kp + 4096); kf[5] = *(const FG_LAS h16x8*)(kp + 4608);
    kf[6] = *(const FG_LAS h16x8*)(kp + 6144); kf[7] = *(const FG_LAS h16x8*)(kp + 6656);
}
__device__ __forceinline__ void kload2(h16x8* kf, lds_cptr kp, int j) { kf[2 * j] = *(const FG_LAS h16x8*)(kp + j * 2048); kf[2 * j + 1] = *(const FG_LAS h16x8*)(kp + j * 2048 + 512); }
__device__ __forceinline__ s16x4 vtr(lds_cptr p) { return __builtin_bit_cast(s16x4, __builtin_amdgcn_ds_read_tr16_b64_v4i16((FG_LAS v4i16_t*)p)); }
__device__ __forceinline__ void qkt(f32x16& p0, f32x16& p1, lds_cptr Kslot, const h16x8* qr, const f32x16& negm, int r32, int hi) {
    lds_cptr kb = Kslot + hi * 1024 + r32 * 16;
#pragma unroll
    for (int d0 = 0; d0 < 4; ++d0) {
        const h16x8 b0 = *(const FG_LAS h16x8*)(kb + d0 * 2048), b1 = *(const FG_LAS h16x8*)(kb + d0 * 2048 + 512);
        if (d0 == 0) { p0 = __builtin_amdgcn_mfma_f32_32x32x16_f16(b0, qr[0], negm, 0, 0, 0); p1 = __builtin_amdgcn_mfma_f32_32x32x16_f16(b1, qr[0], negm, 0, 0, 0); }
        else { p0 = __builtin_amdgcn_mfma_f32_32x32x16_f16(b0, qr[d0], p0, 0, 0, 0); p1 = __builtin_amdgcn_mfma_f32_32x32x16_f16(b1, qr[d0], p1, 0, 0, 0); } }
}
__device__ __forceinline__ float rowmax(const f32x16& p0, const f32x16& p1) {
    float a = max3f(p0[0], p0[1], p1[0]), b = max3f(p0[2], p0[3], p1[1]); a = max3f(a, p1[2], p1[3]);
#pragma unroll
    for (int r = 4; r < 16; r += 4) { a = max3f(a, p0[r], p0[r + 1]); b = max3f(b, p0[r + 2], p0[r + 3]); a = max3f(a, p1[r], p1[r + 1]); b = max3f(b, p1[r + 2], p1[r + 3]); }
    const float m = max2f(a, b);
    auto rr = __builtin_amdgcn_permlane32_swap(__float_as_uint(m), __float_as_uint(m), false, false);
    return max2f(__uint_as_float(rr[0]), __uint_as_float(rr[1]));
}
__device__ __forceinline__ void pv(f32x16* o, lds_cptr vb, h16x8 pa0, h16x8 pa1, h16x8 pa2, h16x8 pa3) {
    typedef short s8 __attribute__((ext_vector_type(8)));
#pragma unroll
    for (int d0 = 0; d0 < 2; ++d0) { s16x4 lo[4], hh[4];
#pragma unroll
        for (int ks = 0; ks < 4; ++ks) { lo[ks] = vtr(vb + d0 * 4096 + ks * 1024); hh[ks] = vtr(vb + d0 * 4096 + ks * 1024 + 512); }
#define PKV(k) __builtin_bit_cast(h16x8, (s8){lo[k][0], lo[k][1], lo[k][2], lo[k][3], hh[k][0], hh[k][1], hh[k][2], hh[k][3]})
        o[d0] = __builtin_amdgcn_mfma_f32_32x32x16_f16(pa0, PKV(0), o[d0], 0, 0, 0);
        o[d0] = __builtin_amdgcn_mfma_f32_32x32x16_f16(pa1, PKV(1), o[d0], 0, 0, 0);
        o[d0] = __builtin_amdgcn_mfma_f32_32x32x16_f16(pa2, PKV(2), o[d0], 0, 0, 0);
        o[d0] = __builtin_amdgcn_mfma_f32_32x32x16_f16(pa3, PKV(3), o[d0], 0, 0, 0);
#undef PKV
    }
}
template <int MIXER, int THRL>
__device__ __forceinline__ void attn_unit(const unsigned char* QI, const unsigned char* KI, const unsigned char* VI, h16* br, const float* sinkp, const float* rpb, int mixer, int b, int kvh, int qb, bool isctx, ldsp_t lds, unsigned* qctr, volatile FG_LAS unsigned* qw) {
    const int tid = tidx(), lane = tid & 63, wid = __builtin_amdgcn_readfirstlane(tid >> 6), r32 = lane & 31, hi = lane >> 5, g = wid >> 2, qsub = wid & 3, hq = kvh * 2 + g;
    const int brcol = (mixer == 0 ? 0 : mixer == 1 ? 512 : 768) + hq * 64;
    const int q0 = (isctx ? TL + b * 256 + qb * 128 : b * 2048 + qb * 128) + qsub * 32;
    int jlo = 0, nlat = 0;
    if (!isctx) {
        if (MIXER == 0) { jlo = 0; nlat = 32; }
        else if (MIXER == 1) { jlo = max(0, 2 * qb - 2); nlat = min(31, 2 * qb + 3) - jlo + 1; }
        else { jlo = min(max(2 * qb - 4, 0), 24); nlat = min(max(2 * qb - 3, 0), 24) + 7 - jlo + 1; }
    }
    const int nreal = 4 + nlat; const int NT = (nreal + 1) & ~1;
#define FA_TILE(s) ((s) < 4 ? (s) : 4 + jlo + min((s), nreal - 1) - 4)
    const unsigned lds0 = (unsigned)(size_t)lds;
    FG_LAS float* wsf = (FG_LAS float*)(lds + LDS_WS) + wid * 64;
    const unsigned char* ksrc = KI + ((size_t)((mixer * 16 + b) * 2 + kvh) * 36) * 8192 + wid * 1024 + lane * 16;
    const unsigned char* vsrc = VI + ((size_t)((mixer * 16 + b) * 2 + kvh) * 36) * 8192 + wid * 1024 + lane * 16;
    const unsigned kdst = lds0 + LDS_K + wid * 1024, vdst = lds0 + LDS_V + wid * 1024;
#define DMA_K(t, slot) glds16(ksrc + (size_t)FA_TILE(t) * 8192, (unsigned)__builtin_amdgcn_readfirstlane(kdst + (slot)))
#define DMA_V(t, slot) glds16(vsrc + (size_t)FA_TILE(t) * 8192, (unsigned)__builtin_amdgcn_readfirstlane(vdst + (slot)))
    h16x8 kf[8];
    const lds_cptr shm3 = (lds_cptr)lds; const lds_cptr kp0 = shm3 + LDS_K + hi * 1024 + r32 * 16;
    const lds_cptr vp0 = shm3 + LDS_V + ((lane >> 4) & 1) * 32 + (lane & 3) * 8 + (4 * hi + ((lane & 15) >> 2)) * 64;
    DMA_K(0, 0); DMA_V(0, 0); DMA_K(1, SLOTB);
    if (MIXER == 2) { FG_LAS float* tb = (FG_LAS float*)(lds + LDS_RPB); for (int i = tid; i < 930; i += NTHREADS) tb[i] = rpb[(size_t)(kvh * 2) * 465 + i] * LOG2E; }
    h16x8 qr[4];
    { const int qtile = (isctx ? 0 : 4) + 2 * qb + (qsub >> 1);
      const unsigned char* qp = QI + (((size_t)((mixer * 16 + b) * 4 + hq) * 36) + qtile) * 8192 + hi * 1024 + ((qsub & 1) * 32 + r32) * 16;
#pragma unroll
      for (int d0 = 0; d0 < 4; ++d0) qr[d0] = *(const h16x8*)(qp + d0 * 2048); }
    float mhat = 0.f, l_reg = 0.f; f32x16 o[2]; o[0] = f32x16{}; o[1] = f32x16{}; f32x16 negm = f32x16{}; asm volatile("" : "+v"(negm));
    const int tq = qb * 128 + qsub * 32 + r32;
    const int qrow = 2 * qb + (qsub >> 1);
    const int qcl = tq & 63; const int r0w = min(max(qrow - 4, 0), 24), c0q = min(max(qcl - 8, 0), 48);
#define CMASK(P0, P1, s) do { if (MIXER != 0 && (s) >= 4) { const float NEGI = -INFINITY; const int j_ = jlo + (s) - 4; \
        if ((s) >= nreal) { _Pragma("unroll") for (int r = 0; r < 16; ++r) { P0[r] = NEGI; P1[r] = NEGI; } } \
        else if (MIXER == 1) { const int dt = tq - 64 * j_; \
            _Pragma("unroll") for (int r = 0; r < 16; ++r) { const int kk = crow(r, hi); P0[r] = ((unsigned)(kk - dt + 128) <= 256u) ? P0[r] : NEGI; P1[r] = ((unsigned)(kk + 32 - dt + 128) <= 256u) ? P1[r] : NEGI; } } \
        else { const bool rowok = (j_ >= r0w) && (j_ <= r0w + 7); const int jr_ = rowok ? j_ : r0w; \
            const FG_LAS float* tb = (const FG_LAS float*)(lds + LDS_RPB) + g * 465 + (jr_ - qrow + 7) * 31 + (15 - qcl); \
            _Pragma("unroll") for (int r = 0; r < 16; ++r) { const int kc = crow(r, hi); \
                { const bool ok = rowok && ((unsigned)(kc - c0q) < 16u); const float bv = tb[ok ? kc : qcl]; P0[r] = ok ? P0[r] + bv : NEGI; } \
                { const int kc1 = kc + 32; const bool ok = rowok && ((unsigned)(kc1 - c0q) < 16u); const float bv = tb[ok ? kc1 : qcl]; P1[r] = ok ? P1[r] + bv : NEGI; } } } } } while (0)
    bool resc = false;
#define START(P0, P1) do { const float rm = rowmax(P0, P1); resc = false; \
    { const float dl = rm; mhat = fadd_s(mhat, dl); \
      _Pragma("unroll") for (int r = 0; r < 16; ++r) { P0[r] = fsub_s(P0[r], dl); P1[r] = fsub_s(P1[r], dl); } \
      _Pragma("unroll") for (int r = 0; r < 16; ++r) negm[r] = -mhat; asm volatile("" : "+v"(negm)); } \
    _Pragma("unroll") for (int r = 0; r < 16; ++r) P0[r] = __builtin_amdgcn_exp2f(P0[r]); } while (0)
#define RESC() do { if (resc) { asm volatile("s_waitcnt lgkmcnt(0)" ::: "memory"); \
      _Pragma("unroll") for (int d_ = 0; d_ < 2; ++d_) _Pragma("unroll") for (int r = 0; r < 16; ++r) o[d_][r] *= wsf[crow(r, hi)]; } } while (0)
    f32x16 pA0, pA1, pB0, pB1;
    int sl_prev = 0, sl_cur = 0, sl_next = SLOTB;
#define ROT() do { sl_prev = sl_cur; sl_cur = sl_next; sl_next = (sl_next == (NSLOT - 1) * SLOTB) ? 0 : sl_next + SLOTB; } while (0)
    DMA_K(2, 2 * SLOTB);
    WAIT_BAR(3);
    qkt(pA0, pA1, shm3 + LDS_K, qr, negm, r32, hi); asm volatile("s_nop 15\n\ts_nop 7" : "+v"(pA0), "+v"(pA1));
    START(pA0, pA1);
#pragma unroll
    for (int r = 0; r < 16; ++r) pA1[r] = __builtin_amdgcn_exp2f(pA1[r]);
    WAIT_BAR(0);
    DMA_K(3, 0); DMA_V(1, SLOTB);
    ROT();
    kload8(kf, kp0 + sl_cur);
    WAIT_BAR(2);
    s16x4 vlo[8], vhi[8]; u32x4 pw0, pw1, pw2, pw3;
    typedef short s8v __attribute__((ext_vector_type(8)));
#define PKW(P, B) pk_h2(P[B], P[B + 1])
#define PAF(k) __builtin_bit_cast(h16x8, pw##k)
#define VFR(i) __builtin_bit_cast(h16x8, (s8v){vlo[i][0], vlo[i][1], vlo[i][2], vlo[i][3], vhi[i][0], vhi[i][1], vhi[i][2], vhi[i][3]})
#define PIN(x) asm volatile("" : "+v"(x))
#define MX3(a, b, c) __builtin_fmaxf(__builtin_fmaxf((a), (b)), (c))
#define GAPA(MF, A0, A1, A2, A3, W0, W1, PW) do { MF; sacc += A0; sacc += A1; sacc += A2; sacc += A3; PIN(sacc); W0; W1; PIN(PW); SBAR(); } while (0)
#define EX(v) __builtin_amdgcn_exp2f(v)
#define GAPB(MF, X, B) do { MF; X[B] = EX(X[B]); X[B + 1] = EX(X[B + 1]); X[B + 2] = EX(X[B + 2]); X[B + 3] = EX(X[B + 3]); PIN(X); SBAR(); } while (0)
#define VRD(i) do { vlo[i] = vtr(vp_ + (((i) >> 2) * 4096 + ((i) & 3) * 1024)); vhi[i] = vtr(vp_ + (((i) >> 2) * 4096 + ((i) & 3) * 1024 + 512)); } while (0)
#define KRD(G, j) do { if (G) { kload2(kf, kp0 + sl_next, j); SBAR(); } } while (0)
#define MF32(a, b, c) __builtin_amdgcn_mfma_f32_32x32x16_f16(a, b, c, 0, 0, 0)
#define STEP(C0, C1, P0, P1, t, GK, GV, GL) do { SBAR(); \
    const lds_cptr vp_ = vp0 + sl_prev; \
    VRD(0); SBAR(); float sacc = (P0[0] + P0[1]); \
    GAPA(C0 = MF32(kf[0], qr[0], negm), P0[2], P0[3], P0[4], P0[5],     pw0[0] = PKW(P0, 0), pw0[1] = PKW(P0, 2), pw0); \
    VRD(4); SBAR(); GAPA(C1 = MF32(kf[1], qr[0], negm), P0[6], P0[7], P0[8], P0[9],     pw0[2] = PKW(P0, 4), pw0[3] = PKW(P0, 6), pw0); \
    VRD(1); SBAR(); GAPA(C0 = MF32(kf[2], qr[1], C0),   P0[10], P0[11], P0[12], P0[13], pw1[0] = PKW(P0, 8), pw1[1] = PKW(P0, 10), pw1); \
    VRD(5); SBAR(); GAPA(C1 = MF32(kf[3], qr[1], C1),   P0[14], P0[15], P1[0], P1[1],   pw1[2] = PKW(P0, 12), pw1[3] = PKW(P0, 14), pw1); \
    VRD(2); SBAR(); GAPA(C0 = MF32(kf[4], qr[2], C0),   P1[2], P1[3], P1[4], P1[5],     pw2[0] = PKW(P1, 0), pw2[1] = PKW(P1, 2), pw2); \
    VRD(6); SBAR(); GAPA(C1 = MF32(kf[5], qr[2], C1),   P1[6], P1[7], P1[8], P1[9],     pw2[2] = PKW(P1, 4), pw2[3] = PKW(P1, 6), pw2); \
    VRD(3); SBAR(); GAPA(C0 = MF32(kf[6], qr[3], C0),   P1[10], P1[11], P1[12], P1[13], pw3[0] = PKW(P1, 8), pw3[1] = PKW(P1, 10), pw3); \
    VRD(7); SBAR(); GAPA(C1 = MF32(kf[7], qr[3], C1),   P1[14], P1[15], 0.f, 0.f,       pw3[2] = PKW(P1, 12), pw3[3] = PKW(P1, 14), pw3); \
    l_reg += sacc; \
    if (GK) { DMA_K((t) + 3, sl_cur); } if (GV) { DMA_V((t) + 1, sl_next); } \
    CMASK(C0, C1, t); \
    { float a = MX3(C0[0], C0[1], C1[0]), b_ = MX3(C0[2], C0[3], C1[1]); a = MX3(a, C1[2], C1[3]); \
      _Pragma("unroll") for (int r = 4; r < 16; r += 4) { a = MX3(a, C0[r], C0[r + 1]); b_ = MX3(b_, C0[r + 2], C0[r + 3]); a = MX3(a, C1[r], C1[r + 1]); b_ = MX3(b_, C1[r + 2], C1[r + 3]); } \
      float rm = __builtin_fmaxf(a, b_); { auto rr = __builtin_amdgcn_permlane32_swap(__float_as_uint(rm), __float_as_uint(rm), false, false); rm = __builtin_fmaxf(__uint_as_float(rr[0]), __uint_as_float(rr[1])); } \
      resc = false; \
      if (__builtin_expect(__any(rm > (float)THRL), 0)) { const float dl = __builtin_fmaxf(rm, 0.f); mhat += dl; \
        _Pragma("unroll") for (int r = 0; r < 16; ++r) { C0[r] -= dl; C1[r] -= dl; } \
        _Pragma("unroll") for (int r = 0; r < 16; ++r) negm[r] = -mhat; asm volatile("" : "+v"(negm)); \
        const float f = __builtin_amdgcn_exp2f(-dl); l_reg *= f; if (hi == 0) wsf[r32] = f; resc = true; } } \
    SBAR(); \
    GAPB(o[0] = MF32(PAF(0), VFR(0), o[0]), C0, 0); \
    GAPB(o[1] = MF32(PAF(0), VFR(4), o[1]), C0, 4); \
    KRD(GL, 0); GAPB(o[0] = MF32(PAF(1), VFR(1), o[0]), C0, 8); \
    KRD(GL, 1); GAPB(o[1] = MF32(PAF(1), VFR(5), o[1]), C0, 12); \
    KRD(GL, 2); GAPB(o[0] = MF32(PAF(2), VFR(2), o[0]), C1, 0); \
    KRD(GL, 3); GAPB(o[1] = MF32(PAF(2), VFR(6), o[1]), C1, 4); \
    GAPB(o[0] = MF32(PAF(3), VFR(3), o[0]), C1, 8); \
    GAPB(o[1] = MF32(PAF(3), VFR(7), o[1]), C1, 12); \
    } while (0)
    int t = 1;
    for (; t + 5 < NT; t += 2) {
        STEP(pB0, pB1, pA0, pA1, t, true, true, true);     WAIT_BAR(2); RESC(); ROT();
        STEP(pA0, pA1, pB0, pB1, t + 1, true, true, true); WAIT_BAR(2); RESC(); ROT();
    }
#define ENDW(tt) do { if ((tt) + 3 < NT) { WAIT_BAR(2); } else if ((tt) + 2 < NT) { WAIT_BAR(1); } else { WAIT_BAR(0); } } while (0)
    for (; t + 1 < NT; t += 2) {
        STEP(pB0, pB1, pA0, pA1, t, (t + 3 < NT), (t + 1 < NT), (t + 1 < NT));         ENDW(t);     RESC(); ROT();
        STEP(pA0, pA1, pB0, pB1, t + 1, (t + 4 < NT), (t + 2 < NT), (t + 2 < NT));     ENDW(t + 1); RESC(); ROT();
    }
    STEP(pB0, pB1, pA0, pA1, NT - 1, false, false, false); RESC();
    unsigned nraw = 0u; if (tid == 0) nraw = __hip_atomic_fetch_add(qctr, 1u, __ATOMIC_RELAXED, __HIP_MEMORY_SCOPE_AGENT);
    { float sacc = pB0[0] + pB0[1];
#pragma unroll
      for (int r = 2; r < 16; ++r) sacc += pB0[r];
#pragma unroll
      for (int r = 0; r < 16; ++r) sacc += pB1[r];
      l_reg += sacc;
      pw0 = (u32x4){PKW(pB0, 0), PKW(pB0, 2), PKW(pB0, 4), PKW(pB0, 6)}; pw1 = (u32x4){PKW(pB0, 8), PKW(pB0, 10), PKW(pB0, 12), PKW(pB0, 14)};
      pw2 = (u32x4){PKW(pB1, 0), PKW(pB1, 2), PKW(pB1, 4), PKW(pB1, 6)}; pw3 = (u32x4){PKW(pB1, 8), PKW(pB1, 10), PKW(pB1, 12), PKW(pB1, 14)};
      SBAR(); pv(o, vp0 + sl_cur, PAF(0), PAF(1), PAF(2), PAF(3)); }
    { auto rr = __builtin_amdgcn_permlane32_swap(__float_as_uint(l_reg), __float_as_uint(l_reg), false, false); l_reg = __uint_as_float(rr[0]) + __uint_as_float(rr[1]); }
    if (mixer == 1) l_reg += __builtin_amdgcn_exp2f(sinkp[hq] * LOG2E - mhat);
    if (hi == 0) wsf[32 + r32] = l_reg; asm volatile("s_waitcnt lgkmcnt(0)" ::: "memory");
    float rli[16];
#pragma unroll
    for (int r = 0; r < 16; ++r) rli[r] = __builtin_amdgcn_rcpf(wsf[32 + crow(r, hi)]);
    h16* Ow = br + (size_t)q0 * DM + brcol;
    { FG_LAS h16* stg = (FG_LAS h16*)(lds + LDS_OST) + wid * 2048;
#pragma unroll
      for (int r = 0; r < 16; ++r) { const int orow = crow(r, hi);
#pragma unroll
          for (int d0 = 0; d0 < 2; ++d0) stg[orow * 64 + d0 * 32 + r32] = (h16)(o[d0][r] * rli[r]); }
      asm volatile("s_waitcnt lgkmcnt(0)" ::: "memory");
#pragma unroll
      for (int i = 0; i < 4; ++i) { const int row = i * 8 + (lane >> 3), ch = lane & 7; const u32x4 v = *(const FG_LAS u32x4*)(stg + row * 64 + ch * 8); *(u32x4*)(Ow + (size_t)row * DM + ch * 8) = v; } }
    if (tid == 0) qw[0] = nraw;
    asm volatile("s_waitcnt lgkmcnt(0)\n\ts_barrier" ::: "memory");
#undef FA_TILE
#undef DMA_K
#undef DMA_V
#undef CMASK
#undef START
#undef RESC
#undef ROT
#undef PKW
#undef PAF
#undef VFR
#undef PIN
#undef MX3
#undef GAPA
#undef GAPB
#undef EX
#undef VRD
#undef KRD
#undef MF32
#undef STEP
#undef ENDW
}
#undef SBAR
#undef WAIT_BAR
}
struct SchedTwo { fg::Unit u0, u1; __device__ __forceinline__ bool next(int i, fg::Unit& o) const { if (i == 0) { o = u0; return true; } if (i == 1) { o = u1; return true; } return false; } };
struct EpiDftSym {
    static constexpr bool PERM = true;
    h16* br; unsigned char* scr;
    __device__ __forceinline__ void operator()(const f32x4 (&acc)[2][2][4][2], const fg::Unit& u, int wr, int wc, int fr, int fq) const {
        const int tid = tidx(); const float scl = 0.022097086912079608f;
        if (u.aux == 0) {
#pragma unroll
            for (int ai = 0; ai < 2; ++ai)
#pragma unroll
                for (int m = 0; m < 4; ++m)
#pragma unroll
                    for (int bj = 0; bj < 2; ++bj)
#pragma unroll
                        for (int n = 0; n < 2; ++n) { const int q = ((ai * 4 + m) * 2 + bj) * 2 + n; *(f32x4*)(scr + ((size_t)q * 512 + tid) * 16) = acc[ai][bj][m][n]; }
        } else {
#pragma unroll
            for (int ai = 0; ai < 2; ++ai) {
                f32x4 pv[4][2][2];
#pragma unroll
                for (int m = 0; m < 4; ++m)
#pragma unroll
                    for (int bj = 0; bj < 2; ++bj)
#pragma unroll
                        for (int n = 0; n < 2; ++n) { const int q = ((ai * 4 + m) * 2 + bj) * 2 + n; pv[m][bj][n] = *(const f32x4*)(scr + ((size_t)q * 512 + tid) * 16); }
                asm volatile("" ::: "memory");
#pragma unroll
                for (int m = 0; m < 4; ++m) { const int k = u.pm * 256 + 128 * ai + 64 * wr + 16 * m + fr + 1;
                    h16* lo = br + ((size_t)u.pn * 2048 + k) * DM + 256; h16* hi = br + ((size_t)u.pn * 2048 + (2048 - k)) * DM + 256;
#pragma unroll
                    for (int bj = 0; bj < 2; ++bj) { const int col = 128 * bj + 32 * wc + 8 * fq;
                        const f32x4 p0 = pv[m][bj][0], p1 = pv[m][bj][1];
                        const f32x4 q0v = acc[ai][bj][m][0], q1v = acc[ai][bj][m][1];
                        const f32x4 a0 = (p0 - q0v) * scl, a1 = (p1 - q1v) * scl, b0 = (p0 + q0v) * scl, b1 = (p1 + q1v) * scl;
                        *(u32x4*)(lo + col) = (u32x4){pk_h2(a0[0], a0[1]), pk_h2(a0[2], a0[3]), pk_h2(a1[0], a1[1]), pk_h2(a1[2], a1[3])};
                        *(u32x4*)(hi + col) = (u32x4){pk_h2(b0[0], b0[1]), pk_h2(b0[2], b0[3]), pk_h2(b1[0], b1[1]), pk_h2(b1[2], b1[3])}; } }
                asm volatile("" ::: "memory");
            }
        }
    }
};
struct SchedOne { fg::Unit u; __device__ __forceinline__ bool next(int i, fg::Unit& o) const { if (i != 0) return false; o = u; return true; } };
__device__ __forceinline__ void phase_mixers(const Params& p, int l, ldsp_t lds, int rep = 0) {
    const unsigned char* QI = p.ws + WS_QI; const unsigned char* KI = p.ws + WS_KI; const unsigned char* VI = p.ws + WS_VI; h16* br = (h16*)(p.ws + WS_BR);
    const float* sinkp = p.sink + l * 4; const float* rpb = p.rpb + (size_t)l * 4 * 465;
    const int x = bidx() & 7;
    unsigned* qctr = (unsigned*)(p.ws + WS_CTL) + 64 * (rep * 16 + l * 8 + x) + 32;
    volatile FG_LAS unsigned* qw = (volatile FG_LAS unsigned*)(lds + LDS_BYTES - 512);
    const int nq = (l == 0) ? 226 : 200;
    const int tid = tidx();
    if (rep == 0) fourier_row0(p);
    __syncthreads();
    bool have = false;
    for (;;) {
        if (!have && tid == 0) qw[0] = __hip_atomic_fetch_add(qctr, 1u, __ATOMIC_RELAXED, __HIP_MEMORY_SCOPE_AGENT);
        __syncthreads();
        int idx = (int)qw[0];
        have = false;
        if (idx >= nq) break;
        if (l == 0 && idx >= 72) idx = idx < 74 ? idx + 152 : idx - 2;
        if (rep > 0) { const bool isdft = idx < 8 || idx >= 224; if ((PROBE_MODE == 1 && isdft) || (PROBE_MODE == 2 && !isdft)) continue; }
        if (idx < 8) {
            const int id = idx;
            SchedTwo S; S.u0.pm = id & 3; S.u0.pn = 2 * x + (id >> 2); S.u0.nt = 32; S.u0.aux = 0;
            S.u0.A = (const char*)(p.ws + WS_DFT) + (size_t)S.u0.pm * 256 * 4096 * 2; S.u0.B = (const char*)(p.ws + WS_ZTL) + (size_t)S.u0.pn * 256 * 4096 * 2;
            S.u1 = S.u0; S.u1.aux = 1; S.u1.A += 4096; S.u1.B += 4096;
            EpiDftSym E{br, p.ws + WS_GSCR + (size_t)bidx() * 262144};
            fg::gemm_phase<EpiDftSym, SchedTwo, 4096>(lds, S, E);
        } else if (idx < 200) {
            const int w = (idx - 8) & 63; const int ty = (idx - 8) >> 6;
            if (ty == 0) { fa::attn_unit<0, 8>(QI, KI, VI, br, sinkp, rpb, 0, 2 * x + (w >> 5), (w >> 4) & 1, w & 15, false, lds, qctr, qw); }
            else if (ty == 1) { fa::attn_unit<2, 8>(QI, KI, VI, br, sinkp, rpb, 2, 2 * x + (w >> 5), (w >> 4) & 1, w & 15, false, lds, qctr, qw); }
            else { fa::attn_unit<1, 8>(QI, KI, VI, br, sinkp, rpb, 1, 2 * x + (w >> 5), (w >> 4) & 1, w & 15, false, lds, qctr, qw); }
            have = true;
        } else if (idx < 224) {
            const int w = idx - 200; const int mixer = w >> 3, rest = w & 7;
            fa::attn_unit<0, 8>(QI, KI, VI, br, sinkp, rpb, mixer, 2 * x + (rest >> 2), (rest >> 1) & 1, rest & 1, true, lds, qctr, qw); have = true;
        } else {
            SchedOne S; S.u.pm = 0; S.u.pn = 2 * x + (idx - 224); S.u.nt = 8; S.u.aux = 0;
            S.u.A = (const char*)(p.ws + WS_DFTC); S.u.B = (const char*)(p.ws + WS_ZTC) + (size_t)S.u.pn * 256 * 512 * 2;
            EpiDft E{br, TL, 256, 0.0625f};
            fg::gemm_phase<EpiDft, SchedOne, 512>(lds, S, E);
        }
    }
    __syncthreads();
}

#define XB_TMO      128
#define XB_XCNT(j)  (256  + 64 * (j))
#define XB_XSUB(j)  (1280 + 64 * (j))
#define XB_XGEN(j)  (2304 + 64 * (j))
#define XB_TOP      3328
#define XB_TOPGEN   3392
#define XB_SPIN_CAP (1u << 22)
__device__ __forceinline__ unsigned xb_ld(unsigned* p)              { return __hip_atomic_load(p, __ATOMIC_RELAXED, __HIP_MEMORY_SCOPE_AGENT); }
__device__ __forceinline__ unsigned xb_add(unsigned* p, unsigned v) { return __hip_atomic_fetch_add(p, v, __ATOMIC_RELAXED, __HIP_MEMORY_SCOPE_AGENT); }
__device__ __forceinline__ unsigned xb_xcc_id() { return (unsigned)__builtin_amdgcn_s_getreg((3 << 11) | 20) & 0xFu; }
#define XB_SPIN(cond, bar) do { unsigned _sp = 0; while (cond) { __builtin_amdgcn_s_sleep(1); \
    if ((++_sp & 255u) == 0u) { if (xb_ld(&(bar)[XB_TMO])) break; if (_sp > XB_SPIN_CAP) { atomicAdd(&(bar)[XB_TMO], 1u); break; } } } } while (0)
struct XcdBarrier { unsigned* bar; unsigned x; volatile FG_LAS unsigned* st; };
__device__ __forceinline__ XcdBarrier xcd_barrier_post(unsigned* bar, volatile FG_LAS unsigned* st) {
    XcdBarrier b; b.bar = bar; b.x = xb_xcc_id(); b.st = st;
    if (threadIdx.x == 0) (void)xb_add(&bar[XB_XCNT(b.x)], 1u);
    return b;
}
__device__ __forceinline__ void xcd_barrier_complete(unsigned* bar, unsigned x, unsigned& nloc, unsigned& nx) {
    const unsigned G = gridDim.x * gridDim.y * gridDim.z;
    unsigned sum, cnt, mine, sp = 0u;
    for (;;) {
        sum = 0u; cnt = 0u; mine = 0u;
#pragma unroll
        for (unsigned j = 0; j < 16; ++j) { const unsigned c = xb_ld(&bar[XB_XCNT(j)]); sum += c; cnt += (c > 0u) ? 1u : 0u; mine = (j == x) ? c : mine; }
        if (sum == G) break;
        __builtin_amdgcn_s_sleep(1);
        if ((++sp & 255u) == 0u) { if (xb_ld(&bar[XB_TMO])) break; if (sp > XB_SPIN_CAP) { atomicAdd(&bar[XB_TMO], 1u); break; } }
    }
    nloc = mine > 0u ? mine : 1u; nx = cnt > 0u ? cnt : 1u;
}
__device__ __forceinline__ void xcd_barrier(const XcdBarrier& b) {
    asm volatile("s_waitcnt vmcnt(0)" ::: "memory");
    unsigned* bar = b.bar; unsigned bx = __builtin_amdgcn_readfirstlane(b.x); asm volatile("" : "+s"(bar), "+s"(bx));
    __syncthreads();
    if (tidx() == 0) {
        __builtin_amdgcn_s_waitcnt(0);
        unsigned nloc = b.st[0], nx = b.st[1];
        if (nloc == 0u) { xcd_barrier_complete(bar, bx, nloc, nx); b.st[0] = nloc; b.st[1] = nx; }
        const unsigned old = xb_add(&bar[XB_XSUB(bx)], 1u);
        const unsigned gen = old / nloc;
        if (old + 1u == (gen + 1u) * nloc) {
            __builtin_amdgcn_fence(__ATOMIC_RELEASE, "agent");
            asm volatile("s_waitcnt vmcnt(0)" ::: "memory");
            const unsigned og = xb_add(&bar[XB_TOP], 1u);
            const unsigned tg = og / nx;
            if (og + 1u == (tg + 1u) * nx) xb_add(&bar[XB_TOPGEN], 1u);
            else XB_SPIN(xb_ld(&bar[XB_TOPGEN]) == tg, bar);
            __builtin_amdgcn_fence(__ATOMIC_ACQUIRE, "agent");
            xb_add(&bar[XB_XGEN(bx)], 1u);
            asm volatile("s_waitcnt vmcnt(0)" ::: "memory");
        } else {
            XB_SPIN(xb_ld(&bar[XB_XGEN(bx)]) == gen, bar);
            __builtin_amdgcn_fence(__ATOMIC_ACQUIRE, "agent");
            asm volatile("s_waitcnt vmcnt(0)" ::: "memory");
        }
    }
    __syncthreads();
}

__device__ __forceinline__ void xcd_barrier_arrive(const XcdBarrier& b) {
    asm volatile("s_waitcnt vmcnt(0)" ::: "memory");
    unsigned* bar = b.bar; unsigned bx = __builtin_amdgcn_readfirstlane(b.x); asm volatile("" : "+s"(bar), "+s"(bx));
    __syncthreads();
    if (tidx() == 0) {
        __builtin_amdgcn_s_waitcnt(0);
        unsigned nloc = b.st[0], nx = b.st[1];
        if (nloc == 0u) { xcd_barrier_complete(bar, bx, nloc, nx); b.st[0] = nloc; b.st[1] = nx; }
        const unsigned old = xb_add(&bar[XB_XSUB(bx)], 1u);
        const unsigned gen = old / nloc;
        unsigned mode = 0u, tg = 0u;
        if (old + 1u == (gen + 1u) * nloc) {
            __builtin_amdgcn_fence(__ATOMIC_RELEASE, "agent");
            asm volatile("s_waitcnt vmcnt(0)" ::: "memory");
            const unsigned og = xb_add(&bar[XB_TOP], 1u);
            tg = og / nx; mode = 1u;
            if (og + 1u == (tg + 1u) * nx) { xb_add(&bar[XB_TOPGEN], 1u); mode = 2u; }
            xb_add(&bar[XB_XGEN(bx)], 1u);
        }
        b.st[2] = mode; b.st[3] = gen; b.st[4] = tg;
    }
    __syncthreads();
}
__device__ __forceinline__ void xcd_barrier_wait(const XcdBarrier& b) {
    unsigned* bar = b.bar; unsigned bx = __builtin_amdgcn_readfirstlane(b.x); asm volatile("" : "+s"(bar), "+s"(bx));
    __syncthreads();
    if (tidx() == 0) {
        const unsigned mode = b.st[2], gen = b.st[3];
        if (mode != 2u) XB_SPIN(xb_ld(&bar[XB_TOPGEN]) == gen, bar);
        __builtin_amdgcn_fence(__ATOMIC_ACQUIRE, "agent");
        asm volatile("s_waitcnt vmcnt(0)" ::: "memory");
    }
    __syncthreads();
}

__global__ void __launch_bounds__(NTHREADS) mk_fwd(Params p_in) {
    extern __shared__ __attribute__((aligned(16))) unsigned char lds_raw[];
    float* lds = (float*)lds_raw; ldsp_t ldsf = (ldsp_t)lds_raw;
    cg::grid_group grid = cg::this_grid();
    volatile FG_LAS unsigned* misc = (volatile FG_LAS unsigned*)(ldsf + LDS_BYTES - 256);
    if (threadIdx.x < 32) misc[threadIdx.x] = (threadIdx.x == 16) ? blockIdx.x : 0u;
    __syncthreads();
    XcdBarrier xbar = xcd_barrier_post((unsigned*)(ldp().ws + WS_CTL) + 4096, misc + 8);
#define GSYNC() do { xcd_barrier_arrive(xbar); xcd_barrier_wait(xbar); } while (0)
    unsigned* cen = (unsigned*)(ldp().ws + WS_CTL) + 2048;
    if (threadIdx.x == 0) misc[17] = __hip_atomic_fetch_add(cen + 64 * xb_xcc_id(), 1u, __ATOMIC_RELAXED, __HIP_MEMORY_SCOPE_AGENT);
    for (int r_ = 0; r_ < RP_P0; ++r_) phase0(ldp(), lds);
    dense_transposes(ldp(), lds);
    if (ldp().ws == nullptr) grid.sync();
    GSYNC();
    if (threadIdx.x == 0) { bool ok = (gridDim.x == 256);
        for (int j = 0; j < 16; ++j) { const unsigned cj = __hip_atomic_load(cen + 64 * j, __ATOMIC_RELAXED, __HIP_MEMORY_SCOPE_AGENT); ok = ok && (cj == (j < 8 ? 32u : 0u)); }
        if (ok) misc[16] = misc[17] * 8u + xb_xcc_id(); }
    __syncthreads();
    phase_convert_dense(ldp(), lds, ldsf);
    phase_wg(ldp());
    for (int r_ = 0; r_ < RP_U; ++r_) phase_u(ldp(), 0);
    GSYNC();
    for (int l = 0; l < DEPTH; ++l) {
        for (int r_ = 0; r_ < RP_G1; ++r_) phase_g1_fast(ldp(), l, ldsf);
        xcd_barrier_arrive(xbar);
        if (l == 0 ? ((bidx() & 7) >= 4) : (bidx() >= 48)) bg_convert(ldp(), l, lds, BG_G1, true);
        xcd_barrier_wait(xbar);
        for (int r_ = 0; r_ < RP_ATT; ++r_) phase_mixers(ldp(), l, ldsf, r_);
        xcd_barrier_arrive(xbar);
        phase_merge_fast(ldp(), l, ldsf, 0, 1);
        xcd_barrier_wait(xbar);
        phase_merge_fast(ldp(), l, ldsf, 1, 18);
        GSYNC();
        if (l == 0) { phase_merge_sum(ldp()); xcd_barrier_arrive(xbar); }
        phase_out_fast(ldp(), l, ldsf, 0, 2);
        if (l == 0) {
            if ((bidx() & 7) >= 2) bg_convert(ldp(), 0, lds, BG_OUT, true);
            xcd_barrier_wait(xbar);
            phase_out_fast(ldp(), l, ldsf, 2, 3); }
        xcd_barrier_arrive(xbar);
        phase_ln1_fill(ldp(), l, lds);
        xcd_barrier_wait(xbar);
        phase_ln1(ldp(), l, lds);
        GSYNC();
        for (int r_ = 0; r_ < RP_TOPK; ++r_) phase_topk(ldp(), l, lds);
        xcd_barrier_arrive(xbar);
        bg_convert(ldp(), l, lds, 1 << 20);
        xcd_barrier_wait(xbar);
        for (int r_ = 0; r_ < RP_UP; ++r_) phase_up_fast(ldp(), l, ldsf);
        GSYNC();
        for (int r_ = 0; r_ < RP_DN; ++r_) phase_down_fast(ldp(), l, ldsf);
        if (l == 0 && (bidx() & 7) >= 4) bg_convert(ldp(), 1, lds, BG_DN, true);
        GSYNC();
        for (int r_ = 0; r_ < (l == 1 ? RP_LN2 : 1); ++r_) phase_ln2(ldp(), l, lds);
        if (l == 0) GSYNC();
    }
}

extern "C" void kernel_launch(void* const* d_in, const int* in_sizes, int n_in, void* d_out, int out_size, void* d_ws, size_t ws_size, hipStream_t stream) {
    static int grid = 0;
    if (grid == 0) {
        if (n_in != 20 || ws_size < WS_END) { fprintf(stderr, "kernel_launch: unexpected n_in %d or ws_size %zu (need %zu)\n", n_in, ws_size, (size_t)WS_END); grid = -1; return; }
        int dev = 0, cus = 0, per_cu = 0;
        hipGetDevice(&dev); hipDeviceGetAttribute(&cus, hipDeviceAttributeMultiprocessorCount, dev);
        hipFuncSetAttribute((const void*)mk_fwd, hipFuncAttributeMaxDynamicSharedMemorySize, LDS_BYTES);
        hipOccupancyMaxActiveBlocksPerMultiprocessor(&per_cu, (const void*)mk_fwd, NTHREADS, LDS_BYTES);
        if (per_cu < 1) { fprintf(stderr, "kernel_launch: occupancy query says %d blocks per CU\n", per_cu); per_cu = 1; }
        (void)hipGetLastError();
        if (cus * per_cu < 256) { fprintf(stderr, "kernel_launch: needs 256 co-resident workgroups, device offers %d x %d\n", cus, per_cu); grid = -1; return; }
        grid = 256;
    }
    if (grid < 0) return;
    hipMemsetAsync((char*)d_ws + WS_CTL, 0, 64 * 1024, stream);
    Params p{};
    const float** pp = (const float**)&p;
    for (int i = 0; i < 20; ++i) pp[i] = (const float*)d_in[i];
    p.out = (float*)d_out; p.ws = (unsigned char*)d_ws;
    void* args[] = {&p};
    hipError_t e = hipLaunchCooperativeKernel((const void*)mk_fwd, dim3(grid), dim3(NTHREADS), args, LDS_BYTES, stream);
    if (e != hipSuccess) fprintf(stderr, "cooperative launch failed: %s (grid %d)\n", hipGetErrorString(e), grid);
}
```

```cpp
#include <hip/hip_runtime.h>
#include <hip/hip_cooperative_groups.h>
#include <cstdio>
#include <cstdint>
#include <type_traits>
namespace cg = cooperative_groups;

typedef _Float16 h16;
typedef _Float16 h16x8 __attribute__((ext_vector_type(8)));
typedef _Float16 h16x4 __attribute__((ext_vector_type(4)));
typedef float f32x4 __attribute__((ext_vector_type(4)));

constexpr int DM = 1024, NBATCH = 16, SEQ = 2048, CTX = 256, DEPTH = 2;
constexpr int TL = NBATCH * SEQ;
constexpr int TC = NBATCH * CTX;
constexpr int TT = TL + TC;
constexpr int INW = 5888, NMOD = 6 * DM, PMW = 1536;
constexpr int NEXP = 16, FF = 1024, CAPL = 256, CAPC = 32;
constexpr int GL = NBATCH * NEXP * CAPL;
constexpr int GC = NBATCH * NEXP * CAPC;
constexpr int GT = GL + GC;
constexpr float ALPHA = 1.4142135623730951f;
constexpr float LN_EPS = 1e-6f, RMS_EPS = 1e-6f;
constexpr int NTHREADS = 512, NWAVES = 8;
constexpr int LDS_BYTES = 147456;
constexpr int BG_G1 = 2, BG_OUT = 3, BG_DN = 1;
constexpr int PROBE_MODE = 0, RP_P0 = 1, RP_LN2 = 1;
constexpr int RP_G1 = 1, RP_FOU = 1, RP_MRG = 1, RP_OUT = 1, RP_UP = 1, RP_DN = 1, RP_ATT = 1, RP_U = 1, RP_TOPK = 1;


constexpr size_t MiB = 1u << 20;
constexpr size_t WS_CTL = 0;
constexpr size_t WS_MODV = 1 * MiB;
constexpr size_t WS_WFIN = 2 * MiB;
constexpr size_t WS_BDT = 3 * MiB;
constexpr size_t WS_TAB = 6 * MiB;
constexpr size_t WS_AFFL = 7 * MiB;
constexpr size_t WS_AFFC = 9 * MiB;
constexpr size_t WS_SELW = 10 * MiB;
constexpr size_t WS_STAT = 9 * MiB + 512 * 1024;
constexpr size_t WS_SELR = 10 * MiB + 512 * 1024;
constexpr size_t WS_SLOT = 11 * MiB;
constexpr size_t WS_WG = 13 * MiB + 512 * 1024;
constexpr size_t WS_SGB = 15 * MiB + 768 * 1024;
constexpr size_t WS_HB = 16 * MiB;
constexpr size_t WS_S = 160 * MiB;
constexpr size_t WS_U16 = WS_S;
constexpr size_t WS_PM = WS_S + 72 * MiB;
constexpr size_t WS_QI = WS_PM;
constexpr size_t WS_KI = WS_PM + 54 * MiB;
constexpr size_t WS_VI = WS_PM + 81 * MiB;
constexpr size_t WS_ZTL = WS_PM + 108 * MiB;
constexpr size_t WS_ZTC = WS_ZTL + 32 * MiB;
constexpr size_t WS_XG = WS_S + 72 * MiB;
constexpr size_t WS_BR = WS_S + 216 * MiB;
constexpr size_t WS_H16 = WS_S + 216 * MiB;
constexpr size_t WS_GSCR = WS_S + 288 * MiB;
constexpr size_t WS_MPART = WS_S + 320 * MiB;
constexpr size_t WS_WINT = WS_S + 360 * MiB;
constexpr size_t WS_WBT = WS_WINT + 24 * MiB;
constexpr size_t WS_WOT = WS_WBT + 4 * MiB;
constexpr size_t WS_DFT = WS_WOT + 4 * MiB;
constexpr size_t WS_DFTC = WS_DFT + 16 * MiB;
constexpr size_t WS_WGU1 = WS_DFTC + 1 * MiB;
constexpr size_t WS_END = WS_WGU1 + 64 * MiB;
constexpr size_t DO_WGU = 0;
constexpr size_t DO_WD = 64 * MiB;
constexpr size_t DO_WD1 = 96 * MiB;

struct Params {
    const float *x, *c, *ctx, *c_ctx, *w_mod, *b_mod, *w_in, *qk_gain, *sink, *rpb, *w_branch, *w_out, *ln1_g, *ln1_b, *w_router, *w_gate, *w_up, *w_down, *ln2_g, *ln2_b;
    float* out; unsigned char* ws;
};
typedef const __attribute__((address_space(4))) Params* kargp_t;
#if defined(__HIP_DEVICE_COMPILE__)
__device__ __forceinline__ Params ldp() { kargp_t q = (kargp_t)__builtin_amdgcn_kernarg_segment_ptr(); asm volatile("" : "+s"(q)); return *q; }
#else
__device__ __forceinline__ Params ldp() { return Params{}; }
#endif

#define VCU_LDS_ADDR (LDS_BYTES - 256 + 64)
__device__ __forceinline__ int bidx() { const unsigned v = *(volatile __attribute__((address_space(3))) unsigned*)(VCU_LDS_ADDR); int b = __builtin_amdgcn_readfirstlane((int)v); asm volatile("" : "+s"(b)); return b; }
__device__ __forceinline__ int tidx() { int t = threadIdx.x; asm volatile("" : "+v"(t)); return t; }
template <int CTRL> __device__ __forceinline__ float dpp_f(float v) { return __builtin_bit_cast(float, __builtin_amdgcn_update_dpp(0, __builtin_bit_cast(int, v), CTRL, 0xf, 0xf, true)); }
__device__ __forceinline__ float xor16_sum(float v) { const auto r = __builtin_amdgcn_permlane16_swap(__float_as_uint(v), __float_as_uint(v), false, false); return __uint_as_float(r[0]) + __uint_as_float(r[1]); }
__device__ __forceinline__ float xor32_sum(float v) { const auto r = __builtin_amdgcn_permlane32_swap(__float_as_uint(v), __float_as_uint(v), false, false); return __uint_as_float(r[0]) + __uint_as_float(r[1]); }
__device__ __forceinline__ float xor16_max(float v) { const auto r = __builtin_amdgcn_permlane16_swap(__float_as_uint(v), __float_as_uint(v), false, false); return fmaxf(__uint_as_float(r[0]), __uint_as_float(r[1])); }
__device__ __forceinline__ float xor32_max(float v) { const auto r = __builtin_amdgcn_permlane32_swap(__float_as_uint(v), __float_as_uint(v), false, false); return fmaxf(__uint_as_float(r[0]), __uint_as_float(r[1])); }
__device__ __forceinline__ float wave_sum(float v) {
    v += dpp_f<0xB1>(v);
    v += dpp_f<0x4E>(v);
    v += dpp_f<0x141>(v);
    v += dpp_f<0x140>(v);
    v = xor16_sum(v); v = xor32_sum(v);
    return v;
}
__device__ __forceinline__ float wave_max(float v) {
    v = fmaxf(v, dpp_f<0xB1>(v)); v = fmaxf(v, dpp_f<0x4E>(v)); v = fmaxf(v, dpp_f<0x141>(v)); v = fmaxf(v, dpp_f<0x140>(v));
    v = xor16_max(v); v = xor32_max(v);
    return v;
}
typedef unsigned u32x4 __attribute__((ext_vector_type(4)));
__device__ __forceinline__ unsigned pk_h2(float lo, float hi) { typedef _Float16 h2 __attribute__((ext_vector_type(2))); h2 v = {(h16)lo, (h16)hi}; return __builtin_bit_cast(unsigned, v); }
typedef __bf16 bf16x2_t __attribute__((ext_vector_type(2)));
typedef float f32x2_t __attribute__((ext_vector_type(2)));
typedef short bf16x8_t __attribute__((ext_vector_type(8)));
__device__ __forceinline__ unsigned pk_b2(float lo, float hi) { f32x2_t v = {lo, hi}; bf16x2_t b = __builtin_convertvector(v, bf16x2_t); return __builtin_bit_cast(unsigned, b); }
__device__ __forceinline__ float sigmoid_f(float v) { return __builtin_amdgcn_rcpf(1.f + __builtin_amdgcn_exp2f(v * -1.4426950408889634f)); }
__device__ __forceinline__ float silu_f(float v) { return v * sigmoid_f(v); }
__device__ __forceinline__ float sig2_f(float t) { return __builtin_amdgcn_rcpf(1.f + __builtin_amdgcn_exp2f(t)); }
__device__ __forceinline__ int mv_of(int R) { return R < TL ? (R >> 11) : 16; }

__device__ __forceinline__ void phase0(const Params& p, float* lds) {
    float* modv = (float*)(p.ws + WS_MODV); float* tab = (float*)(p.ws + WS_TAB);
    const int tid = tidx(), lane = tid & 63, wave = tid >> 6, c = bidx(), G = gridDim.x;
    if (c < 192) {
        float* sc = lds;
        float* red = lds + 17 * 1024;
        for (int e = tid; e < 17 * 1024; e += NTHREADS) { const int mv = e >> 10, k = e & 1023; const float v = mv < 16 ? p.c[mv * 1024 + k] : p.c_ctx[k]; sc[e] = silu_f(v); }
        __syncthreads();
        const int col0 = c * 64; const int l = col0 / NMOD, n0 = col0 % NMOD; const int rg = lane >> 4, cq = lane & 15;
        f32x4 acc[17];
#pragma unroll
        for (int m = 0; m < 17; ++m) acc[m] = (f32x4){0.f, 0.f, 0.f, 0.f};
        const float* w = p.w_mod + ((size_t)l * DM + wave * 128 + rg) * NMOD + n0 + cq * 4;
#pragma unroll 4
        for (int i = 0; i < 32; ++i) { const f32x4 wv = *(const f32x4*)(w + (size_t)(4 * i) * NMOD);
#pragma unroll
            for (int m = 0; m < 17; ++m) acc[m] += wv * sc[m * 1024 + wave * 128 + rg + 4 * i]; }
#pragma unroll
        for (int m = 0; m < 17; ++m) {
#pragma unroll
            for (int e = 0; e < 4; ++e) { float v = acc[m][e]; v += __shfl_xor(v, 16); v += __shfl_xor(v, 32); acc[m][e] = v; }
            if (rg == 0) *(f32x4*)(red + (wave * 17 + m) * 64 + cq * 4) = acc[m]; }
        __syncthreads();
        for (int e = tid; e < 17 * 64; e += NTHREADS) { const int m = e >> 6, ln = e & 63; float sacc = 0.f;
#pragma unroll
            for (int wv = 0; wv < 8; ++wv) sacc += red[(wv * 17 + m) * 64 + ln];
            const int nn = n0 + ln; modv[((size_t)l * 17 + m) * NMOD + nn] = sacc + p.b_mod[l * NMOD + nn]; }
        __syncthreads();
    }
    float* cT = lds; float* sT = lds + 2048;
    __syncthreads();
    for (int j = tid; j < 2048; j += NTHREADS) { cT[j] = cospif((float)j / 1024.f); sT[j] = sinpif((float)j / 1024.f); }
    if (c == G - 1) for (int e = tid; e < 64 * 16; e += NTHREADS) { const int pos = e >> 4, j = e & 15; const float inv = powf(10000.f, -(float)j / 16.f); const float ang = (float)pos * inv;
        tab[4096 + e] = cosf(ang); tab[4096 + 1024 + e] = sinf(ang); }
    __syncthreads();
    const int gt = c * NTHREADS + tid, NG = G * NTHREADS;
    { h16* DFT = (h16*)(p.ws + WS_DFT); h16* DFTC = (h16*)(p.ws + WS_DFTC);
      for (int o = gt; o < 1024 * 512 + 256 * 64; o += NG) {
        unsigned w[4];
        if (o < 1024 * 512) { const int k = (o >> 9) + 1, j0 = (o & 511) * 8;
#pragma unroll
            for (int q = 0; q < 4; ++q) { float v[2];
#pragma unroll
                for (int h = 0; h < 2; ++h) { const int j = j0 + q * 2 + h; const int idx = (k * (j & 2047)) & 2047; v[h] = (j >> 11) ? sT[idx] : cT[idx]; }
                w[q] = pk_h2(v[0], v[1]); }
            *(u32x4*)(DFT + (size_t)(k - 1) * 4096 + j0) = (u32x4){w[0], w[1], w[2], w[3]}; }
        else { const int oo = o - 1024 * 512; const int k = oo >> 6, j0 = (oo & 63) * 8;
#pragma unroll
            for (int q = 0; q < 4; ++q) { float v[2];
#pragma unroll
                for (int h = 0; h < 2; ++h) { const int j = j0 + q * 2 + h; const int idx = ((k * (j & 255)) & 255) * 8; v[h] = (j >> 8) ? -sT[idx] : cT[idx]; }
                w[q] = pk_h2(v[0], v[1]); }
            *(u32x4*)(DFTC + (size_t)k * 512 + j0) = (u32x4){w[0], w[1], w[2], w[3]}; } } }
    { h16* BDT = (h16*)(p.ws + WS_BDT);
      for (int o = gt; o < 512 * 256; o += NG) { const int zc = o >> 8, gc = o & 255; const int g = zc >> 7, cs = (zc >> 6) & 1, m = zc & 63; const int idx = ((m * (gc & 63)) & 63) * 32;
          BDT[o] = (h16)(((gc >> 6) == g) ? (cs ? sT[idx] : cT[idx]) * 0.125f : 0.f); } }
    { h16* WFIN = (h16*)(p.ws + WS_WFIN);
      for (int o = gt; o < 2 * 1024 * 64; o += NG) { const int gc4 = (o & 63) * 4, lk = o >> 6; const f32x4 v = *(const f32x4*)(p.w_in + (size_t)lk * INW + 512 + gc4);
          h16x4 hv = {(h16)v[0], (h16)v[1], (h16)v[2], (h16)v[3]}; *(h16x4*)(WFIN + (size_t)lk * 256 + gc4) = hv; } }
    __syncthreads();
}

__device__ __forceinline__ const float* hrow_of(const Params& p, const float* hB, int l, int R) { return l == 0 ? (R < TL ? p.x + (size_t)R * DM : p.ctx + (size_t)(R - TL) * DM) : hB + (size_t)R * DM; }
__device__ __forceinline__ void phase_u(const Params& p, int l) {
    const float* modv = (const float*)(p.ws + WS_MODV) + (size_t)l * 17 * NMOD; h16* u16 = (h16*)(p.ws + WS_U16); const float* hB = (const float*)(p.ws + WS_HB);
    const int lane = tidx() & 63, gw = bidx() * NWAVES + (tidx() >> 6);
    constexpr int rpw = TT / 2048;
    f32x4 sh[4], sc[4], h[4], hn[4]; int curmv = -1;
    const int R0 = gw * rpw;
    { const float* hr = hrow_of(p, hB, l, R0);
#pragma unroll
      for (int j = 0; j < 4; ++j) h[j] = *(const f32x4*)(hr + lane * 4 + 256 * j); }
    for (int i = 0; i < rpw; ++i) {
        const int R = R0 + i; const int mv = mv_of(R);
        if (mv != curmv) { const float* mvp = modv + (size_t)mv * NMOD; curmv = mv;
#pragma unroll
            for (int j = 0; j < 4; ++j) { const int col = lane * 4 + 256 * j; sh[j] = *(const f32x4*)(mvp + col); sc[j] = *(const f32x4*)(mvp + DM + col); } }
        asm volatile("" ::: "memory");
        if (i + 1 < rpw) { const float* hr = hrow_of(p, hB, l, R + 1);
#pragma unroll
            for (int j = 0; j < 4; ++j) hn[j] = *(const f32x4*)(hr + lane * 4 + 256 * j); }
        asm volatile("" ::: "memory");
#pragma unroll
        for (int j = 0; j < 4; ++j) { const int col = lane * 4 + 256 * j; const f32x4 u = h[j] * (1.f + sc[j]) + sh[j];
            *(unsigned long long*)(u16 + (size_t)R * DM + col) = (unsigned long long)pk_h2(u[0], u[1]) | ((unsigned long long)pk_h2(u[2], u[3]) << 32); }
#pragma unroll
        for (int j = 0; j < 4; ++j) h[j] = hn[j];
    }
}

constexpr float QSCALE = 0.125f * 1.4426950408889634f;
__device__ __forceinline__ void fourier_row0(const Params& p) {
    {
      const h16* ZTL = (const h16*)(p.ws + WS_ZTL); h16* brp = (h16*)(p.ws + WS_BR);
      const int lane_ = tidx() & 63, gw_ = bidx() * NWAVES + (tidx() >> 6), NGW_ = gridDim.x * NWAVES;
      for (int col = gw_; col < 4096; col += NGW_) { float sa = 0.f;
#pragma unroll
          for (int q = 0; q < 4; ++q) { const h16x8 v = *(const h16x8*)(ZTL + (size_t)col * 4096 + q * 512 + lane_ * 8);
#pragma unroll
              for (int e = 0; e < 8; ++e) sa += (float)v[e]; }
          sa = wave_sum(sa);
          if (lane_ == 0) brp[(size_t)((col >> 8) * 2048) * DM + 256 + (col & 255)] = (h16)(sa * 0.022097086912079608f); } }
}

#define MEMFENCE() asm volatile("" ::: "memory")
__device__ __forceinline__ void phase_wg(const Params& p) {
    const float* modv = (const float*)(p.ws + WS_MODV); float* wg = (float*)(p.ws + WS_WG); float* sgb = (float*)(p.ws + WS_SGB);
    const int tid = tidx(), lane = tid & 63, gw = bidx() * NWAVES + (tid >> 6), NGW = gridDim.x * NWAVES;
    for (int it = bidx() * NTHREADS + tid; it < 2 * 17 * 1024; it += gridDim.x * NTHREADS) {
        const int k = it & 1023, lm = it >> 10, l = lm / 17;
        const float G = p.ln1_g[l * DM + k] * (1.f + modv[(size_t)lm * NMOD + 4 * DM + k]);
        const float* w = p.w_router + ((size_t)l * DM + k) * 16; float* o = wg + (size_t)lm * 16384 + (size_t)((k >> 2) * 16) * 4 + (k & 3);
#pragma unroll
        for (int e4 = 0; e4 < 4; ++e4) { const f32x4 wv = *(const f32x4*)(w + e4 * 4);
#pragma unroll
            for (int c = 0; c < 4; ++c) o[(e4 * 4 + c) * 4] = G * wv[c]; } }
    for (int lm = gw; lm < 34; lm += NGW) { const int l = lm / 17;
        float sg[16], sb[16];
#pragma unroll
        for (int e = 0; e < 16; ++e) { sg[e] = 0.f; sb[e] = 0.f; }
        for (int q = 0; q < 16; ++q) { const int k = lane + 64 * q; const float sc = modv[(size_t)lm * NMOD + 4 * DM + k], sh = modv[(size_t)lm * NMOD + 3 * DM + k];
            const float G = p.ln1_g[l * DM + k] * (1.f + sc), Bp = p.ln1_b[l * DM + k] * (1.f + sc) + sh; const float* w = p.w_router + ((size_t)l * DM + k) * 16;
#pragma unroll
            for (int e4 = 0; e4 < 4; ++e4) { const f32x4 wv = *(const f32x4*)(w + e4 * 4);
#pragma unroll
                for (int c = 0; c < 4; ++c) { sg[e4 * 4 + c] += G * wv[c]; sb[e4 * 4 + c] += Bp * wv[c]; } } }
#pragma unroll
        for (int e = 0; e < 16; ++e) { const float a = wave_sum(sg[e]), b = wave_sum(sb[e]); if (lane == 0) { sgb[lm * 32 + e] = a; sgb[lm * 32 + 16 + e] = b; } } }
}
__device__ __forceinline__ void ln1_rows(const float* hB, h16* u16, float* stat, const float* mvp, const float* g, const float* bb, int R0, int nrows, int ioff, int lane, float& mu, float& rho, float* cst) {
    f32x4 gg[4], bv[4], sh[4], sc[4];
#pragma unroll
    for (int j = 0; j < 4; ++j) { const int col = lane * 4 + 256 * j; gg[j] = *(const f32x4*)(g + col); bv[j] = *(const f32x4*)(bb + col); sh[j] = *(const f32x4*)(mvp + 3 * DM + col); sc[j] = *(const f32x4*)(mvp + 4 * DM + col); }
    f32x4 v[4], vn[4];
#pragma unroll
    for (int j = 0; j < 4; ++j) v[j] = *(const f32x4*)(hB + (size_t)R0 * DM + lane * 4 + 256 * j);
    for (int i = 0; i < nrows; ++i) {
        const int R = R0 + i;
        MEMFENCE();
        if (i + 1 < nrows) {
#pragma unroll
            for (int j = 0; j < 4; ++j) vn[j] = *(const f32x4*)(hB + (size_t)(R + 1) * DM + lane * 4 + 256 * j); }
        MEMFENCE();
        float s = 0.f;
#pragma unroll
        for (int j = 0; j < 4; ++j) s += (v[j][0] + v[j][1]) + (v[j][2] + v[j][3]);
        const float mean = wave_sum(s) * (1.f / DM); float q = 0.f;
#pragma unroll
        for (int j = 0; j < 4; ++j) { v[j] = v[j] - mean; q += (v[j][0] * v[j][0] + v[j][1] * v[j][1]) + (v[j][2] * v[j][2] + v[j][3] * v[j][3]); }
        const float rstd = rsqrtf(wave_sum(q) * (1.f / DM) + LN_EPS);
        if (lane == 0) { float* st = stat + (size_t)R * 2; st[0] = mean; st[1] = rstd; if (cst) { cst[(ioff + i) * 2] = mean; cst[(ioff + i) * 2 + 1] = rstd; } }
        if ((lane & 15) == ioff + i) { mu = mean; rho = rstd; }
#pragma unroll
        for (int j = 0; j < 4; ++j) { const int col = lane * 4 + 256 * j;
            const f32x4 h1 = v[j] * rstd * gg[j] + bv[j];
            const f32x4 u2 = h1 * (1.f + sc[j]) + sh[j];
            *(unsigned long long*)(u16 + (size_t)R * DM + col) = (unsigned long long)pk_b2(u2[0], u2[1]) | ((unsigned long long)pk_b2(u2[2], u2[3]) << 32); }
#pragma unroll
        for (int j = 0; j < 4; ++j) v[j] = vn[j];
    }
}
__device__ __forceinline__ f32x4 ln1_router_mfma(const float* vrow, const float* wgl, int t0, int t1) {
    f32x4 a0 = {0.f, 0.f, 0.f, 0.f}, a1 = {0.f, 0.f, 0.f, 0.f};
    f32x4 b[8], bn[8];
#pragma unroll
    for (int u = 0; u < 8; ++u) b[u] = *(const f32x4*)(vrow + 16 * (t0 + u));
    for (int t = t0; t < t1; t += 8) {
        if (t + 8 < t1) {
#pragma unroll
            for (int u = 0; u < 8; ++u) bn[u] = *(const f32x4*)(vrow + 16 * (t + 8 + u)); }
#pragma unroll
        for (int u = 0; u < 8; ++u) { const f32x4 a = *(const f32x4*)(wgl + (t + u) * 256);
#pragma unroll
            for (int i = 0; i < 4; ++i) { if (u & 1) a1 = __builtin_amdgcn_mfma_f32_16x16x4f32(a[i], b[u][i], a1, 0, 0, 0); else a0 = __builtin_amdgcn_mfma_f32_16x16x4f32(a[i], b[u][i], a0, 0, 0, 0); } }
#pragma unroll
        for (int u = 0; u < 8; ++u) b[u] = bn[u];
    }
    return a0 + a1;
}
__device__ __forceinline__ void ln1_finish(const Params& p, const float* sgbm, const f32x4 D, float mu, float rho, int R, int lane) {
    float* affL = (float*)(p.ws + WS_AFFL); float* affC = (float*)(p.ws + WS_AFFC);
    const int eq = lane >> 4; const f32x4 sg = *(const f32x4*)(sgbm + 4 * eq), sb = *(const f32x4*)(sgbm + 16 + 4 * eq);
    const float rm = rho * mu; float lg[4];
#pragma unroll
    for (int r = 0; r < 4; ++r) lg[r] = rho * D[r] - rm * sg[r] + sb[r];
    float mx = fmaxf(fmaxf(lg[0], lg[1]), fmaxf(lg[2], lg[3])); mx = xor16_max(mx); mx = xor32_max(mx);
    float ex[4], se = 0.f;
#pragma unroll
    for (int r = 0; r < 4; ++r) { ex[r] = __builtin_amdgcn_exp2f((lg[r] - mx) * 1.4426950408889634f); se += ex[r]; }
    se = xor16_sum(se); se = xor32_sum(se);
#pragma unroll
    for (int r = 0; r < 4; ++r) { const float a = ex[r] / se; const int e = 4 * eq + r;
        if (R < TL) affL[((size_t)((R >> 11) * 16 + e)) * 2048 + (R & 2047)] = a; else { const int rr = R - TL; affC[((size_t)((rr >> 8) * 16 + e)) * 256 + (rr & 255)] = a; } }
}
__device__ __forceinline__ void phase_ln1_fill(const Params& p, int l, float* lds) {
    const float* wg = (const float*)(p.ws + WS_WG) + (size_t)l * 17 * 16384; const int tid = tidx(), bt = bidx() >> 4;
    __syncthreads();
    for (int e = tid; e < 4096; e += NTHREADS) *(f32x4*)(lds + e * 4) = *(const f32x4*)(wg + (size_t)bt * 16384 + e * 4);
    if (l == 0) for (int e = tid; e < 4096; e += NTHREADS) *(f32x4*)(lds + 16384 + e * 4) = *(const f32x4*)(wg + (size_t)16 * 16384 + e * 4);
    __syncthreads();
}
__device__ __forceinline__ void phase_ln1(const Params& p, int l, float* lds) {
    float* hB = (float*)(p.ws + WS_HB); h16* u16 = (h16*)(p.ws + WS_U16); const float* modv = (const float*)(p.ws + WS_MODV) + (size_t)l * 17 * NMOD;
    float* stat = (float*)(p.ws + WS_STAT); const float* wg = (const float*)(p.ws + WS_WG) + (size_t)l * 17 * 16384; const float* sgb = (const float*)(p.ws + WS_SGB) + l * 17 * 32;
    const float* g = p.ln1_g + l * DM; const float* bb = p.ln1_b + l * DM;
    const int tid = tidx(), lane = tid & 63, w = tid >> 6, c = bidx();
    const int bt = c >> 4;
    float* cst = lds + 32768; float* part = lds + 32768 + 64;
    __syncthreads();
    { const int Rg = c * 128 + w * 16; float mu = 0.f, rho = 0.f;
      ln1_rows(hB, u16, stat, modv + (size_t)bt * NMOD, g, bb, Rg, 16, 0, lane, mu, rho, nullptr);
      const f32x4 D = ln1_router_mfma(hB + (size_t)(Rg + (lane & 15)) * DM + 4 * (lane >> 4), lds + lane * 4, 0, 64);
      ln1_finish(p, sgb + bt * 32, D, mu, rho, Rg + (lane & 15), lane); }
    if (l == 0) { const int Cg = TL + c * 16; float mu = 0.f, rho = 0.f;
      ln1_rows(hB, u16, stat, modv + (size_t)16 * NMOD, g, bb, Cg + 2 * w, 2, 2 * w, lane, mu, rho, cst);
      __syncthreads();
      const f32x4 D = ln1_router_mfma(hB + (size_t)(Cg + (lane & 15)) * DM + 4 * (lane >> 4), lds + 16384 + lane * 4, 8 * w, 8 * w + 8);
      *(f32x4*)(part + (w * 64 + lane) * 4) = D;
      __syncthreads();
      if (w == 0) { f32x4 Ds = *(const f32x4*)(part + lane * 4);
#pragma unroll
          for (int q = 1; q < 8; ++q) Ds += *(const f32x4*)(part + (q * 64 + lane) * 4);
          ln1_finish(p, sgb + 16 * 32, Ds, cst[(lane & 15) * 2], cst[(lane & 15) * 2 + 1], Cg + (lane & 15), lane); } }
    __syncthreads();
}

__device__ __forceinline__ void phase_topk(const Params& p, int l, float* lds) {
    const float* affL = (const float*)(p.ws + WS_AFFL); const float* affC = (const float*)(p.ws + WS_AFFC); float* selw = (float*)(p.ws + WS_SELW); int* slot_of = (int*)(p.ws + WS_SLOT);
    int* selrow = (int*)(p.ws + WS_SELR);
    unsigned* a = (unsigned*)lds; unsigned* hist = (unsigned*)(lds + 2048 + 256); int* wsum = (int*)(lds + 2048 + 512); unsigned* ctl = (unsigned*)(lds + 2048 + 512 + 32);
    const int tid = tidx(), lane = tid & 63, wave = tid >> 6;
    const int nitems = (l == 0) ? 512 : 256;
    __syncthreads();
    for (int it = bidx(); it < nitems; it += gridDim.x) {
        const bool lat = it < 256; const int be = lat ? it : it - 256; const int b = be >> 4, e = be & 15; const int n = lat ? 2048 : 256, cap = lat ? CAPL : CAPC;
        const float* src = lat ? affL + (size_t)be * 2048 : affC + (size_t)be * 256;
        for (int i = tid; i < n; i += NTHREADS) a[i] = __float_as_uint(src[i]);
        unsigned prefix = 0u, pmask = 0u; int remaining = cap;
        for (int pass = 0; pass < 4; ++pass) {
            const int shift = 24 - 8 * pass;
            if (tid < 256) hist[tid] = 0u;
            __syncthreads();
            for (int i = tid; i < n; i += NTHREADS) { const unsigned u = a[i]; if ((u & pmask) == prefix) atomicAdd(&hist[(u >> shift) & 255u], 1u); }
            __syncthreads();
            if (tid < 64) {
                unsigned c4[4]; unsigned s4 = 0;
#pragma unroll
                for (int q = 0; q < 4; ++q) { c4[q] = hist[255 - (lane * 4 + q)]; s4 += c4[q]; }
                unsigned incl = s4;
#pragma unroll
                for (int o = 1; o < 64; o <<= 1) { const unsigned t = __shfl_up(incl, o); if (lane >= o) incl += t; }
                unsigned excl = incl - s4;
                const bool mine = (excl < (unsigned)remaining) && (incl >= (unsigned)remaining);
                if (mine) { unsigned cum = excl; int bin = 0; unsigned above = 0;
#pragma unroll
                    for (int q = 0; q < 4; ++q) { if (cum < (unsigned)remaining && cum + c4[q] >= (unsigned)remaining) { bin = 255 - (lane * 4 + q); above = cum; } cum += c4[q]; }
                    ctl[0] = (unsigned)bin; ctl[1] = above; }
            }
            __syncthreads();
            prefix |= ctl[0] << shift; pmask |= 255u << shift; remaining -= (int)ctl[1];
            __syncthreads();
        }
        const unsigned T = prefix; const int need_eq = remaining;
        const int i0 = tid * 4; int ngt = 0, neq = 0; unsigned u4[4];
#pragma unroll
        for (int q = 0; q < 4; ++q) { const int i = i0 + q; u4[q] = (i < n) ? a[i] : 0u; ngt += (i < n && u4[q] > T) ? 1 : 0; neq += (i < n && u4[q] == T) ? 1 : 0; }
        int ieq = neq;
#pragma unroll
        for (int o = 1; o < 64; o <<= 1) { const int t = __shfl_up(ieq, o); if (lane >= o) ieq += t; }
        if (lane == 63) wsum[wave] = ieq;
        __syncthreads();
        int eqbase = 0;
#pragma unroll
        for (int wv = 0; wv < 8; ++wv) eqbase += (wv < wave) ? wsum[wv] : 0;
        int eqrank = eqbase + ieq - neq;
        int nsel = 0; bool sel[4];
#pragma unroll
        for (int q = 0; q < 4; ++q) { const int i = i0 + q; const bool gt = (i < n) && (u4[q] > T); const bool eq = (i < n) && (u4[q] == T); sel[q] = gt || (eq && eqrank < need_eq); eqrank += eq ? 1 : 0; nsel += sel[q] ? 1 : 0; }
        __syncthreads();
        int isel = nsel;
#pragma unroll
        for (int o = 1; o < 64; o <<= 1) { const int t = __shfl_up(isel, o); if (lane >= o) isel += t; }
        if (lane == 63) wsum[wave] = isel;
        __syncthreads();
        int sbase = 0;
#pragma unroll
        for (int wv = 0; wv < 8; ++wv) sbase += (wv < wave) ? wsum[wv] : 0;
        int slot = sbase + isel - nsel;
        const int gbase = lat ? be * 256 : GL + e * 512 + b * 32;
#pragma unroll
        for (int q = 0; q < 4; ++q) { const int i = i0 + q; if (i < n) { const int R = lat ? b * 2048 + i : TL + b * 256 + i;
            if (sel[q]) { selrow[gbase + slot] = R; selw[gbase + slot] = __uint_as_float(u4[q]); slot_of[(size_t)R * 16 + e] = gbase + slot; ++slot; } else slot_of[(size_t)R * 16 + e] = -1; } }
        __syncthreads();
    }
}

struct Ln2S { int sl; float m, r; };
__device__ __forceinline__ Ln2S ln2_ldS(const int* slot_of, const float* stat, int R, int lane) { Ln2S s; s.sl = slot_of[(size_t)R * 16 + (lane & 15)]; s.m = stat[(size_t)R * 2]; s.r = stat[(size_t)R * 2 + 1]; return s; }
__device__ __forceinline__ void ln2_issue(const h16* Y, const float* hB, int R, int sl, int lane, h16x4 (&yv)[4][4], f32x4 (&h)[4]) {
    unsigned long long msk = __ballot(sl >= 0) & 0xFFFFull;
#pragma unroll
    for (int q = 0; q < 4; ++q) { if (msk) { const int e = __builtin_ctzll(msk); msk &= msk - 1; const int sr = __builtin_amdgcn_readlane(sl, e);
#pragma unroll
            for (int j = 0; j < 4; ++j) yv[q][j] = *(const h16x4*)(Y + (size_t)sr * DM + lane * 4 + 256 * j); }
        else {
#pragma unroll
            for (int j = 0; j < 4; ++j) yv[q][j] = (h16x4){(h16)0.f, (h16)0.f, (h16)0.f, (h16)0.f}; } }
#pragma unroll
    for (int j = 0; j < 4; ++j) h[j] = *(const f32x4*)(hB + (size_t)R * DM + lane * 4 + 256 * j);
}
__device__ __forceinline__ void ln2_rows(const Params& p, int l, const float* ldsv, int R0, int nrows, int mv, int lane) {
    float* hB = (float*)(p.ws + WS_HB); h16* u16 = (h16*)(p.ws + WS_U16); const h16* Y = (const h16*)(p.ws + WS_XG); const int* slot_of = (const int*)(p.ws + WS_SLOT);
    const float* mvp = (const float*)(p.ws + WS_MODV) + ((size_t)l * 17 + mv) * NMOD; const float* mvn = mvp + (size_t)17 * NMOD; const float* stat = (const float*)(p.ws + WS_STAT);
    const bool nextu = (l < DEPTH - 1);
    f32x4 gate[4], nsh[4], nsc[4];
#pragma unroll
    for (int j = 0; j < 4; ++j) { const int col = lane * 4 + 256 * j; gate[j] = *(const f32x4*)(mvp + 5 * DM + col); nsh[j] = (f32x4){0.f, 0.f, 0.f, 0.f}; nsc[j] = nsh[j];
        if (nextu) { nsh[j] = *(const f32x4*)(mvn + col); nsc[j] = *(const f32x4*)(mvn + DM + col); } }
    Ln2S sA = ln2_ldS(slot_of, stat, R0, lane), sB = sA, sC = sA, sD = sA;
    if (nrows > 1) sB = ln2_ldS(slot_of, stat, R0 + 1, lane);
    if (nrows > 2) sC = ln2_ldS(slot_of, stat, R0 + 2, lane);
    h16x4 yv0[4][4], yv1[4][4]; f32x4 h0[4], h1b[4];
    ln2_issue(Y, hB, R0, sA.sl, lane, yv0, h0);
    for (int i = 0; i < nrows; ++i) {
        const int R = R0 + i;
        MEMFENCE();
        if (i + 1 < nrows) ln2_issue(Y, hB, R + 1, sB.sl, lane, yv1, h1b);
        if (i + 3 < nrows) sD = ln2_ldS(slot_of, stat, R + 3, lane);
        MEMFENCE();
        f32x4 f[4];
#pragma unroll
        for (int j = 0; j < 4; ++j) { f[j] = (f32x4){0.f, 0.f, 0.f, 0.f};
#pragma unroll
            for (int q = 0; q < 4; ++q) { f[j][0] += (float)yv0[q][j][0]; f[j][1] += (float)yv0[q][j][1]; f[j][2] += (float)yv0[q][j][2]; f[j][3] += (float)yv0[q][j][3]; } }
        { unsigned long long msk = __ballot(sA.sl >= 0) & 0xFFFFull;
#pragma unroll
          for (int q = 0; q < 4; ++q) msk &= msk - 1;
          while (msk) { const int e = __builtin_ctzll(msk); msk &= msk - 1; const int sr = __builtin_amdgcn_readlane(sA.sl, e);
#pragma unroll
            for (int j = 0; j < 4; ++j) { const h16x4 y = *(const h16x4*)(Y + (size_t)sr * DM + lane * 4 + 256 * j); f[j][0] += (float)y[0]; f[j][1] += (float)y[1]; f[j][2] += (float)y[2]; f[j][3] += (float)y[3]; } } }
        f32x4 v[4]; float s = 0.f;
#pragma unroll
        for (int j = 0; j < 4; ++j) { const f32x4 g1v = *(const f32x4*)(ldsv + lane * 4 + 256 * j), b1v = *(const f32x4*)(ldsv + 1024 + lane * 4 + 256 * j);
            const f32x4 hh = (h0[j] - sA.m) * sA.r * g1v + b1v;
            v[j] = ALPHA * hh + gate[j] * f[j]; s += (v[j][0] + v[j][1]) + (v[j][2] + v[j][3]); }
        const float mean = wave_sum(s) * (1.f / DM); float q = 0.f;
#pragma unroll
        for (int j = 0; j < 4; ++j) { v[j] = v[j] - mean; q += (v[j][0] * v[j][0] + v[j][1] * v[j][1]) + (v[j][2] * v[j][2] + v[j][3] * v[j][3]); }
        const float rstd = rsqrtf(wave_sum(q) * (1.f / DM) + LN_EPS);
        float* orow = (l == DEPTH - 1) ? p.out + (size_t)R * DM : hB + (size_t)R * DM;
#pragma unroll
        for (int j = 0; j < 4; ++j) { const int col = lane * 4 + 256 * j; const f32x4 g2v = *(const f32x4*)(ldsv + 2048 + col), b2v = *(const f32x4*)(ldsv + 3072 + col);
            const f32x4 h2 = v[j] * rstd * g2v + b2v; if (l == DEPTH - 1) __builtin_nontemporal_store(h2, (f32x4*)(orow + col)); else *(f32x4*)(orow + col) = h2;
            if (nextu) { const f32x4 u = h2 * (1.f + nsc[j]) + nsh[j];
                *(unsigned long long*)(u16 + (size_t)R * DM + col) = (unsigned long long)pk_h2(u[0], u[1]) | ((unsigned long long)pk_h2(u[2], u[3]) << 32); } }
#pragma unroll
        for (int q2 = 0; q2 < 4; ++q2)
#pragma unroll
            for (int j = 0; j < 4; ++j) yv0[q2][j] = yv1[q2][j];
#pragma unroll
        for (int j = 0; j < 4; ++j) h0[j] = h1b[j];
        sA = sB; sB = sC; sC = sD;
    }
}
__device__ __forceinline__ void phase_ln2(const Params& p, int l, float* lds) {
    const int tid = tidx(), lane = tid & 63, w = tid >> 6, c = bidx();
    __syncthreads();
    for (int e = tid; e < 1024; e += NTHREADS) { const int k = e >> 8, col = (e & 255) * 4; const float* src = (k == 0 ? p.ln1_g : k == 1 ? p.ln1_b : k == 2 ? p.ln2_g : p.ln2_b) + l * DM + col;
        *(f32x4*)(lds + k * 1024 + col) = *(const f32x4*)src; }
    __syncthreads();
    ln2_rows(p, l, lds, c * 128 + w * 16, 16, c >> 4, lane);
    if (l == 0) ln2_rows(p, l, lds, TL + c * 16 + 2 * w, 2, 16, lane);
    __syncthreads();
}

namespace fg {
#define FG_LAS __attribute__((address_space(3)))
constexpr int BM = 256, BK = 64, HALF = 128, HTB = HALF * BK * 2, STAGE_BYTES = 8 * HTB;
__host__ __device__ __forceinline__ int lds_byte(int r, int c) { const int st = (r >> 4) * 2 + (c >> 5), rr = r & 15, cc = c & 31, ob = rr * 64 + cc * 2; return st * 1024 + (ob ^ (((ob >> 9) & 1) << 5)); }
__host__ __device__ __forceinline__ void stage_rc(int b, int& R, int& C) { const int st = b / 1024, sb = b % 1024, swz = sb ^ (((sb >> 9) & 1) << 5); R = (st >> 1) * 16 + swz / 64; C = (st & 1) * 32 + (swz % 64) / 2; }
__host__ __device__ __forceinline__ int perm32(int rho) { const int n = rho >> 4, i = rho & 15; return 8 * (i >> 2) + 4 * n + (i & 3); }
struct Unit { const char* A; const char* B; int nt; int pm, pn, aux; const int* rows; };
template <class Epi, class Sched, int LD, bool BF = false, bool GATHER = false>
__device__ __forceinline__ void gemm_phase(FG_LAS unsigned char* lds, const Sched& S, const Epi& E) {
    const int tid = tidx(), wid = __builtin_amdgcn_readfirstlane(tid >> 6), lane = tid & 63, wr = wid >> 2, wc = wid & 3, fr = lane & 15, fq = lane >> 4;
    unsigned voffA[2], voffB[2]; int rowA[2], colA[2];
#pragma unroll
    for (int i = 0; i < 2; ++i) { int R, C; stage_rc(tid * 16 + i * 8192, R, C); const int Rb = Epi::PERM ? ((R & ~31) + perm32(R & 31)) : R;
        voffA[i] = (unsigned)(R * LD + C) * 2u; voffB[i] = (unsigned)(Rb * LD + C) * 2u; rowA[i] = R; colA[i] = C; }
    const size_t kstep = (size_t)(BK * 2);
    const size_t hstep = GATHER ? (size_t)0 : (size_t)HALF * LD * 2;
    const unsigned ldsw = (unsigned)wid * 1024u;
    const int aoff = lds_byte(wr * 64 + fr, fq * 8), boff = lds_byte(wc * 32 + fr, fq * 8);
#define FG_SA(b, h) (((b) * 2 + (h)) * HTB)
#define FG_SB(b, h) ((4 + (b) * 2 + (h)) * HTB)
#define FG_STAGE(bufoff, gbase, voff) do { _Pragma("unroll") for (int _i = 0; _i < 2; ++_i) \
        __builtin_amdgcn_global_load_lds((const unsigned*)((const char*)(gbase) + (voff)[_i]), (FG_LAS unsigned*)(lds + (bufoff) + ldsw + _i * 8192), 16, 0, 0); } while (0)
#define FG_STAGEA(bufoff, gbase, h, cur_) do { if (GATHER) { if (cur_) FG_STAGE(bufoff, gbase, cvA[h]); else FG_STAGE(bufoff, gbase, nvA[h]); } else FG_STAGE(bufoff, (gbase) + (h) * ((size_t)HALF * LD * 2), voffA); } while (0)
#define FG_LDA(dst, b, h) do { _Pragma("unroll") for (int m = 0; m < 4; ++m) _Pragma("unroll") for (int k = 0; k < 2; ++k) dst[m][k] = *(const FG_LAS h16x8*)(lds + FG_SA(b, h) + aoff + m * 2048 + k * 1024); } while (0)
#define FG_LDB(dst, b, h) do { _Pragma("unroll") for (int n = 0; n < 2; ++n) _Pragma("unroll") for (int k = 0; k < 2; ++k) dst[n][k] = *(const FG_LAS h16x8*)(lds + FG_SB(b, h) + boff + n * 2048 + k * 1024); } while (0)
#define FG_MMA(ai, bj, At, Bt) do { __builtin_amdgcn_s_setprio(1); _Pragma("unroll") for (int m = 0; m < 4; ++m) _Pragma("unroll") for (int n = 0; n < 2; ++n) _Pragma("unroll") for (int k = 0; k < 2; ++k) \
        acc[ai][bj][m][n] = BF ? __builtin_amdgcn_mfma_f32_16x16x32_bf16(__builtin_bit_cast(bf16x8_t, Bt[n][k]), __builtin_bit_cast(bf16x8_t, At[m][k]), acc[ai][bj][m][n], 0, 0, 0) : __builtin_amdgcn_mfma_f32_16x16x32_f16(Bt[n][k], At[m][k], acc[ai][bj][m][n], 0, 0, 0); __builtin_amdgcn_s_setprio(0); } while (0)
#define FG_WAIT_V(n) asm volatile("s_waitcnt vmcnt(" #n ")" ::: "memory")
#define FG_WAIT_L(n) asm volatile("s_waitcnt lgkmcnt(" #n ")" ::: "memory")
#define FG_BAR __builtin_amdgcn_s_barrier()
#define FG_SCHED __builtin_amdgcn_sched_barrier(0)
    Unit cur, nxt; int ui = 0;
    __syncthreads();
    if (!S.next(0, cur)) return;
    f32x4 acc[2][2][4][2];
#pragma unroll
    for (int a = 0; a < 2; ++a)
#pragma unroll
        for (int b = 0; b < 2; ++b)
#pragma unroll
            for (int m = 0; m < 4; ++m)
#pragma unroll
                for (int n = 0; n < 2; ++n) acc[a][b][m][n] = (f32x4){0.f, 0.f, 0.f, 0.f};
    h16x8 At[4][2], B0[2][2], B1[2][2];
    const char* cA = cur.A; const char* cB = cur.B;
    const size_t hstepB = (size_t)HALF * LD * 2;
    unsigned cvA[2][2], nvA[2][2];
    if (GATHER) {
#pragma unroll
        for (int h = 0; h < 2; ++h)
#pragma unroll
            for (int i = 0; i < 2; ++i) { cvA[h][i] = (unsigned)(cur.rows[h * HALF + rowA[i]] * LD + colA[i]) * 2u; nvA[h][i] = cvA[h][i]; } }
    FG_STAGE(FG_SB(0, 0), cB, voffB); FG_STAGE(FG_SB(0, 1), cB + hstepB, voffB); FG_STAGEA(FG_SA(0, 0), cA, 0, true); FG_STAGEA(FG_SA(0, 1), cA, 1, true);
    if (wr == 1) FG_BAR;
    FG_WAIT_V(2); FG_BAR;
    FG_STAGE(FG_SB(1, 0), cB + kstep, voffB); FG_STAGEA(FG_SA(1, 0), cA + kstep, 0, true); FG_STAGE(FG_SB(1, 1), cB + hstepB + kstep, voffB);
    FG_WAIT_V(6); FG_BAR;
    for (;;) {
        const bool has_next = S.next(ui + 1, nxt);
        const char* nA = has_next ? nxt.A : cA; const char* nB = has_next ? nxt.B : cB;
        if (GATHER && has_next) {
#pragma unroll
            for (int h = 0; h < 2; ++h)
#pragma unroll
                for (int i = 0; i < 2; ++i) nvA[h][i] = (unsigned)(nxt.rows[h * HALF + rowA[i]] * LD + colA[i]) * 2u; }
        const int nt = cur.nt;
        for (int t = 0; t < nt; t += 2) {
            const bool last = (t == nt - 2);
            const char* a1 = cA + (size_t)(t + 1) * kstep;
            const char* a2 = last ? nA : cA + (size_t)(t + 2) * kstep; const char* b2 = last ? nB : cB + (size_t)(t + 2) * kstep;
            const char* a3 = a2 + kstep; const char* b3 = b2 + kstep;
            FG_LDB(B0, 0, 0); FG_LDB(B1, 0, 1); FG_SCHED; FG_LDA(At, 0, 0); FG_STAGEA(FG_SA(1, 1), a1, 1, true);
            FG_WAIT_V(8); FG_WAIT_L(0); FG_BAR; FG_MMA(0, 0, At, B0); FG_MMA(0, 1, At, B1); FG_BAR; FG_SCHED;
            FG_LDA(At, 0, 1); FG_STAGE(FG_SB(0, 0), b2, voffB); FG_STAGE(FG_SB(0, 1), b2 + hstepB, voffB); FG_STAGEA(FG_SA(0, 0), a2, 0, !last);
            FG_WAIT_V(8); FG_WAIT_L(0); FG_BAR; FG_MMA(1, 0, At, B0); FG_MMA(1, 1, At, B1); FG_BAR; FG_SCHED;
            FG_LDB(B0, 1, 0); FG_LDB(B1, 1, 1); FG_SCHED; FG_LDA(At, 1, 0); FG_STAGEA(FG_SA(0, 1), a2, 1, !last);
            FG_WAIT_V(8); FG_WAIT_L(0); FG_BAR; FG_MMA(0, 0, At, B0); FG_MMA(0, 1, At, B1); FG_BAR; FG_SCHED;
            FG_LDA(At, 1, 1); FG_STAGE(FG_SB(1, 0), b3, voffB); FG_STAGE(FG_SB(1, 1), b3 + hstepB, voffB); FG_STAGEA(FG_SA(1, 0), a3, 0, !last);
            FG_WAIT_V(8); FG_WAIT_L(0); FG_BAR; FG_MMA(1, 0, At, B0); FG_MMA(1, 1, At, B1); FG_BAR; FG_SCHED;
        }
        if (wr == 0) FG_BAR;
        { const int t2_ = tidx(); E(acc, cur, wr, wc, t2_ & 15, (t2_ >> 4) & 3); }
        if (!has_next) break;
#pragma unroll
        for (int a = 0; a < 2; ++a)
#pragma unroll
            for (int b = 0; b < 2; ++b)
#pragma unroll
                for (int m = 0; m < 4; ++m)
#pragma unroll
                    for (int n = 0; n < 2; ++n) acc[a][b][m][n] = (f32x4){0.f, 0.f, 0.f, 0.f};
        cur = nxt; cA = nA; cB = nB; ++ui;
        if (GATHER) {
#pragma unroll
            for (int h = 0; h < 2; ++h)
#pragma unroll
                for (int i = 0; i < 2; ++i) cvA[h][i] = nvA[h][i]; }
        if (wr == 1) FG_BAR;
    }
    FG_WAIT_V(0);
    FG_BAR;
#undef FG_SA
#undef FG_SB
#undef FG_STAGE
#undef FG_LDA
#undef FG_STAGEA
#undef FG_LDB
#undef FG_MMA
#undef FG_WAIT_V
#undef FG_WAIT_L
#undef FG_BAR
#undef FG_SCHED
}
}
typedef FG_LAS unsigned char* ldsp_t;

template <bool BF = false>
__device__ __forceinline__ void transpose_item(const float* W, int ldw, h16* WT, int ldt, float* scr, int lane, float scl = 1.f) {
    f32x4 t[16];
#pragma unroll
    for (int i = 0; i < 16; ++i) t[i] = __builtin_nontemporal_load((const f32x4*)(W + (size_t)(i * 4 + (lane >> 4)) * ldw + (lane & 15) * 4));
#pragma unroll
    for (int i = 0; i < 16; ++i) { float* d = scr + (i * 4 + (lane >> 4)) * 65 + (lane & 15) * 4; d[0] = t[i][0]; d[1] = t[i][1]; d[2] = t[i][2]; d[3] = t[i][3]; }
    __builtin_amdgcn_wave_barrier();
    const int c = lane & 7;
#pragma unroll
    for (int j = 0; j < 8; ++j) { const int n = (lane >> 3) + 8 * j; const float* sp = scr + (8 * c) * 65 + n;
        u32x4 o; if (BF) { o.x = pk_b2(sp[0 * 65], sp[1 * 65]); o.y = pk_b2(sp[2 * 65], sp[3 * 65]); o.z = pk_b2(sp[4 * 65], sp[5 * 65]); o.w = pk_b2(sp[6 * 65], sp[7 * 65]); }
        else { o.x = pk_h2(sp[0 * 65] * scl, sp[1 * 65] * scl); o.y = pk_h2(sp[2 * 65] * scl, sp[3 * 65] * scl); o.z = pk_h2(sp[4 * 65] * scl, sp[5 * 65] * scl); o.w = pk_h2(sp[6 * 65] * scl, sp[7 * 65] * scl); }
        *(u32x4*)(WT + (size_t)n * ldt + 8 * c) = o; }
    __builtin_amdgcn_wave_barrier();
}
struct SchedWF {
    const char* BDT; const char* WFIN; int c;
    __device__ __forceinline__ bool next(int i, fg::Unit& u) const {
        if (i != 0 || c >= 16) return false;
        u.aux = c >> 3; u.pm = (c >> 2) & 1; u.pn = c & 3; u.nt = 4;
        u.A = BDT + (size_t)u.pm * 256 * 256 * 2; u.B = WFIN + ((size_t)u.aux * 1024 + u.pn * 256) * 256 * 2; return true;
    }
};
struct EpiWF {
    static constexpr bool PERM = true;
    h16* WinT;
    __device__ __forceinline__ void operator()(const f32x4 (&acc)[2][2][4][2], const fg::Unit& u, int wr, int wc, int fr, int fq) const {
        h16* base = WinT + ((size_t)u.aux * 6144 + 5632 + u.pm * 256 + 64 * wr + fr) * DM + u.pn * 256 + 32 * wc + 8 * fq;
#pragma unroll
        for (int ai = 0; ai < 2; ++ai)
#pragma unroll
            for (int m = 0; m < 4; ++m)
#pragma unroll
                for (int bj = 0; bj < 2; ++bj) { const f32x4 v0 = acc[ai][bj][m][0], v1 = acc[ai][bj][m][1];
                    *(u32x4*)(base + (size_t)(128 * ai + 16 * m) * DM + 128 * bj) = (u32x4){pk_h2(v0[0], v0[1]), pk_h2(v0[2], v0[3]), pk_h2(v1[0], v1[1]), pk_h2(v1[2], v1[3])}; }
    }
};
__device__ __forceinline__ void phase_convert_dense(const Params& p, float* lds, ldsp_t ldsf) {
    { SchedWF S{(const char*)(p.ws + WS_BDT), (const char*)(p.ws + WS_WFIN), bidx()}; EpiWF E{(h16*)(p.ws + WS_WINT)};
      fg::gemm_phase<EpiWF, SchedWF, 256>(ldsf, S, E); }
    __syncthreads();
}
__device__ __forceinline__ void dense_transposes(const Params& p, float* lds) {
    if (bidx() < 192) return;
    __syncthreads();
    const int lane = tidx() & 63, wave = tidx() >> 6, gw = (bidx() - 192) * NWAVES + wave, NGW = (gridDim.x - 192) * NWAVES;
    float* scr = lds + wave * (64 * 65);
    h16* WinT = (h16*)(p.ws + WS_WINT); h16* WbT = (h16*)(p.ws + WS_WBT); h16* WoT = (h16*)(p.ws + WS_WOT);
    constexpr int I_IN = 16 * 88, I_BR = 4 * 4 * 16, I_OUT = 16 * 16, I_L = I_IN + I_BR + I_OUT;
    for (int it = gw; it < 2 * I_L; it += NGW) {
        const int l = it / I_L; int r = it % I_L;
        if (r < I_IN) { const int kb = r / 88, db = r % 88; const int d0 = db * 64; const int sc0 = d0 < 512 ? d0 : d0 + 256;
            transpose_item(p.w_in + ((size_t)l * DM + kb * 64) * INW + sc0, INW, WinT + ((size_t)l * 6144 + d0) * DM + kb * 64, DM, scr, lane, d0 >= 1536 ? -1.4426950408889634f : 1.f); continue; }
        r -= I_IN;
        if (r < I_BR) { const int i = r >> 6, kb = (r >> 4) & 3, nb = r & 15;
            transpose_item(p.w_branch + (((size_t)l * 4 + i) * 256 + kb * 64) * DM + nb * 64, DM, WbT + ((size_t)l * DM + nb * 64) * DM + i * 256 + kb * 64, DM, scr, lane); continue; }
        r -= I_BR;
        { const int kb = r >> 4, nb = r & 15;
            transpose_item(p.w_out + ((size_t)l * DM + kb * 64) * DM + nb * 64, DM, WoT + ((size_t)l * DM + nb * 64) * DM + kb * 64, DM, scr, lane); }
    }
    __syncthreads();
}
__device__ __forceinline__ h16* wgu_of(const Params& p, int l) { return l == 0 ? (h16*)((unsigned char*)p.out + DO_WGU) : (h16*)(p.ws + WS_WGU1); }
__device__ __forceinline__ h16* wd_of(const Params& p, int l) { return (h16*)((unsigned char*)p.out + (l == 0 ? DO_WD : DO_WD1)); }
__device__ __forceinline__ void bg_convert(const Params& p, int l, float* lds, int budget, bool spread = false) {
    const int lane = tidx() & 63, wave = tidx() >> 6;
    float* scr = lds + wave * (64 * 65);
    h16* Wgu = wgu_of(p, l); h16* Wd = wd_of(p, l);
    const int x = spread ? ((bidx() >> 3) + (bidx() & 7)) & 7 : (bidx() & 7);
    unsigned* ctr = (unsigned*)(p.ws + WS_CTL) + 3072 + 64 * (l * 8 + x);
    constexpr int I_GU = 2 * 16 * 16, I_D = 16 * 16, I_E = I_GU + I_D, NIT = 16 * I_E, NPG = NIT / 8, BATCH = 4;
    __syncthreads();
    for (int n = 0; n < budget; ++n) {
        unsigned i0 = 0; if (lane == 0) i0 = __hip_atomic_fetch_add(ctr, (unsigned)BATCH, __ATOMIC_RELAXED, __HIP_MEMORY_SCOPE_AGENT);
        i0 = __builtin_amdgcn_readfirstlane(i0);
        if (i0 >= (unsigned)NPG) break;
        for (int q = 0; q < BATCH; ++q) { const int it = x * NPG + (int)i0 + q;
            const int e = it / I_E; int r = it % I_E;
            if (r < I_GU) { const int h = r >> 8, kb = (r >> 4) & 15, nb = r & 15; const int n0 = nb * 64; const int drow = (n0 >> 7) * 256 + h * 128 + (n0 & 127);
                const float* src = (h ? p.w_up : p.w_gate) + (((size_t)l * NEXP + e) * DM + kb * 64) * FF + n0;
                transpose_item<true>(src, FF, Wgu + ((size_t)e * 2048 + drow) * DM + kb * 64, DM, scr, lane); }
            else { r -= I_GU; const int kb = r >> 4, nb = r & 15;
                transpose_item<true>(p.w_down + (((size_t)l * NEXP + e) * FF + kb * 64) * DM + nb * 64, DM, Wd + ((size_t)e * DM + nb * 64) * FF + kb * 64, FF, scr, lane); } }
    }
    __syncthreads();
}

struct SchedG1 {
    const char* u16; const char* WinT; int l, c, G;
    __device__ __forceinline__ bool next(int i, fg::Unit& u) const {
        const int nsup_full = (l == 0) ? 36 : 32;
        const int L = (i * 8 + (c & 7)) * 32 + (c >> 3); const int s = L >> 5;
        if (s < nsup_full) { u.pm = s * 4 + ((L >> 3) & 3); u.pn = L & 7; }
        else { if (l == 0) return false; const int r = i - 4; if (r != 0 || c >= 48) return false; u.pm = 128 + c / 3; u.pn = 1 + 2 * (c % 3); }
        u.nt = 16; u.aux = 0;
        if (u.pn < 6) { u.A = u16 + (size_t)u.pm * 256 * DM * 2; u.B = WinT + (size_t)u.pn * 256 * DM * 2; }
        else { u.A = WinT + (size_t)(5632 + (u.pn - 6) * 256) * DM * 2; u.B = u16 + (size_t)u.pm * 256 * DM * 2; }
        return true;
    }
};
struct EpiG1 {
    static constexpr bool PERM = true;
    unsigned char* QI; unsigned char* KI; unsigned char* VI; h16* ZTL; h16* ZTC;
    const float* gain; const float* ropeC; const float* ropeS; FG_LAS float* xs; int lastlayer;
    __device__ __forceinline__ void operator()(const f32x4 (&acc)[2][2][4][2], const fg::Unit& u, int wr, int wc, int fr, int fq) const {
        if (u.pn < 6) {
            const int mixer = u.pn >> 1; const bool lat = u.pm < 128; const int b = lat ? (u.pm >> 3) : (u.pm - 128); const int tile0 = lat ? 4 + 4 * (u.pm & 7) : 0;
            const bool isq = (u.pn & 1) == 0; const int half = wc & 1; const int chunk = 4 * half + fq;
            const bool do_rms = (mixer == 0); const bool do_rope = lat && (mixer < 2);
            float rs[2][2][4];
            if (do_rms) {
#pragma unroll
                for (int bj = 0; bj < 2; ++bj)
#pragma unroll
                    for (int ai = 0; ai < 2; ++ai)
#pragma unroll
                        for (int m = 0; m < 4; ++m) { const f32x4 v0 = acc[ai][bj][m][0], v1 = acc[ai][bj][m][1];
                            float ss = (v0[0] * v0[0] + v0[1] * v0[1]) + (v0[2] * v0[2] + v0[3] * v0[3]) + (v1[0] * v1[0] + v1[1] * v1[1]) + (v1[2] * v1[2] + v1[3] * v1[3]);
                            ss = xor16_sum(ss); ss = xor32_sum(ss); rs[bj][ai][m] = ss;
                            if (fq == 0) xs[(half * 256 + 128 * ai + 64 * wr + 16 * m + fr) * 4 + 2 * bj + (wc >> 1)] = ss; }
                asm volatile("s_waitcnt lgkmcnt(0)" ::: "memory"); __builtin_amdgcn_s_barrier(); asm volatile("" ::: "memory");
#pragma unroll
                for (int bj = 0; bj < 2; ++bj)
#pragma unroll
                    for (int ai = 0; ai < 2; ++ai)
#pragma unroll
                        for (int m = 0; m < 4; ++m) { const float so = xs[((half ^ 1) * 256 + 128 * ai + 64 * wr + 16 * m + fr) * 4 + 2 * bj + (wc >> 1)];
                            rs[bj][ai][m] = rsqrtf((rs[bj][ai][m] + so) * (1.f / 64.f) + RMS_EPS); }
            }
            f32x4 g0 = {1.f, 1.f, 1.f, 1.f}, g1 = {1.f, 1.f, 1.f, 1.f};
            if (do_rms) { const float* gp = gain + (isq ? 0 : 64) + chunk * 8; g0 = *(const f32x4*)gp; g1 = *(const f32x4*)(gp + 4); }
            const int j0 = (fq & 1) * 8;
            const bool upper = (fq & 2) != 0;
            auto body = [&](auto HC) {
                constexpr bool H1 = decltype(HC)::value;
#pragma unroll
                for (int mh = 0; mh < 2; ++mh) {
                    f32x4 tc0[2], tc1[2], ts0[2], ts1[2];
                    if (do_rope) {
#pragma unroll
                        for (int k = 0; k < 2; ++k) { const int pos = H1 ? (16 * (2 * mh + k) + fr) : (4 * (u.pm & 7) + 2 * k + wr);
                            tc0[k] = *(const f32x4*)(ropeC + pos * 16 + j0); tc1[k] = *(const f32x4*)(ropeC + pos * 16 + j0 + 4); ts0[k] = *(const f32x4*)(ropeS + pos * 16 + j0); ts1[k] = *(const f32x4*)(ropeS + pos * 16 + j0 + 4); }
                        asm volatile("" ::: "memory"); }
#pragma unroll
                    for (int bj = 0; bj < 2; ++bj) { const int hh = 2 * bj + (wc >> 1);
                        const bool isv = !isq && bj == 1; const bool proc = !isv && (isq || mixer < 2);
                        unsigned char* base; int rstride;
                        if (isq) { base = QI + ((size_t)((mixer * 16 + b) * 4 + hh) * 36 + tile0) * 8192 + chunk * 1024; rstride = 16; }
                        else if (bj == 0) { base = KI + ((size_t)((mixer * 16 + b) * 2 + hh) * 36 + tile0) * 8192 + chunk * 1024; rstride = 16; }
                        else { base = VI + ((size_t)((mixer * 16 + b) * 2 + (hh - 2)) * 36 + tile0) * 8192 + half * 4096 + fq * 16; rstride = 64; }
#pragma unroll
                        for (int ai = 0; ai < 2; ++ai)
#pragma unroll
                            for (int mm = 0; mm < 2; ++mm) { const int m = 2 * mh + mm; f32x4 v0 = acc[ai][bj][m][0], v1 = acc[ai][bj][m][1];
                                if (proc) {
                                    if (do_rms) { const float r_ = rs[bj][ai][m]; v0 = v0 * r_ * g0; v1 = v1 * r_ * g1; }
                                    if (do_rope) { const int k = H1 ? mm : ai;
                                        const f32x4 c0 = tc0[k], c1 = tc1[k], s0 = ts0[k], s1 = ts1[k];
                                        f32x4 p0, p1;
#pragma unroll
                                        for (int e = 0; e < 4; ++e) { const auto r0 = __builtin_amdgcn_permlane32_swap(__float_as_uint(v0[e]), __float_as_uint(v0[e]), false, false); p0[e] = __uint_as_float(upper ? r0[0] : r0[1]);
                                            const auto r1 = __builtin_amdgcn_permlane32_swap(__float_as_uint(v1[e]), __float_as_uint(v1[e]), false, false); p1[e] = __uint_as_float(upper ? r1[0] : r1[1]); }
                                        if (upper) { v0 = p0 * s0 + v0 * c0; v1 = p1 * s1 + v1 * c1; } else { v0 = v0 * c0 - p0 * s0; v1 = v1 * c1 - p1 * s1; } }
                                    if (isq) { v0 = v0 * QSCALE; v1 = v1 * QSCALE; } }
                                *(u32x4*)(base + (size_t)(2 * ai + wr) * 8192 + (16 * m + fr) * rstride) = (u32x4){pk_h2(v0[0], v0[1]), pk_h2(v0[2], v0[3]), pk_h2(v1[0], v1[1]), pk_h2(v1[2], v1[3])}; } }
                }
            };
            if (half) body(std::true_type{}); else body(std::false_type{});
            __builtin_amdgcn_s_waitcnt(0x0F70);
        } else {
            const int R0 = u.pm * 256 + 32 * wc + 8 * fq;
            h16* zb; size_t pitch; int cstride;
            if (R0 < TL) { const int b = R0 >> 11; zb = ZTL + (size_t)b * 256 * 4096 + (R0 & 2047); pitch = 4096; cstride = 2048; }
            else { const int rr = R0 - TL; const int b = rr >> 8; zb = ZTC + (size_t)b * 256 * 512 + (rr & 255); pitch = 512; cstride = 256; }
#pragma unroll
            for (int ai = 0; ai < 2; ++ai)
#pragma unroll
                for (int m = 0; m < 4; ++m) { const int zc = (u.pn - 6) * 256 + 128 * ai + 64 * wr + 16 * m + fr; const int g = zc >> 7, cs = (zc >> 6) & 1, mm = zc & 63;
                    h16* rowp = zb + (size_t)(g * 64 + mm) * pitch + cs * cstride;
#pragma unroll
                    for (int bj = 0; bj < 2; ++bj) { const f32x4 v0 = acc[ai][bj][m][0], v1 = acc[ai][bj][m][1];
                        *(u32x4*)(rowp + 128 * bj) = (u32x4){pk_h2(v0[0], v0[1]), pk_h2(v0[2], v0[3]), pk_h2(v1[0], v1[1]), pk_h2(v1[2], v1[3])}; } }
        }
    }
};
__device__ __forceinline__ void phase_g1_fast(const Params& p, int l, ldsp_t lds) {
    SchedG1 S{(const char*)(p.ws + WS_U16), (const char*)(p.ws + WS_WINT) + (size_t)l * 6144 * DM * 2, l, (int)bidx(), (int)gridDim.x};
    const float* tab = (const float*)(p.ws + WS_TAB);
    EpiG1 E{p.ws + WS_QI, p.ws + WS_KI, p.ws + WS_VI, (h16*)(p.ws + WS_ZTL), (h16*)(p.ws + WS_ZTC), p.qk_gain + l * 128, tab + 4096, tab + 4096 + 1024, (FG_LAS float*)(lds + 131072), l == DEPTH - 1};
    fg::gemm_phase<EpiG1, SchedG1, DM>(lds, S, E);
}

struct SchedOut {
    const char* A; const char* B; int l, c, i0, i1;
    __device__ __forceinline__ bool next(int i, fg::Unit& u) const {
        i += i0; if (i >= i1) return false;
        const int nsup = (l == 0) ? 18 : 16;
        const int L = (i * 8 + (c & 7)) * 32 + (c >> 3); const int s = L >> 5; if (s >= nsup) return false;
        u.pm = s * 8 + ((L >> 2) & 7); u.pn = L & 3; u.nt = 16; u.aux = 0;
        u.A = A + (size_t)u.pm * 256 * DM * 2; u.B = B + (size_t)u.pn * 256 * DM * 2; return true;
    }
};
struct EpiOut {
    static constexpr bool PERM = false;
    const float* x; const float* ctx; float* hB; const float* modv; int l;
    __device__ __forceinline__ void operator()(const f32x4 (&acc)[2][2][4][2], const fg::Unit& u, int wr, int wc, int fr, int fq) const {
        const int mv = u.pm < 128 ? (u.pm >> 3) : 16; const float* g1p = modv + (size_t)mv * NMOD + 2 * DM;
        const int R0 = u.pm * 256 + 64 * wr + fr; const int c0 = u.pn * 256 + 32 * wc + 4 * fq;
        const float* hbase = (l == 0 ? (R0 < TL ? x + (size_t)R0 * DM : ctx + (size_t)(R0 - TL) * DM) : hB + (size_t)R0 * DM) + c0;
        float* obase = hB + (size_t)R0 * DM + c0;
        f32x4 g1[2][2];
#pragma unroll
        for (int bj = 0; bj < 2; ++bj)
#pragma unroll
            for (int n = 0; n < 2; ++n) g1[bj][n] = *(const f32x4*)(g1p + c0 + 128 * bj + 16 * n);
#pragma unroll
        for (int ai = 0; ai < 2; ++ai) {
            f32x4 hv[4][2][2];
#pragma unroll
            for (int m = 0; m < 4; ++m)
#pragma unroll
                for (int bj = 0; bj < 2; ++bj)
#pragma unroll
                    for (int n = 0; n < 2; ++n) hv[m][bj][n] = *(const f32x4*)(hbase + (size_t)(128 * ai + 16 * m) * DM + 128 * bj + 16 * n);
            asm volatile("" ::: "memory");
#pragma unroll
            for (int m = 0; m < 4; ++m)
#pragma unroll
                for (int bj = 0; bj < 2; ++bj)
#pragma unroll
                    for (int n = 0; n < 2; ++n) *(f32x4*)(obase + (size_t)(128 * ai + 16 * m) * DM + 128 * bj + 16 * n) = ALPHA * hv[m][bj][n] + g1[bj][n] * acc[ai][bj][m][n];
            asm volatile("" ::: "memory");
        }
    }
};
__device__ __forceinline__ void phase_out_fast(const Params& p, int l, ldsp_t lds, int i0, int i1) {
    SchedOut S{(const char*)(p.ws + WS_PM), (const char*)(p.ws + WS_WOT) + (size_t)l * DM * DM * 2, l, (int)bidx(), i0, i1};
    EpiOut E{p.x, p.ctx, (float*)(p.ws + WS_HB), (const float*)(p.ws + WS_MODV) + (size_t)l * 17 * NMOD, l};
    fg::gemm_phase<EpiOut, SchedOut, DM>(lds, S, E);
}

__device__ __forceinline__ int expert_of_rtile(int rt) { return rt < 256 ? (rt & 15) : ((rt - 256) >> 1); }
struct SchedUp {
    const char* u16; const char* Wgu; const int* selrow; int l, c;
    __device__ __forceinline__ bool next(int i, fg::Unit& u) const {
        const int nsup = (l == 0) ? 72 : 64;
        const int L = (i * 8 + (c & 7)) * 32 + (c >> 3); const int s = L >> 5; if (s >= nsup) return false;
        const int o = s * 4 + ((L >> 3) & 3); const int rt = o < 256 ? ((o & 15) * 16 + (o >> 4)) : o;
        u.pm = rt; u.pn = L & 7; u.nt = 16; u.aux = expert_of_rtile(rt);
        u.A = u16; u.rows = selrow + rt * 256; u.B = Wgu + ((size_t)u.aux * 2048 + u.pn * 256) * DM * 2; return true;
    }
};
struct EpiUp {
    static constexpr bool PERM = true;
    h16* H;
    __device__ __forceinline__ void operator()(const f32x4 (&acc)[2][2][4][2], const fg::Unit& u, int wr, int wc, int fr, int fq) const {
#pragma unroll
        for (int ai = 0; ai < 2; ++ai)
#pragma unroll
            for (int m = 0; m < 4; ++m) { const int R = u.pm * 256 + 128 * ai + 64 * wr + 16 * m + fr; const int col = u.pn * 128 + 32 * wc + 8 * fq; float o[8];
#pragma unroll
                for (int n = 0; n < 2; ++n)
#pragma unroll
                    for (int j = 0; j < 4; ++j) o[n * 4 + j] = silu_f(acc[ai][0][m][n][j]) * acc[ai][1][m][n][j];
                *(u32x4*)(H + (size_t)R * FF + col) = (u32x4){pk_b2(o[0], o[1]), pk_b2(o[2], o[3]), pk_b2(o[4], o[5]), pk_b2(o[6], o[7])}; }
    }
};
__device__ __forceinline__ void phase_up_fast(const Params& p, int l, ldsp_t lds) {
    SchedUp S{(const char*)(p.ws + WS_U16), (const char*)wgu_of(p, l), (const int*)(p.ws + WS_SELR), l, (int)bidx()};
    EpiUp E{(h16*)(p.ws + WS_H16)};
    fg::gemm_phase<EpiUp, SchedUp, DM, true, true>(lds, S, E);
}
struct SchedDown {
    const char* H; const char* Wd; int l, c;
    __device__ __forceinline__ bool next(int i, fg::Unit& u) const {
        const int nsup = (l == 0) ? 36 : 32;
        const int L = (i * 8 + (c & 7)) * 32 + (c >> 3); const int s = L >> 5; if (s >= nsup) return false;
        const int o = s * 8 + ((L >> 2) & 7); const int rt = o < 256 ? ((o & 15) * 16 + (o >> 4)) : o;
        u.pm = rt; u.pn = L & 3; u.nt = 16; u.aux = expert_of_rtile(rt);
        u.A = H + (size_t)rt * 256 * FF * 2; u.B = Wd + ((size_t)u.aux * DM + u.pn * 256) * FF * 2; return true;
    }
};
struct EpiDown {
    static constexpr bool PERM = true;
    h16* Y; const float* selw;
    __device__ __forceinline__ void operator()(const f32x4 (&acc)[2][2][4][2], const fg::Unit& u, int wr, int wc, int fr, int fq) const {
        const int R0 = u.pm * 256 + 64 * wr + fr;
        float w[2][4];
#pragma unroll
        for (int ai = 0; ai < 2; ++ai)
#pragma unroll
            for (int m = 0; m < 4; ++m) w[ai][m] = selw[R0 + 128 * ai + 16 * m];
        asm volatile("" ::: "memory");
        h16* base = Y + (size_t)R0 * DM + u.pn * 256 + 32 * wc + 8 * fq;
#pragma unroll
        for (int ai = 0; ai < 2; ++ai)
#pragma unroll
            for (int m = 0; m < 4; ++m)
#pragma unroll
                for (int bj = 0; bj < 2; ++bj) { const f32x4 v0 = acc[ai][bj][m][0] * w[ai][m], v1 = acc[ai][bj][m][1] * w[ai][m];
                    *(u32x4*)(base + (size_t)(128 * ai + 16 * m) * DM + 128 * bj) = (u32x4){pk_h2(v0[0], v0[1]), pk_h2(v0[2], v0[3]), pk_h2(v1[0], v1[1]), pk_h2(v1[2], v1[3])}; }
    }
};
__device__ __forceinline__ void phase_down_fast(const Params& p, int l, ldsp_t lds) {
    SchedDown S{(const char*)(p.ws + WS_H16), (const char*)wd_of(p, l), l, (int)bidx()};
    EpiDown E{(h16*)(p.ws + WS_XG), (const float*)(p.ws + WS_SELW)};
    fg::gemm_phase<EpiDown, SchedDown, DM, true>(lds, S, E);
}


struct SchedMerge {
    const char* u16; const char* br; const char* WinT; const char* WbT; int l, c, i0, i1;
    __device__ __forceinline__ bool next(int i, fg::Unit& u) const {
        i += i0; if (i >= i1) return false;
        int ib, sub;
        if (i < 16) { const int ti = i >> 3; sub = i & 7; ib = sub >> 1;
            const int L = (ti * 8 + (c & 7)) * 32 + (c >> 3); const int s = L >> 5;
            u.pm = s * 8 + ((L >> 2) & 7); u.pn = L & 3; u.aux = sub; }
        else { if (l != 0 || i >= 18) return false; const int tct = c >> 2; ib = c & 3; sub = 2 * ib + (i & 1);
            u.pm = 128 + (tct >> 2); u.pn = tct & 3; u.aux = sub | 8; }
        if ((sub & 1) == 0) { u.nt = 16; u.A = u16 + (size_t)u.pm * 256 * DM * 2; u.B = WinT + (size_t)(1536 + ib * 1024 + u.pn * 256) * DM * 2; }
        else { u.nt = 4; u.A = br + (size_t)u.pm * 256 * DM * 2 + ib * 512; u.B = WbT + (size_t)u.pn * 256 * DM * 2 + ib * 512; }
        return true;
    }
};
struct EpiMerge {
    static constexpr bool PERM = true;
    h16* mg; h16* part; unsigned char* scr;
    __device__ __forceinline__ void operator()(const f32x4 (&acc)[2][2][4][2], const fg::Unit& u, int wr, int wc, int fr, int fq) const {
        const int tid = tidx();
        if ((u.aux & 1) == 0) {
#pragma unroll
            for (int ai = 0; ai < 2; ++ai)
#pragma unroll
                for (int m = 0; m < 4; ++m)
#pragma unroll
                    for (int bj = 0; bj < 2; ++bj) { const int q = (ai * 4 + m) * 2 + bj; const f32x4 v0 = acc[ai][bj][m][0], v1 = acc[ai][bj][m][1];
                        *(u32x4*)(scr + ((size_t)q * 512 + tid) * 16) = (u32x4){pk_h2(sig2_f(v0[0]), sig2_f(v0[1])), pk_h2(sig2_f(v0[2]), sig2_f(v0[3])), pk_h2(sig2_f(v1[0]), sig2_f(v1[1])), pk_h2(sig2_f(v1[2]), sig2_f(v1[3]))}; }
        } else {
            const bool partial = (u.aux & 8) != 0; const bool first = partial || ((u.aux & 7) == 1);
            h16* base = partial ? part + ((size_t)((u.aux & 7) >> 1) * TC + (size_t)(u.pm - 128) * 256) * DM : mg + (size_t)u.pm * 256 * DM;
            base += (size_t)(64 * wr + fr) * DM + u.pn * 256 + 32 * wc + 8 * fq;
#pragma unroll
            for (int ai = 0; ai < 2; ++ai) {
                h16x8 gv[8], pr[8];
#pragma unroll
                for (int m = 0; m < 4; ++m)
#pragma unroll
                    for (int bj = 0; bj < 2; ++bj) { const int q = (ai * 4 + m) * 2 + bj; gv[m * 2 + bj] = *(const h16x8*)(scr + ((size_t)q * 512 + tid) * 16);
                        if (!first) pr[m * 2 + bj] = *(const h16x8*)(base + (size_t)(128 * ai + 16 * m) * DM + 128 * bj); }
                asm volatile("" ::: "memory");
#pragma unroll
                for (int m = 0; m < 4; ++m)
#pragma unroll
                    for (int bj = 0; bj < 2; ++bj) { const h16x8 g = gv[m * 2 + bj]; const f32x4 v0 = acc[ai][bj][m][0], v1 = acc[ai][bj][m][1];
                        float o[8] = {(float)g[0] * v0[0], (float)g[1] * v0[1], (float)g[2] * v0[2], (float)g[3] * v0[3], (float)g[4] * v1[0], (float)g[5] * v1[1], (float)g[6] * v1[2], (float)g[7] * v1[3]};
                        if (!first) { const h16x8 pp = pr[m * 2 + bj];
#pragma unroll
                            for (int e = 0; e < 8; ++e) o[e] += (float)pp[e]; }
                        *(u32x4*)(base + (size_t)(128 * ai + 16 * m) * DM + 128 * bj) = (u32x4){pk_h2(o[0], o[1]), pk_h2(o[2], o[3]), pk_h2(o[4], o[5]), pk_h2(o[6], o[7])}; }
                asm volatile("" ::: "memory");
            }
        }
    }
};
__device__ __forceinline__ void phase_merge_fast(const Params& p, int l, ldsp_t lds, int i0, int i1) {
    SchedMerge S{(const char*)(p.ws + WS_U16), (const char*)(p.ws + WS_BR), (const char*)(p.ws + WS_WINT) + (size_t)l * 6144 * DM * 2, (const char*)(p.ws + WS_WBT) + (size_t)l * DM * DM * 2, l, bidx(), i0, i1};
    EpiMerge E{(h16*)(p.ws + WS_PM), (h16*)(p.ws + WS_MPART), (l == 0 ? p.ws + WS_WGU1 : (unsigned char*)p.out + DO_WGU) + (size_t)bidx() * 131072};
    fg::gemm_phase<EpiMerge, SchedMerge, DM>(lds, S, E);
}
__device__ __forceinline__ void phase_merge_sum(const Params& p) {
    const h16* part = (const h16*)(p.ws + WS_MPART); h16* mg = (h16*)(p.ws + WS_PM) + (size_t)TL * DM;
    const int gt = bidx() * NTHREADS + tidx(), NG = gridDim.x * NTHREADS;
    for (int o = gt; o < TC * DM / 8; o += NG) { float acc[8];
#pragma unroll
        for (int e = 0; e < 8; ++e) acc[e] = 0.f;
#pragma unroll
        for (int i = 0; i < 4; ++i) { const h16x8 v = *(const h16x8*)(part + (size_t)i * TC * DM + (size_t)o * 8);
#pragma unroll
            for (int e = 0; e < 8; ++e) acc[e] += (float)v[e]; }
        *(u32x4*)(mg + (size_t)o * 8) = (u32x4){pk_h2(acc[0], acc[1]), pk_h2(acc[2], acc[3]), pk_h2(acc[4], acc[5]), pk_h2(acc[6], acc[7])}; }
}

struct EpiDft {
    static constexpr bool PERM = true;
    h16* br; int row0, rows_per_b; float scl;
    __device__ __forceinline__ void operator()(const f32x4 (&acc)[2][2][4][2], const fg::Unit& u, int wr, int wc, int fr, int fq) const {
#pragma unroll
        for (int ai = 0; ai < 2; ++ai)
#pragma unroll
            for (int m = 0; m < 4; ++m) { const int kr = u.pm * 256 + 128 * ai + 64 * wr + 16 * m + fr; const size_t R = (size_t)row0 + (size_t)u.pn * rows_per_b + kr;
#pragma unroll
                for (int bj = 0; bj < 2; ++bj) { const int col = 128 * bj + 32 * wc + 8 * fq; const f32x4 v0 = acc[ai][bj][m][0] * scl, v1 = acc[ai][bj][m][1] * scl;
                    *(u32x4*)(br + R * DM + 256 + col) = (u32x4){pk_h2(v0[0], v0[1]), pk_h2(v0[2], v0[3]), pk_h2(v1[0], v1[1]), pk_h2(v1[2], v1[3])}; } }
    }
};

namespace fa {
typedef float f32x16 __attribute__((ext_vector_type(16)));
typedef short v4i16_t __attribute__((ext_vector_type(4)));
typedef short s16x4 __attribute__((ext_vector_type(4)));
constexpr float LOG2E = 1.4426950408889634f;
constexpr int NSLOT = 3, SLOTB = 8192;
constexpr int LDS_K = 0, LDS_V = NSLOT * SLOTB, LDS_WS = 2 * NSLOT * SLOTB, LDS_OST = LDS_WS + 8 * 64 * 4, LDS_RPB = LDS_OST + 8 * 4096;
__device__ __forceinline__ int crow(int r, int hi) { return (r & 3) + 8 * (r >> 2) + 4 * hi; }
#define SBAR() __builtin_amdgcn_sched_barrier(0)
__device__ __forceinline__ void glds16(const void* gsrc, unsigned lds_dst) { unsigned keep;
    asm volatile("s_mov_b32 %0, m0\n\ts_mov_b32 m0, %2\n\ts_nop 0\n\tglobal_load_lds_dwordx4 %1, off\n\ts_mov_b32 m0, %0" : "=&s"(keep) : "v"(gsrc), "s"(lds_dst) : "memory"); }
__device__ __forceinline__ float max3f(float a, float b, float c) { float r; asm("v_max3_f32 %0, %1, %2, %3" : "=v"(r) : "v"(a), "v"(b), "v"(c)); return r; }
__device__ __forceinline__ float max2f(float a, float b) { float r; asm("v_max_f32_e32 %0, %1, %2" : "=v"(r) : "v"(a), "v"(b)); return r; }
__device__ __forceinline__ float fadd_s(float a, float b) { float r; asm("v_add_f32_e32 %0, %1, %2" : "=v"(r) : "v"(a), "v"(b)); return r; }
__device__ __forceinline__ float fsub_s(float a, float b) { float r; asm("v_sub_f32_e32 %0, %1, %2" : "=v"(r) : "v"(a), "v"(b)); return r; }
#define WAIT_BAR(N) asm volatile("s_waitcnt vmcnt(" #N ") lgkmcnt(0)\n\ts_barrier" ::: "memory")
typedef __attribute__((address_space(3))) const char* lds_cptr;
__device__ __forceinline__ void kload8(h16x8* kf, lds_cptr kp) {
    kf[0] = *(const FG_LAS h16x8*)(kp);        kf[1] = *(const FG_LAS h16x8*)(kp + 512);
    kf[2] = *(const FG_LAS h16x8*)(kp + 2048); kf[3] = *(const FG_LAS h16x8*)(kp + 2560);
    kf[4] = *(const FG_LAS h16x8*)(kp + 4096); kf[5] = *(const FG_LAS h16x8*)(kp + 4608);
    kf[6] = *(const FG_LAS h16x8*)(kp + 6144); kf[7] = *(const FG_LAS h16x8*)(kp + 6656);
}
__device__ __forceinline__ void kload2(h16x8* kf, lds_cptr kp, int j) { kf[2 * j] = *(const FG_LAS h16x8*)(kp + j * 2048); kf[2 * j + 1] = *(const FG_LAS h16x8*)(kp + j * 2048 + 512); }
__device__ __forceinline__ s16x4 vtr(lds_cptr p) { return __builtin_bit_cast(s16x4, __builtin_amdgcn_ds_read_tr16_b64_v4i16((FG_LAS v4i16_t*)p)); }
__device__ __forceinline__ void qkt(f32x16& p0, f32x16& p1, lds_cptr Kslot, const h16x8* qr, const f32x16& negm, int r32, int hi) {
    lds_cptr kb = Kslot + hi * 1024 + r32 * 16;
#pragma unroll
    for (int d0 = 0; d0 < 4; ++d0) {
        const h16x8 b0 = *(const FG_LAS h16x8*)(kb + d0 * 2048), b1 = *(const FG_LAS h16x8*)(kb + d0 * 2048 + 512);
        if (d0 == 0) { p0 = __builtin_amdgcn_mfma_f32_32x32x16_f16(b0, qr[0], negm, 0, 0, 0); p1 = __builtin_amdgcn_mfma_f32_32x32x16_f16(b1, qr[0], negm, 0, 0, 0); }
        else { p0 = __builtin_amdgcn_mfma_f32_32x32x16_f16(b0, qr[d0], p0, 0, 0, 0); p1 = __builtin_amdgcn_mfma_f32_32x32x16_f16(b1, qr[d0], p1, 0, 0, 0); } }
}
__device__ __forceinline__ float rowmax(const f32x16& p0, const f32x16& p1) {
    float a = max3f(p0[0], p0[1], p1[0]), b = max3f(p0[2], p0[3], p1[1]); a = max3f(a, p1[2], p1[3]);
#pragma unroll
    for (int r = 4; r < 16; r += 4) { a = max3f(a, p0[r], p0[r + 1]); b = max3f(b, p0[r + 2], p0[r + 3]); a = max3f(a, p1[r], p1[r + 1]); b = max3f(b, p1[r + 2], p1[r + 3]); }
    const float m = max2f(a, b);
    auto rr = __builtin_amdgcn_permlane32_swap(__float_as_uint(m), __float_as_uint(m), false, false);
    return max2f(__uint_as_float(rr[0]), __uint_as_float(rr[1]));
}
__device__ __forceinline__ void pv(f32x16* o, lds_cptr vb, h16x8 pa0, h16x8 pa1, h16x8 pa2, h16x8 pa3) {
    typedef short s8 __attribute__((ext_vector_type(8)));
#pragma unroll
    for (int d0 = 0; d0 < 2; ++d0) { s16x4 lo[4], hh[4];
#pragma unroll
        for (int ks = 0; ks < 4; ++ks) { lo[ks] = vtr(vb + d0 * 4096 + ks * 1024); hh[ks] = vtr(vb + d0 * 4096 + ks * 1024 + 512); }
#define PKV(k) __builtin_bit_cast(h16x8, (s8){lo[k][0], lo[k][1], lo[k][2], lo[k][3], hh[k][0], hh[k][1], hh[k][2], hh[k][3]})
        o[d0] = __builtin_amdgcn_mfma_f32_32x32x16_f16(pa0, PKV(0), o[d0], 0, 0, 0);
        o[d0] = __builtin_amdgcn_mfma_f32_32x32x16_f16(pa1, PKV(1), o[d0], 0, 0, 0);
        o[d0] = __builtin_amdgcn_mfma_f32_32x32x16_f16(pa2, PKV(2), o[d0], 0, 0, 0);
        o[d0] = __builtin_amdgcn_mfma_f32_32x32x16_f16(pa3, PKV(3), o[d0], 0, 0, 0);
#undef PKV
    }
}
template <int MIXER, int THRL>
__device__ __forceinline__ void attn_unit(const unsigned char* QI, const unsigned char* KI, const unsigned char* VI, h16* br, const float* sinkp, const float* rpb, int mixer, int b, int kvh, int qb, bool isctx, ldsp_t lds, unsigned* qctr, volatile FG_LAS unsigned* qw) {
    const int tid = tidx(), lane = tid & 63, wid = __builtin_amdgcn_readfirstlane(tid >> 6), r32 = lane & 31, hi = lane >> 5, g = wid >> 2, qsub = wid & 3, hq = kvh * 2 + g;
    const int brcol = (mixer == 0 ? 0 : mixer == 1 ? 512 : 768) + hq * 64;
    const int q0 = (isctx ? TL + b * 256 + qb * 128 : b * 2048 + qb * 128) + qsub * 32;
    int jlo = 0, nlat = 0;
    if (!isctx) {
        if (MIXER == 0) { jlo = 0; nlat = 32; }
        else if (MIXER == 1) { jlo = max(0, 2 * qb - 2); nlat = min(31, 2 * qb + 3) - jlo + 1; }
        else { jlo = min(max(2 * qb - 4, 0), 24); nlat = min(max(2 * qb - 3, 0), 24) + 7 - jlo + 1; }
    }
    const int nreal = 4 + nlat; const int NT = (nreal + 1) & ~1;
#define FA_TILE(s) ((s) < 4 ? (s) : 4 + jlo + min((s), nreal - 1) - 4)
    const unsigned lds0 = (unsigned)(size_t)lds;
    FG_LAS float* wsf = (FG_LAS float*)(lds + LDS_WS) + wid * 64;
    const unsigned char* ksrc = KI + ((size_t)((mixer * 16 + b) * 2 + kvh) * 36) * 8192 + wid * 1024 + lane * 16;
    const unsigned char* vsrc = VI + ((size_t)((mixer * 16 + b) * 2 + kvh) * 36) * 8192 + wid * 1024 + lane * 16;
    const unsigned kdst = lds0 + LDS_K + wid * 1024, vdst = lds0 + LDS_V + wid * 1024;
#define DMA_K(t, slot) glds16(ksrc + (size_t)FA_TILE(t) * 8192, (unsigned)__builtin_amdgcn_readfirstlane(kdst + (slot)))
#define DMA_V(t, slot) glds16(vsrc + (size_t)FA_TILE(t) * 8192, (unsigned)__builtin_amdgcn_readfirstlane(vdst + (slot)))
    h16x8 kf[8];
    const lds_cptr shm3 = (lds_cptr)lds; const lds_cptr kp0 = shm3 + LDS_K + hi * 1024 + r32 * 16;
    const lds_cptr vp0 = shm3 + LDS_V + ((lane >> 4) & 1) * 32 + (lane & 3) * 8 + (4 * hi + ((lane & 15) >> 2)) * 64;
    DMA_K(0, 0); DMA_V(0, 0); DMA_K(1, SLOTB);
    if (MIXER == 2) { FG_LAS float* tb = (FG_LAS float*)(lds + LDS_RPB); for (int i = tid; i < 930; i += NTHREADS) tb[i] = rpb[(size_t)(kvh * 2) * 465 + i] * LOG2E; }
    h16x8 qr[4];
    { const int qtile = (isctx ? 0 : 4) + 2 * qb + (qsub >> 1);
      const unsigned char* qp = QI + (((size_t)((mixer * 16 + b) * 4 + hq) * 36) + qtile) * 8192 + hi * 1024 + ((qsub & 1) * 32 + r32) * 16;
#pragma unroll
      for (int d0 = 0; d0 < 4; ++d0) qr[d0] = *(const h16x8*)(qp + d0 * 2048); }
    float mhat = 0.f, l_reg = 0.f; f32x16 o[2]; o[0] = f32x16{}; o[1] = f32x16{}; f32x16 negm = f32x16{}; asm volatile("" : "+v"(negm));
    const int tq = qb * 128 + qsub * 32 + r32;
    const int qrow = 2 * qb + (qsub >> 1);
    const int qcl = tq & 63; const int r0w = min(max(qrow - 4, 0), 24), c0q = min(max(qcl - 8, 0), 48);
#define CMASK(P0, P1, s) do { if (MIXER != 0 && (s) >= 4) { const float NEGI = -INFINITY; const int j_ = jlo + (s) - 4; \
        if ((s) >= nreal) { _Pragma("unroll") for (int r = 0; r < 16; ++r) { P0[r] = NEGI; P1[r] = NEGI; } } \
        else if (MIXER == 1) { const int dt = tq - 64 * j_; \
            _Pragma("unroll") for (int r = 0; r < 16; ++r) { const int kk = crow(r, hi); P0[r] = ((unsigned)(kk - dt + 128) <= 256u) ? P0[r] : NEGI; P1[r] = ((unsigned)(kk + 32 - dt + 128) <= 256u) ? P1[r] : NEGI; } } \
        else { const bool rowok = (j_ >= r0w) && (j_ <= r0w + 7); const int jr_ = rowok ? j_ : r0w; \
            const FG_LAS float* tb = (const FG_LAS float*)(lds + LDS_RPB) + g * 465 + (jr_ - qrow + 7) * 31 + (15 - qcl); \
            _Pragma("unroll") for (int r = 0; r < 16; ++r) { const int kc = crow(r, hi); \
                { const bool ok = rowok && ((unsigned)(kc - c0q) < 16u); const float bv = tb[ok ? kc : qcl]; P0[r] = ok ? P0[r] + bv : NEGI; } \
                { const int kc1 = kc + 32; const bool ok = rowok && ((unsigned)(kc1 - c0q) < 16u); const float bv = tb[ok ? kc1 : qcl]; P1[r] = ok ? P1[r] + bv : NEGI; } } } } } while (0)
    bool resc = false;
#define START(P0, P1) do { const float rm = rowmax(P0, P1); resc = false; \
    { const float dl = rm; mhat = fadd_s(mhat, dl); \
      _Pragma("unroll") for (int r = 0; r < 16; ++r) { P0[r] = fsub_s(P0[r], dl); P1[r] = fsub_s(P1[r], dl); } \
      _Pragma("unroll") for (int r = 0; r < 16; ++r) negm[r] = -mhat; asm volatile("" : "+v"(negm)); } \
    _Pragma("unroll") for (int r = 0; r < 16; ++r) P0[r] = __builtin_amdgcn_exp2f(P0[r]); } while (0)
#define RESC() do { if (resc) { asm volatile("s_waitcnt lgkmcnt(0)" ::: "memory"); \
      _Pragma("unroll") for (int d_ = 0; d_ < 2; ++d_) _Pragma("unroll") for (int r = 0; r < 16; ++r) o[d_][r] *= wsf[crow(r, hi)]; } } while (0)
    f32x16 pA0, pA1, pB0, pB1;
    int sl_prev = 0, sl_cur = 0, sl_next = SLOTB;
#define ROT() do { sl_prev = sl_cur; sl_cur = sl_next; sl_next = (sl_next == (NSLOT - 1) * SLOTB) ? 0 : sl_next + SLOTB; } while (0)
    DMA_K(2, 2 * SLOTB);
    WAIT_BAR(3);
    qkt(pA0, pA1, shm3 + LDS_K, qr, negm, r32, hi); asm volatile("s_nop 15\n\ts_nop 7" : "+v"(pA0), "+v"(pA1));
    START(pA0, pA1);
#pragma unroll
    for (int r = 0; r < 16; ++r) pA1[r] = __builtin_amdgcn_exp2f(pA1[r]);
    WAIT_BAR(0);
    DMA_K(3, 0); DMA_V(1, SLOTB);
    ROT();
    kload8(kf, kp0 + sl_cur);
    WAIT_BAR(2);
    s16x4 vlo[8], vhi[8]; u32x4 pw0, pw1, pw2, pw3;
    typedef short s8v __attribute__((ext_vector_type(8)));
#define PKW(P, B) pk_h2(P[B], P[B + 1])
#define PAF(k) __builtin_bit_cast(h16x8, pw##k)
#define VFR(i) __builtin_bit_cast(h16x8, (s8v){vlo[i][0], vlo[i][1], vlo[i][2], vlo[i][3], vhi[i][0], vhi[i][1], vhi[i][2], vhi[i][3]})
#define PIN(x) asm volatile("" : "+v"(x))
#define MX3(a, b, c) __builtin_fmaxf(__builtin_fmaxf((a), (b)), (c))
#define GAPA(MF, A0, A1, A2, A3, W0, W1, PW) do { MF; sacc += A0; sacc += A1; sacc += A2; sacc += A3; PIN(sacc); W0; W1; PIN(PW); SBAR(); } while (0)
#define EX(v) __builtin_amdgcn_exp2f(v)
#define GAPB(MF, X, B) do { MF; X[B] = EX(X[B]); X[B + 1] = EX(X[B + 1]); X[B + 2] = EX(X[B + 2]); X[B + 3] = EX(X[B + 3]); PIN(X); SBAR(); } while (0)
#define VRD(i) do { vlo[i] = vtr(vp_ + (((i) >> 2) * 4096 + ((i) & 3) * 1024)); vhi[i] = vtr(vp_ + (((i) >> 2) * 4096 + ((i) & 3) * 1024 + 512)); } while (0)
#define KRD(G, j) do { if (G) { kload2(kf, kp0 + sl_next, j); SBAR(); } } while (0)
#define MF32(a, b, c) __builtin_amdgcn_mfma_f32_32x32x16_f16(a, b, c, 0, 0, 0)
#define STEP(C0, C1, P0, P1, t, GK, GV, GL) do { SBAR(); \
    const lds_cptr vp_ = vp0 + sl_prev; \
    VRD(0); SBAR(); float sacc = (P0[0] + P0[1]); \
    GAPA(C0 = MF32(kf[0], qr[0], negm), P0[2], P0[3], P0[4], P0[5],     pw0[0] = PKW(P0, 0), pw0[1] = PKW(P0, 2), pw0); \
    VRD(4); SBAR(); GAPA(C1 = MF32(kf[1], qr[0], negm), P0[6], P0[7], P0[8], P0[9],     pw0[2] = PKW(P0, 4), pw0[3] = PKW(P0, 6), pw0); \
    VRD(1); SBAR(); GAPA(C0 = MF32(kf[2], qr[1], C0),   P0[10], P0[11], P0[12], P0[13], pw1[0] = PKW(P0, 8), pw1[1] = PKW(P0, 10), pw1); \
    VRD(5); SBAR(); GAPA(C1 = MF32(kf[3], qr[1], C1),   P0[14], P0[15], P1[0], P1[1],   pw1[2] = PKW(P0, 12), pw1[3] = PKW(P0, 14), pw1); \
    VRD(2); SBAR(); GAPA(C0 = MF32(kf[4], qr[2], C0),   P1[2], P1[3], P1[4], P1[5],     pw2[0] = PKW(P1, 0), pw2[1] = PKW(P1, 2), pw2); \
    VRD(6); SBAR(); GAPA(C1 = MF32(kf[5], qr[2], C1),   P1[6], P1[7], P1[8], P1[9],     pw2[2] = PKW(P1, 4), pw2[3] = PKW(P1, 6), pw2); \
    VRD(3); SBAR(); GAPA(C0 = MF32(kf[6], qr[3], C0),   P1[10], P1[11], P1[12], P1[13], pw3[0] = PKW(P1, 8), pw3[1] = PKW(P1, 10), pw3); \
    VRD(7); SBAR(); GAPA(C1 = MF32(kf[7], qr[3], C1),   P1[14], P1[15], 0.f, 0.f,       pw3[2] = PKW(P1, 12), pw3[3] = PKW(P1, 14), pw3); \
    l_reg += sacc; \
    if (GK) { DMA_K((t) + 3, sl_cur); } if (GV) { DMA_V((t) + 1, sl_next); } \
    CMASK(C0, C1, t); \
    { float a = MX3(C0[0], C0[1], C1[0]), b_ = MX3(C0[2], C0[3], C1[1]); a = MX3(a, C1[2], C1[3]); \
      _Pragma("unroll") for (int r = 4; r < 16; r += 4) { a = MX3(a, C0[r], C0[r + 1]); b_ = MX3(b_, C0[r + 2], C0[r + 3]); a = MX3(a, C1[r], C1[r + 1]); b_ = MX3(b_, C1[r + 2], C1[r + 3]); } \
      float rm = __builtin_fmaxf(a, b_); { auto rr = __builtin_amdgcn_permlane32_swap(__float_as_uint(rm), __float_as_uint(rm), false, false); rm = __builtin_fmaxf(__uint_as_float(rr[0]), __uint_as_float(rr[1])); } \
      resc = false; \
      if (__builtin_expect(__any(rm > (float)THRL), 0)) { const float dl = __builtin_fmaxf(rm, 0.f); mhat += dl; \
        _Pragma("unroll") for (int r = 0; r < 16; ++r) { C0[r] -= dl; C1[r] -= dl; } \
        _Pragma("unroll") for (int r = 0; r < 16; ++r) negm[r] = -mhat; asm volatile("" : "+v"(negm)); \
        const float f = __builtin_amdgcn_exp2f(-dl); l_reg *= f; if (hi == 0) wsf[r32] = f; resc = true; } } \
    SBAR(); \
    GAPB(o[0] = MF32(PAF(0), VFR(0), o[0]), C0, 0); \
    GAPB(o[1] = MF32(PAF(0), VFR(4), o[1]), C0, 4); \
    KRD(GL, 0); GAPB(o[0] = MF32(PAF(1), VFR(1), o[0]), C0, 8); \
    KRD(GL, 1); GAPB(o[1] = MF32(PAF(1), VFR(5), o[1]), C0, 12); \
    KRD(GL, 2); GAPB(o[0] = MF32(PAF(2), VFR(2), o[0]), C1, 0); \
    KRD(GL, 3); GAPB(o[1] = MF32(PAF(2), VFR(6), o[1]), C1, 4); \
    GAPB(o[0] = MF32(PAF(3), VFR(3), o[0]), C1, 8); \
    GAPB(o[1] = MF32(PAF(3), VFR(7), o[1]), C1, 12); \
    } while (0)
    int t = 1;
    for (; t + 5 < NT; t += 2) {
        STEP(pB0, pB1, pA0, pA1, t, true, true, true);     WAIT_BAR(2); RESC(); ROT();
        STEP(pA0, pA1, pB0, pB1, t + 1, true, true, true); WAIT_BAR(2); RESC(); ROT();
    }
#define ENDW(tt) do { if ((tt) + 3 < NT) { WAIT_BAR(2); } else if ((tt) + 2 < NT) { WAIT_BAR(1); } else { WAIT_BAR(0); } } while (0)
    for (; t + 1 < NT; t += 2) {
        STEP(pB0, pB1, pA0, pA1, t, (t + 3 < NT), (t + 1 < NT), (t + 1 < NT));         ENDW(t);     RESC(); ROT();
        STEP(pA0, pA1, pB0, pB1, t + 1, (t + 4 < NT), (t + 2 < NT), (t + 2 < NT));     ENDW(t + 1); RESC(); ROT();
    }
    STEP(pB0, pB1, pA0, pA1, NT - 1, false, false, false); RESC();
    unsigned nraw = 0u; if (tid == 0) nraw = __hip_atomic_fetch_add(qctr, 1u, __ATOMIC_RELAXED, __HIP_MEMORY_SCOPE_AGENT);
    { float sacc = pB0[0] + pB0[1];
#pragma unroll
      for (int r = 2; r < 16; ++r) sacc += pB0[r];
#pragma unroll
      for (int r = 0; r < 16; ++r) sacc += pB1[r];
      l_reg += sacc;
      pw0 = (u32x4){PKW(pB0, 0), PKW(pB0, 2), PKW(pB0, 4), PKW(pB0, 6)}; pw1 = (u32x4){PKW(pB0, 8), PKW(pB0, 10), PKW(pB0, 12), PKW(pB0, 14)};
      pw2 = (u32x4){PKW(pB1, 0), PKW(pB1, 2), PKW(pB1, 4), PKW(pB1, 6)}; pw3 = (u32x4){PKW(pB1, 8), PKW(pB1, 10), PKW(pB1, 12), PKW(pB1, 14)};
      SBAR(); pv(o, vp0 + sl_cur, PAF(0), PAF(1), PAF(2), PAF(3)); }
    { auto rr = __builtin_amdgcn_permlane32_swap(__float_as_uint(l_reg), __float_as_uint(l_reg), false, false); l_reg = __uint_as_float(rr[0]) + __uint_as_float(rr[1]); }
    if (mixer == 1) l_reg += __builtin_amdgcn_exp2f(sinkp[hq] * LOG2E - mhat);
    if (hi == 0) wsf[32 + r32] = l_reg; asm volatile("s_waitcnt lgkmcnt(0)" ::: "memory");
    float rli[16];
#pragma unroll
    for (int r = 0; r < 16; ++r) rli[r] = __builtin_amdgcn_rcpf(wsf[32 + crow(r, hi)]);
    h16* Ow = br + (size_t)q0 * DM + brcol;
    { FG_LAS h16* stg = (FG_LAS h16*)(lds + LDS_OST) + wid * 2048;
#pragma unroll
      for (int r = 0; r < 16; ++r) { const int orow = crow(r, hi);
#pragma unroll
          for (int d0 = 0; d0 < 2; ++d0) stg[orow * 64 + d0 * 32 + r32] = (h16)(o[d0][r] * rli[r]); }
      asm volatile("s_waitcnt lgkmcnt(0)" ::: "memory");
#pragma unroll
      for (int i = 0; i < 4; ++i) { const int row = i * 8 + (lane >> 3), ch = lane & 7; const u32x4 v = *(const FG_LAS u32x4*)(stg + row * 64 + ch * 8); *(u32x4*)(Ow + (size_t)row * DM + ch * 8) = v; } }
    if (tid == 0) qw[0] = nraw;
    asm volatile("s_waitcnt lgkmcnt(0)\n\ts_barrier" ::: "memory");
#undef FA_TILE
#undef DMA_K
#undef DMA_V
#undef CMASK
#undef START
#undef RESC
#undef ROT
#undef PKW
#undef PAF
#undef VFR
#undef PIN
#undef MX3
#undef GAPA
#undef GAPB
#undef EX
#undef VRD
#undef KRD
#undef MF32
#undef STEP
#undef ENDW
}
#undef SBAR
#undef WAIT_BAR
}
struct SchedTwo { fg::Unit u0, u1; __device__ __forceinline__ bool next(int i, fg::Unit& o) const { if (i == 0) { o = u0; return true; } if (i == 1) { o = u1; return true; } return false; } };
struct EpiDftSym {
    static constexpr bool PERM = true;
    h16* br; unsigned char* scr;
    __device__ __forceinline__ void operator()(const f32x4 (&acc)[2][2][4][2], const fg::Unit& u, int wr, int wc, int fr, int fq) const {
        const int tid = tidx(); const float scl = 0.022097086912079608f;
        if (u.aux == 0) {
#pragma unroll
            for (int ai = 0; ai < 2; ++ai)
#pragma unroll
                for (int m = 0; m < 4; ++m)
#pragma unroll
                    for (int bj = 0; bj < 2; ++bj)
#pragma unroll
                        for (int n = 0; n < 2; ++n) { const int q = ((ai * 4 + m) * 2 + bj) * 2 + n; *(f32x4*)(scr + ((size_t)q * 512 + tid) * 16) = acc[ai][bj][m][n]; }
        } else {
#pragma unroll
            for (int ai = 0; ai < 2; ++ai) {
                f32x4 pv[4][2][2];
#pragma unroll
                for (int m = 0; m < 4; ++m)
#pragma unroll
                    for (int bj = 0; bj < 2; ++bj)
#pragma unroll
                        for (int n = 0; n < 2; ++n) { const int q = ((ai * 4 + m) * 2 + bj) * 2 + n; pv[m][bj][n] = *(const f32x4*)(scr + ((size_t)q * 512 + tid) * 16); }
                asm volatile("" ::: "memory");
#pragma unroll
                for (int m = 0; m < 4; ++m) { const int k = u.pm * 256 + 128 * ai + 64 * wr + 16 * m + fr + 1;
                    h16* lo = br + ((size_t)u.pn * 2048 + k) * DM + 256; h16* hi = br + ((size_t)u.pn * 2048 + (2048 - k)) * DM + 256;
#pragma unroll
                    for (int bj = 0; bj < 2; ++bj) { const int col = 128 * bj + 32 * wc + 8 * fq;
                        const f32x4 p0 = pv[m][bj][0], p1 = pv[m][bj][1];
                        const f32x4 q0v = acc[ai][bj][m][0], q1v = acc[ai][bj][m][1];
                        const f32x4 a0 = (p0 - q0v) * scl, a1 = (p1 - q1v) * scl, b0 = (p0 + q0v) * scl, b1 = (p1 + q1v) * scl;
                        *(u32x4*)(lo + col) = (u32x4){pk_h2(a0[0], a0[1]), pk_h2(a0[2], a0[3]), pk_h2(a1[0], a1[1]), pk_h2(a1[2], a1[3])};
                        *(u32x4*)(hi + col) = (u32x4){pk_h2(b0[0], b0[1]), pk_h2(b0[2], b0[3]), pk_h2(b1[0], b1[1]), pk_h2(b1[2], b1[3])}; } }
                asm volatile("" ::: "memory");
            }
        }
    }
};
struct SchedOne { fg::Unit u; __device__ __forceinline__ bool next(int i, fg::Unit& o) const { if (i != 0) return false; o = u; return true; } };
__device__ __forceinline__ void phase_mixers(const Params& p, int l, ldsp_t lds, int rep = 0) {
    const unsigned char* QI = p.ws + WS_QI; const unsigned char* KI = p.ws + WS_KI; const unsigned char* VI = p.ws + WS_VI; h16* br = (h16*)(p.ws + WS_BR);
    const float* sinkp = p.sink + l * 4; const float* rpb = p.rpb + (size_t)l * 4 * 465;
    const int x = bidx() & 7;
    unsigned* qctr = (unsigned*)(p.ws + WS_CTL) + 64 * (rep * 16 + l * 8 + x) + 32;
    volatile FG_LAS unsigned* qw = (volatile FG_LAS unsigned*)(lds + LDS_BYTES - 512);
    const int nq = (l == 0) ? 226 : 200;
    const int tid = tidx();
    if (rep == 0) fourier_row0(p);
    __syncthreads();
    bool have = false;
    for (;;) {
        if (!have && tid == 0) qw[0] = __hip_atomic_fetch_add(qctr, 1u, __ATOMIC_RELAXED, __HIP_MEMORY_SCOPE_AGENT);
        __syncthreads();
        int idx = (int)qw[0];
        have = false;
        if (idx >= nq) break;
        if (l == 0 && idx >= 72) idx = idx < 74 ? idx + 152 : idx - 2;
        if (rep > 0) { const bool isdft = idx < 8 || idx >= 224; if ((PROBE_MODE == 1 && isdft) || (PROBE_MODE == 2 && !isdft)) continue; }
        if (idx < 8) {
            const int id = idx;
            SchedTwo S; S.u0.pm = id & 3; S.u0.pn = 2 * x + (id >> 2); S.u0.nt = 32; S.u0.aux = 0;
            S.u0.A = (const char*)(p.ws + WS_DFT) + (size_t)S.u0.pm * 256 * 4096 * 2; S.u0.B = (const char*)(p.ws + WS_ZTL) + (size_t)S.u0.pn * 256 * 4096 * 2;
            S.u1 = S.u0; S.u1.aux = 1; S.u1.A += 4096; S.u1.B += 4096;
            EpiDftSym E{br, p.ws + WS_GSCR + (size_t)bidx() * 262144};
            fg::gemm_phase<EpiDftSym, SchedTwo, 4096>(lds, S, E);
        } else if (idx < 200) {
            const int w = (idx - 8) & 63; const int ty = (idx - 8) >> 6;
            if (ty == 0) { fa::attn_unit<0, 8>(QI, KI, VI, br, sinkp, rpb, 0, 2 * x + (w >> 5), (w >> 4) & 1, w & 15, false, lds, qctr, qw); }
            else if (ty == 1) { fa::attn_unit<2, 8>(QI, KI, VI, br, sinkp, rpb, 2, 2 * x + (w >> 5), (w >> 4) & 1, w & 15, false, lds, qctr, qw); }
            else { fa::attn_unit<1, 8>(QI, KI, VI, br, sinkp, rpb, 1, 2 * x + (w >> 5), (w >> 4) & 1, w & 15, false, lds, qctr, qw); }
            have = true;
        } else if (idx < 224) {
            const int w = idx - 200; const int mixer = w >> 3, rest = w & 7;
            fa::attn_unit<0, 8>(QI, KI, VI, br, sinkp, rpb, mixer, 2 * x + (rest >> 2), (rest >> 1) & 1, rest & 1, true, lds, qctr, qw); have = true;
        } else {
            SchedOne S; S.u.pm = 0; S.u.pn = 2 * x + (idx - 224); S.u.nt = 8; S.u.aux = 0;
            S.u.A = (const char*)(p.ws + WS_DFTC); S.u.B = (const char*)(p.ws + WS_ZTC) + (size_t)S.u.pn * 256 * 512 * 2;
            EpiDft E{br, TL, 256, 0.0625f};
            fg::gemm_phase<EpiDft, SchedOne, 512>(lds, S, E);
        }
    }
    __syncthreads();
}

#define XB_TMO      128
#define XB_XCNT(j)  (256  + 64 * (j))
#define XB_XSUB(j)  (1280 + 64 * (j))
#define XB_XGEN(j)  (2304 + 64 * (j))
#define XB_TOP      3328
#define XB_TOPGEN   3392
#define XB_SPIN_CAP (1u << 22)
__device__ __forceinline__ unsigned xb_ld(unsigned* p)              { return __hip_atomic_load(p, __ATOMIC_RELAXED, __HIP_MEMORY_SCOPE_AGENT); }
__device__ __forceinline__ unsigned xb_add(unsigned* p, unsigned v) { return __hip_atomic_fetch_add(p, v, __ATOMIC_RELAXED, __HIP_MEMORY_SCOPE_AGENT); }
__device__ __forceinline__ unsigned xb_xcc_id() { return (unsigned)__builtin_amdgcn_s_getreg((3 << 11) | 20) & 0xFu; }
#define XB_SPIN(cond, bar) do { unsigned _sp = 0; while (cond) { __builtin_amdgcn_s_sleep(1); \
    if ((++_sp & 255u) == 0u) { if (xb_ld(&(bar)[XB_TMO])) break; if (_sp > XB_SPIN_CAP) { atomicAdd(&(bar)[XB_TMO], 1u); break; } } } } while (0)
struct XcdBarrier { unsigned* bar; unsigned x; volatile FG_LAS unsigned* st; };
__device__ __forceinline__ XcdBarrier xcd_barrier_post(unsigned* bar, volatile FG_LAS unsigned* st) {
    XcdBarrier b; b.bar = bar; b.x = xb_xcc_id(); b.st = st;
    if (threadIdx.x == 0) (void)xb_add(&bar[XB_XCNT(b.x)], 1u);
    return b;
}
__device__ __forceinline__ void xcd_barrier_complete(unsigned* bar, unsigned x, unsigned& nloc, unsigned& nx) {
    const unsigned G = gridDim.x * gridDim.y * gridDim.z;
    unsigned sum, cnt, mine, sp = 0u;
    for (;;) {
        sum = 0u; cnt = 0u; mine = 0u;
#pragma unroll
        for (unsigned j = 0; j < 16; ++j) { const unsigned c = xb_ld(&bar[XB_XCNT(j)]); sum += c; cnt += (c > 0u) ? 1u : 0u; mine = (j == x) ? c : mine; }
        if (sum == G) break;
        __builtin_amdgcn_s_sleep(1);
        if ((++sp & 255u) == 0u) { if (xb_ld(&bar[XB_TMO])) break; if (sp > XB_SPIN_CAP) { atomicAdd(&bar[XB_TMO], 1u); break; } }
    }
    nloc = mine > 0u ? mine : 1u; nx = cnt > 0u ? cnt : 1u;
}
__device__ __forceinline__ void xcd_barrier(const XcdBarrier& b) {
    asm volatile("s_waitcnt vmcnt(0)" ::: "memory");
    unsigned* bar = b.bar; unsigned bx = __builtin_amdgcn_readfirstlane(b.x); asm volatile("" : "+s"(bar), "+s"(bx));
    __syncthreads();
    if (tidx() == 0) {
        __builtin_amdgcn_s_waitcnt(0);
        unsigned nloc = b.st[0], nx = b.st[1];
        if (nloc == 0u) { xcd_barrier_complete(bar, bx, nloc, nx); b.st[0] = nloc; b.st[1] = nx; }
        const unsigned old = xb_add(&bar[XB_XSUB(bx)], 1u);
        const unsigned gen = old / nloc;
        if (old + 1u == (gen + 1u) * nloc) {
            __builtin_amdgcn_fence(__ATOMIC_RELEASE, "agent");
            asm volatile("s_waitcnt vmcnt(0)" ::: "memory");
            const unsigned og = xb_add(&bar[XB_TOP], 1u);
            const unsigned tg = og / nx;
            if (og + 1u == (tg + 1u) * nx) xb_add(&bar[XB_TOPGEN], 1u);
            else XB_SPIN(xb_ld(&bar[XB_TOPGEN]) == tg, bar);
            __builtin_amdgcn_fence(__ATOMIC_ACQUIRE, "agent");
            xb_add(&bar[XB_XGEN(bx)], 1u);
            asm volatile("s_waitcnt vmcnt(0)" ::: "memory");
        } else {
            XB_SPIN(xb_ld(&bar[XB_XGEN(bx)]) == gen, bar);
            __builtin_amdgcn_fence(__ATOMIC_ACQUIRE, "agent");
            asm volatile("s_waitcnt vmcnt(0)" ::: "memory");
        }
    }
    __syncthreads();
}

__device__ __forceinline__ void xcd_barrier_arrive(const XcdBarrier& b) {
    asm volatile("s_waitcnt vmcnt(0)" ::: "memory");
    unsigned* bar = b.bar; unsigned bx = __builtin_amdgcn_readfirstlane(b.x); asm volatile("" : "+s"(bar), "+s"(bx));
    __syncthreads();
    if (tidx() == 0) {
        __builtin_amdgcn_s_waitcnt(0);
        unsigned nloc = b.st[0], nx = b.st[1];
        if (nloc == 0u) { xcd_barrier_complete(bar, bx, nloc, nx); b.st[0] = nloc; b.st[1] = nx; }
        const unsigned old = xb_add(&bar[XB_XSUB(bx)], 1u);
        const unsigned gen = old / nloc;
        unsigned mode = 0u, tg = 0u;
        if (old + 1u == (gen + 1u) * nloc) {
            __builtin_amdgcn_fence(__ATOMIC_RELEASE, "agent");
            asm volatile("s_waitcnt vmcnt(0)" ::: "memory");
            const unsigned og = xb_add(&bar[XB_TOP], 1u);
            tg = og / nx; mode = 1u;
            if (og + 1u == (tg + 1u) * nx) { xb_add(&bar[XB_TOPGEN], 1u); mode = 2u; }
            xb_add(&bar[XB_XGEN(bx)], 1u);
        }
        b.st[2] = mode; b.st[3] = gen; b.st[4] = tg;
    }
    __syncthreads();
}
__device__ __forceinline__ void xcd_barrier_wait(const XcdBarrier& b) {
    unsigned* bar = b.bar; unsigned bx = __builtin_amdgcn_readfirstlane(b.x); asm volatile("" : "+s"(bar), "+s"(bx));
    __syncthreads();
    if (tidx() == 0) {
        const unsigned mode = b.st[2], gen = b.st[3];
        if (mode != 2u) XB_SPIN(xb_ld(&bar[XB_TOPGEN]) == gen, bar);
        __builtin_amdgcn_fence(__ATOMIC_ACQUIRE, "agent");
        asm volatile("s_waitcnt vmcnt(0)" ::: "memory");
    }
    __syncthreads();
}

__global__ void __launch_bounds__(NTHREADS) mk_fwd(Params p_in) {
    extern __shared__ __attribute__((aligned(16))) unsigned char lds_raw[];
    float* lds = (float*)lds_raw; ldsp_t ldsf = (ldsp_t)lds_raw;
    cg::grid_group grid = cg::this_grid();
    volatile FG_LAS unsigned* misc = (volatile FG_LAS unsigned*)(ldsf + LDS_BYTES - 256);
    if (threadIdx.x < 32) misc[threadIdx.x] = (threadIdx.x == 16) ? blockIdx.x : 0u;
    __syncthreads();
    XcdBarrier xbar = xcd_barrier_post((unsigned*)(ldp().ws + WS_CTL) + 4096, misc + 8);
#define GSYNC() do { xcd_barrier_arrive(xbar); xcd_barrier_wait(xbar); } while (0)
    unsigned* cen = (unsigned*)(ldp().ws + WS_CTL) + 2048;
    if (threadIdx.x == 0) misc[17] = __hip_atomic_fetch_add(cen + 64 * xb_xcc_id(), 1u, __ATOMIC_RELAXED, __HIP_MEMORY_SCOPE_AGENT);
    for (int r_ = 0; r_ < RP_P0; ++r_) phase0(ldp(), lds);
    dense_transposes(ldp(), lds);
    if (ldp().ws == nullptr) grid.sync();
    GSYNC();
    if (threadIdx.x == 0) { bool ok = (gridDim.x == 256);
        for (int j = 0; j < 16; ++j) { const unsigned cj = __hip_atomic_load(cen + 64 * j, __ATOMIC_RELAXED, __HIP_MEMORY_SCOPE_AGENT); ok = ok && (cj == (j < 8 ? 32u : 0u)); }
        if (ok) misc[16] = misc[17] * 8u + xb_xcc_id(); }
    __syncthreads();
    phase_convert_dense(ldp(), lds, ldsf);
    phase_wg(ldp());
    for (int r_ = 0; r_ < RP_U; ++r_) phase_u(ldp(), 0);
    GSYNC();
    for (int l = 0; l < DEPTH; ++l) {
        for (int r_ = 0; r_ < RP_G1; ++r_) phase_g1_fast(ldp(), l, ldsf);
        xcd_barrier_arrive(xbar);
        if (l == 0 ? ((bidx() & 7) >= 4) : (bidx() >= 48)) bg_convert(ldp(), l, lds, l == 0 ? 1 : BG_G1, true);
        xcd_barrier_wait(xbar);
        for (int r_ = 0; r_ < RP_ATT; ++r_) phase_mixers(ldp(), l, ldsf, r_);
        xcd_barrier_arrive(xbar);
        phase_merge_fast(ldp(), l, ldsf, 0, 1);
        xcd_barrier_wait(xbar);
        phase_merge_fast(ldp(), l, ldsf, 1, 18);
        GSYNC();
        if (l == 0) { phase_merge_sum(ldp()); xcd_barrier_arrive(xbar); }
        phase_out_fast(ldp(), l, ldsf, 0, 2);
        if (l == 0) {
            if ((bidx() & 7) >= 2) bg_convert(ldp(), 0, lds, BG_OUT, true);
            xcd_barrier_wait(xbar);
            phase_out_fast(ldp(), l, ldsf, 2, 3); }
        xcd_barrier_arrive(xbar);
        phase_ln1_fill(ldp(), l, lds);
        xcd_barrier_wait(xbar);
        phase_ln1(ldp(), l, lds);
        GSYNC();
        for (int r_ = 0; r_ < RP_TOPK; ++r_) phase_topk(ldp(), l, lds);
        xcd_barrier_arrive(xbar);
        bg_convert(ldp(), l, lds, 1 << 20);
        xcd_barrier_wait(xbar);
        for (int r_ = 0; r_ < RP_UP; ++r_) phase_up_fast(ldp(), l, ldsf);
        GSYNC();
        for (int r_ = 0; r_ < RP_DN; ++r_) phase_down_fast(ldp(), l, ldsf);
        if (l == 0 && (bidx() & 7) >= 4) bg_convert(ldp(), 1, lds, BG_DN, true);
        GSYNC();
        for (int r_ = 0; r_ < (l == 1 ? RP_LN2 : 1); ++r_) phase_ln2(ldp(), l, lds);
        if (l == 0) GSYNC();
    }
}

extern "C" void kernel_launch(void* const* d_in, const int* in_sizes, int n_in, void* d_out, int out_size, void* d_ws, size_t ws_size, hipStream_t stream) {
    static int grid = 0;
    if (grid == 0) {
        if (n_in != 20 || ws_size < WS_END) { fprintf(stderr, "kernel_launch: unexpected n_in %d or ws_size %zu (need %zu)\n", n_in, ws_size, (size_t)WS_END); grid = -1; return; }
        int dev = 0, cus = 0, per_cu = 0;
        hipGetDevice(&dev); hipDeviceGetAttribute(&cus, hipDeviceAttributeMultiprocessorCount, dev);
        hipFuncSetAttribute((const void*)mk_fwd, hipFuncAttributeMaxDynamicSharedMemorySize, LDS_BYTES);
        hipOccupancyMaxActiveBlocksPerMultiprocessor(&per_cu, (const void*)mk_fwd, NTHREADS, LDS_BYTES);
        if (per_cu < 1) { fprintf(stderr, "kernel_launch: occupancy query says %d blocks per CU\n", per_cu); per_cu = 1; }
        (void)hipGetLastError();
        if (cus * per_cu < 256) { fprintf(stderr, "kernel_launch: needs 256 co-resident workgroups, device offers %d x %d\n", cus, per_cu); grid = -1; return; }
        grid = 256;
    }
    if (grid < 0) return;
    hipMemsetAsync((char*)d_ws + WS_CTL, 0, 64 * 1024, stream);
    Params p{};
    const float** pp = (const float**)&p;
    for (int i = 0; i < 20; ++i) pp[i] = (const float*)d_in[i];
    p.out = (float*)d_out; p.ws = (unsigned char*)d_ws;
    void* args[] = {&p};
    hipError_t e = hipLaunchCooperativeKernel((const void*)mk_fwd, dim3(grid), dim3(NTHREADS), args, LDS_BYTES, stream);
    if (e != hipSuccess) fprintf(stderr, "cooperative launch failed: %s (grid %d)\n", hipGetErrorString(e), grid);
}
```
